# Optimizing an MI355X kernel written in HIP

```python
import math
import jax, jax.numpy as jnp
from jax import lax
import numpy as np

D_MODEL = 1024
BATCH = 8
SEQ = 4096
DEPTH = 2

HEAD_DIM = 128
N_A_LAYERS = DEPTH // 2
N_B_LAYERS = DEPTH - N_A_LAYERS
MAIN_WIDTH = D_MODEL
POOL_WINDOWS = (2, 4, 8, 16)
POOL_GROUP = MAIN_WIDTH // len(POOL_WINDOWS)
MOBA_HEADS = MAIN_WIDTH // HEAD_DIM
MOBA_BLOCK = 256
MOBA_TOPK = 3
MOBA_CHUNK = 8
MEM_TOKENS = 256
MEM_HEADS = 4
MEM_WIDTH = MEM_HEADS * HEAD_DIM
MIX_WIDTH = MAIN_WIDTH + MEM_WIDTH
ROPE_THETA = 10000.0
PEER_HEADS = 8
PEER_NKEYS = 128
PEER_EXPERTS = PEER_NKEYS * PEER_NKEYS
PEER_TOPK = 16
PEER_QDIM = 256
PEER_HALF = PEER_QDIM // 2
PEER_CHUNK = 128
RMS_EPS = 1e-6
NEG = -1e30

kernel_name = "yoco_pool_moba_peer_hybrid"


def rmsnorm(x, g):
    xf = x.astype(jnp.float32)
    y = xf * lax.rsqrt(jnp.mean(xf * xf, axis=-1, keepdims=True) + RMS_EPS)
    return (y * g.astype(jnp.float32)).astype(x.dtype)


def rope_tables(S):
    inv = 1.0 / (ROPE_THETA ** (jnp.arange(0, HEAD_DIM, 2, dtype=jnp.float32) / HEAD_DIM))
    ang = jnp.arange(S, dtype=jnp.float32)[:, None] * inv[None, :]
    return jnp.cos(ang), jnp.sin(ang)


def apply_rope(x, cos, sin):
    xf = x.astype(jnp.float32)
    x1, x2 = xf[..., : HEAD_DIM // 2], xf[..., HEAD_DIM // 2:]
    return jnp.concatenate([x1 * cos - x2 * sin, x2 * cos + x1 * sin], axis=-1).astype(x.dtype)


def pool_mixer(main, pool_w, pool_scale):
    B, S, _ = main.shape
    t = jnp.arange(S)
    outs = []
    for g, w in enumerate(POOL_WINDOWS):
        xg = main[..., g * POOL_GROUP:(g + 1) * POOL_GROUP].astype(jnp.float32)
        c = lax.cumsum(xg, axis=1)
        lag = jnp.pad(c, ((0, 0), (w, 0), (0, 0)))[:, :S]
        cnt = jnp.minimum(t + 1, w).astype(jnp.float32)[None, :, None]
        d = ((c - lag) / cnt - xg).astype(main.dtype)
        outs.append(jnp.einsum('bsc,ce->bse', d, pool_w[g]))
    return jnp.concatenate(outs, axis=-1) * pool_scale


def memory_attention(qm, mem, w_mem_kv):
    B, S, _ = qm.shape
    M = mem.shape[1]
    kv = mem @ w_mem_kv
    k = kv[..., :MEM_WIDTH].reshape(B, M, MEM_HEADS, HEAD_DIM)
    v = kv[..., MEM_WIDTH:].reshape(B, M, MEM_HEADS, HEAD_DIM)
    q = qm.reshape(B, S, MEM_HEADS, HEAD_DIM)
    logits = jnp.einsum('bshd,bmhd->bhsm', q, k).astype(jnp.float32) * (HEAD_DIM ** -0.5)
    p = jax.nn.softmax(logits, axis=-1).astype(v.dtype)
    return jnp.einsum('bhsm,bmhd->bshd', p, v).reshape(B, S, MEM_WIDTH)


def shared_kv(x, kv_norm_g, w_kv_shared, cos, sin):
    B, S, _ = x.shape
    h = rmsnorm(x, kv_norm_g)
    kv = h @ w_kv_shared
    k = kv[..., :MAIN_WIDTH].reshape(B, S, MOBA_HEADS, HEAD_DIM).transpose(0, 2, 1, 3)
    v = kv[..., MAIN_WIDTH:].reshape(B, S, MOBA_HEADS, HEAD_DIM).transpose(0, 2, 1, 3)
    k = apply_rope(k, cos, sin)
    nb = -(-S // MOBA_BLOCK)
    pad = nb * MOBA_BLOCK - S
    k = jnp.pad(k, ((0, 0), (0, 0), (0, pad), (0, 0))).reshape(B, MOBA_HEADS, nb, MOBA_BLOCK, HEAD_DIM)
    v = jnp.pad(v, ((0, 0), (0, 0), (0, pad), (0, 0))).reshape(B, MOBA_HEADS, nb, MOBA_BLOCK, HEAD_DIM)
    kmean = jnp.mean(k.astype(jnp.float32), axis=3)
    return k, v, kmean


def moba_attention(qmain, k_blocks, v_blocks, kmean, cos, sin):
    B, S, _ = qmain.shape
    H, hd, BLK = MOBA_HEADS, HEAD_DIM, MOBA_BLOCK
    nb = k_blocks.shape[2]
    topk = min(MOBA_TOPK, nb)
    q = apply_rope(qmain.reshape(B, S, H, hd).transpose(0, 2, 1, 3), cos, sin)
    t = jnp.arange(S)
    own = t // BLK
    gate = jnp.einsum('bhsd,bhnd->bhsn', q.astype(jnp.float32), kmean)
    past = jnp.arange(nb)[None, :] < own[:, None]
    gate = jnp.where(past, gate, NEG)
    _, sel = lax.top_k(gate, topk)
    valid = sel < own[:, None]
    nc = S // MOBA_CHUNK

    def to_chunks(a):
        a = a.reshape(a.shape[:2] + (nc, MOBA_CHUNK) + a.shape[3:])
        return jnp.moveaxis(a, 2, 0)

    scale = hd ** -0.5
    bi = jnp.arange(B)[:, None, None, None]
    hi = jnp.arange(H)[None, :, None, None]
    kpos_local = jnp.arange(BLK)

    def attend(args):
        q_c, sel_c, valid_c, pos_c = args
        kg = k_blocks[bi, hi, sel_c]
        vg = v_blocks[bi, hi, sel_c]
        blk = pos_c[0] // BLK
        k_own = lax.dynamic_index_in_dim(k_blocks, blk, axis=2, keepdims=False)
        v_own = lax.dynamic_index_in_dim(v_blocks, blk, axis=2, keepdims=False)
        s_sel = jnp.einsum('bhcd,bhcnkd->bhcnk', q_c, kg).astype(jnp.float32) * scale
        s_sel = jnp.where(valid_c[..., None], s_sel, NEG).reshape(B, H, MOBA_CHUNK, topk * BLK)
        s_own = jnp.einsum('bhcd,bhkd->bhck', q_c, k_own).astype(jnp.float32) * scale
        kpos = blk * BLK + kpos_local
        s_own = jnp.where(kpos[None, :] <= pos_c[:, None], s_own, NEG)
        p = jax.nn.softmax(jnp.concatenate([s_sel, s_own], axis=-1), axis=-1).astype(v_blocks.dtype)
        p_sel = p[..., : topk * BLK].reshape(B, H, MOBA_CHUNK, topk, BLK)
        p_own = p[..., topk * BLK:]
        return (jnp.einsum('bhcnk,bhcnkd->bhcd', p_sel, vg)
                + jnp.einsum('bhck,bhkd->bhcd', p_own, v_own))

    out = lax.map(attend, (to_chunks(q), to_chunks(sel), to_chunks(valid), t.reshape(nc, MOBA_CHUNK)))
    out = jnp.moveaxis(out, 0, 2).reshape(B, H, S, hd)
    return out.transpose(0, 2, 1, 3).reshape(B, S, H * hd)


def peer_ffn(h, wq, subkeys, u, v):
    B, S, D = h.shape
    T = B * S
    ht = h.reshape(T, D)
    q = (ht @ wq).reshape(T, PEER_HEADS, 2, PEER_HALF).astype(jnp.float32)
    s = jnp.einsum('thpd,hpnd->thpn', q, subkeys.astype(jnp.float32))
    sv, si = lax.top_k(s, PEER_TOPK)
    cand = (sv[:, :, 0, :, None] + sv[:, :, 1, None, :]).reshape(T, PEER_HEADS, PEER_TOPK * PEER_TOPK)
    cv, ci = lax.top_k(cand, PEER_TOPK)
    e1 = jnp.take_along_axis(si[:, :, 0], ci // PEER_TOPK, axis=-1)
    e2 = jnp.take_along_axis(si[:, :, 1], ci % PEER_TOPK, axis=-1)
    experts = e1 * PEER_NKEYS + e2
    gates = jax.nn.softmax(cv, axis=-1)
    nc = T // PEER_CHUNK
    E = PEER_HEADS * PEER_TOPK

    def expert_chunk(args):
        xc, ec, gc = args
        a = jnp.einsum('cd,ced->ce', xc, u[ec]).astype(jnp.float32)
        hh = (jax.nn.gelu(a, approximate=False) * gc).astype(v.dtype)
        return jnp.einsum('ce,ced->cd', hh, v[ec])

    out = lax.map(expert_chunk, (ht.reshape(nc, PEER_CHUNK, D),
                                 experts.reshape(nc, PEER_CHUNK, E),
                                 gates.reshape(nc, PEER_CHUNK, E)))
    return out.reshape(B, S, D)


def setup_inputs(seed: int = 0) -> dict:
    key = jax.random.key(seed)
    ks = jax.random.split(key, 20)
    f32 = jnp.float32
    D = D_MODEL

    def nrm(k, shape, scale):
        return jax.random.normal(k, shape, f32) * scale

    return {
        "x": nrm(ks[0], (BATCH, SEQ, D), 1.0),
        "mem": nrm(ks[1], (BATCH, MEM_TOKENS, D), 1.0),
        "norm_mix_g": 1.0 + nrm(ks[2], (DEPTH, D), 0.05),
        "w_in": nrm(ks[3], (DEPTH, D, MIX_WIDTH), D ** -0.5),
        "w_out": nrm(ks[4], (DEPTH, MIX_WIDTH, D), MIX_WIDTH ** -0.5),
        "w_mem_kv": nrm(ks[5], (DEPTH, D, 2 * MEM_WIDTH), D ** -0.5),
        "pool_w": nrm(ks[6], (N_A_LAYERS, len(POOL_WINDOWS), POOL_GROUP, POOL_GROUP), POOL_GROUP ** -0.5),
        "pool_scale": 1.0 + nrm(ks[7], (N_A_LAYERS, MAIN_WIDTH), 0.05),
        "kv_norm_g": 1.0 + nrm(ks[8], (D,), 0.05),
        "w_kv_shared": nrm(ks[9], (D, 2 * MAIN_WIDTH), D ** -0.5),
        "norm_ffn_g": 1.0 + nrm(ks[10], (DEPTH, D), 0.05),
        "peer_wq": nrm(ks[11], (DEPTH, D, PEER_HEADS * PEER_QDIM), D ** -0.5),
        "peer_subkeys": nrm(ks[12], (DEPTH, PEER_HEADS, 2, PEER_NKEYS, PEER_HALF), PEER_HALF ** -0.5),
        "peer_u": nrm(ks[13], (DEPTH, PEER_EXPERTS, D), D ** -0.5),
        "peer_v": nrm(ks[14], (DEPTH, PEER_EXPERTS, D), PEER_HEADS ** -0.5),
        "final_norm_g": 1.0 + nrm(ks[15], (D,), 0.05),
    }


def reference(x, mem, norm_mix_g, w_in, w_out, w_mem_kv, pool_w, pool_scale, kv_norm_g,
              w_kv_shared, norm_ffn_g, peer_wq, peer_subkeys, peer_u, peer_v, final_norm_g):
    S = x.shape[1]
    cos, sin = rope_tables(S)
    shared = None
    for l in range(DEPTH):
        h = rmsnorm(x, norm_mix_g[l])
        proj = h @ w_in[l]
        main, qm = proj[..., :MAIN_WIDTH], proj[..., MAIN_WIDTH:]
        if l < N_A_LAYERS:
            mixed = pool_mixer(main, pool_w[l], pool_scale[l])
        else:
            k_blocks, v_blocks, kmean = shared
            mixed = moba_attention(main, k_blocks, v_blocks, kmean, cos, sin)
        mem_out = memory_attention(qm, mem, w_mem_kv[l])
        x = x + jnp.concatenate([mixed, mem_out], axis=-1) @ w_out[l]
        x = x + peer_ffn(rmsnorm(x, norm_ffn_g[l]), peer_wq[l], peer_subkeys[l], peer_u[l], peer_v[l])
        if l == N_A_LAYERS - 1:
            shared = shared_kv(x, kv_norm_g, w_kv_shared, cos, sin)
    return rmsnorm(x, final_norm_g)
```

```cpp
#include <hip/hip_runtime.h>
#include <hip/hip_cooperative_groups.h>
#include <cstdio>
#include <cstdint>
namespace cg = cooperative_groups;

#ifndef MK_LAUNCHES
#define MK_LAUNCHES 1
#endif

#define GAS __attribute__((address_space(1)))
#define LAS __attribute__((address_space(3)))
typedef unsigned short bf16;
typedef unsigned u32x4 __attribute__((ext_vector_type(4)));
typedef unsigned u32x2 __attribute__((ext_vector_type(2)));
typedef float f32x4 __attribute__((ext_vector_type(4)));
typedef float f32x2 __attribute__((ext_vector_type(2)));
typedef float f32x16 __attribute__((ext_vector_type(16)));
typedef short bf16x8 __attribute__((ext_vector_type(8)));
typedef short s16x4 __attribute__((ext_vector_type(4)));
typedef __bf16 bf16x2_t __attribute__((ext_vector_type(2)));

constexpr int NB = 8, SEQ = 4096, DM = 1024, T = NB * SEQ, MIXW = 1536, MEMT = 256;
constexpr int NEXP = 16384, NWAVES = 8, NTHR = 512;
constexpr float EPS = 1e-6f;

constexpr size_t MiB = 1u << 20;
constexpr size_t WS_RSTD0 = 1 * MiB;
constexpr size_t WS_RSTD2 = WS_RSTD0 + 128 * 1024;
constexpr size_t WS_USC   = WS_RSTD0 + 256 * 1024;
constexpr size_t WS_VSC   = WS_RSTD0 + 384 * 1024;
constexpr size_t WS_SSQ   = 2 * MiB;
constexpr size_t WS_KMP   = 4 * MiB;
constexpr size_t WS_ROPE  = 5 * MiB;
constexpr size_t WS_WIN0  = 8 * MiB;
constexpr size_t WS_WC4   = 11 * MiB;
constexpr size_t WS_WC0   = 18 * MiB;
constexpr size_t WS_WOUT1 = 21 * MiB;
constexpr size_t WS_WMKV  = 24 * MiB;
constexpr size_t WS_WQ0   = 28 * MiB;
constexpr size_t WS_WQ1   = 32 * MiB;
constexpr size_t WS_SUBK  = 36 * MiB;
constexpr size_t WS_MEMB  = 37 * MiB;
constexpr size_t WS_MEMKV = 41 * MiB;
constexpr size_t WS_EXP   = 49 * MiB;
constexpr size_t WS_GATE  = 57 * MiB;
constexpr size_t WS_UB    = 73 * MiB;
constexpr size_t WS_VB    = 105 * MiB;
constexpr size_t WS_XB    = 201 * MiB;
constexpr size_t WS_RB    = 265 * MiB;
constexpr size_t WS_P0MAIN = WS_RB;
constexpr size_t WS_A2    = WS_RB + 64 * MiB;
constexpr size_t WS_PQ    = WS_RB;
constexpr size_t WS_KR    = WS_RB;
constexpr size_t WS_VV    = WS_RB + 64 * MiB;
constexpr size_t WS_A3    = WS_RB + 128 * MiB;
constexpr size_t WS_END   = WS_RB + 224 * MiB;

constexpr int LDS_BYTES = 147456;

__device__ __forceinline__ unsigned f2bf(float f) { unsigned u = __builtin_bit_cast(unsigned, f); return (u + 0x7fffu + ((u >> 16) & 1u)) >> 16; }
__device__ __forceinline__ unsigned pk2(float lo, float hi) { return f2bf(lo) | (f2bf(hi) << 16); }
__device__ __forceinline__ unsigned cvtpk(float lo, float hi) { unsigned r; asm volatile("v_cvt_pk_bf16_f32 %0, %1, %2" : "=v"(r) : "v"(lo), "v"(hi)); return r; }
__device__ __forceinline__ float bflo(unsigned w) { return __builtin_bit_cast(float, w << 16); }
__device__ __forceinline__ float bfhi(unsigned w) { return __builtin_bit_cast(float, w & 0xffff0000u); }
template <int J> __device__ __forceinline__ unsigned shx_u(unsigned v) {
    if constexpr (J == 32) { auto rr = __builtin_amdgcn_permlane32_swap(v, v, false, false); return ((threadIdx.x & 32) ? rr[0] : rr[1]); }
    else return (unsigned)__builtin_amdgcn_ds_swizzle((int)v, (J << 10) | 0x1f);
}
template <int J> __device__ __forceinline__ float shx_f(float v) { return __uint_as_float(shx_u<J>(__float_as_uint(v))); }
template <int CTRL> __device__ __forceinline__ float dpp_f(float v) { return __uint_as_float((unsigned)__builtin_amdgcn_update_dpp(0, (int)__float_as_uint(v), CTRL, 0xF, 0xF, false)); }
__device__ __forceinline__ float wave_sum(float v) {
    v += dpp_f<0xB1>(v); v += dpp_f<0x4E>(v); v += dpp_f<0x141>(v); v += dpp_f<0x128>(v);
    v += shx_f<16>(v);
    { auto rr = __builtin_amdgcn_permlane32_swap(__float_as_uint(v), __float_as_uint(v), false, false); v = __uint_as_float(rr[0]) + __uint_as_float(rr[1]); }
    return v;
}
__device__ __forceinline__ float dot2(unsigned w, unsigned x, float acc) { return __builtin_amdgcn_fdot2_f32_bf16(__builtin_bit_cast(bf16x2_t, w), __builtin_bit_cast(bf16x2_t, x), acc, false); }
#define LDS_WAIT() asm volatile("s_waitcnt lgkmcnt(0)" ::: "memory")
#define VM_WAIT() asm volatile("s_waitcnt vmcnt(0)" ::: "memory")

namespace pg8 {
#define PG8_LAS __attribute__((address_space(3)))
typedef unsigned short bf16_t;
constexpr int BM = 256, BK = 64, HALF = 128, HTB = HALF * BK * 2, STAGE_BYTES = 8 * HTB, NXCD = 8, WGM = 8;
__host__ __device__ __forceinline__ int lds_byte(int r, int c) { const int st = (r >> 4) * 2 + (c >> 5), rr = r & 15, cc = c & 31, ob = rr * 64 + cc * 2; return st * 1024 + (ob ^ (((ob >> 9) & 1) << 5)); }
__host__ __device__ __forceinline__ void stage_rc(int b, int& R, int& C) { const int st = b / 1024, sb = b % 1024, swz = sb ^ (((sb >> 9) & 1) << 5); R = (st >> 1) * 16 + swz / 64; C = (st & 1) * 32 + (swz % 64) / 2; }
__host__ __device__ __forceinline__ int perm32(int rho) { const int n = rho >> 4, i = rho & 15; return 8 * (i >> 2) + 4 * n + (i & 3); }
struct Unit { int pm, pn; };
struct Gemm { const bf16_t* A; const bf16_t* Bt; int M, N, K; };
struct StaticOrder {
    int nM, nN, nwg, G, c;
    __host__ __device__ void init(int M, int N, int G_, int c_) { nM = M / BM; nN = N / BM; nwg = nM * nN; G = G_; c = c_; }
    __host__ __device__ bool next(int i, Unit& u) const {
        const long L = (long)i * G + c; if (L >= nwg) return false;
        int wgid = (int)L; { const int q = nwg / NXCD, r = nwg % NXCD, xcd = wgid % NXCD, off = wgid / NXCD; wgid = (xcd < r ? xcd * (q + 1) : r * (q + 1) + (xcd - r) * q) + off; }
        const int nig = WGM * nN, gid = wgid / nig, fm = gid * WGM, gsz = (nM - fm) < WGM ? (nM - fm) : WGM;
        u.pm = fm + ((wgid % nig) % gsz); u.pn = (wgid % nig) / gsz; return true;
    }
    __device__ __forceinline__ void a_ready(const Unit&) const {}
    __device__ __forceinline__ void done(const Unit&) const {}
};

struct EpiRowBf16 {
    static constexpr bool PERM = true, AFTER_DRAIN = false;
    bf16_t* O0; int ld0; bf16_t* O1; int ld1; int split; const float* rs; const float* ssq;
    __device__ __forceinline__ void operator()(const f32x4 (&acc)[2][2][4][2], const Unit& u, int wr, int wc, int fr, int fq) const {
        const int row0 = u.pm * BM + wr * 64 + fr; int colt = u.pn * BM; bf16_t* base = O0; int ldc = ld0;
        if (colt >= split) { base = O1; ldc = ld1; colt -= split; }
        const int col0 = colt + wc * 32 + 8 * fq;
#pragma unroll
        for (int ai = 0; ai < 2; ++ai)
#pragma unroll
            for (int m = 0; m < 4; ++m) { const int row = row0 + ai * HALF + m * 16; float sc = 1.f;
                if (rs) sc = rs[row];
                else if (ssq) { const f32x4* q = (const f32x4*)(ssq + (size_t)row * 16); const f32x4 a = q[0], b = q[1], c = q[2], d = q[3];
                    const float s = ((a[0] + a[1]) + (a[2] + a[3])) + ((b[0] + b[1]) + (b[2] + b[3])) + ((c[0] + c[1]) + (c[2] + c[3])) + ((d[0] + d[1]) + (d[2] + d[3]));
                    sc = __builtin_amdgcn_rsqf(s * (1.0f / 1024.0f) + EPS); }
                bf16_t* rowp = base + (size_t)row * ldc + col0;
#pragma unroll
                for (int bj = 0; bj < 2; ++bj) { const f32x4 v0 = acc[ai][bj][m][0] * sc, v1 = acc[ai][bj][m][1] * sc;
                    u32x4 w; w.x = cvtpk(v0[0], v0[1]); w.y = cvtpk(v0[2], v0[3]); w.z = cvtpk(v1[0], v1[1]); w.w = cvtpk(v1[2], v1[3]);
                    *(u32x4*)(rowp + bj * HALF) = w; } }
    }
};
struct EpiRes {
    static constexpr bool PERM = true, AFTER_DRAIN = false;
    bf16_t* xb; float* ssq;
    __device__ __forceinline__ void operator()(const f32x4 (&acc)[2][2][4][2], const Unit& u, int wr, int wc, int fr, int fq) const {
        const int row0 = u.pm * BM + wr * 64 + fr, col0 = u.pn * BM + wc * 32 + 8 * fq;
#pragma unroll
        for (int ai = 0; ai < 2; ++ai)
#pragma unroll
            for (int m = 0; m < 4; ++m) { const int row = row0 + ai * HALF + m * 16; bf16_t* p = xb + (size_t)row * DM + col0; float ss = 0.f;
#pragma unroll
                for (int bj = 0; bj < 2; ++bj) { const u32x4 r = *(const u32x4*)(p + bj * HALF); const f32x4 a0 = acc[ai][bj][m][0], a1 = acc[ai][bj][m][1];
                    const float o0 = bflo(r.x) + a0[0], o1 = bfhi(r.x) + a0[1], o2 = bflo(r.y) + a0[2], o3 = bfhi(r.y) + a0[3], o4 = bflo(r.z) + a1[0], o5 = bfhi(r.z) + a1[1], o6 = bflo(r.w) + a1[2], o7 = bfhi(r.w) + a1[3];
                    u32x4 w; w.x = cvtpk(o0, o1); w.y = cvtpk(o2, o3); w.z = cvtpk(o4, o5); w.w = cvtpk(o6, o7); *(u32x4*)(p + bj * HALF) = w;
                    ss += ((o0 * o0 + o1 * o1) + (o2 * o2 + o3 * o3)) + ((o4 * o4 + o5 * o5) + (o6 * o6 + o7 * o7)); }
                ss += __shfl_xor(ss, 16); ss += __shfl_xor(ss, 32);
                if (fq == 0) ssq[(size_t)row * 16 + u.pn * 4 + wc] = ss; }
    }
};
struct EpiKVQ {
    static constexpr bool PERM = true, AFTER_DRAIN = false;
    bf16_t* KR; bf16_t* VV; bf16_t* A3; float* KMP; const float* rs; const float* rope;
    __device__ __forceinline__ void operator()(const f32x4 (&acc)[2][2][4][2], const Unit& u, int wr, int wc, int fr, int fq) const {
        const int pn = u.pn, pm = u.pm, b = pm >> 4, s0 = (pm & 15) * 256, rl0 = wr * 64 + fr, g0 = 32 * wc + 8 * fq;
        float rsv[2][4];
#pragma unroll
        for (int ai = 0; ai < 2; ++ai)
#pragma unroll
            for (int m = 0; m < 4; ++m) rsv[ai][m] = rs[pm * BM + rl0 + ai * HALF + m * 16];
        if (pn < 4 || (pn >= 8 && pn < 12)) {
            const bool isK = pn < 4; const int hp = isK ? pn : pn - 8; const int i0 = 16 * wc + 4 * fq;
            f32x4 klo[2] = {{0.f, 0.f, 0.f, 0.f}, {0.f, 0.f, 0.f, 0.f}}, khi[2] = {{0.f, 0.f, 0.f, 0.f}, {0.f, 0.f, 0.f, 0.f}};
#pragma unroll
            for (int ai = 0; ai < 2; ++ai)
#pragma unroll
                for (int m = 0; m < 4; ++m) { const int rl = rl0 + ai * HALF + m * 16, s = s0 + rl;
                    const f32x4 cs0 = *(const f32x4*)(rope + ((size_t)s * 64 + i0) * 2), cs1 = *(const f32x4*)(rope + ((size_t)s * 64 + i0) * 2 + 4);
                    const f32x4 c = {cs0[0], cs0[2], cs1[0], cs1[2]}, sn = {cs0[1], cs0[3], cs1[1], cs1[3]};
#pragma unroll
                    for (int bj = 0; bj < 2; ++bj) { const int head = 2 * hp + bj;
                        const f32x4 v1 = acc[ai][bj][m][0] * rsv[ai][m], v2 = acc[ai][bj][m][1] * rsv[ai][m];
                        const f32x4 lo = v1 * c - v2 * sn, hi = v2 * c + v1 * sn;
                        u32x4 w; w.x = cvtpk(lo[0], lo[1]); w.y = cvtpk(lo[2], lo[3]); w.z = cvtpk(hi[0], hi[1]); w.w = cvtpk(hi[2], hi[3]);
                        bf16_t* dst = isK ? KR + ((size_t)(b * 8 + head) * SEQ + s) * 128 + g0 : A3 + (size_t)(pm * BM + rl) * MIXW + head * 128 + g0;
                        *(u32x4*)dst = w;
                        klo[bj] += lo; khi[bj] += hi; } }
            if (isK) {
#pragma unroll
                for (int bj = 0; bj < 2; ++bj) {
#pragma unroll
                    for (int j = 0; j < 4; ++j) {
#pragma unroll
                        for (int o = 1; o < 16; o <<= 1) { klo[bj][j] += __shfl_xor(klo[bj][j], o); khi[bj][j] += __shfl_xor(khi[bj][j], o); } }
                    if (fr == 0) { float* kp = KMP + ((size_t)pm * 2 + wr) * 1024 + (2 * hp + bj) * 128 + g0; *(f32x4*)kp = klo[bj]; *(f32x4*)(kp + 4) = khi[bj]; } } }
        } else {
            const bool isV = pn < 8;
#pragma unroll
            for (int bj = 0; bj < 2; ++bj)
#pragma unroll
                for (int ai = 0; ai < 2; ++ai)
#pragma unroll
                    for (int m = 0; m < 4; ++m) { const int rl = rl0 + ai * HALF + m * 16, s = s0 + rl;
                        const f32x4 v0 = acc[ai][bj][m][0] * rsv[ai][m], v1 = acc[ai][bj][m][1] * rsv[ai][m];
                        u32x4 w; w.x = cvtpk(v0[0], v0[1]); w.y = cvtpk(v0[2], v0[3]); w.z = cvtpk(v1[0], v1[1]); w.w = cvtpk(v1[2], v1[3]);
                        bf16_t* dst = isV ? VV + ((size_t)(b * 8 + 2 * (pn - 4) + bj) * SEQ + s) * 128 + g0 : A3 + (size_t)(pm * BM + rl) * MIXW + 1024 + (pn - 12) * 256 + bj * HALF + g0;
                        *(u32x4*)dst = w; }
        }
    }
};

template <class Epi, class Sched, bool ALIGN_EPI = true, bool SP2 = true>
__device__ __forceinline__ void gemm_phase(PG8_LAS unsigned char* lds, const Gemm g, const Sched& S, const Epi& E) {
    int tid = threadIdx.x; asm volatile("" : "+v"(tid));
    const int wid = __builtin_amdgcn_readfirstlane(tid >> 6), lane = tid & 63, wr = wid >> 2, wc = wid & 3, fr = lane & 15, fq = lane >> 4;
    const int K = g.K, nt = K / BK;
    unsigned voffA[2], voffB[2];
#pragma unroll
    for (int i = 0; i < 2; ++i) { int R, C; stage_rc(tid * 16 + i * 8192, R, C); const int Rb = Epi::PERM ? ((R & ~31) + perm32(R & 31)) : R;
        voffA[i] = (unsigned)(R * K + C) * 2u; voffB[i] = (unsigned)(Rb * K + C) * 2u; }
    const size_t kstep = (size_t)(BK * 2);
    const size_t hstep = (size_t)HALF * K * 2;
    const size_t tstep = 2 * hstep;
    const unsigned ldsw = (unsigned)wid * 1024u;
    const int aoff = lds_byte(wr * 64 + fr, fq * 8), boff = lds_byte(wc * 32 + fr, fq * 8);
#define PG8_SA(b, h) (((b) * 2 + (h)) * HTB)
#define PG8_SB(b, h) ((4 + (b) * 2 + (h)) * HTB)
#define PG8_STAGE(bufoff, gbase, voff) do { _Pragma("unroll") for (int _i = 0; _i < 2; ++_i) \
        __builtin_amdgcn_global_load_lds((const unsigned*)((const char*)(gbase) + (voff)[_i]), (PG8_LAS unsigned*)(lds + (bufoff) + ldsw + _i * 8192), 16, 0, 0); } while (0)
#define PG8_LDA(dst, b, h) do { _Pragma("unroll") for (int m = 0; m < 4; ++m) _Pragma("unroll") for (int k = 0; k < 2; ++k) dst[m][k] = *(const PG8_LAS bf16x8*)(lds + PG8_SA(b, h) + aoff + m * 2048 + k * 1024); } while (0)
#define PG8_LDB(dst, b, h) do { _Pragma("unroll") for (int n = 0; n < 2; ++n) _Pragma("unroll") for (int k = 0; k < 2; ++k) dst[n][k] = *(const PG8_LAS bf16x8*)(lds + PG8_SB(b, h) + boff + n * 2048 + k * 1024); } while (0)
#define PG8_MMA(ai, bj, At, Bt) do { __builtin_amdgcn_s_setprio(1); _Pragma("unroll") for (int m = 0; m < 4; ++m) _Pragma("unroll") for (int n = 0; n < 2; ++n) _Pragma("unroll") for (int k = 0; k < 2; ++k) \
        acc[ai][bj][m][n] = __builtin_amdgcn_mfma_f32_16x16x32_bf16(Bt[n][k], At[m][k], acc[ai][bj][m][n], 0, 0, 0); __builtin_amdgcn_s_setprio(0); } while (0)
#define PG8_WAIT_V(n) asm volatile("s_waitcnt vmcnt(" #n ")" ::: "memory")
#define PG8_WAIT_L(n) asm volatile("s_waitcnt lgkmcnt(" #n ")" ::: "memory")
#define PG8_BAR __builtin_amdgcn_s_barrier()
#define PG8_SCHED __builtin_amdgcn_sched_barrier(0)
    Unit cur, nxt; int ui = 0;
    if (!S.next(0, cur)) return;
    f32x4 acc[2][2][4][2];
#pragma unroll
    for (int a = 0; a < 2; ++a)
#pragma unroll
        for (int b = 0; b < 2; ++b)
#pragma unroll
            for (int m = 0; m < 4; ++m)
#pragma unroll
                for (int n = 0; n < 2; ++n) acc[a][b][m][n] = (f32x4){0.f, 0.f, 0.f, 0.f};
    bf16x8 At[4][2], B0[2][2], B1[2][2];
    const char* cA = (const char*)g.A + (size_t)cur.pm * tstep; const char* cB = (const char*)g.Bt + (size_t)cur.pn * tstep;
    S.a_ready(cur);
    if constexpr (SP2) {
        PG8_STAGE(PG8_SB(0, 0), cB, voffB); PG8_STAGE(PG8_SB(0, 1), cB + hstep, voffB); PG8_STAGE(PG8_SA(0, 0), cA, voffA); PG8_STAGE(PG8_SA(0, 1), cA + hstep, voffA);
        if (wr == 1) PG8_BAR;
        PG8_WAIT_V(2); PG8_BAR;
        PG8_STAGE(PG8_SB(1, 0), cB + kstep, voffB); PG8_STAGE(PG8_SA(1, 0), cA + kstep, voffA); PG8_STAGE(PG8_SB(1, 1), cB + hstep + kstep, voffB);
        PG8_WAIT_V(6); PG8_BAR;
    } else {
        PG8_STAGE(PG8_SB(0, 0), cB, voffB); PG8_STAGE(PG8_SA(0, 0), cA, voffA); PG8_STAGE(PG8_SB(0, 1), cB + hstep, voffB); PG8_STAGE(PG8_SA(0, 1), cA + hstep, voffA);
        if (wr == 1) PG8_BAR;
        PG8_WAIT_V(4); PG8_BAR;
        PG8_STAGE(PG8_SB(1, 0), cB + kstep, voffB); PG8_STAGE(PG8_SA(1, 0), cA + kstep, voffA); PG8_STAGE(PG8_SB(1, 1), cB + hstep + kstep, voffB);
        PG8_WAIT_V(6); PG8_BAR;
    }
    for (;;) {
        const bool has_next = S.next(ui + 1, nxt);
        const char* nA = has_next ? (const char*)g.A + (size_t)nxt.pm * tstep : cA; const char* nB = has_next ? (const char*)g.Bt + (size_t)nxt.pn * tstep : cB;
        for (int t = 0; t < nt; t += 2) {
            const bool last = (t == nt - 2);
            const char* a1 = cA + (size_t)(t + 1) * kstep;
            const char* a2 = last ? nA : cA + (size_t)(t + 2) * kstep; const char* b2 = last ? nB : cB + (size_t)(t + 2) * kstep;
            const char* a3 = a2 + kstep; const char* b3 = b2 + kstep;
            if (last && has_next) S.a_ready(nxt);
            if constexpr (SP2) {
            PG8_LDB(B0, 0, 0); PG8_LDB(B1, 0, 1); PG8_SCHED; PG8_LDA(At, 0, 0); PG8_STAGE(PG8_SA(1, 1), a1 + hstep, voffA);
            PG8_WAIT_V(8); PG8_WAIT_L(0); PG8_BAR; PG8_MMA(0, 0, At, B0); PG8_MMA(0, 1, At, B1); PG8_BAR; PG8_SCHED;
            PG8_LDA(At, 0, 1); PG8_STAGE(PG8_SB(0, 0), b2, voffB); PG8_STAGE(PG8_SB(0, 1), b2 + hstep, voffB); PG8_STAGE(PG8_SA(0, 0), a2, voffA);
            PG8_WAIT_V(8); PG8_WAIT_L(0); PG8_BAR; PG8_MMA(1, 0, At, B0); PG8_MMA(1, 1, At, B1); PG8_BAR; PG8_SCHED;
            PG8_LDB(B0, 1, 0); PG8_LDB(B1, 1, 1); PG8_SCHED; PG8_LDA(At, 1, 0); PG8_STAGE(PG8_SA(0, 1), a2 + hstep, voffA);
            PG8_WAIT_V(8); PG8_WAIT_L(0); PG8_BAR; PG8_MMA(0, 0, At, B0); PG8_MMA(0, 1, At, B1); PG8_BAR; PG8_SCHED;
            PG8_LDA(At, 1, 1); PG8_STAGE(PG8_SB(1, 0), b3, voffB); PG8_STAGE(PG8_SB(1, 1), b3 + hstep, voffB); PG8_STAGE(PG8_SA(1, 0), a3, voffA);
            PG8_WAIT_V(8); PG8_WAIT_L(0); PG8_BAR; PG8_MMA(1, 0, At, B0); PG8_MMA(1, 1, At, B1); PG8_BAR; PG8_SCHED;
            } else {
            PG8_LDB(B0, 0, 0); PG8_SCHED; PG8_LDA(At, 0, 0); PG8_STAGE(PG8_SA(1, 1), a1 + hstep, voffA);
            PG8_WAIT_L(8); PG8_BAR; PG8_WAIT_L(0); PG8_MMA(0, 0, At, B0); PG8_BAR; PG8_SCHED;
            PG8_LDB(B1, 0, 1); PG8_STAGE(PG8_SB(0, 0), b2, voffB);
            PG8_BAR; PG8_WAIT_L(0); PG8_MMA(0, 1, At, B1); PG8_BAR;
            PG8_LDA(At, 0, 1); PG8_STAGE(PG8_SA(0, 0), a2, voffA);
            PG8_BAR; PG8_WAIT_L(0); PG8_MMA(1, 0, At, B0); PG8_BAR; PG8_SCHED;
            PG8_STAGE(PG8_SB(0, 1), b2 + hstep, voffB);
            PG8_WAIT_V(6); PG8_BAR; PG8_MMA(1, 1, At, B1); PG8_BAR;
            PG8_LDB(B0, 1, 0); PG8_SCHED; PG8_LDA(At, 1, 0); PG8_STAGE(PG8_SA(0, 1), a2 + hstep, voffA);
            PG8_WAIT_L(8); PG8_BAR; PG8_WAIT_L(0); PG8_MMA(0, 0, At, B0); PG8_BAR; PG8_SCHED;
            PG8_LDB(B1, 1, 1); PG8_STAGE(PG8_SB(1, 0), b3, voffB);
            PG8_BAR; PG8_WAIT_L(0); PG8_MMA(0, 1, At, B1); PG8_BAR;
            PG8_LDA(At, 1, 1); PG8_STAGE(PG8_SA(1, 0), a3, voffA);
            PG8_BAR; PG8_WAIT_L(0); PG8_MMA(1, 0, At, B0); PG8_BAR; PG8_SCHED;
            PG8_STAGE(PG8_SB(1, 1), b3 + hstep, voffB);
            PG8_WAIT_V(6); PG8_BAR; PG8_MMA(1, 1, At, B1); PG8_BAR;
            }
        }
        if constexpr (ALIGN_EPI) { if (wr == 0) PG8_BAR; }
        if constexpr (!Epi::AFTER_DRAIN) { E(acc, cur, wr, wc, fr, fq); S.done(cur); }
        if (!has_next) break;
#pragma unroll
        for (int a = 0; a < 2; ++a)
#pragma unroll
            for (int b = 0; b < 2; ++b)
#pragma unroll
                for (int m = 0; m < 4; ++m)
#pragma unroll
                    for (int n = 0; n < 2; ++n) acc[a][b][m][n] = (f32x4){0.f, 0.f, 0.f, 0.f};
        cur = nxt; cA = nA; cB = nB; ++ui;
        if constexpr (ALIGN_EPI) { if (wr == 1) PG8_BAR; }
    }
    PG8_WAIT_V(0);
    if constexpr (!ALIGN_EPI) { if (wr == 0) PG8_BAR; }
    PG8_BAR;
#undef PG8_SA
#undef PG8_SB
#undef PG8_STAGE
#undef PG8_LDA
#undef PG8_LDB
#undef PG8_MMA
#undef PG8_WAIT_V
#undef PG8_WAIT_L
#undef PG8_BAR
#undef PG8_SCHED
}
}

namespace att {
constexpr int D = 128, NW = 8, QBLK = 32, KVBLK = 64;
constexpr float SCALE = 0.088388347648318440f;
constexpr float THR = 8.f;
constexpr size_t SHM_V = KVBLK * D * 2, SHM_K = KVBLK * D * 2, SHM_ATTN = 2 * SHM_V + 2 * SHM_K + NW * 64 * 4;
#define KSWZ(row, colB) ((row) * 256 + ((colB) ^ (((row) & 7) << 4)))
#define SBAR() __builtin_amdgcn_sched_barrier(0)
__device__ __forceinline__ int crow(int r, int hi) { return (r & 3) + 8 * (r >> 2) + 4 * hi; }

template <bool MOBA>
__device__ __forceinline__ void partialSM(f32x16& p0, f32x16& p1, float& m_reg, float& mn, float& alpha, int t, int qrow, int hi, unsigned selmask) {
  constexpr float C = SCALE * 1.4426950408889634f;
  if constexpr (MOBA) {
    if (t < 4) { const int kb = t * 64 + 4 * hi;
#pragma unroll
      for (int r = 0; r < 16; ++r) { const int kk = kb + (r & 3) + 8 * (r >> 2); p0[r] = (kk > qrow) ? -1e30f : p0[r]; p1[r] = (kk + 32 > qrow) ? -1e30f : p1[r]; }
    } else { const bool keep = (selmask >> ((t - 4) >> 2)) & 1u;
#pragma unroll
      for (int r = 0; r < 16; ++r) { p0[r] = keep ? p0[r] : -1e30f; p1[r] = keep ? p1[r] : -1e30f; } }
  }
  float pmax = p0[0];
#pragma unroll
  for (int r = 1; r < 16; ++r) pmax = fmaxf(pmax, p0[r]);
#pragma unroll
  for (int r = 0; r < 16; ++r) pmax = fmaxf(pmax, p1[r]);
  { auto rr = __builtin_amdgcn_permlane32_swap(__float_as_uint(pmax), __float_as_uint(pmax), false, false);
    pmax = fmaxf(__uint_as_float(rr[0]), __uint_as_float(rr[1])); }
  if (__builtin_expect(__all(pmax - m_reg <= THR / SCALE), 1)) { mn = m_reg; alpha = 1.f; }
  else { mn = fmaxf(m_reg, pmax); alpha = __builtin_amdgcn_exp2f((m_reg - mn) * C); m_reg = mn; }
  float mnC = -mn * C;
#pragma unroll
  for (int r = 0; r < 16; ++r) p0[r] = fmaf(p0[r], C, mnC);
#pragma unroll
  for (int r = 0; r < 16; ++r) p1[r] = fmaf(p1[r], C, mnC);
#pragma unroll
  for (int r = 0; r < 16; ++r) p0[r] = __builtin_amdgcn_exp2f(p0[r]);
}
__device__ __forceinline__ void finishSM(f32x16& p0, f32x16& p1, float alpha, float& l_reg, bf16x8& pa0, bf16x8& pa1, bf16x8& pa2, bf16x8& pa3) {
#pragma unroll
  for (int r = 0; r < 16; ++r) p1[r] = __builtin_amdgcn_exp2f(p1[r]);
  float ps = 0;
#pragma unroll
  for (int r = 0; r < 16; ++r) ps += p0[r];
#pragma unroll
  for (int r = 0; r < 16; ++r) ps += p1[r];
  { auto rr = __builtin_amdgcn_permlane32_swap(__float_as_uint(ps), __float_as_uint(ps), false, false);
    ps = __uint_as_float(rr[0]) + __uint_as_float(rr[1]); }
  l_reg = l_reg * alpha + ps;
#define PK4(P, BASE, OUT) do { unsigned a0 = cvtpk(P[BASE + 0], P[BASE + 1]), a1 = cvtpk(P[BASE + 2], P[BASE + 3]);   \
    unsigned b0 = cvtpk(P[BASE + 4], P[BASE + 5]), b1 = cvtpk(P[BASE + 6], P[BASE + 7]);                              \
    auto r0 = __builtin_amdgcn_permlane32_swap(a0, b0, false, false); auto r1 = __builtin_amdgcn_permlane32_swap(a1, b1, false, false); \
    u32x4 w = {r0[0], r1[0], r0[1], r1[1]}; OUT = *reinterpret_cast<bf16x8*>(&w); } while (0)
  PK4(p0, 0, pa0); PK4(p0, 8, pa1); PK4(p1, 0, pa2); PK4(p1, 8, pa3);
#undef PK4
}
__device__ __forceinline__ void qkt(f32x16& p0, f32x16& p1, const char* Ks, const bf16x8* qr, const int (&ka)[4]) {
  p0 = f32x16{}; p1 = f32x16{};
#pragma unroll
  for (int d0 = 0; d0 < 8; ++d0) {
    bf16x8 b0 = *reinterpret_cast<const bf16x8*>(Ks + ka[d0 & 3] + (d0 >> 2) * 128);
    bf16x8 b1 = *reinterpret_cast<const bf16x8*>(Ks + ka[d0 & 3] + (d0 >> 2) * 128 + 8192);
    p0 = __builtin_amdgcn_mfma_f32_32x32x16_bf16(b0, qr[d0], p0, 0, 0, 0);
    p1 = __builtin_amdgcn_mfma_f32_32x32x16_bf16(b1, qr[d0], p1, 0, 0, 0); }
}
__device__ __forceinline__ void qkt1(f32x16& p0, const char* Ks, const bf16x8* qr, const int (&ka)[4]) {
  p0 = f32x16{};
#pragma unroll
  for (int d0 = 0; d0 < 8; ++d0) {
    bf16x8 b0 = *reinterpret_cast<const bf16x8*>(Ks + ka[d0 & 3] + (d0 >> 2) * 128);
    p0 = __builtin_amdgcn_mfma_f32_32x32x16_bf16(b0, qr[d0], p0, 0, 0, 0); }
}
__device__ __forceinline__ int v_st(int k, int c) { const int kk = (k & ~0xC) | ((k & 4) << 1) | ((k & 8) >> 1); return ((kk >> 3) * 4 + (c >> 5)) * 512 + ((kk & 7) * 32 + (c & 31)) * 2; }
__device__ __forceinline__ int v_rd_base(int lane) { return ((lane & 3) << 3) | (((lane >> 2) & 3) << 6) | (((lane >> 4) & 1) << 5) | (((lane >> 5) & 1) << 8); }
constexpr int v_rd_off(int d0, int ks, int half) { return d0 * 512 + ks * 4096 + half * 2048; }
template <int OFF> __device__ __forceinline__ s16x4 tr_read(int vb) {
  s16x4 r; asm volatile("ds_read_b64_tr_b16 %0, %1 offset:%2" : "=&v"(r) : "v"(vb), "i"(OFF) : "memory"); return r;
}
template <int D0> __device__ __forceinline__ void pv_one(f32x16& od, int vb, bf16x8 pa0, bf16x8 pa1, bf16x8 pa2, bf16x8 pa3) {
  const s16x4 l0 = tr_read<v_rd_off(D0, 0, 0)>(vb), h0 = tr_read<v_rd_off(D0, 0, 1)>(vb), l1 = tr_read<v_rd_off(D0, 1, 0)>(vb), h1 = tr_read<v_rd_off(D0, 1, 1)>(vb);
  const s16x4 l2 = tr_read<v_rd_off(D0, 2, 0)>(vb), h2 = tr_read<v_rd_off(D0, 2, 1)>(vb), l3 = tr_read<v_rd_off(D0, 3, 0)>(vb), h3 = tr_read<v_rd_off(D0, 3, 1)>(vb);
  asm volatile("s_waitcnt lgkmcnt(0)" ::: "memory"); SBAR();
#define PK(L, H) (bf16x8){L[0], L[1], L[2], L[3], H[0], H[1], H[2], H[3]}
  od = __builtin_amdgcn_mfma_f32_32x32x16_bf16(pa0, PK(l0, h0), od, 0, 0, 0);
  od = __builtin_amdgcn_mfma_f32_32x32x16_bf16(pa1, PK(l1, h1), od, 0, 0, 0);
  od = __builtin_amdgcn_mfma_f32_32x32x16_bf16(pa2, PK(l2, h2), od, 0, 0, 0);
  od = __builtin_amdgcn_mfma_f32_32x32x16_bf16(pa3, PK(l3, h3), od, 0, 0, 0);
#undef PK
}
__device__ __forceinline__ void pv_d0(f32x16* o, int vb, bf16x8 pa0, bf16x8 pa1, bf16x8 pa2, bf16x8 pa3) {
  pv_one<0>(o[0], vb, pa0, pa1, pa2, pa3); pv_one<1>(o[1], vb, pa0, pa1, pa2, pa3); pv_one<2>(o[2], vb, pa0, pa1, pa2, pa3); pv_one<3>(o[3], vb, pa0, pa1, pa2, pa3);
}

template <int LDQ, int LDK, bool MOBA, int SDEPTH>
__device__ __forceinline__ void attn_unit(const bf16* Qb, const bf16* Kh, const bf16* Vh, bf16* Ob, int jblk, const float* kmp, char* lds) {
  int tid = threadIdx.x; asm volatile("" : "+v"(tid));
  const int wid = __builtin_amdgcn_readfirstlane(tid >> 6), lane = tid & 63, r32 = lane & 31, hi = lane >> 5;
  char* V_lds = lds; char* K_lds = lds + 2 * SHM_V;
  float* ws = (float*)(lds + 2 * SHM_V + 2 * SHM_K) + wid * 64; float* li_l = ws; float* al_l = ws + 32;
  float m_reg = -1e30f, l_reg = 0; f32x16 o[4] = {}; bf16x8 qr[8];
  const bf16* Qw = Qb + (long)(wid * QBLK + r32) * LDQ + hi * 8;
#pragma unroll
  for (int d0 = 0; d0 < 8; ++d0) qr[d0] = *reinterpret_cast<const bf16x8*>(Qw + d0 * 16);
  const int sr = tid >> 4, sc = (tid & 15) * 8, vst0 = v_st(sr, sc), vst1 = v_st(32 + sr, sc);
  const unsigned goff = (unsigned)(sr * LDK + sc) * 2u;
  const int vb0 = (int)(uintptr_t)V_lds + v_rd_base(lane);
  const int qrow = wid * QBLK + r32;
  int ka[4];
#pragma unroll
  for (int i = 0; i < 4; ++i) ka[i] = r32 * 256 + (((2 * i + hi) ^ (r32 & 7)) << 4);
  unsigned selmask = 0;
  struct { bf16x8 vs0, vs1, ks0, ks1; } sr_[SDEPTH];
  const int NT = MOBA ? 4 * (jblk + 1) : 4;
#define KOFF(t) (MOBA ? ((t) < 4 ? jblk * 256 + (t) * 64 : ((t) - 4) * 64) : (t) * 64)
#define SLOAD(i, k0) do { const char* kb_ = (const char*)Kh + (size_t)(k0) * (LDK * 2); const char* vb_ = (const char*)Vh + (size_t)(k0) * (LDK * 2); \
    sr_[i].vs0 = *reinterpret_cast<const bf16x8*>(vb_ + goff); sr_[i].vs1 = *reinterpret_cast<const bf16x8*>(vb_ + 32 * LDK * 2 + goff); \
    sr_[i].ks0 = *reinterpret_cast<const bf16x8*>(kb_ + goff); sr_[i].ks1 = *reinterpret_cast<const bf16x8*>(kb_ + 32 * LDK * 2 + goff); } while (0)
#define SWRITE(b, i) do { *(bf16x8*)(V_lds + (b) * SHM_V + vst0) = sr_[i].vs0;          \
    *(bf16x8*)(V_lds + (b) * SHM_V + vst1) = sr_[i].vs1; int kc = sc * 2;               \
    *(bf16x8*)(K_lds + (b) * SHM_K + KSWZ(sr, kc)) = sr_[i].ks0;                       \
    *(bf16x8*)(K_lds + (b) * SHM_K + KSWZ(32 + sr, kc)) = sr_[i].ks1; } while (0)
#define SWAIT() do { if constexpr (SDEPTH == 2) asm volatile("s_waitcnt vmcnt(4)" ::: "memory"); else asm volatile("s_waitcnt vmcnt(0)" ::: "memory"); } while (0)
#define RESC(a) do { if (__any((a) < 1.f)) { if (hi == 0) al_l[r32] = (a); asm volatile("s_waitcnt lgkmcnt(0)" ::: "memory"); \
    _Pragma("unroll") for (int d = 0; d < 4; ++d) _Pragma("unroll") for (int r = 0; r < 16; ++r) o[d][r] *= al_l[crow(r, hi)]; } } while (0)
  f32x16 pA0, pA1, pB0, pB1; float mnA, mnB, alA, alB; bf16x8 pa0, pa1, pa2, pa3;
  constexpr int SE = 0, SO = SDEPTH - 1;
  SLOAD(SE, KOFF(0));
  if constexpr (MOBA) {
    const int gr = tid >> 4, gc = (tid & 15) * 8; f32x4 a = {0.f, 0.f, 0.f, 0.f}, b = {0.f, 0.f, 0.f, 0.f};
    if (gr < jblk) { const float* p0_ = kmp + (size_t)gr * 2048 + gc; const f32x4 a0 = *(const f32x4*)p0_, a1 = *(const f32x4*)(p0_ + 4), b0 = *(const f32x4*)(p0_ + 1024), b1 = *(const f32x4*)(p0_ + 1028);
      a = (a0 + b0) * (1.0f / 256.0f); b = (a1 + b1) * (1.0f / 256.0f); }
    u32x4 w = {pk2(a[0], a[1]), pk2(a[2], a[3]), pk2(b[0], b[1]), pk2(b[2], b[3])};
    *(u32x4*)(K_lds + SHM_K + KSWZ(gr, gc * 2)) = w;
  }
  asm volatile("s_waitcnt vmcnt(0)" ::: "memory"); SWRITE(0, SE); __syncthreads();
  qkt(pA0, pA1, K_lds, qr, ka);
  if constexpr (MOBA) {
    f32x16 g; qkt1(g, K_lds + SHM_K, qr, ka);
    float gv[16];
#pragma unroll
    for (int r = 0; r < 8; ++r) { auto rr = __builtin_amdgcn_permlane32_swap(__float_as_uint(g[r]), __float_as_uint(g[r]), false, false);
      const float lo_ = __uint_as_float(rr[0]), hi_ = __uint_as_float(rr[1]);
      const int n0 = (r & 3) + 8 * (r >> 2); gv[n0] = lo_; gv[n0 + 4] = hi_; }
#pragma unroll
    for (int n = 0; n < 16; ++n) gv[n] = (n < jblk) ? gv[n] : -3e38f;
#pragma unroll
    for (int k = 0; k < 3; ++k) { float best = gv[0];
#pragma unroll
      for (int n = 1; n < 16; ++n) best = fmaxf(best, gv[n]);
      int idx = 16;
#pragma unroll
      for (int n = 15; n >= 0; --n) idx = (gv[n] == best) ? n : idx;
      if (best > -1e38f) selmask |= 1u << idx;
#pragma unroll
      for (int n = 0; n < 16; ++n) gv[n] = (n == idx) ? -3e38f : gv[n]; }
  }
  partialSM<MOBA>(pA0, pA1, m_reg, mnA, alA, 0, qrow, hi, selmask);
  SLOAD(SO, KOFF(1)); if constexpr (SDEPTH == 2) { if (2 < NT) SLOAD(SE, KOFF(2)); }
  if constexpr (MOBA) __syncthreads();
  SWAIT(); SWRITE(1, SO); __syncthreads();
  for (int j = 1; j + 1 < NT; j += 2) {
    SBAR(); qkt(pB0, pB1, K_lds + SHM_K, qr, ka);
    finishSM(pA0, pA1, alA, l_reg, pa0, pa1, pa2, pa3); SBAR();
    SLOAD(SO, KOFF(j + SDEPTH)); SBAR();
    pv_d0(o, vb0, pa0, pa1, pa2, pa3); partialSM<MOBA>(pB0, pB1, m_reg, mnB, alB, j, qrow, hi, selmask);
    __syncthreads(); SWAIT(); SWRITE(0, SE);
    RESC(alB); __syncthreads();
    SBAR(); qkt(pA0, pA1, K_lds, qr, ka);
    finishSM(pB0, pB1, alB, l_reg, pa0, pa1, pa2, pa3); SBAR();
    if (SDEPTH == 1 || j + 3 < NT) SLOAD(SE, KOFF(j + 1 + SDEPTH)); SBAR();
    pv_d0(o, vb0 + (int)SHM_V, pa0, pa1, pa2, pa3); partialSM<MOBA>(pA0, pA1, m_reg, mnA, alA, j + 1, qrow, hi, selmask);
    __syncthreads(); SWAIT(); SWRITE(1, SO);
    RESC(alA); __syncthreads();
  }
  SBAR(); qkt(pB0, pB1, K_lds + SHM_K, qr, ka);
  finishSM(pA0, pA1, alA, l_reg, pa0, pa1, pa2, pa3); SBAR();
  pv_d0(o, vb0, pa0, pa1, pa2, pa3); partialSM<MOBA>(pB0, pB1, m_reg, mnB, alB, NT - 1, qrow, hi, selmask);
  __syncthreads(); RESC(alB);
  finishSM(pB0, pB1, alB, l_reg, pa0, pa1, pa2, pa3); SBAR();
  pv_d0(o, vb0 + (int)SHM_V, pa0, pa1, pa2, pa3);
  if (hi == 0) li_l[r32] = l_reg; asm volatile("s_waitcnt lgkmcnt(0)" ::: "memory");
  float rli[16];
#pragma unroll
  for (int r = 0; r < 16; ++r) rli[r] = __builtin_amdgcn_rcpf(li_l[crow(r, hi)]);
  __syncthreads();
  char* ost = lds + wid * 8192;
#pragma unroll
  for (int r = 0; r < 16; ++r) { const int orow = crow(r, hi);
#pragma unroll
    for (int d0 = 0; d0 < 4; ++d0) *(unsigned short*)(ost + orow * 256 + (d0 * 32 + r32) * 2) = (unsigned short)f2bf(o[d0][r] * rli[r]); }
  asm volatile("s_waitcnt lgkmcnt(0)" ::: "memory");
  bf16* Ow = Ob + (long)(wid * QBLK) * LDQ;
#pragma unroll
  for (int i = 0; i < 8; ++i) { const int row = i * 4 + (lane >> 4), ch = lane & 15; const u32x4 v = *(const u32x4*)(ost + row * 256 + ch * 16);
    *(u32x4*)(Ow + (long)row * LDQ + ch * 8) = v; }
  __syncthreads();
#undef KOFF
#undef SLOAD
#undef SWRITE
#undef SWAIT
#undef RESC
}
}

#ifndef ATT_SD_MEM
#define ATT_SD_MEM 1
#endif
#ifndef ATT_SD_MOBA
#define ATT_SD_MOBA 1
#endif
struct Args {
    const float* in[16]; float* out; unsigned char* ws; int ph_lo, ph_hi;
};
struct Frame {
    LAS unsigned char* lds; char* ldsg;
    int wave, vcu, G;
};
__device__ __forceinline__ int fresh_tid() { int t = threadIdx.x; asm volatile("" : "+v"(t)); return t; }

template <int MAP>
__device__ __forceinline__ void transpose_item(const float* W, int ldw, bf16* dst, int ldd, int row_off, int koff, const float* sc, LAS float* scr, int kb, int nb, int lane) {
    const int k0 = 64 * kb, n0 = 32 * nb;
#pragma unroll 8
    for (int i = 0; i < 32; ++i) { const int kk = 2 * i + (lane >> 5); float v = W[(size_t)(k0 + kk) * ldw + n0 + (lane & 31)]; if (sc) v *= sc[k0 + kk]; scr[kk * 33 + (lane & 31)] = v; }
    LDS_WAIT(); asm volatile("" ::: "memory");
    const int c = lane & 7;
#pragma unroll
    for (int j = 0; j < 4; ++j) { const int n = (lane >> 3) + 8 * j; const LAS float* s = scr + (8 * c) * 33 + n;
        u32x4 o; o.x = pk2(s[0 * 33], s[1 * 33]); o.y = pk2(s[2 * 33], s[3 * 33]); o.z = pk2(s[4 * 33], s[5 * 33]); o.w = pk2(s[6 * 33], s[7 * 33]);
        const int ns = n0 + n; int row;
        if (MAP == 1 && ns < 1024) { const int d = ns & 127; row = row_off + (ns & ~127) + 32 * ((d >> 4) & 3) + 8 * ((d >> 2) & 3) + 4 * (d >> 6) + (d & 3); } else row = row_off + ns;
        *(u32x4*)(dst + (size_t)row * ldd + koff + k0 + 8 * c) = o; }
    LDS_WAIT(); asm volatile("" ::: "memory");
}

__device__ __forceinline__ void phase0(const Args& a, Frame& F) {
    unsigned char* ws = a.ws;
    const int lane = fresh_tid() & 63;
    const int gw = F.vcu * NWAVES + F.wave, NGW = F.G * NWAVES;
    const int gt = gw * 64 + lane, NGT = NGW * 64;
    LAS float* scr = (LAS float*)(F.lds + F.wave * 16384);
    const float* x = a.in[0]; const float* mem = a.in[1]; const float* g_mix = a.in[2]; const float* w_in = a.in[3]; const float* w_out = a.in[4]; const float* w_mkv = a.in[5];
    const float* pool_w = a.in[6]; const float* pool_sc = a.in[7]; const float* g_kv = a.in[8]; const float* w_kv = a.in[9]; const float* g_ffn = a.in[10]; const float* wq = a.in[11];
    const float* subk = a.in[12]; const float* pu = a.in[13]; const float* pv = a.in[14];
    constexpr int I1 = 16 * 48, I2 = 16 * 48, I3 = 16 * 64, I4 = 8 * 32, I5 = 24 * 32, I6 = 2 * 16 * 32, I7 = 2 * 16 * 64;
    constexpr int NIT = I1 + I2 + I3 + I4 + I5 + I6 + I7;
    for (int it = gw; it < NIT; it += NGW) {
        int r = it;
        if (r < I1) { transpose_item<0>(w_in, MIXW, (bf16*)(ws + WS_WIN0), DM, 0, 0, g_mix, scr, r / 48, r % 48, lane); continue; } r -= I1;
        if (r < I2) { transpose_item<1>(w_in + (size_t)DM * MIXW, MIXW, (bf16*)(ws + WS_WC4), DM, 2048, 0, g_mix + DM, scr, r / 48, r % 48, lane); continue; } r -= I2;
        if (r < I3) { transpose_item<1>(w_kv, 2048, (bf16*)(ws + WS_WC4), DM, 0, 0, g_kv, scr, r / 64, r % 64, lane); continue; } r -= I3;
        if (r < I4) { transpose_item<0>(w_out + (size_t)1024 * DM, DM, (bf16*)(ws + WS_WC0), MIXW, 0, 1024, nullptr, scr, r / 32, r % 32, lane); continue; } r -= I4;
        if (r < I5) { transpose_item<0>(w_out + (size_t)MIXW * DM, DM, (bf16*)(ws + WS_WOUT1), MIXW, 0, 0, nullptr, scr, r / 32, r % 32, lane); continue; } r -= I5;
        if (r < I6) { const int l = r / 512, q = r % 512; transpose_item<0>(w_mkv + (size_t)l * DM * 1024, 1024, (bf16*)(ws + WS_WMKV), DM, l * 1024, 0, nullptr, scr, q / 32, q % 32, lane); continue; } r -= I6;
        { const int l = r / 1024, q = r % 1024; transpose_item<0>(wq + (size_t)l * DM * 2048, 2048, (bf16*)(ws + (l ? WS_WQ1 : WS_WQ0)), DM, 0, 0, g_ffn + l * DM, scr, q / 64, q % 64, lane); }
    }
    for (int it = gw; it < 2048; it += NGW) {
        const int itu = __builtin_amdgcn_readfirstlane(it); const int g = itu >> 9, cg8 = (itu >> 4) & 31, nch = itu & 15; const int n = nch * 64 + lane;
        float acc[8];
#pragma unroll
        for (int i = 0; i < 8; ++i) acc[i] = 0.f;
        const float* pw = pool_w + ((size_t)g * 256 + cg8 * 8) * 256;
#pragma unroll
        for (int k = 0; k < 4; ++k) { float cf[8]; const float sc = pool_sc[g * 256 + k * 64 + lane];
#pragma unroll
            for (int i = 0; i < 8; ++i) cf[i] = pw[i * 256 + k * 64 + lane] * sc;
#pragma unroll 4
            for (int l = 0; l < 64; ++l) { const float w = w_out[(size_t)(g * 256 + k * 64 + l) * DM + n];
#pragma unroll
                for (int i = 0; i < 8; ++i) acc[i] = fmaf(__builtin_bit_cast(float, __builtin_amdgcn_readlane(__builtin_bit_cast(int, cf[i]), l)), w, acc[i]); } }
        u32x4 o; o.x = pk2(acc[0], acc[1]); o.y = pk2(acc[2], acc[3]); o.z = pk2(acc[4], acc[5]); o.w = pk2(acc[6], acc[7]);
        *(u32x4*)((bf16*)(ws + WS_WC0) + (size_t)n * MIXW + g * 256 + cg8 * 8) = o;
    }
    {
        const size_t n8a = (size_t)2 * 16 * 128 * 128 / 8, n8b = (size_t)2048 * 1024 / 8;
        for (size_t i = gt; i < n8a + n8b; i += NGT) { const bool A = i < n8a; const size_t j = A ? i : i - n8a; const float* src = (A ? subk : mem) + j * 8; bf16* dst = (bf16*)(ws + (A ? WS_SUBK : WS_MEMB)) + j * 8;
            const f32x4 v0 = *(const f32x4*)src, v1 = *(const f32x4*)(src + 4); u32x4 o = {pk2(v0[0], v0[1]), pk2(v0[2], v0[3]), pk2(v1[0], v1[1]), pk2(v1[2], v1[3])}; *(u32x4*)dst = o; }
    }
    for (int r = gw; r < 4 * NEXP; r += NGW) { const int tb = r / (2 * NEXP), rr = r % (2 * NEXP), l = rr / NEXP;
        const f32x4* src = (const f32x4*)((tb ? pv : pu) + (size_t)rr * DM) + lane; f32x4 v[4];
#pragma unroll
        for (int i = 0; i < 4; ++i) v[i] = src[64 * i];
        if (!tb) { const f32x4* gp = (const f32x4*)(g_ffn + l * DM) + lane;
#pragma unroll
            for (int i = 0; i < 4; ++i) v[i] *= gp[64 * i]; }
        float am = 0.f;
#pragma unroll
        for (int i = 0; i < 4; ++i) am = fmaxf(fmaxf(fmaxf(am, fabsf(v[i][0])), fmaxf(fabsf(v[i][1]), fabsf(v[i][2]))), fabsf(v[i][3]));
#pragma unroll
        for (int o = 1; o < 64; o <<= 1) am = fmaxf(am, __shfl_xor(am, o));
        const int eb = (int)((__builtin_bit_cast(unsigned, am) >> 23) & 0xffu);
        const float sc = (eb < 16) ? 1.0f : __builtin_bit_cast(float, (unsigned)(127 + 7 + 127 - eb) << 23);
        const float isc = (eb < 16) ? 1.0f : __builtin_bit_cast(float, (unsigned)(eb - 7) << 23);
        unsigned* dst = (unsigned*)(ws + (tb ? WS_VB : WS_UB) + (size_t)rr * DM) + lane;
#pragma unroll
        for (int i = 0; i < 4; ++i) { int w = __builtin_amdgcn_cvt_pk_fp8_f32(v[i][0] * sc, v[i][1] * sc, 0, false); w = __builtin_amdgcn_cvt_pk_fp8_f32(v[i][2] * sc, v[i][3] * sc, w, true); dst[64 * i] = (unsigned)w; }
        if (lane == 0) ((float*)(ws + (tb ? WS_VSC : WS_USC)))[rr] = isc; }
    for (int i = gt; i < SEQ * 64; i += NGT) { const int pos = i >> 6, fi = i & 63; const double inv = exp(-(double)fi * (9.210340371976184 / 64.0)); const double ang = (double)pos * inv;
        f32x2 cs = {(float)cos(ang), (float)sin(ang)}; *(f32x2*)((float*)(ws + WS_ROPE) + (size_t)i * 2) = cs; }
    for (int t = gw; t < T; t += NGW) { const f32x4* xr = (const f32x4*)(x + (size_t)t * DM) + lane; f32x4 v[4]; float s = 0.f;
#pragma unroll
        for (int j = 0; j < 4; ++j) { v[j] = xr[64 * j]; s += (v[j][0] * v[j][0] + v[j][1] * v[j][1]) + (v[j][2] * v[j][2] + v[j][3] * v[j][3]); }
        s = wave_sum(s);
        u32x2* o8 = (u32x2*)((bf16*)(ws + WS_XB) + (size_t)t * DM) + lane;
#pragma unroll
        for (int j = 0; j < 4; ++j) { u32x2 w = {pk2(v[j][0], v[j][1]), pk2(v[j][2], v[j][3])}; o8[64 * j] = w; }
        if (lane == 0) ((float*)(ws + WS_RSTD0))[t] = 1.0f / sqrtf(s * (1.0f / DM) + EPS); }
}

__device__ __forceinline__ void pool_diff(const Args& a, Frame& F) {
    const bf16* pm = (const bf16*)(a.ws + WS_P0MAIN); bf16* A2 = (bf16*)(a.ws + WS_A2);
    const int gt = (F.vcu * NWAVES + F.wave) * 64 + (fresh_tid() & 63), NGT = F.G * NTHR;
    for (int it = gt; it < (T / 16) * 128; it += NGT) {
        const int cc = it & 127, tg = it >> 7, t0 = tg * 16, s0 = t0 & (SEQ - 1), w = 2 << (cc >> 5), c0 = cc * 8;
        float sum[8];
#pragma unroll
        for (int i = 0; i < 8; ++i) sum[i] = 0.f;
        const int hist = (w - 1) < s0 ? (w - 1) : s0;
        for (int i = 1; i <= hist; ++i) { const u32x4 v = *(const u32x4*)(pm + (size_t)(t0 - i) * DM + c0);
            sum[0] += bflo(v.x); sum[1] += bfhi(v.x); sum[2] += bflo(v.y); sum[3] += bfhi(v.y); sum[4] += bflo(v.z); sum[5] += bfhi(v.z); sum[6] += bflo(v.w); sum[7] += bfhi(v.w); }
        for (int k = 0; k < 16; ++k) { const int t = t0 + k, s = s0 + k; const u32x4 v = *(const u32x4*)(pm + (size_t)t * DM + c0);
            float xv[8] = {bflo(v.x), bfhi(v.x), bflo(v.y), bfhi(v.y), bflo(v.z), bfhi(v.z), bflo(v.w), bfhi(v.w)};
#pragma unroll
            for (int i = 0; i < 8; ++i) sum[i] += xv[i];
            const float inv = 1.0f / (float)((s + 1) < w ? (s + 1) : w);
            u32x4 o = {pk2(sum[0] * inv - xv[0], sum[1] * inv - xv[1]), pk2(sum[2] * inv - xv[2], sum[3] * inv - xv[3]), pk2(sum[4] * inv - xv[4], sum[5] * inv - xv[5]), pk2(sum[6] * inv - xv[6], sum[7] * inv - xv[7])};
            *(u32x4*)(A2 + (size_t)t * MIXW + c0) = o;
            if (s >= w - 1) { const u32x4 q = *(const u32x4*)(pm + (size_t)(t - w + 1) * DM + c0);
                sum[0] -= bflo(q.x); sum[1] -= bfhi(q.x); sum[2] -= bflo(q.y); sum[3] -= bfhi(q.y); sum[4] -= bflo(q.z); sum[5] -= bfhi(q.z); sum[6] -= bflo(q.w); sum[7] -= bfhi(q.w); } }
    }
}

__device__ __forceinline__ void mem_attn(const Args& a, Frame& F, bf16* Abuf, int layer, bool dry = false) {
    const bf16* MKV = (const bf16*)(a.ws + WS_MEMKV);
    for (int U = F.vcu; U < 512; U += F.G) { const int b = U >> 6, h = (U >> 4) & 3, qt = U & 15;
        bf16* Q = Abuf + ((size_t)b * SEQ + qt * 256) * MIXW + 1024 + h * 128;
        const bf16* K = MKV + (size_t)b * MEMT * 2048 + layer * 1024 + h * 128;
        att::attn_unit<MIXW, 2048, false, ATT_SD_MEM>(Q, K, K + 512, dry ? (bf16*)(a.ws + WS_XB) : Q, 0, nullptr, F.ldsg); }
}

__device__ __forceinline__ int ord_enc(float x) { const int b = __builtin_bit_cast(int, x); return b ^ ((b >> 31) & 0x7fffffff); }
__device__ __forceinline__ float ord_dec(int k) { return __builtin_bit_cast(float, k ^ ((k >> 31) & 0x7fffffff)); }
template <int N> __device__ __forceinline__ void bitonic_desc(int (&a)[N]) {
#pragma unroll
    for (int k = 2; k <= N; k <<= 1)
#pragma unroll
        for (int j = k >> 1; j > 0; j >>= 1)
#pragma unroll
            for (int i = 0; i < N; ++i) { const int l = i ^ j; if (l > i) { const bool desc = ((i & k) == 0) || (k == N);
                const int hi = max(a[i], a[l]), lo = min(a[i], a[l]); a[i] = desc ? hi : lo; a[l] = desc ? lo : hi; } }
}
__device__ __forceinline__ void merge16(int (&a)[16], const int (&b)[16]) {
#pragma unroll
    for (int i = 0; i < 16; ++i) a[i] = max(a[i], b[15 - i]);
#pragma unroll
    for (int j = 8; j > 0; j >>= 1)
#pragma unroll
        for (int i = 0; i < 16; ++i) { const int l = i ^ j; if (l > i) { const int hi = max(a[i], a[l]), lo = min(a[i], a[l]); a[i] = hi; a[l] = lo; } }
}
constexpr int cand_slot(int i, int j) { int s = 0; for (int a = 0; a < 16; ++a) for (int b = 0; b < 16; ++b) { if ((a + 1) * (b + 1) > 16) continue; if (a == i && b == j) return s; ++s; } return -1; }

__device__ __forceinline__ void peer_topk(const Args& a, Frame& F, int layer) {
    const bf16* PQ = (const bf16*)(a.ws + WS_PQ); const bf16* SUBK = (const bf16*)(a.ws + WS_SUBK) + (size_t)layer * 16 * 128 * 128;
    unsigned short* EXPo = (unsigned short*)(a.ws + WS_EXP); float* GATEo = (float*)(a.ws + WS_GATE);
    const int tid = fresh_tid(), lane = tid & 63, wid = F.wave, r32 = lane & 31, hi = lane >> 5;
    const int h = F.vcu & 7;
    int ka[4];
#pragma unroll
    for (int i = 0; i < 4; ++i) ka[i] = r32 * 256 + (((2 * i + hi) ^ (r32 & 7)) << 4);
    char* Ks = F.ldsg;
    LAS unsigned char* ib = F.lds + 65536 + tid * 36;
    for (int i = tid; i < 2 * 128 * 16; i += NTHR) { const int row = i >> 4, ch = i & 15; const u32x4 v = *(const u32x4*)(SUBK + ((size_t)h * 256 + row) * 128 + ch * 8);
        *(u32x4*)(Ks + (row >> 7) * 32768 + KSWZ(row & 127, ch * 16)) = v; }
    __syncthreads();
    for (int tt = (F.vcu >> 3); tt < T / 256; tt += (F.G >> 3)) {
        const int t = tt * 256 + wid * 32 + r32;
        int top[2][16];
#pragma unroll
        for (int p = 0; p < 2; ++p) {
            bf16x8 qr[8]; const bf16* qp = PQ + (size_t)t * 2048 + h * 256 + p * 128 + hi * 8;
#pragma unroll
            for (int d0 = 0; d0 < 8; ++d0) qr[d0] = *reinterpret_cast<const bf16x8*>(qp + d0 * 16);
            int cur[16];
#pragma unroll
            for (int kt = 0; kt < 4; ++kt) { f32x16 sacc; att::qkt1(sacc, Ks + p * 32768 + kt * 32 * 256, qr, ka);
                int grp[16];
#pragma unroll
                for (int r = 0; r < 16; ++r) grp[r] = (ord_enc(sacc[r]) & ~0x7F) | (kt * 32 + (r & 3) + 8 * (r >> 2) + 4 * hi);
                bitonic_desc<16>(grp);
                if (kt == 0) {
#pragma unroll
                    for (int r = 0; r < 16; ++r) cur[r] = grp[r];
                } else merge16(cur, grp); }
            int oth[16];
#pragma unroll
            for (int r = 0; r < 16; ++r) { auto rr = __builtin_amdgcn_permlane32_swap((unsigned)cur[r], (unsigned)cur[r], false, false); cur[r] = (int)rr[0]; oth[r] = (int)rr[1]; }
            merge16(cur, oth);
#pragma unroll
            for (int r = 0; r < 16; ++r) top[p][r] = cur[r];
        }
        float v0[16], v1[16];
#pragma unroll
        for (int r = 0; r < 16; ++r) { v0[r] = ord_dec(top[0][r] & ~0x7F); v1[r] = ord_dec(top[1][r] & ~0x7F); }
#pragma unroll
        for (int q = 0; q < 4; ++q) { *(LAS unsigned*)(ib + q * 4) = (top[0][4 * q] & 0x7F) | ((top[0][4 * q + 1] & 0x7F) << 8) | ((top[0][4 * q + 2] & 0x7F) << 16) | ((top[0][4 * q + 3] & 0x7F) << 24);
            *(LAS unsigned*)(ib + 16 + q * 4) = (top[1][4 * q] & 0x7F) | ((top[1][4 * q + 1] & 0x7F) << 8) | ((top[1][4 * q + 2] & 0x7F) << 16) | ((top[1][4 * q + 3] & 0x7F) << 24); }
        int cnd[64];
#pragma unroll
        for (int i = 0; i < 64; ++i) cnd[i] = (int)0x80000000;
#pragma unroll
        for (int i = 0; i < 16; ++i)
#pragma unroll
            for (int j = 0; j < 16; ++j) if ((i + 1) * (j + 1) <= 16) cnd[cand_slot(i, j)] = (ord_enc(v0[i] + v1[j]) & ~0xFF) | (i * 16 + j);
        int best[16], g1[16];
#pragma unroll
        for (int r = 0; r < 16; ++r) best[r] = cnd[r];
        bitonic_desc<16>(best);
#pragma unroll
        for (int gq = 1; gq < 4; ++gq) {
#pragma unroll
            for (int r = 0; r < 16; ++r) g1[r] = cnd[gq * 16 + r];
            bitonic_desc<16>(g1); merge16(best, g1); }
        float cv[16], ex[16]; float sum = 0.f;
#pragma unroll
        for (int r = 0; r < 16; ++r) cv[r] = ord_dec(best[r] & ~0xFF);
#pragma unroll
        for (int r = 0; r < 16; ++r) { ex[r] = __builtin_amdgcn_exp2f((cv[r] - cv[0]) * 1.4426950408889634f); sum += ex[r]; }
        const float rs = 1.0f / sum;
        LDS_WAIT();
        unsigned ee[16];
#pragma unroll
        for (int r = 0; r < 16; ++r) { const int code = best[r] & 0xFF; const unsigned e1 = ib[code >> 4], e2 = ib[16 + (code & 15)]; ee[r] = e1 * 128u + e2; }
        const size_t ob = ((size_t)t * 8 + h) * 16;
        if (hi == 0) { u32x4 w0 = {ee[0] | (ee[1] << 16), ee[2] | (ee[3] << 16), ee[4] | (ee[5] << 16), ee[6] | (ee[7] << 16)}, w1 = {ee[8] | (ee[9] << 16), ee[10] | (ee[11] << 16), ee[12] | (ee[13] << 16), ee[14] | (ee[15] << 16)};
            *(u32x4*)(EXPo + ob) = w0; *(u32x4*)(EXPo + ob + 8) = w1; }
        else {
#pragma unroll
            for (int q = 0; q < 4; ++q) { f32x4 gq = {ex[4 * q] * rs, ex[4 * q + 1] * rs, ex[4 * q + 2] * rs, ex[4 * q + 3] * rs}; *(f32x4*)(GATEo + ob + 4 * q) = gq; } }
        LDS_WAIT();
    }
    __syncthreads();
}

__device__ __forceinline__ float gelu_exact(float v) {
    const float av = fabsf(v), t = __builtin_amdgcn_rcpf(fmaf(av, 0.2316418882f, 1.0f));
    float q = fmaf(t, 0.5307027145f, -0.7265760135f); q = fmaf(q, t, 0.7107068705f); q = fmaf(q, t, -0.142248368f); q = fmaf(q, t, 0.127414796f); q = q * t;
    const float e = __builtin_amdgcn_exp2f(v * v * -0.72134752044f), m = v * (q * e);
    return v < 0.f ? m : v - m;
}
__device__ __forceinline__ float dot16_fp8(const u32x4 u, const f32x2 (&x2)[8]) {
    f32x2 d = {0.f, 0.f};
#pragma unroll
    for (int i = 0; i < 4; ++i) { const f32x2 a = __builtin_amdgcn_cvt_pk_f32_fp8((int)u[i], false), b = __builtin_amdgcn_cvt_pk_f32_fp8((int)u[i], true);
        d = __builtin_elementwise_fma(a, x2[2 * i], d); d = __builtin_elementwise_fma(b, x2[2 * i + 1], d); }
    return d.x + d.y;
}
__device__ __forceinline__ void axpy16_fp8(f32x2 (&o2)[8], const float h, const u32x4 v) {
    const f32x2 h2 = {h, h};
#pragma unroll
    for (int i = 0; i < 4; ++i) { const f32x2 a = __builtin_amdgcn_cvt_pk_f32_fp8((int)v[i], false), b = __builtin_amdgcn_cvt_pk_f32_fp8((int)v[i], true);
        o2[2 * i] = __builtin_elementwise_fma(a, h2, o2[2 * i]); o2[2 * i + 1] = __builtin_elementwise_fma(b, h2, o2[2 * i + 1]); }
}
__device__ __forceinline__ float reduce8(const float (&p)[8], int lane) {
    float s[4];
#pragma unroll
    for (int i = 0; i < 4; ++i) { auto rr = __builtin_amdgcn_permlane32_swap(__float_as_uint(p[2 * i]), __float_as_uint(p[2 * i + 1]), false, false); s[i] = __uint_as_float(rr[0]) + __uint_as_float(rr[1]); }
    float t[2];
#pragma unroll
    for (int i = 0; i < 2; ++i) { const bool hi = lane & 16; const float u = hi ? s[2 * i + 1] : s[2 * i], o = hi ? s[2 * i] : s[2 * i + 1]; t[i] = u + shx_f<16>(o); }
    const bool h8 = lane & 8; const float u = h8 ? t[1] : t[0], o = h8 ? t[0] : t[1]; float w = u + dpp_f<0x128>(o);
    w += dpp_f<0x141>(w); w += dpp_f<0x1B>(w); w += dpp_f<0xB1>(w);
    return w;
}
constexpr int qgrp(int q) { return 2 * ((q & 3) == 1 ? 2 : (q & 3) == 2 ? 1 : (q & 3)) + (q >> 2); }

template <int K, int J> __device__ __forceinline__ void sort128_stage(unsigned& lo, unsigned& hi, int lane) {
    const unsigned plo = shx_u<J>(lo), phi = shx_u<J>(hi);
    const bool up_lo = (K >= 64) ? true : ((lane & K) == 0), up_hi = (K == 64) ? false : up_lo, lower = (lane & J) == 0;
    lo = (lower == up_lo) ? min(lo, plo) : max(lo, plo); hi = (lower == up_hi) ? min(hi, phi) : max(hi, phi);
    if constexpr (J > 1) sort128_stage<K, J / 2>(lo, hi, lane);
}
template <int K> __device__ __forceinline__ void sort128_level(unsigned& lo, unsigned& hi, int lane) { sort128_stage<K, K / 2>(lo, hi, lane); if constexpr (K < 64) sort128_level<K * 2>(lo, hi, lane); }
__device__ __forceinline__ void sort128(unsigned& lo, unsigned& hi, int lane) {
    sort128_level<2>(lo, hi, lane);
    { const unsigned a = min(lo, hi), b = max(lo, hi); lo = a; hi = b; }
    sort128_stage<128, 32>(lo, hi, lane);
}
template <bool FINAL, bool DRY = false>
__device__ __forceinline__ void peer_gather(const Args& a, Frame& F, int layer) {
    const unsigned char* UB = a.ws + WS_UB + (size_t)layer * NEXP * DM; const unsigned char* VB = a.ws + WS_VB + (size_t)layer * NEXP * DM;
    const float* USC = (const float*)(a.ws + WS_USC) + layer * NEXP; const float* VSC = (const float*)(a.ws + WS_VSC) + layer * NEXP;
    const unsigned short* EXPi = (const unsigned short*)(a.ws + WS_EXP); const float* GATEi = (const float*)(a.ws + WS_GATE);
    float* X = a.out; bf16* XB = (bf16*)(a.ws + WS_XB); float* RSTD2 = (float*)(a.ws + WS_RSTD2); const float* gfin = a.in[15];
    const int lane = fresh_tid() & 63, gw = F.vcu * NWAVES + F.wave, NGW = F.G * NWAVES;
    const unsigned lane16 = (unsigned)lane * 16u;
    const int grp = lane >> 3; const int jperm = 8 * (lane & 7) + ((grp >> 1) == 1 ? 2 : (grp >> 1) == 2 ? 1 : (grp >> 1)) + 4 * (grp & 1);
    for (int t = gw; t < T; t += NGW) {
        __syncthreads();
        bf16* xbr = XB + (size_t)t * DM + 16 * lane;
        float x[16];
        { const u32x4 v0 = *(const u32x4*)xbr, v1 = *(const u32x4*)(xbr + 8);
          x[0] = bflo(v0.x); x[1] = bfhi(v0.x); x[2] = bflo(v0.y); x[3] = bfhi(v0.y); x[4] = bflo(v0.z); x[5] = bfhi(v0.z); x[6] = bflo(v0.w); x[7] = bfhi(v0.w);
          x[8] = bflo(v1.x); x[9] = bfhi(v1.x); x[10] = bflo(v1.y); x[11] = bfhi(v1.y); x[12] = bflo(v1.z); x[13] = bfhi(v1.z); x[14] = bflo(v1.w); x[15] = bfhi(v1.w); }
        f32x2 x2[8];
#pragma unroll
        for (int i = 0; i < 8; ++i) { x2[i].x = x[2 * i]; x2[i].y = x[2 * i + 1]; }
        float ss = 0.f;
#pragma unroll
        for (int i = 0; i < 16; ++i) ss = fmaf(x[i], x[i], ss);
        ss = wave_sum(ss);
        const float rstd = 1.0f / sqrtf(ss * (1.0f / DM) + EPS);
        const unsigned short* et = EXPi + (size_t)t * 128; const float* gt_ = GATEi + (size_t)t * 128;
        unsigned k_lo = ((unsigned)et[lane] << 7) | (unsigned)lane, k_hi = ((unsigned)et[64 + lane] << 7) | (unsigned)(64 + lane);
        sort128(k_lo, k_hi, lane);
        const int e_lo = (int)(k_lo >> 7), e_hi = (int)(k_hi >> 7);
        const float gs_lo = gt_[k_lo & 127u], gs_hi = gt_[k_hi & 127u];
        const int ep_lo = __shfl(e_lo, jperm), ep_hi = __shfl(e_hi, jperm);
        const float gl = __shfl(gs_lo, jperm) * VSC[ep_lo], gh = __shfl(gs_hi, jperm) * VSC[ep_hi];
        const float ul = USC[ep_lo] * rstd, uh = USC[ep_hi] * rstd;
        float a_lo = 0.f, a_hi = 0.f;
        u32x4 b0[8], b1[8], b2[8];
#define ROWLD(dst, tab, e_) dst = *(const u32x4*)((tab) + (size_t)(e_) * DM + lane16)
#define ULOAD(buf, B) do { const int ev_ = ((B) >> 3) ? e_hi : e_lo; _Pragma("unroll") for (int q = 0; q < 8; ++q) { const int e = __builtin_amdgcn_readlane(ev_, 8 * ((B) & 7) + q); ROWLD(buf[q], UB, e); } } while (0)
#define VLOAD(buf, B) do { const int ev_ = ((B) >> 3) ? e_hi : e_lo; _Pragma("unroll") for (int q = 0; q < 8; ++q) { const int e = __builtin_amdgcn_readlane(ev_, 8 * ((B) & 7) + q); ROWLD(buf[q], VB, e); } } while (0)
#define UCOMP(buf, B) do { float p[8]; _Pragma("unroll") for (int q = 0; q < 8; ++q) p[q] = dot16_fp8(buf[q], x2); const float w = reduce8(p, lane); const bool mine = (lane & 7) == ((B) & 7); \
        if ((B) >> 3) a_hi = mine ? w : a_hi; else a_lo = mine ? w : a_lo; } while (0)
        ULOAD(b0, 0); ULOAD(b1, 1);
#pragma unroll 1
        for (int B = 0; B < 12; B += 3) {
            if (B > 0) __syncthreads();
            ULOAD(b2, B + 2); UCOMP(b0, B);
            ULOAD(b0, B + 3); UCOMP(b1, B + 1);
            ULOAD(b1, B + 4); UCOMP(b2, B + 2); }
        ULOAD(b2, 14); UCOMP(b0, 12);
        ULOAD(b0, 15); UCOMP(b1, 13);
        VLOAD(b1, 0);  UCOMP(b2, 14);
        VLOAD(b2, 1);  UCOMP(b0, 15);
#undef ULOAD
#undef UCOMP
        __syncthreads();
        const float h_lo = gelu_exact(a_lo * ul) * gl, h_hi = gelu_exact(a_hi * uh) * gh;
        f32x2 o2[8];
#pragma unroll
        for (int i = 0; i < 8; ++i) o2[i] = (f32x2){0.f, 0.f};
#define VCOMP(buf, B) do { const int hv_ = __builtin_bit_cast(int, ((B) >> 3) ? h_hi : h_lo); _Pragma("unroll") for (int q = 0; q < 8; ++q) { const float hq = __builtin_bit_cast(float, __builtin_amdgcn_readlane(hv_, 8 * qgrp(q) + ((B) & 7))); axpy16_fp8(o2, hq, buf[q]); } } while (0)
#pragma unroll 1
        for (int B = 0; B < 12; B += 3) {
            if (B > 0) __syncthreads();
            VLOAD(b0, B + 2); VCOMP(b1, B);
            VLOAD(b1, B + 3); VCOMP(b2, B + 1);
            VLOAD(b2, B + 4); VCOMP(b0, B + 2); }
        VLOAD(b0, 14); VCOMP(b1, 12);
        VLOAD(b1, 15); VCOMP(b2, 13);
        VCOMP(b0, 14);
        VCOMP(b1, 15);
#undef VLOAD
#undef VCOMP
#undef ROWLD
        float o[16]; float s2 = 0.f;
#pragma unroll
        for (int i = 0; i < 8; ++i) { o[2 * i] = o2[i].x; o[2 * i + 1] = o2[i].y; }
        { const u32x4 v0 = *(const u32x4*)xbr, v1 = *(const u32x4*)(xbr + 8);
          o[0] += bflo(v0.x); o[1] += bfhi(v0.x); o[2] += bflo(v0.y); o[3] += bfhi(v0.y); o[4] += bflo(v0.z); o[5] += bfhi(v0.z); o[6] += bflo(v0.w); o[7] += bfhi(v0.w);
          o[8] += bflo(v1.x); o[9] += bfhi(v1.x); o[10] += bflo(v1.y); o[11] += bfhi(v1.y); o[12] += bflo(v1.z); o[13] += bfhi(v1.z); o[14] += bflo(v1.w); o[15] += bfhi(v1.w); }
#pragma unroll
        for (int i = 0; i < 16; ++i) s2 = fmaf(o[i], o[i], s2);
        s2 = wave_sum(s2);
        const float r2 = 1.0f / sqrtf(s2 * (1.0f / DM) + EPS);
        if constexpr (FINAL) {
            float* xw = (DRY ? (float*)(a.ws + WS_RB) : X) + (size_t)t * DM;
#pragma unroll
            for (int i = 0; i < 4; ++i) { const f32x4 g = *(const f32x4*)(gfin + 16 * lane + 4 * i); f32x4 y = {o[4 * i] * r2 * g[0], o[4 * i + 1] * r2 * g[1], o[4 * i + 2] * r2 * g[2], o[4 * i + 3] * r2 * g[3]}; *(f32x4*)(xw + 16 * lane + 4 * i) = y; }
        } else {
            bf16* xo = DRY ? (bf16*)(a.ws + WS_RB) + (size_t)t * DM + 16 * lane : xbr;
            u32x4 wa = {pk2(o[0], o[1]), pk2(o[2], o[3]), pk2(o[4], o[5]), pk2(o[6], o[7])}, wb = {pk2(o[8], o[9]), pk2(o[10], o[11]), pk2(o[12], o[13]), pk2(o[14], o[15])};
            *(u32x4*)xo = wa; *(u32x4*)(xo + 8) = wb;
            if (!DRY && lane == 0) RSTD2[t] = r2;
        }
    }
}

#define XB_TMO      128
#define XB_XCNT(j)  (256  + 64 * (j))
#define XB_XSUB(j)  (1280 + 64 * (j))
#define XB_XGEN(j)  (2304 + 64 * (j))
#define XB_TOP      3328
#define XB_TOPGEN   3392
#define XCD_BAR_WORDS 3456
#define XB_SPIN_CAP (1u << 22)
__device__ __forceinline__ unsigned xb_ld(unsigned* p)              { return __hip_atomic_load(p, __ATOMIC_RELAXED, __HIP_MEMORY_SCOPE_AGENT); }
__device__ __forceinline__ unsigned xb_add(unsigned* p, unsigned v) { return __hip_atomic_fetch_add(p, v, __ATOMIC_RELAXED, __HIP_MEMORY_SCOPE_AGENT); }
__device__ __forceinline__ unsigned xb_xcc_id() { return (unsigned)__builtin_amdgcn_s_getreg((3 << 11) | 20) & 0xFu; }
#define XB_SPIN(cond, bar) do { unsigned _sp = 0; while (cond) { __builtin_amdgcn_s_sleep(1); \
    if ((++_sp & 255u) == 0u) { if (xb_ld(&(bar)[XB_TMO])) break; if (_sp > XB_SPIN_CAP) { atomicAdd(&(bar)[XB_TMO], 1u); break; } } } } while (0)
struct XcdBarrier { unsigned* bar; unsigned x; volatile LAS unsigned* st; };
__device__ __forceinline__ XcdBarrier xcd_barrier_post(unsigned* bar, volatile LAS unsigned* st) {
    XcdBarrier b; b.bar = bar; b.x = xb_xcc_id(); b.st = st;
    if (threadIdx.x == 0) (void)xb_add(&bar[XB_XCNT(b.x)], 1u);
    return b;
}
__device__ __forceinline__ void xcd_barrier_complete(unsigned* bar, unsigned x, unsigned& nloc, unsigned& nx) {
    const unsigned G = gridDim.x * gridDim.y * gridDim.z;
    unsigned sum, cnt, mine, sp = 0u;
    for (;;) {
        sum = 0u; cnt = 0u; mine = 0u;
#pragma unroll
        for (unsigned j = 0; j < 16; ++j) { const unsigned c = xb_ld(&bar[XB_XCNT(j)]); sum += c; cnt += (c > 0u) ? 1u : 0u; mine = (j == x) ? c : mine; }
        if (sum == G) break;
        __builtin_amdgcn_s_sleep(1);
        if ((++sp & 255u) == 0u) { if (xb_ld(&bar[XB_TMO])) break; if (sp > XB_SPIN_CAP) { atomicAdd(&bar[XB_TMO], 1u); break; } }
    }
    nloc = mine > 0u ? mine : 1u; nx = cnt > 0u ? cnt : 1u;
}
__device__ __forceinline__ void xcd_barrier(const XcdBarrier& b) {
    asm volatile("s_waitcnt vmcnt(0)" ::: "memory");
    __syncthreads();
    if (threadIdx.x == 0) {
        unsigned* bar = b.bar;
        __builtin_amdgcn_s_waitcnt(0);
        unsigned nloc = b.st[0], nx = b.st[1];
        if (nloc == 0u) { xcd_barrier_complete(bar, b.x, nloc, nx); b.st[0] = nloc; b.st[1] = nx; }
        const unsigned old = xb_add(&bar[XB_XSUB(b.x)], 1u);
        const unsigned gen = old / nloc;
        if (old + 1u == (gen + 1u) * nloc) {
            __builtin_amdgcn_fence(__ATOMIC_RELEASE, "agent");
            asm volatile("s_waitcnt vmcnt(0)" ::: "memory");
            const unsigned og = xb_add(&bar[XB_TOP], 1u);
            const unsigned tg = og / nx;
            if (og + 1u == (tg + 1u) * nx) xb_add(&bar[XB_TOPGEN], 1u);
            else XB_SPIN(xb_ld(&bar[XB_TOPGEN]) == tg, bar);
            __builtin_amdgcn_fence(__ATOMIC_ACQUIRE, "agent");
            xb_add(&bar[XB_XGEN(b.x)], 1u);
            asm volatile("s_waitcnt vmcnt(0)" ::: "memory");
        } else {
            XB_SPIN(xb_ld(&bar[XB_XGEN(b.x)]) == gen, bar);
            __builtin_amdgcn_fence(__ATOMIC_ACQUIRE, "agent");
            asm volatile("s_waitcnt vmcnt(0)" ::: "memory");
        }
    }
    __syncthreads();
}

__global__ void __launch_bounds__(NTHR, 2) yoco_fwd(Args args) {
    extern __shared__ __attribute__((aligned(16))) unsigned char lds_raw[];
    cg::grid_group grid = cg::this_grid();
    Frame F;
    F.lds = (LAS unsigned char*)lds_raw; F.ldsg = (char*)lds_raw;
    F.wave = __builtin_amdgcn_readfirstlane(threadIdx.x >> 6);
    F.G = gridDim.x; { const int bx = blockIdx.x; F.vcu = (F.G % 8 == 0) ? (bx % 8) * (F.G / 8) + bx / 8 : bx; }
    unsigned char* ws = args.ws;
    const int lo = args.ph_lo, hi = args.ph_hi;
    volatile LAS unsigned* bst = (volatile LAS unsigned*)(F.lds + 131072 + 320);
    if (threadIdx.x < 2) bst[threadIdx.x] = 0u;
    __syncthreads();
    XcdBarrier xbar; xbar.bar = (unsigned*)ws; xbar.x = 0; xbar.st = bst;
    if (hi - lo > 1) xbar = xcd_barrier_post((unsigned*)ws, bst);
#ifndef PH_MASK
#define PH_MASK 0x1fff
#endif
#define IN(k) (((PH_MASK >> (k)) & 1) && lo <= (k) && (k) < hi)
#define SEAM(k) do { if (IN(k) && IN((k) + 1)) { if ((k) == 0) grid.sync(); else xcd_barrier(xbar); } } while (0)
#define GSYNC() xcd_barrier(xbar)
#ifndef REP_MASK
#define REP_MASK 0
#endif
#define NREP(k) (((REP_MASK >> (k)) & 1) ? 2 : 1)
    typedef pg8::bf16_t pb;

    for (int rep_ = 0; rep_ < NREP(0); ++rep_) { if (rep_) GSYNC();
    if (IN(0)) { phase0(args, F); } } SEAM(0);

    for (int rep_ = 0; rep_ < NREP(1); ++rep_) { if (rep_) GSYNC();
    if (IN(1)) {
        { pg8::Gemm g{(const pb*)(ws + WS_XB), (const pb*)(ws + WS_WIN0), T, MIXW, DM}; pg8::StaticOrder S; S.init(T, MIXW, F.G, (int)blockIdx.x);
          pg8::EpiRowBf16 E{(pb*)(ws + WS_P0MAIN), DM, (pb*)(ws + WS_A2) + 1024, MIXW, 1024, (const float*)(ws + WS_RSTD0), nullptr};
          pg8::gemm_phase<pg8::EpiRowBf16, pg8::StaticOrder>(F.lds, g, S, E); }
        { pg8::Gemm g{(const pb*)(ws + WS_MEMB), (const pb*)(ws + WS_WMKV), 2048, 2048, DM}; pg8::StaticOrder S; S.init(2048, 2048, F.G, (int)blockIdx.x);
          pg8::EpiRowBf16 E{(pb*)(ws + WS_MEMKV), 2048, (pb*)(ws + WS_MEMKV), 2048, 1 << 30, nullptr, nullptr};
          pg8::gemm_phase<pg8::EpiRowBf16, pg8::StaticOrder>(F.lds, g, S, E); }
    } } SEAM(1);

    if (IN(2)) { if (NREP(2) > 1) { pool_diff(args, F); mem_attn(args, F, (bf16*)(ws + WS_A2), 0, true); GSYNC(); }
        pool_diff(args, F); mem_attn(args, F, (bf16*)(ws + WS_A2), 0); } SEAM(2);

    for (int rep_ = 0; rep_ < NREP(3); ++rep_) { if (rep_) GSYNC();
    if (IN(3)) {
        pg8::Gemm g{(const pb*)(ws + WS_A2), (const pb*)(ws + WS_WC0), T, DM, MIXW}; pg8::StaticOrder S; S.init(T, DM, F.G, (int)blockIdx.x);
        pg8::EpiRes E{(pb*)(ws + WS_XB), (float*)(ws + WS_SSQ)};
        pg8::gemm_phase<pg8::EpiRes, pg8::StaticOrder>(F.lds, g, S, E);
    } } SEAM(3);

    for (int rep_ = 0; rep_ < NREP(4); ++rep_) { if (rep_) GSYNC();
    if (IN(4)) {
        pg8::Gemm g{(const pb*)(ws + WS_XB), (const pb*)(ws + WS_WQ0), T, 2048, DM}; pg8::StaticOrder S; S.init(T, 2048, F.G, (int)blockIdx.x);
        pg8::EpiRowBf16 E{(pb*)(ws + WS_PQ), 2048, (pb*)(ws + WS_PQ), 2048, 1 << 30, nullptr, (const float*)(ws + WS_SSQ)};
        pg8::gemm_phase<pg8::EpiRowBf16, pg8::StaticOrder>(F.lds, g, S, E);
    } } SEAM(4);

    for (int rep_ = 0; rep_ < NREP(5); ++rep_) { if (rep_) GSYNC();
    if (IN(5)) { peer_topk(args, F, 0); } } SEAM(5);
    if (IN(6)) {
#ifdef PROBE_PEER
        peer_gather<false, true>(args, F, 0); GSYNC();
#endif
        peer_gather<false>(args, F, 0); } SEAM(6);

    for (int rep_ = 0; rep_ < NREP(7); ++rep_) { if (rep_) GSYNC();
    if (IN(7)) {
        pg8::Gemm g{(const pb*)(ws + WS_XB), (const pb*)(ws + WS_WC4), T, 3584, DM}; pg8::StaticOrder S; S.init(T, 3584, F.G, (int)blockIdx.x);
        pg8::EpiKVQ E{(pb*)(ws + WS_KR), (pb*)(ws + WS_VV), (pb*)(ws + WS_A3), (float*)(ws + WS_KMP), (const float*)(ws + WS_RSTD2), (const float*)(ws + WS_ROPE)};
        pg8::gemm_phase<pg8::EpiKVQ, pg8::StaticOrder>(F.lds, g, S, E);
    } } SEAM(7);

    if (IN(8)) {
        bf16* A3 = (bf16*)(ws + WS_A3); const bf16* KR = (const bf16*)(ws + WS_KR); const bf16* VV = (const bf16*)(ws + WS_VV); const float* KMP = (const float*)(ws + WS_KMP);
        for (int rep_ = 0; rep_ < NREP(8); ++rep_) { const bool dry8 = (NREP(8) > 1) && rep_ == 0;
        for (int P = F.vcu; P < 512; P += F.G) { const int bh = P >> 3, p = P & 7, b = bh >> 3, h = bh & 7;
#pragma unroll 1
            for (int half = 0; half < 2; ++half) { const int j = half ? p : 15 - p;
                bf16* Q = A3 + ((size_t)b * SEQ + j * 256) * MIXW + h * 128;
                const bf16* K = KR + (size_t)bh * SEQ * 128; const bf16* V = VV + (size_t)bh * SEQ * 128;
                att::attn_unit<MIXW, 128, true, ATT_SD_MOBA>(Q, K, V, dry8 ? (bf16*)(ws + WS_XB) : Q, j, KMP + (size_t)b * 16 * 2048 + h * 128, F.ldsg); } }
        if (dry8) { mem_attn(args, F, A3, 1, true); GSYNC(); } }
        mem_attn(args, F, A3, 1);
    } SEAM(8);

    if (IN(9)) {
        pg8::Gemm g{(const pb*)(ws + WS_A3), (const pb*)(ws + WS_WOUT1), T, DM, MIXW}; pg8::StaticOrder S; S.init(T, DM, F.G, (int)blockIdx.x);
        pg8::EpiRes E{(pb*)(ws + WS_XB), (float*)(ws + WS_SSQ)};
        pg8::gemm_phase<pg8::EpiRes, pg8::StaticOrder>(F.lds, g, S, E);
    } SEAM(9);

    for (int rep_ = 0; rep_ < NREP(10); ++rep_) { if (rep_) GSYNC();
    if (IN(10)) {
        pg8::Gemm g{(const pb*)(ws + WS_XB), (const pb*)(ws + WS_WQ1), T, 2048, DM}; pg8::StaticOrder S; S.init(T, 2048, F.G, (int)blockIdx.x);
        pg8::EpiRowBf16 E{(pb*)(ws + WS_PQ), 2048, (pb*)(ws + WS_PQ), 2048, 1 << 30, nullptr, (const float*)(ws + WS_SSQ)};
        pg8::gemm_phase<pg8::EpiRowBf16, pg8::StaticOrder>(F.lds, g, S, E);
    } } SEAM(10);

    for (int rep_ = 0; rep_ < NREP(11); ++rep_) { if (rep_) GSYNC();
    if (IN(11)) { peer_topk(args, F, 1); } } SEAM(11);
    if (IN(12)) {
#ifdef PROBE_PEER
        peer_gather<true, true>(args, F, 1); GSYNC();
#endif
        peer_gather<true>(args, F, 1); }
#undef IN
#undef SEAM
}

extern "C" void kernel_launch(void* const* d_in, const int* in_sizes, int n_in, void* d_out, int out_size, void* d_ws, size_t ws_size, hipStream_t stream) {
    static int grid = 0;
    if (grid == 0) {
        if (n_in != 16 || out_size != T * DM || ws_size < WS_END) { fprintf(stderr, "kernel_launch: unexpected shapes: n_in %d out %d ws %zu (need %zu)\n", n_in, out_size, ws_size, (size_t)WS_END); grid = -1; return; }
        int dev = 0, cus = 0, per_cu = 0;
        if (hipGetDevice(&dev) != hipSuccess || hipDeviceGetAttribute(&cus, hipDeviceAttributeMultiprocessorCount, dev) != hipSuccess) { grid = -1; return; }
        if (hipFuncSetAttribute((const void*)yoco_fwd, hipFuncAttributeMaxDynamicSharedMemorySize, LDS_BYTES) != hipSuccess) { fprintf(stderr, "kernel_launch: hipFuncSetAttribute failed\n"); grid = -1; return; }
        if (hipOccupancyMaxActiveBlocksPerMultiprocessor(&per_cu, (const void*)yoco_fwd, NTHR, LDS_BYTES) != hipSuccess || per_cu < 1) { fprintf(stderr, "kernel_launch: occupancy query says %d\n", per_cu); per_cu = 1; }
        (void)hipGetLastError();
        grid = cus;
        fprintf(stderr, "kernel_launch: grid %d, per_cu %d, ws %zu\n", grid, per_cu, ws_size);
    }
    if (grid < 0) return;
    if (hipMemsetAsync(d_ws, 0, 16384, stream) != hipSuccess) { fprintf(stderr, "kernel_launch: memset failed\n"); return; }
    Args a{};
    for (int i = 0; i < 16; ++i) a.in[i] = (const float*)d_in[i];
    a.out = (float*)d_out; a.ws = (unsigned char*)d_ws;
#if MK_LAUNCHES == 1
    a.ph_lo = 0; a.ph_hi = 13;
    void* kargs[] = {&a};
    hipError_t e = hipLaunchCooperativeKernel((const void*)yoco_fwd, dim3(grid), dim3(NTHR), kargs, LDS_BYTES, stream);
    if (e != hipSuccess) fprintf(stderr, "kernel_launch: cooperative launch failed: %s (grid %d)\n", hipGetErrorString(e), grid);
#else
    for (int p = 0; p < 13; ++p) { a.ph_lo = p; a.ph_hi = p + 1;
        hipLaunchKernelGGL(yoco_fwd, dim3(grid), dim3(NTHR), LDS_BYTES, stream, a);
        const hipError_t le = hipPeekAtLastError(); if (le != hipSuccess) { fprintf(stderr, "kernel_launch: launch %d failed: %s\n", p, hipGetErrorName(le)); break; } }
#endif
}
```

```cpp
#include <hip/hip_runtime.h>
#include <hip/hip_cooperative_groups.h>
#include <cstdio>
#include <cstdint>
namespace cg = cooperative_groups;

#ifndef MK_LAUNCHES
#define MK_LAUNCHES 1
#endif

#define GAS __attribute__((address_space(1)))
#define LAS __attribute__((address_space(3)))
typedef unsigned short bf16;
typedef unsigned u32x4 __attribute__((ext_vector_type(4)));
typedef unsigned u32x2 __attribute__((ext_vector_type(2)));
typedef float f32x4 __attribute__((ext_vector_type(4)));
typedef float f32x2 __attribute__((ext_vector_type(2)));
typedef float f32x16 __attribute__((ext_vector_type(16)));
typedef short bf16x8 __attribute__((ext_vector_type(8)));
typedef short s16x4 __attribute__((ext_vector_type(4)));
typedef __bf16 bf16x2_t __attribute__((ext_vector_type(2)));

constexpr int NB = 8, SEQ = 4096, DM = 1024, T = NB * SEQ, MIXW = 1536, MEMT = 256;
constexpr int NEXP = 16384, NWAVES = 8, NTHR = 512;
constexpr float EPS = 1e-6f;

constexpr size_t MiB = 1u << 20;
constexpr size_t WS_RSTD0 = 1 * MiB;
constexpr size_t WS_RSTD2 = WS_RSTD0 + 128 * 1024;
constexpr size_t WS_USC   = WS_RSTD0 + 256 * 1024;
constexpr size_t WS_VSC   = WS_RSTD0 + 384 * 1024;
constexpr size_t WS_SSQ   = 2 * MiB;
constexpr size_t WS_KMP   = 4 * MiB;
constexpr size_t WS_ROPE  = 5 * MiB;
constexpr size_t WS_WIN0  = 8 * MiB;
constexpr size_t WS_WC4   = 11 * MiB;
constexpr size_t WS_WC0   = 18 * MiB;
constexpr size_t WS_WOUT1 = 21 * MiB;
constexpr size_t WS_WMKV  = 24 * MiB;
constexpr size_t WS_WQ0   = 28 * MiB;
constexpr size_t WS_WQ1   = 32 * MiB;
constexpr size_t WS_SUBK  = 36 * MiB;
constexpr size_t WS_MEMB  = 37 * MiB;
constexpr size_t WS_MEMKV = 41 * MiB;
constexpr size_t WS_EXP   = 49 * MiB;
constexpr size_t WS_GATE  = 57 * MiB;
constexpr size_t WS_UB    = 73 * MiB;
constexpr size_t WS_VB    = 105 * MiB;
constexpr size_t WS_XB    = 201 * MiB;
constexpr size_t WS_RB    = 265 * MiB;
constexpr size_t WS_P0MAIN = WS_RB;
constexpr size_t WS_A2    = WS_RB + 64 * MiB;
constexpr size_t WS_PQ    = WS_RB;
constexpr size_t WS_KR    = WS_RB;
constexpr size_t WS_VV    = WS_RB + 64 * MiB;
constexpr size_t WS_A3    = WS_RB + 128 * MiB;
constexpr size_t WS_END   = WS_RB + 224 * MiB;

constexpr int LDS_BYTES = 147456;

__device__ __forceinline__ unsigned f2bf(float f) { unsigned u = __builtin_bit_cast(unsigned, f); return (u + 0x7fffu + ((u >> 16) & 1u)) >> 16; }
__device__ __forceinline__ unsigned pk2(float lo, float hi) { return f2bf(lo) | (f2bf(hi) << 16); }
__device__ __forceinline__ unsigned cvtpk(float lo, float hi) { unsigned r; asm volatile("v_cvt_pk_bf16_f32 %0, %1, %2" : "=v"(r) : "v"(lo), "v"(hi)); return r; }
__device__ __forceinline__ float bflo(unsigned w) { return __builtin_bit_cast(float, w << 16); }
__device__ __forceinline__ float bfhi(unsigned w) { return __builtin_bit_cast(float, w & 0xffff0000u); }
template <int J> __device__ __forceinline__ unsigned shx_u(unsigned v) {
    if constexpr (J == 32) { auto rr = __builtin_amdgcn_permlane32_swap(v, v, false, false); return ((threadIdx.x & 32) ? rr[0] : rr[1]); }
    else return (unsigned)__builtin_amdgcn_ds_swizzle((int)v, (J << 10) | 0x1f);
}
template <int J> __device__ __forceinline__ float shx_f(float v) { return __uint_as_float(shx_u<J>(__float_as_uint(v))); }
template <int CTRL> __device__ __forceinline__ float dpp_f(float v) { return __uint_as_float((unsigned)__builtin_amdgcn_update_dpp(0, (int)__float_as_uint(v), CTRL, 0xF, 0xF, false)); }
__device__ __forceinline__ float wave_sum(float v) {
    v += dpp_f<0xB1>(v); v += dpp_f<0x4E>(v); v += dpp_f<0x141>(v); v += dpp_f<0x128>(v);
    v += shx_f<16>(v);
    { auto rr = __builtin_amdgcn_permlane32_swap(__float_as_uint(v), __float_as_uint(v), false, false); v = __uint_as_float(rr[0]) + __uint_as_float(rr[1]); }
    return v;
}
__device__ __forceinline__ float dot2(unsigned w, unsigned x, float acc) { return __builtin_amdgcn_fdot2_f32_bf16(__builtin_bit_cast(bf16x2_t, w), __builtin_bit_cast(bf16x2_t, x), acc, false); }
#define LDS_WAIT() asm volatile("s_waitcnt lgkmcnt(0)" ::: "memory")
#define VM_WAIT() asm volatile("s_waitcnt vmcnt(0)" ::: "memory")

namespace pg8 {
#define PG8_LAS __attribute__((address_space(3)))
typedef unsigned short bf16_t;
constexpr int BM = 256, BK = 64, HALF = 128, HTB = HALF * BK * 2, STAGE_BYTES = 8 * HTB, NXCD = 8, WGM = 8;
__host__ __device__ __forceinline__ int lds_byte(int r, int c) { const int st = (r >> 4) * 2 + (c >> 5), rr = r & 15, cc = c & 31, ob = rr * 64 + cc * 2; return st * 1024 + (ob ^ (((ob >> 9) & 1) << 5)); }
__host__ __device__ __forceinline__ void stage_rc(int b, int& R, int& C) { const int st = b / 1024, sb = b % 1024, swz = sb ^ (((sb >> 9) & 1) << 5); R = (st >> 1) * 16 + swz / 64; C = (st & 1) * 32 + (swz % 64) / 2; }
__host__ __device__ __forceinline__ int perm32(int rho) { const int n = rho >> 4, i = rho & 15; return 8 * (i >> 2) + 4 * n + (i & 3); }
struct Unit { int pm, pn; };
struct Gemm { const bf16_t* A; const bf16_t* Bt; int M, N, K; };
struct StaticOrder {
    int nM, nN, nwg, G, c;
    __host__ __device__ void init(int M, int N, int G_, int c_) { nM = M / BM; nN = N / BM; nwg = nM * nN; G = G_; c = c_; }
    __host__ __device__ bool next(int i, Unit& u) const {
        const long L = (long)i * G + c; if (L >= nwg) return false;
        int wgid = (int)L; { const int q = nwg / NXCD, r = nwg % NXCD, xcd = wgid % NXCD, off = wgid / NXCD; wgid = (xcd < r ? xcd * (q + 1) : r * (q + 1) + (xcd - r) * q) + off; }
        const int nig = WGM * nN, gid = wgid / nig, fm = gid * WGM, gsz = (nM - fm) < WGM ? (nM - fm) : WGM;
        u.pm = fm + ((wgid % nig) % gsz); u.pn = (wgid % nig) / gsz; return true;
    }
    __device__ __forceinline__ void a_ready(const Unit&) const {}
    __device__ __forceinline__ void done(const Unit&) const {}
};

struct EpiRowBf16 {
    static constexpr bool PERM = true, AFTER_DRAIN = false;
    bf16_t* O0; int ld0; bf16_t* O1; int ld1; int split; const float* rs; const float* ssq;
    __device__ __forceinline__ void operator()(const f32x4 (&acc)[2][2][4][2], const Unit& u, int wr, int wc, int fr, int fq) const {
        const int row0 = u.pm * BM + wr * 64 + fr; int colt = u.pn * BM; bf16_t* base = O0; int ldc = ld0;
        if (colt >= split) { base = O1; ldc = ld1; colt -= split; }
        const int col0 = colt + wc * 32 + 8 * fq;
#pragma unroll
        for (int ai = 0; ai < 2; ++ai)
#pragma unroll
            for (int m = 0; m < 4; ++m) { const int row = row0 + ai * HALF + m * 16; float sc = 1.f;
                if (rs) sc = rs[row];
                else if (ssq) { const f32x4* q = (const f32x4*)(ssq + (size_t)row * 16); const f32x4 a = q[0], b = q[1], c = q[2], d = q[3];
                    const float s = ((a[0] + a[1]) + (a[2] + a[3])) + ((b[0] + b[1]) + (b[2] + b[3])) + ((c[0] + c[1]) + (c[2] + c[3])) + ((d[0] + d[1]) + (d[2] + d[3]));
                    sc = __builtin_amdgcn_rsqf(s * (1.0f / 1024.0f) + EPS); }
                bf16_t* rowp = base + (size_t)row * ldc + col0;
#pragma unroll
                for (int bj = 0; bj < 2; ++bj) { const f32x4 v0 = acc[ai][bj][m][0] * sc, v1 = acc[ai][bj][m][1] * sc;
                    u32x4 w; w.x = cvtpk(v0[0], v0[1]); w.y = cvtpk(v0[2], v0[3]); w.z = cvtpk(v1[0], v1[1]); w.w = cvtpk(v1[2], v1[3]);
                    *(u32x4*)(rowp + bj * HALF) = w; } }
    }
};
struct EpiRes {
    static constexpr bool PERM = true, AFTER_DRAIN = false;
    bf16_t* xb; float* ssq;
    __device__ __forceinline__ void operator()(const f32x4 (&acc)[2][2][4][2], const Unit& u, int wr, int wc, int fr, int fq) const {
        const int row0 = u.pm * BM + wr * 64 + fr, col0 = u.pn * BM + wc * 32 + 8 * fq;
#pragma unroll
        for (int ai = 0; ai < 2; ++ai)
#pragma unroll
            for (int m = 0; m < 4; ++m) { const int row = row0 + ai * HALF + m * 16; bf16_t* p = xb + (size_t)row * DM + col0; float ss = 0.f;
#pragma unroll
                for (int bj = 0; bj < 2; ++bj) { const u32x4 r = *(const u32x4*)(p + bj * HALF); const f32x4 a0 = acc[ai][bj][m][0], a1 = acc[ai][bj][m][1];
                    const float o0 = bflo(r.x) + a0[0], o1 = bfhi(r.x) + a0[1], o2 = bflo(r.y) + a0[2], o3 = bfhi(r.y) + a0[3], o4 = bflo(r.z) + a1[0], o5 = bfhi(r.z) + a1[1], o6 = bflo(r.w) + a1[2], o7 = bfhi(r.w) + a1[3];
                    u32x4 w; w.x = cvtpk(o0, o1); w.y = cvtpk(o2, o3); w.z = cvtpk(o4, o5); w.w = cvtpk(o6, o7); *(u32x4*)(p + bj * HALF) = w;
                    ss += ((o0 * o0 + o1 * o1) + (o2 * o2 + o3 * o3)) + ((o4 * o4 + o5 * o5) + (o6 * o6 + o7 * o7)); }
                ss += __shfl_xor(ss, 16); ss += __shfl_xor(ss, 32);
                if (fq == 0) ssq[(size_t)row * 16 + u.pn * 4 + wc] = ss; }
    }
};
struct EpiKVQ {
    static constexpr bool PERM = true, AFTER_DRAIN = false;
    bf16_t* KR; bf16_t* VV; bf16_t* A3; float* KMP; const float* rs; const float* rope;
    __device__ __forceinline__ void operator()(const f32x4 (&acc)[2][2][4][2], const Unit& u, int wr, int wc, int fr, int fq) const {
        const int pn = u.pn, pm = u.pm, b = pm >> 4, s0 = (pm & 15) * 256, rl0 = wr * 64 + fr, g0 = 32 * wc + 8 * fq;
        float rsv[2][4];
#pragma unroll
        for (int ai = 0; ai < 2; ++ai)
#pragma unroll
            for (int m = 0; m < 4; ++m) rsv[ai][m] = rs[pm * BM + rl0 + ai * HALF + m * 16];
        if (pn < 4 || (pn >= 8 && pn < 12)) {
            const bool isK = pn < 4; const int hp = isK ? pn : pn - 8; const int i0 = 16 * wc + 4 * fq;
            f32x4 klo[2] = {{0.f, 0.f, 0.f, 0.f}, {0.f, 0.f, 0.f, 0.f}}, khi[2] = {{0.f, 0.f, 0.f, 0.f}, {0.f, 0.f, 0.f, 0.f}};
#pragma unroll
            for (int ai = 0; ai < 2; ++ai)
#pragma unroll
                for (int m = 0; m < 4; ++m) { const int rl = rl0 + ai * HALF + m * 16, s = s0 + rl;
                    const f32x4 cs0 = *(const f32x4*)(rope + ((size_t)s * 64 + i0) * 2), cs1 = *(const f32x4*)(rope + ((size_t)s * 64 + i0) * 2 + 4);
                    const f32x4 c = {cs0[0], cs0[2], cs1[0], cs1[2]}, sn = {cs0[1], cs0[3], cs1[1], cs1[3]};
#pragma unroll
                    for (int bj = 0; bj < 2; ++bj) { const int head = 2 * hp + bj;
                        const f32x4 v1 = acc[ai][bj][m][0] * rsv[ai][m], v2 = acc[ai][bj][m][1] * rsv[ai][m];
                        const f32x4 lo = v1 * c - v2 * sn, hi = v2 * c + v1 * sn;
                        u32x4 w; w.x = cvtpk(lo[0], lo[1]); w.y = cvtpk(lo[2], lo[3]); w.z = cvtpk(hi[0], hi[1]); w.w = cvtpk(hi[2], hi[3]);
                        bf16_t* dst = isK ? KR + ((size_t)(b * 8 + head) * SEQ + s) * 128 + g0 : A3 + (size_t)(pm * BM + rl) * MIXW + head * 128 + g0;
                        *(u32x4*)dst = w;
                        klo[bj] += lo; khi[bj] += hi; } }
            if (isK) {
#pragma unroll
                for (int bj = 0; bj < 2; ++bj) {
#pragma unroll
                    for (int j = 0; j < 4; ++j) {
#pragma unroll
                        for (int o = 1; o < 16; o <<= 1) { klo[bj][j] += __shfl_xor(klo[bj][j], o); khi[bj][j] += __shfl_xor(khi[bj][j], o); } }
                    if (fr == 0) { float* kp = KMP + ((size_t)pm * 2 + wr) * 1024 + (2 * hp + bj) * 128 + g0; *(f32x4*)kp = klo[bj]; *(f32x4*)(kp + 4) = khi[bj]; } } }
        } else {
            const bool isV = pn < 8;
#pragma unroll
            for (int bj = 0; bj < 2; ++bj)
#pragma unroll
                for (int ai = 0; ai < 2; ++ai)
#pragma unroll
                    for (int m = 0; m < 4; ++m) { const int rl = rl0 + ai * HALF + m * 16, s = s0 + rl;
                        const f32x4 v0 = acc[ai][bj][m][0] * rsv[ai][m], v1 = acc[ai][bj][m][1] * rsv[ai][m];
                        u32x4 w; w.x = cvtpk(v0[0], v0[1]); w.y = cvtpk(v0[2], v0[3]); w.z = cvtpk(v1[0], v1[1]); w.w = cvtpk(v1[2], v1[3]);
                        bf16_t* dst = isV ? VV + ((size_t)(b * 8 + 2 * (pn - 4) + bj) * SEQ + s) * 128 + g0 : A3 + (size_t)(pm * BM + rl) * MIXW + 1024 + (pn - 12) * 256 + bj * HALF + g0;
                        *(u32x4*)dst = w; }
        }
    }
};

template <class Epi, class Sched, bool ALIGN_EPI = true, bool SP2 = true>
__device__ __forceinline__ void gemm_phase(PG8_LAS unsigned char* lds, const Gemm g, const Sched& S, const Epi& E) {
    int tid = threadIdx.x; asm volatile("" : "+v"(tid));
    const int wid = __builtin_amdgcn_readfirstlane(tid >> 6), lane = tid & 63, wr = wid >> 2, wc = wid & 3, fr = lane & 15, fq = lane >> 4;
    const int K = g.K, nt = K / BK;
    unsigned voffA[2], voffB[2];
#pragma unroll
    for (int i = 0; i < 2; ++i) { int R, C; stage_rc(tid * 16 + i * 8192, R, C); const int Rb = Epi::PERM ? ((R & ~31) + perm32(R & 31)) : R;
        voffA[i] = (unsigned)(R * K + C) * 2u; voffB[i] = (unsigned)(Rb * K + C) * 2u; }
    const size_t kstep = (size_t)(BK * 2);
    const size_t hstep = (size_t)HALF * K * 2;
    const size_t tstep = 2 * hstep;
    const unsigned ldsw = (unsigned)wid * 1024u;
    const int aoff = lds_byte(wr * 64 + fr, fq * 8), boff = lds_byte(wc * 32 + fr, fq * 8);
#define PG8_SA(b, h) (((b) * 2 + (h)) * HTB)
#define PG8_SB(b, h) ((4 + (b) * 2 + (h)) * HTB)
#define PG8_STAGE(bufoff, gbase, voff) do { _Pragma("unroll") for (int _i = 0; _i < 2; ++_i) \
        __builtin_amdgcn_global_load_lds((const unsigned*)((const char*)(gbase) + (voff)[_i]), (PG8_LAS unsigned*)(lds + (bufoff) + ldsw + _i * 8192), 16, 0, 0); } while (0)
#define PG8_LDA(dst, b, h) do { _Pragma("unroll") for (int m = 0; m < 4; ++m) _Pragma("unroll") for (int k = 0; k < 2; ++k) dst[m][k] = *(const PG8_LAS bf16x8*)(lds + PG8_SA(b, h) + aoff + m * 2048 + k * 1024); } while (0)
#define PG8_LDB(dst, b, h) do { _Pragma("unroll") for (int n = 0; n < 2; ++n) _Pragma("unroll") for (int k = 0; k < 2; ++k) dst[n][k] = *(const PG8_LAS bf16x8*)(lds + PG8_SB(b, h) + boff + n * 2048 + k * 1024); } while (0)
#define PG8_MMA(ai, bj, At, Bt) do { __builtin_amdgcn_s_setprio(1); _Pragma("unroll") for (int m = 0; m < 4; ++m) _Pragma("unroll") for (int n = 0; n < 2; ++n) _Pragma("unroll") for (int k = 0; k < 2; ++k) \
        acc[ai][bj][m][n] = __builtin_amdgcn_mfma_f32_16x16x32_bf16(Bt[n][k], At[m][k], acc[ai][bj][m][n], 0, 0, 0); __builtin_amdgcn_s_setprio(0); } while (0)
#define PG8_WAIT_V(n) asm volatile("s_waitcnt vmcnt(" #n ")" ::: "memory")
#define PG8_WAIT_L(n) asm volatile("s_waitcnt lgkmcnt(" #n ")" ::: "memory")
#define PG8_BAR __builtin_amdgcn_s_barrier()
#define PG8_SCHED __builtin_amdgcn_sched_barrier(0)
    Unit cur, nxt; int ui = 0;
    if (!S.next(0, cur)) return;
    f32x4 acc[2][2][4][2];
#pragma unroll
    for (int a = 0; a < 2; ++a)
#pragma unroll
        for (int b = 0; b < 2; ++b)
#pragma unroll
            for (int m = 0; m < 4; ++m)
#pragma unroll
                for (int n = 0; n < 2; ++n) acc[a][b][m][n] = (f32x4){0.f, 0.f, 0.f, 0.f};
    bf16x8 At[4][2], B0[2][2], B1[2][2];
    const char* cA = (const char*)g.A + (size_t)cur.pm * tstep; const char* cB = (const char*)g.Bt + (size_t)cur.pn * tstep;
    S.a_ready(cur);
    if constexpr (SP2) {
        PG8_STAGE(PG8_SB(0, 0), cB, voffB); PG8_STAGE(PG8_SB(0, 1), cB + hstep, voffB); PG8_STAGE(PG8_SA(0, 0), cA, voffA); PG8_STAGE(PG8_SA(0, 1), cA + hstep, voffA);
        if (wr == 1) PG8_BAR;
        PG8_WAIT_V(2); PG8_BAR;
        PG8_STAGE(PG8_SB(1, 0), cB + kstep, voffB); PG8_STAGE(PG8_SA(1, 0), cA + kstep, voffA); PG8_STAGE(PG8_SB(1, 1), cB + hstep + kstep, voffB);
        PG8_WAIT_V(6); PG8_BAR;
    } else {
        PG8_STAGE(PG8_SB(0, 0), cB, voffB); PG8_STAGE(PG8_SA(0, 0), cA, voffA); PG8_STAGE(PG8_SB(0, 1), cB + hstep, voffB); PG8_STAGE(PG8_SA(0, 1), cA + hstep, voffA);
        if (wr == 1) PG8_BAR;
        PG8_WAIT_V(4); PG8_BAR;
        PG8_STAGE(PG8_SB(1, 0), cB + kstep, voffB); PG8_STAGE(PG8_SA(1, 0), cA + kstep, voffA); PG8_STAGE(PG8_SB(1, 1), cB + hstep + kstep, voffB);
        PG8_WAIT_V(6); PG8_BAR;
    }
    for (;;) {
        const bool has_next = S.next(ui + 1, nxt);
        const char* nA = has_next ? (const char*)g.A + (size_t)nxt.pm * tstep : cA; const char* nB = has_next ? (const char*)g.Bt + (size_t)nxt.pn * tstep : cB;
        for (int t = 0; t < nt; t += 2) {
            const bool last = (t == nt - 2);
            const char* a1 = cA + (size_t)(t + 1) * kstep;
            const char* a2 = last ? nA : cA + (size_t)(t + 2) * kstep; const char* b2 = last ? nB : cB + (size_t)(t + 2) * kstep;
            const char* a3 = a2 + kstep; const char* b3 = b2 + kstep;
            if (last && has_next) S.a_ready(nxt);
            if constexpr (SP2) {
            PG8_LDB(B0, 0, 0); PG8_LDB(B1, 0, 1); PG8_SCHED; PG8_LDA(At, 0, 0); PG8_STAGE(PG8_SA(1, 1), a1 + hstep, voffA);
            PG8_WAIT_V(8); PG8_WAIT_L(0); PG8_BAR; PG8_MMA(0, 0, At, B0); PG8_MMA(0, 1, At, B1); PG8_BAR; PG8_SCHED;
            PG8_LDA(At, 0, 1); PG8_STAGE(PG8_SB(0, 0), b2, voffB); PG8_STAGE(PG8_SB(0, 1), b2 + hstep, voffB); PG8_STAGE(PG8_SA(0, 0), a2, voffA);
            PG8_WAIT_V(8); PG8_WAIT_L(0); PG8_BAR; PG8_MMA(1, 0, At, B0); PG8_MMA(1, 1, At, B1); PG8_BAR; PG8_SCHED;
            PG8_LDB(B0, 1, 0); PG8_LDB(B1, 1, 1); PG8_SCHED; PG8_LDA(At, 1, 0); PG8_STAGE(PG8_SA(0, 1), a2 + hstep, voffA);
            PG8_WAIT_V(8); PG8_WAIT_L(0); PG8_BAR; PG8_MMA(0, 0, At, B0); PG8_MMA(0, 1, At, B1); PG8_BAR; PG8_SCHED;
            PG8_LDA(At, 1, 1); PG8_STAGE(PG8_SB(1, 0), b3, voffB); PG8_STAGE(PG8_SB(1, 1), b3 + hstep, voffB); PG8_STAGE(PG8_SA(1, 0), a3, voffA);
            PG8_WAIT_V(8); PG8_WAIT_L(0); PG8_BAR; PG8_MMA(1, 0, At, B0); PG8_MMA(1, 1, At, B1); PG8_BAR; PG8_SCHED;
            } else {
            PG8_LDB(B0, 0, 0); PG8_SCHED; PG8_LDA(At, 0, 0); PG8_STAGE(PG8_SA(1, 1), a1 + hstep, voffA);
            PG8_WAIT_L(8); PG8_BAR; PG8_WAIT_L(0); PG8_MMA(0, 0, At, B0); PG8_BAR; PG8_SCHED;
            PG8_LDB(B1, 0, 1); PG8_STAGE(PG8_SB(0, 0), b2, voffB);
            PG8_BAR; PG8_WAIT_L(0); PG8_MMA(0, 1, At, B1); PG8_BAR;
            PG8_LDA(At, 0, 1); PG8_STAGE(PG8_SA(0, 0), a2, voffA);
            PG8_BAR; PG8_WAIT_L(0); PG8_MMA(1, 0, At, B0); PG8_BAR; PG8_SCHED;
            PG8_STAGE(PG8_SB(0, 1), b2 + hstep, voffB);
            PG8_WAIT_V(6); PG8_BAR; PG8_MMA(1, 1, At, B1); PG8_BAR;
            PG8_LDB(B0, 1, 0); PG8_SCHED; PG8_LDA(At, 1, 0); PG8_STAGE(PG8_SA(0, 1), a2 + hstep, voffA);
            PG8_WAIT_L(8); PG8_BAR; PG8_WAIT_L(0); PG8_MMA(0, 0, At, B0); PG8_BAR; PG8_SCHED;
            PG8_LDB(B1, 1, 1); PG8_STAGE(PG8_SB(1, 0), b3, voffB);
            PG8_BAR; PG8_WAIT_L(0); PG8_MMA(0, 1, At, B1); PG8_BAR;
            PG8_LDA(At, 1, 1); PG8_STAGE(PG8_SA(1, 0), a3, voffA);
            PG8_BAR; PG8_WAIT_L(0); PG8_MMA(1, 0, At, B0); PG8_BAR; PG8_SCHED;
            PG8_STAGE(PG8_SB(1, 1), b3 + hstep, voffB);
            PG8_WAIT_V(6); PG8_BAR; PG8_MMA(1, 1, At, B1); PG8_BAR;
            }
        }
        if constexpr (ALIGN_EPI) { if (wr == 0) PG8_BAR; }
        if constexpr (!Epi::AFTER_DRAIN) { E(acc, cur, wr, wc, fr, fq); S.done(cur); }
        if (!has_next) break;
#pragma unroll
        for (int a = 0; a < 2; ++a)
#pragma unroll
            for (int b = 0; b < 2; ++b)
#pragma unroll
                for (int m = 0; m < 4; ++m)
#pragma unroll
                    for (int n = 0; n < 2; ++n) acc[a][b][m][n] = (f32x4){0.f, 0.f, 0.f, 0.f};
        cur = nxt; cA = nA; cB = nB; ++ui;
        if constexpr (ALIGN_EPI) { if (wr == 1) PG8_BAR; }
    }
    PG8_WAIT_V(0);
    if constexpr (!ALIGN_EPI) { if (wr == 0) PG8_BAR; }
    PG8_BAR;
#undef PG8_SA
#undef PG8_SB
#undef PG8_STAGE
#undef PG8_LDA
#undef PG8_LDB
#undef PG8_MMA
#undef PG8_WAIT_V
#undef PG8_WAIT_L
#undef PG8_BAR
#undef PG8_SCHED
}
}

namespace att {
constexpr int D = 128, NW = 8, QBLK = 32, KVBLK = 64;
constexpr float SCALE = 0.088388347648318440f;
constexpr float THR = 8.f;
constexpr size_t SHM_V = KVBLK * D * 2, SHM_K = KVBLK * D * 2, SHM_ATTN = 2 * SHM_V + 2 * SHM_K + NW * 64 * 4;
#define KSWZ(row, colB) ((row) * 256 + ((colB) ^ (((row) & 7) << 4)))
#define SBAR() __builtin_amdgcn_sched_barrier(0)
__device__ __forceinline__ int crow(int r, int hi) { return (r & 3) + 8 * (r >> 2) + 4 * hi; }

template <bool MOBA>
__device__ __forceinline__ void partialSM(f32x16& p0, f32x16& p1, float& m_reg, float& mn, float& alpha, int t, int qrow, int hi, unsigned selmask) {
  constexpr float C = SCALE * 1.4426950408889634f;
  if constexpr (MOBA) {
    if (t < 4) { const int kb = t * 64 + 4 * hi;
#pragma unroll
      for (int r = 0; r < 16; ++r) { const int kk = kb + (r & 3) + 8 * (r >> 2); p0[r] = (kk > qrow) ? -1e30f : p0[r]; p1[r] = (kk + 32 > qrow) ? -1e30f : p1[r]; }
    } else { const bool keep = (selmask >> ((t - 4) >> 2)) & 1u;
#pragma unroll
      for (int r = 0; r < 16; ++r) { p0[r] = keep ? p0[r] : -1e30f; p1[r] = keep ? p1[r] : -1e30f; } }
  }
  float pmax = p0[0];
#pragma unroll
  for (int r = 1; r < 16; ++r) pmax = fmaxf(pmax, p0[r]);
#pragma unroll
  for (int r = 0; r < 16; ++r) pmax = fmaxf(pmax, p1[r]);
  { auto rr = __builtin_amdgcn_permlane32_swap(__float_as_uint(pmax), __float_as_uint(pmax), false, false);
    pmax = fmaxf(__uint_as_float(rr[0]), __uint_as_float(rr[1])); }
  if (__builtin_expect(__all(pmax - m_reg <= THR / SCALE), 1)) { mn = m_reg; alpha = 1.f; }
  else { mn = fmaxf(m_reg, pmax); alpha = __builtin_amdgcn_exp2f((m_reg - mn) * C); m_reg = mn; }
  float mnC = -mn * C;
#pragma unroll
  for (int r = 0; r < 16; ++r) p0[r] = fmaf(p0[r], C, mnC);
#pragma unroll
  for (int r = 0; r < 16; ++r) p1[r] = fmaf(p1[r], C, mnC);
#pragma unroll
  for (int r = 0; r < 16; ++r) p0[r] = __builtin_amdgcn_exp2f(p0[r]);
}
__device__ __forceinline__ void finishSM(f32x16& p0, f32x16& p1, float alpha, float& l_reg, bf16x8& pa0, bf16x8& pa1, bf16x8& pa2, bf16x8& pa3) {
#pragma unroll
  for (int r = 0; r < 16; ++r) p1[r] = __builtin_amdgcn_exp2f(p1[r]);
  float ps = 0;
#pragma unroll
  for (int r = 0; r < 16; ++r) ps += p0[r];
#pragma unroll
  for (int r = 0; r < 16; ++r) ps += p1[r];
  { auto rr = __builtin_amdgcn_permlane32_swap(__float_as_uint(ps), __float_as_uint(ps), false, false);
    ps = __uint_as_float(rr[0]) + __uint_as_float(rr[1]); }
  l_reg = l_reg * alpha + ps;
#define PK4(P, BASE, OUT) do { unsigned a0 = cvtpk(P[BASE + 0], P[BASE + 1]), a1 = cvtpk(P[BASE + 2], P[BASE + 3]);   \
    unsigned b0 = cvtpk(P[BASE + 4], P[BASE + 5]), b1 = cvtpk(P[BASE + 6], P[BASE + 7]);                              \
    auto r0 = __builtin_amdgcn_permlane32_swap(a0, b0, false, false); auto r1 = __builtin_amdgcn_permlane32_swap(a1, b1, false, false); \
    u32x4 w = {r0[0], r1[0], r0[1], r1[1]}; OUT = *reinterpret_cast<bf16x8*>(&w); } while (0)
  PK4(p0, 0, pa0); PK4(p0, 8, pa1); PK4(p1, 0, pa2); PK4(p1, 8, pa3);
#undef PK4
}
__device__ __forceinline__ void qkt(f32x16& p0, f32x16& p1, const char* Ks, const bf16x8* qr, const int (&ka)[4]) {
  p0 = f32x16{}; p1 = f32x16{};
#pragma unroll
  for (int d0 = 0; d0 < 8; ++d0) {
    bf16x8 b0 = *reinterpret_cast<const bf16x8*>(Ks + ka[d0 & 3] + (d0 >> 2) * 128);
    bf16x8 b1 = *reinterpret_cast<const bf16x8*>(Ks + ka[d0 & 3] + (d0 >> 2) * 128 + 8192);
    p0 = __builtin_amdgcn_mfma_f32_32x32x16_bf16(b0, qr[d0], p0, 0, 0, 0);
    p1 = __builtin_amdgcn_mfma_f32_32x32x16_bf16(b1, qr[d0], p1, 0, 0, 0); }
}
__device__ __forceinline__ void qkt1(f32x16& p0, const char* Ks, const bf16x8* qr, const int (&ka)[4]) {
  p0 = f32x16{};
#pragma unroll
  for (int d0 = 0; d0 < 8; ++d0) {
    bf16x8 b0 = *reinterpret_cast<const bf16x8*>(Ks + ka[d0 & 3] + (d0 >> 2) * 128);
    p0 = __builtin_amdgcn_mfma_f32_32x32x16_bf16(b0, qr[d0], p0, 0, 0, 0); }
}
__device__ __forceinline__ int v_st(int k, int c) { const int kk = (k & ~0xC) | ((k & 4) << 1) | ((k & 8) >> 1); return ((kk >> 3) * 4 + (c >> 5)) * 512 + ((kk & 7) * 32 + (c & 31)) * 2; }
__device__ __forceinline__ int v_rd_base(int lane) { return ((lane & 3) << 3) | (((lane >> 2) & 3) << 6) | (((lane >> 4) & 1) << 5) | (((lane >> 5) & 1) << 8); }
constexpr int v_rd_off(int d0, int ks, int half) { return d0 * 512 + ks * 4096 + half * 2048; }
template <int OFF> __device__ __forceinline__ s16x4 tr_read(int vb) {
  s16x4 r; asm volatile("ds_read_b64_tr_b16 %0, %1 offset:%2" : "=&v"(r) : "v"(vb), "i"(OFF) : "memory"); return r;
}
template <int D0> __device__ __forceinline__ void pv_one(f32x16& od, int vb, bf16x8 pa0, bf16x8 pa1, bf16x8 pa2, bf16x8 pa3) {
  const s16x4 l0 = tr_read<v_rd_off(D0, 0, 0)>(vb), h0 = tr_read<v_rd_off(D0, 0, 1)>(vb), l1 = tr_read<v_rd_off(D0, 1, 0)>(vb), h1 = tr_read<v_rd_off(D0, 1, 1)>(vb);
  const s16x4 l2 = tr_read<v_rd_off(D0, 2, 0)>(vb), h2 = tr_read<v_rd_off(D0, 2, 1)>(vb), l3 = tr_read<v_rd_off(D0, 3, 0)>(vb), h3 = tr_read<v_rd_off(D0, 3, 1)>(vb);
  asm volatile("s_waitcnt lgkmcnt(0)" ::: "memory"); SBAR();
#define PK(L, H) (bf16x8){L[0], L[1], L[2], L[3], H[0], H[1], H[2], H[3]}
  od = __builtin_amdgcn_mfma_f32_32x32x16_bf16(pa0, PK(l0, h0), od, 0, 0, 0);
  od = __builtin_amdgcn_mfma_f32_32x32x16_bf16(pa1, PK(l1, h1), od, 0, 0, 0);
  od = __builtin_amdgcn_mfma_f32_32x32x16_bf16(pa2, PK(l2, h2), od, 0, 0, 0);
  od = __builtin_amdgcn_mfma_f32_32x32x16_bf16(pa3, PK(l3, h3), od, 0, 0, 0);
#undef PK
}
__device__ __forceinline__ void pv_d0(f32x16* o, int vb, bf16x8 pa0, bf16x8 pa1, bf16x8 pa2, bf16x8 pa3) {
  pv_one<0>(o[0], vb, pa0, pa1, pa2, pa3); pv_one<1>(o[1], vb, pa0, pa1, pa2, pa3); pv_one<2>(o[2], vb, pa0, pa1, pa2, pa3); pv_one<3>(o[3], vb, pa0, pa1, pa2, pa3);
}

template <int LDQ, int LDK, bool MOBA, int SDEPTH>
__device__ __forceinline__ void attn_unit(const bf16* Qb, const bf16* Kh, const bf16* Vh, bf16* Ob, int jblk, const float* kmp, char* lds) {
  int tid = threadIdx.x; asm volatile("" : "+v"(tid));
  const int wid = __builtin_amdgcn_readfirstlane(tid >> 6), lane = tid & 63, r32 = lane & 31, hi = lane >> 5;
  char* V_lds = lds; char* K_lds = lds + 2 * SHM_V;
  float* ws = (float*)(lds + 2 * SHM_V + 2 * SHM_K) + wid * 64; float* li_l = ws; float* al_l = ws + 32;
  float m_reg = -1e30f, l_reg = 0; f32x16 o[4] = {}; bf16x8 qr[8];
  const bf16* Qw = Qb + (long)(wid * QBLK + r32) * LDQ + hi * 8;
#pragma unroll
  for (int d0 = 0; d0 < 8; ++d0) qr[d0] = *reinterpret_cast<const bf16x8*>(Qw + d0 * 16);
  const int sr = tid >> 4, sc = (tid & 15) * 8, vst0 = v_st(sr, sc), vst1 = v_st(32 + sr, sc);
  const unsigned goff = (unsigned)(sr * LDK + sc) * 2u;
  const int vb0 = (int)(uintptr_t)V_lds + v_rd_base(lane);
  const int qrow = wid * QBLK + r32;
  int ka[4];
#pragma unroll
  for (int i = 0; i < 4; ++i) ka[i] = r32 * 256 + (((2 * i + hi) ^ (r32 & 7)) << 4);
  unsigned selmask = 0;
  struct { bf16x8 vs0, vs1, ks0, ks1; } sr_[SDEPTH];
  const int NT = MOBA ? 4 * (jblk + 1) : 4;
#define KOFF(t) (MOBA ? ((t) < 4 ? jblk * 256 + (t) * 64 : ((t) - 4) * 64) : (t) * 64)
#define SLOAD(i, k0) do { const char* kb_ = (const char*)Kh + (size_t)(k0) * (LDK * 2); const char* vb_ = (const char*)Vh + (size_t)(k0) * (LDK * 2); \
    sr_[i].vs0 = *reinterpret_cast<const bf16x8*>(vb_ + goff); sr_[i].vs1 = *reinterpret_cast<const bf16x8*>(vb_ + 32 * LDK * 2 + goff); \
    sr_[i].ks0 = *reinterpret_cast<const bf16x8*>(kb_ + goff); sr_[i].ks1 = *reinterpret_cast<const bf16x8*>(kb_ + 32 * LDK * 2 + goff); } while (0)
#define SWRITE(b, i) do { *(bf16x8*)(V_lds + (b) * SHM_V + vst0) = sr_[i].vs0;          \
    *(bf16x8*)(V_lds + (b) * SHM_V + vst1) = sr_[i].vs1; int kc = sc * 2;               \
    *(bf16x8*)(K_lds + (b) * SHM_K + KSWZ(sr, kc)) = sr_[i].ks0;                       \
    *(bf16x8*)(K_lds + (b) * SHM_K + KSWZ(32 + sr, kc)) = sr_[i].ks1; } while (0)
#define SWAIT() do { if constexpr (SDEPTH == 2) asm volatile("s_waitcnt vmcnt(4)" ::: "memory"); else asm volatile("s_waitcnt vmcnt(0)" ::: "memory"); } while (0)
#define RESC(a) do { if (__any((a) < 1.f)) { if (hi == 0) al_l[r32] = (a); asm volatile("s_waitcnt lgkmcnt(0)" ::: "memory"); \
    _Pragma("unroll") for (int d = 0; d < 4; ++d) _Pragma("unroll") for (int r = 0; r < 16; ++r) o[d][r] *= al_l[crow(r, hi)]; } } while (0)
  f32x16 pA0, pA1, pB0, pB1; float mnA, mnB, alA, alB; bf16x8 pa0, pa1, pa2, pa3;
  constexpr int SE = 0, SO = SDEPTH - 1;
  SLOAD(SE, KOFF(0));
  if constexpr (MOBA) {
    const int gr = tid >> 4, gc = (tid & 15) * 8; f32x4 a = {0.f, 0.f, 0.f, 0.f}, b = {0.f, 0.f, 0.f, 0.f};
    if (gr < jblk) { const float* p0_ = kmp + (size_t)gr * 2048 + gc; const f32x4 a0 = *(const f32x4*)p0_, a1 = *(const f32x4*)(p0_ + 4), b0 = *(const f32x4*)(p0_ + 1024), b1 = *(const f32x4*)(p0_ + 1028);
      a = (a0 + b0) * (1.0f / 256.0f); b = (a1 + b1) * (1.0f / 256.0f); }
    u32x4 w = {pk2(a[0], a[1]), pk2(a[2], a[3]), pk2(b[0], b[1]), pk2(b[2], b[3])};
    *(u32x4*)(K_lds + SHM_K + KSWZ(gr, gc * 2)) = w;
  }
  asm volatile("s_waitcnt vmcnt(0)" ::: "memory"); SWRITE(0, SE); __syncthreads();
  qkt(pA0, pA1, K_lds, qr, ka);
  if constexpr (MOBA) {
    f32x16 g; qkt1(g, K_lds + SHM_K, qr, ka);
    float gv[16];
#pragma unroll
    for (int r = 0; r < 8; ++r) { auto rr = __builtin_amdgcn_permlane32_swap(__float_as_uint(g[r]), __float_as_uint(g[r]), false, false);
      const float lo_ = __uint_as_float(rr[0]), hi_ = __uint_as_float(rr[1]);
      const int n0 = (r & 3) + 8 * (r >> 2); gv[n0] = lo_; gv[n0 + 4] = hi_; }
#pragma unroll
    for (int n = 0; n < 16; ++n) gv[n] = (n < jblk) ? gv[n] : -3e38f;
#pragma unroll
    for (int k = 0; k < 3; ++k) { float best = gv[0];
#pragma unroll
      for (int n = 1; n < 16; ++n) best = fmaxf(best, gv[n]);
      int idx = 16;
#pragma unroll
      for (int n = 15; n >= 0; --n) idx = (gv[n] == best) ? n : idx;
      if (best > -1e38f) selmask |= 1u << idx;
#pragma unroll
      for (int n = 0; n < 16; ++n) gv[n] = (n == idx) ? -3e38f : gv[n]; }
  }
  partialSM<MOBA>(pA0, pA1, m_reg, mnA, alA, 0, qrow, hi, selmask);
  SLOAD(SO, KOFF(1)); if constexpr (SDEPTH == 2) { if (2 < NT) SLOAD(SE, KOFF(2)); }
  if constexpr (MOBA) __syncthreads();
  SWAIT(); SWRITE(1, SO); __syncthreads();
  for (int j = 1; j + 1 < NT; j += 2) {
    SBAR(); qkt(pB0, pB1, K_lds + SHM_K, qr, ka);
    finishSM(pA0, pA1, alA, l_reg, pa0, pa1, pa2, pa3); SBAR();
    SLOAD(SO, KOFF(j + SDEPTH)); SBAR();
    pv_d0(o, vb0, pa0, pa1, pa2, pa3); partialSM<MOBA>(pB0, pB1, m_reg, mnB, alB, j, qrow, hi, selmask);
    __syncthreads(); SWAIT(); SWRITE(0, SE);
    RESC(alB); __syncthreads();
    SBAR(); qkt(pA0, pA1, K_lds, qr, ka);
    finishSM(pB0, pB1, alB, l_reg, pa0, pa1, pa2, pa3); SBAR();
    if (SDEPTH == 1 || j + 3 < NT) SLOAD(SE, KOFF(j + 1 + SDEPTH)); SBAR();
    pv_d0(o, vb0 + (int)SHM_V, pa0, pa1, pa2, pa3); partialSM<MOBA>(pA0, pA1, m_reg, mnA, alA, j + 1, qrow, hi, selmask);
    __syncthreads(); SWAIT(); SWRITE(1, SO);
    RESC(alA); __syncthreads();
  }
  SBAR(); qkt(pB0, pB1, K_lds + SHM_K, qr, ka);
  finishSM(pA0, pA1, alA, l_reg, pa0, pa1, pa2, pa3); SBAR();
  pv_d0(o, vb0, pa0, pa1, pa2, pa3); partialSM<MOBA>(pB0, pB1, m_reg, mnB, alB, NT - 1, qrow, hi, selmask);
  __syncthreads(); RESC(alB);
  finishSM(pB0, pB1, alB, l_reg, pa0, pa1, pa2, pa3); SBAR();
  pv_d0(o, vb0 + (int)SHM_V, pa0, pa1, pa2, pa3);
  if (hi == 0) li_l[r32] = l_reg; asm volatile("s_waitcnt lgkmcnt(0)" ::: "memory");
  float rli[16];
#pragma unroll
  for (int r = 0; r < 16; ++r) rli[r] = __builtin_amdgcn_rcpf(li_l[crow(r, hi)]);
  __syncthreads();
  char* ost = lds + wid * 8192;
#pragma unroll
  for (int r = 0; r < 16; ++r) { const int orow = crow(r, hi);
#pragma unroll
    for (int d0 = 0; d0 < 4; ++d0) *(unsigned short*)(ost + orow * 256 + (d0 * 32 + r32) * 2) = (unsigned short)f2bf(o[d0][r] * rli[r]); }
  asm volatile("s_waitcnt lgkmcnt(0)" ::: "memory");
  bf16* Ow = Ob + (long)(wid * QBLK) * LDQ;
#pragma unroll
  for (int i = 0; i < 8; ++i) { const int row = i * 4 + (lane >> 4), ch = lane & 15; const u32x4 v = *(const u32x4*)(ost + row * 256 + ch * 16);
    *(u32x4*)(Ow + (long)row * LDQ + ch * 8) = v; }
  __syncthreads();
#undef KOFF
#undef SLOAD
#undef SWRITE
#undef SWAIT
#undef RESC
}
}

#ifndef ATT_SD_MEM
#define ATT_SD_MEM 1
#endif
#ifndef ATT_SD_MOBA
#define ATT_SD_MOBA 1
#endif
struct Args {
    const float* in[16]; float* out; unsigned char* ws; int ph_lo, ph_hi;
};
struct Frame {
    LAS unsigned char* lds; char* ldsg;
    int wave, vcu, G;
};
__device__ __forceinline__ int fresh_tid() { int t = threadIdx.x; asm volatile("" : "+v"(t)); return t; }

template <int MAP>
__device__ __forceinline__ void transpose_item(const float* W, int ldw, bf16* dst, int ldd, int row_off, int koff, const float* sc, LAS float* scr, int kb, int nb, int lane) {
    const int k0 = 64 * kb, n0 = 32 * nb;
#pragma unroll 8
    for (int i = 0; i < 32; ++i) { const int kk = 2 * i + (lane >> 5); float v = W[(size_t)(k0 + kk) * ldw + n0 + (lane & 31)]; if (sc) v *= sc[k0 + kk]; scr[kk * 33 + (lane & 31)] = v; }
    LDS_WAIT(); asm volatile("" ::: "memory");
    const int c = lane & 7;
#pragma unroll
    for (int j = 0; j < 4; ++j) { const int n = (lane >> 3) + 8 * j; const LAS float* s = scr + (8 * c) * 33 + n;
        u32x4 o; o.x = pk2(s[0 * 33], s[1 * 33]); o.y = pk2(s[2 * 33], s[3 * 33]); o.z = pk2(s[4 * 33], s[5 * 33]); o.w = pk2(s[6 * 33], s[7 * 33]);
        const int ns = n0 + n; int row;
        if (MAP == 1 && ns < 1024) { const int d = ns & 127; row = row_off + (ns & ~127) + 32 * ((d >> 4) & 3) + 8 * ((d >> 2) & 3) + 4 * (d >> 6) + (d & 3); } else row = row_off + ns;
        *(u32x4*)(dst + (size_t)row * ldd + koff + k0 + 8 * c) = o; }
    LDS_WAIT(); asm volatile("" ::: "memory");
}

__device__ __forceinline__ void phase0(const Args& a, Frame& F) {
    unsigned char* ws = a.ws;
    const int lane = fresh_tid() & 63;
    const int gw = F.vcu * NWAVES + F.wave, NGW = F.G * NWAVES;
    const int gt = gw * 64 + lane, NGT = NGW * 64;
    LAS float* scr = (LAS float*)(F.lds + F.wave * 16384);
    const float* x = a.in[0]; const float* mem = a.in[1]; const float* g_mix = a.in[2]; const float* w_in = a.in[3]; const float* w_out = a.in[4]; const float* w_mkv = a.in[5];
    const float* pool_w = a.in[6]; const float* pool_sc = a.in[7]; const float* g_kv = a.in[8]; const float* w_kv = a.in[9]; const float* g_ffn = a.in[10]; const float* wq = a.in[11];
    const float* subk = a.in[12]; const float* pu = a.in[13]; const float* pv = a.in[14];
    constexpr int I1 = 16 * 48, I2 = 16 * 48, I3 = 16 * 64, I4 = 8 * 32, I5 = 24 * 32, I6 = 2 * 16 * 32, I7 = 2 * 16 * 64;
    constexpr int NIT = I1 + I2 + I3 + I4 + I5 + I6 + I7;
    for (int it = gw; it < NIT; it += NGW) {
        int r = it;
        if (r < I1) { transpose_item<0>(w_in, MIXW, (bf16*)(ws + WS_WIN0), DM, 0, 0, g_mix, scr, r / 48, r % 48, lane); continue; } r -= I1;
        if (r < I2) { transpose_item<1>(w_in + (size_t)DM * MIXW, MIXW, (bf16*)(ws + WS_WC4), DM, 2048, 0, g_mix + DM, scr, r / 48, r % 48, lane); continue; } r -= I2;
        if (r < I3) { transpose_item<1>(w_kv, 2048, (bf16*)(ws + WS_WC4), DM, 0, 0, g_kv, scr, r / 64, r % 64, lane); continue; } r -= I3;
        if (r < I4) { transpose_item<0>(w_out + (size_t)1024 * DM, DM, (bf16*)(ws + WS_WC0), MIXW, 0, 1024, nullptr, scr, r / 32, r % 32, lane); continue; } r -= I4;
        if (r < I5) { transpose_item<0>(w_out + (size_t)MIXW * DM, DM, (bf16*)(ws + WS_WOUT1), MIXW, 0, 0, nullptr, scr, r / 32, r % 32, lane); continue; } r -= I5;
        if (r < I6) { const int l = r / 512, q = r % 512; transpose_item<0>(w_mkv + (size_t)l * DM * 1024, 1024, (bf16*)(ws + WS_WMKV), DM, l * 1024, 0, nullptr, scr, q / 32, q % 32, lane); continue; } r -= I6;
        { const int l = r / 1024, q = r % 1024; transpose_item<0>(wq + (size_t)l * DM * 2048, 2048, (bf16*)(ws + (l ? WS_WQ1 : WS_WQ0)), DM, 0, 0, g_ffn + l * DM, scr, q / 64, q % 64, lane); }
    }
    for (int it = gw; it < 2048; it += NGW) {
        const int itu = __builtin_amdgcn_readfirstlane(it); const int g = itu >> 9, cg8 = (itu >> 4) & 31, nch = itu & 15; const int n = nch * 64 + lane;
        float acc[8];
#pragma unroll
        for (int i = 0; i < 8; ++i) acc[i] = 0.f;
        const float* pw = pool_w + ((size_t)g * 256 + cg8 * 8) * 256;
#pragma unroll 1
        for (int k = 0; k < 4; ++k) { float cf[8]; const float sc = pool_sc[g * 256 + k * 64 + lane];
#pragma unroll
            for (int i = 0; i < 8; ++i) cf[i] = pw[i * 256 + k * 64 + lane] * sc;
            float wv[64];
#pragma unroll
            for (int l = 0; l < 64; ++l) wv[l] = w_out[(size_t)(g * 256 + k * 64 + l) * DM + n];
#pragma unroll
            for (int l = 0; l < 64; ++l) {
#pragma unroll
                for (int i = 0; i < 8; ++i) acc[i] = fmaf(__builtin_bit_cast(float, __builtin_amdgcn_readlane(__builtin_bit_cast(int, cf[i]), l)), wv[l], acc[i]); } }
        u32x4 o; o.x = pk2(acc[0], acc[1]); o.y = pk2(acc[2], acc[3]); o.z = pk2(acc[4], acc[5]); o.w = pk2(acc[6], acc[7]);
        *(u32x4*)((bf16*)(ws + WS_WC0) + (size_t)n * MIXW + g * 256 + cg8 * 8) = o;
    }
    {
        const size_t n8a = (size_t)2 * 16 * 128 * 128 / 8, n8b = (size_t)2048 * 1024 / 8;
        for (size_t i = gt; i < n8a + n8b; i += NGT) { const bool A = i < n8a; const size_t j = A ? i : i - n8a; const float* src = (A ? subk : mem) + j * 8; bf16* dst = (bf16*)(ws + (A ? WS_SUBK : WS_MEMB)) + j * 8;
            const f32x4 v0 = *(const f32x4*)src, v1 = *(const f32x4*)(src + 4); u32x4 o = {pk2(v0[0], v0[1]), pk2(v0[2], v0[3]), pk2(v1[0], v1[1]), pk2(v1[2], v1[3])}; *(u32x4*)dst = o; }
    }
    for (int r = gw; r < 4 * NEXP; r += NGW) { const int tb = r / (2 * NEXP), rr = r % (2 * NEXP), l = rr / NEXP;
        const f32x4* src = (const f32x4*)((tb ? pv : pu) + (size_t)rr * DM) + lane; f32x4 v[4];
#pragma unroll
        for (int i = 0; i < 4; ++i) v[i] = src[64 * i];
        if (!tb) { const f32x4* gp = (const f32x4*)(g_ffn + l * DM) + lane;
#pragma unroll
            for (int i = 0; i < 4; ++i) v[i] *= gp[64 * i]; }
        float am = 0.f;
#pragma unroll
        for (int i = 0; i < 4; ++i) am = fmaxf(fmaxf(fmaxf(am, fabsf(v[i][0])), fmaxf(fabsf(v[i][1]), fabsf(v[i][2]))), fabsf(v[i][3]));
#pragma unroll
        for (int o = 1; o < 64; o <<= 1) am = fmaxf(am, __shfl_xor(am, o));
        const int eb = (int)((__builtin_bit_cast(unsigned, am) >> 23) & 0xffu);
        const float sc = (eb < 16) ? 1.0f : __builtin_bit_cast(float, (unsigned)(127 + 7 + 127 - eb) << 23);
        const float isc = (eb < 16) ? 1.0f : __builtin_bit_cast(float, (unsigned)(eb - 7) << 23);
        unsigned* dst = (unsigned*)(ws + (tb ? WS_VB : WS_UB) + (size_t)rr * DM) + lane;
#pragma unroll
        for (int i = 0; i < 4; ++i) { int w = __builtin_amdgcn_cvt_pk_fp8_f32(v[i][0] * sc, v[i][1] * sc, 0, false); w = __builtin_amdgcn_cvt_pk_fp8_f32(v[i][2] * sc, v[i][3] * sc, w, true); dst[64 * i] = (unsigned)w; }
        if (lane == 0) ((float*)(ws + (tb ? WS_VSC : WS_USC)))[rr] = isc; }
    for (int i = gt; i < SEQ * 64; i += NGT) { const int pos = i >> 6, fi = i & 63; const float inv = exp2f(-(float)fi * 0.20762050593046015f);
        float sn, cs_; sincosf((float)pos * inv, &sn, &cs_); f32x2 cs = {cs_, sn}; *(f32x2*)((float*)(ws + WS_ROPE) + (size_t)i * 2) = cs; }
    for (int t = gw; t < T; t += NGW) { const f32x4* xr = (const f32x4*)(x + (size_t)t * DM) + lane; f32x4 v[4]; float s = 0.f;
#pragma unroll
        for (int j = 0; j < 4; ++j) { v[j] = xr[64 * j]; s += (v[j][0] * v[j][0] + v[j][1] * v[j][1]) + (v[j][2] * v[j][2] + v[j][3] * v[j][3]); }
        s = wave_sum(s);
        u32x2* o8 = (u32x2*)((bf16*)(ws + WS_XB) + (size_t)t * DM) + lane;
#pragma unroll
        for (int j = 0; j < 4; ++j) { u32x2 w = {pk2(v[j][0], v[j][1]), pk2(v[j][2], v[j][3])}; o8[64 * j] = w; }
        if (lane == 0) ((float*)(ws + WS_RSTD0))[t] = 1.0f / sqrtf(s * (1.0f / DM) + EPS); }
}

__device__ __forceinline__ void pool_diff(const Args& a, Frame& F) {
    const bf16* pm = (const bf16*)(a.ws + WS_P0MAIN); bf16* A2 = (bf16*)(a.ws + WS_A2);
    const int gt = (F.vcu * NWAVES + F.wave) * 64 + (fresh_tid() & 63), NGT = F.G * NTHR;
    for (int it = gt; it < (T / 16) * 128; it += NGT) {
        const int cc = it & 127, tg = it >> 7, t0 = tg * 16, s0 = t0 & (SEQ - 1), w = 2 << (cc >> 5), c0 = cc * 8;
        float sum[8];
#pragma unroll
        for (int i = 0; i < 8; ++i) sum[i] = 0.f;
        const int hist = (w - 1) < s0 ? (w - 1) : s0;
        for (int i = 1; i <= hist; ++i) { const u32x4 v = *(const u32x4*)(pm + (size_t)(t0 - i) * DM + c0);
            sum[0] += bflo(v.x); sum[1] += bfhi(v.x); sum[2] += bflo(v.y); sum[3] += bfhi(v.y); sum[4] += bflo(v.z); sum[5] += bfhi(v.z); sum[6] += bflo(v.w); sum[7] += bfhi(v.w); }
        for (int k = 0; k < 16; ++k) { const int t = t0 + k, s = s0 + k; const u32x4 v = *(const u32x4*)(pm + (size_t)t * DM + c0);
            float xv[8] = {bflo(v.x), bfhi(v.x), bflo(v.y), bfhi(v.y), bflo(v.z), bfhi(v.z), bflo(v.w), bfhi(v.w)};
#pragma unroll
            for (int i = 0; i < 8; ++i) sum[i] += xv[i];
            const float inv = 1.0f / (float)((s + 1) < w ? (s + 1) : w);
            u32x4 o = {pk2(sum[0] * inv - xv[0], sum[1] * inv - xv[1]), pk2(sum[2] * inv - xv[2], sum[3] * inv - xv[3]), pk2(sum[4] * inv - xv[4], sum[5] * inv - xv[5]), pk2(sum[6] * inv - xv[6], sum[7] * inv - xv[7])};
            *(u32x4*)(A2 + (size_t)t * MIXW + c0) = o;
            if (s >= w - 1) { const u32x4 q = *(const u32x4*)(pm + (size_t)(t - w + 1) * DM + c0);
                sum[0] -= bflo(q.x); sum[1] -= bfhi(q.x); sum[2] -= bflo(q.y); sum[3] -= bfhi(q.y); sum[4] -= bflo(q.z); sum[5] -= bfhi(q.z); sum[6] -= bflo(q.w); sum[7] -= bfhi(q.w); } }
    }
}

__device__ __forceinline__ void mem_attn(const Args& a, Frame& F, bf16* Abuf, int layer, bool dry = false) {
    const bf16* MKV = (const bf16*)(a.ws + WS_MEMKV);
    for (int U = F.vcu; U < 512; U += F.G) { const int b = U >> 6, h = (U >> 4) & 3, qt = U & 15;
        bf16* Q = Abuf + ((size_t)b * SEQ + qt * 256) * MIXW + 1024 + h * 128;
        const bf16* K = MKV + (size_t)b * MEMT * 2048 + layer * 1024 + h * 128;
        att::attn_unit<MIXW, 2048, false, ATT_SD_MEM>(Q, K, K + 512, dry ? (bf16*)(a.ws + WS_EXP) : Q, 0, nullptr, F.ldsg); }
}

__device__ __forceinline__ int ord_enc(float x) { const int b = __builtin_bit_cast(int, x); return b ^ ((b >> 31) & 0x7fffffff); }
__device__ __forceinline__ float ord_dec(int k) { return __builtin_bit_cast(float, k ^ ((k >> 31) & 0x7fffffff)); }
template <int N> __device__ __forceinline__ void bitonic_desc(int (&a)[N]) {
#pragma unroll
    for (int k = 2; k <= N; k <<= 1)
#pragma unroll
        for (int j = k >> 1; j > 0; j >>= 1)
#pragma unroll
            for (int i = 0; i < N; ++i) { const int l = i ^ j; if (l > i) { const bool desc = ((i & k) == 0) || (k == N);
                const int hi = max(a[i], a[l]), lo = min(a[i], a[l]); a[i] = desc ? hi : lo; a[l] = desc ? lo : hi; } }
}
__device__ __forceinline__ void merge16(int (&a)[16], const int (&b)[16]) {
#pragma unroll
    for (int i = 0; i < 16; ++i) a[i] = max(a[i], b[15 - i]);
#pragma unroll
    for (int j = 8; j > 0; j >>= 1)
#pragma unroll
        for (int i = 0; i < 16; ++i) { const int l = i ^ j; if (l > i) { const int hi = max(a[i], a[l]), lo = min(a[i], a[l]); a[i] = hi; a[l] = lo; } }
}
constexpr int cand_slot(int i, int j) { int s = 0; for (int a = 0; a < 16; ++a) for (int b = 0; b < 16; ++b) { if ((a + 1) * (b + 1) > 16) continue; if (a == i && b == j) return s; ++s; } return -1; }

__device__ __forceinline__ void peer_topk(const Args& a, Frame& F, int layer) {
    const bf16* PQ = (const bf16*)(a.ws + WS_PQ); const bf16* SUBK = (const bf16*)(a.ws + WS_SUBK) + (size_t)layer * 16 * 128 * 128;
    unsigned short* EXPo = (unsigned short*)(a.ws + WS_EXP); float* GATEo = (float*)(a.ws + WS_GATE);
    const int tid = fresh_tid(), lane = tid & 63, wid = F.wave, r32 = lane & 31, hi = lane >> 5;
    const int h = F.vcu & 7;
    int ka[4];
#pragma unroll
    for (int i = 0; i < 4; ++i) ka[i] = r32 * 256 + (((2 * i + hi) ^ (r32 & 7)) << 4);
    char* Ks = F.ldsg;
    LAS unsigned char* ib = F.lds + 65536 + tid * 36;
    for (int i = tid; i < 2 * 128 * 16; i += NTHR) { const int row = i >> 4, ch = i & 15; const u32x4 v = *(const u32x4*)(SUBK + ((size_t)h * 256 + row) * 128 + ch * 8);
        *(u32x4*)(Ks + (row >> 7) * 32768 + KSWZ(row & 127, ch * 16)) = v; }
    __syncthreads();
    for (int tt = (F.vcu >> 3); tt < T / 256; tt += (F.G >> 3)) {
        const int t = tt * 256 + wid * 32 + r32;
        int top[2][16];
#pragma unroll
        for (int p = 0; p < 2; ++p) {
            bf16x8 qr[8]; const bf16* qp = PQ + (size_t)t * 2048 + h * 256 + p * 128 + hi * 8;
#pragma unroll
            for (int d0 = 0; d0 < 8; ++d0) qr[d0] = *reinterpret_cast<const bf16x8*>(qp + d0 * 16);
            int cur[16];
#pragma unroll
            for (int kt = 0; kt < 4; ++kt) { f32x16 sacc; att::qkt1(sacc, Ks + p * 32768 + kt * 32 * 256, qr, ka);
                int grp[16];
#pragma unroll
                for (int r = 0; r < 16; ++r) grp[r] = (ord_enc(sacc[r]) & ~0x7F) | (kt * 32 + (r & 3) + 8 * (r >> 2) + 4 * hi);
                bitonic_desc<16>(grp);
                if (kt == 0) {
#pragma unroll
                    for (int r = 0; r < 16; ++r) cur[r] = grp[r];
                } else merge16(cur, grp); }
            int oth[16];
#pragma unroll
            for (int r = 0; r < 16; ++r) { auto rr = __builtin_amdgcn_permlane32_swap((unsigned)cur[r], (unsigned)cur[r], false, false); cur[r] = (int)rr[0]; oth[r] = (int)rr[1]; }
            merge16(cur, oth);
#pragma unroll
            for (int r = 0; r < 16; ++r) top[p][r] = cur[r];
        }
        float v0[16], v1[16];
#pragma unroll
        for (int r = 0; r < 16; ++r) { v0[r] = ord_dec(top[0][r] & ~0x7F); v1[r] = ord_dec(top[1][r] & ~0x7F); }
#pragma unroll
        for (int q = 0; q < 4; ++q) { *(LAS unsigned*)(ib + q * 4) = (top[0][4 * q] & 0x7F) | ((top[0][4 * q + 1] & 0x7F) << 8) | ((top[0][4 * q + 2] & 0x7F) << 16) | ((top[0][4 * q + 3] & 0x7F) << 24);
            *(LAS unsigned*)(ib + 16 + q * 4) = (top[1][4 * q] & 0x7F) | ((top[1][4 * q + 1] & 0x7F) << 8) | ((top[1][4 * q + 2] & 0x7F) << 16) | ((top[1][4 * q + 3] & 0x7F) << 24); }
        int cnd[64];
#pragma unroll
        for (int i = 0; i < 64; ++i) cnd[i] = (int)0x80000000;
#pragma unroll
        for (int i = 0; i < 16; ++i)
#pragma unroll
            for (int j = 0; j < 16; ++j) if ((i + 1) * (j + 1) <= 16) cnd[cand_slot(i, j)] = (ord_enc(v0[i] + v1[j]) & ~0xFF) | (i * 16 + j);
        int best[16], g1[16];
#pragma unroll
        for (int r = 0; r < 16; ++r) best[r] = cnd[r];
        bitonic_desc<16>(best);
#pragma unroll
        for (int gq = 1; gq < 4; ++gq) {
#pragma unroll
            for (int r = 0; r < 16; ++r) g1[r] = cnd[gq * 16 + r];
            bitonic_desc<16>(g1); merge16(best, g1); }
        float cv[16], ex[16]; float sum = 0.f;
#pragma unroll
        for (int r = 0; r < 16; ++r) cv[r] = ord_dec(best[r] & ~0xFF);
#pragma unroll
        for (int r = 0; r < 16; ++r) { ex[r] = __builtin_amdgcn_exp2f((cv[r] - cv[0]) * 1.4426950408889634f); sum += ex[r]; }
        const float rs = 1.0f / sum;
        LDS_WAIT();
        unsigned ee[16];
#pragma unroll
        for (int r = 0; r < 16; ++r) { const int code = best[r] & 0xFF; const unsigned e1 = ib[code >> 4], e2 = ib[16 + (code & 15)]; ee[r] = e1 * 128u + e2; }
        const size_t ob = ((size_t)t * 8 + h) * 16;
        if (hi == 0) { u32x4 w0 = {ee[0] | (ee[1] << 16), ee[2] | (ee[3] << 16), ee[4] | (ee[5] << 16), ee[6] | (ee[7] << 16)}, w1 = {ee[8] | (ee[9] << 16), ee[10] | (ee[11] << 16), ee[12] | (ee[13] << 16), ee[14] | (ee[15] << 16)};
            *(u32x4*)(EXPo + ob) = w0; *(u32x4*)(EXPo + ob + 8) = w1; }
        else {
#pragma unroll
            for (int q = 0; q < 4; ++q) { f32x4 gq = {ex[4 * q] * rs, ex[4 * q + 1] * rs, ex[4 * q + 2] * rs, ex[4 * q + 3] * rs}; *(f32x4*)(GATEo + ob + 4 * q) = gq; } }
        LDS_WAIT();
    }
    __syncthreads();
}

__device__ __forceinline__ float gelu_exact(float v) {
    const float av = fabsf(v), t = __builtin_amdgcn_rcpf(fmaf(av, 0.2316418882f, 1.0f));
    float q = fmaf(t, 0.5307027145f, -0.7265760135f); q = fmaf(q, t, 0.7107068705f); q = fmaf(q, t, -0.142248368f); q = fmaf(q, t, 0.127414796f); q = q * t;
    const float e = __builtin_amdgcn_exp2f(v * v * -0.72134752044f), m = v * (q * e);
    return v < 0.f ? m : v - m;
}
__device__ __forceinline__ float dot16_fp8(const u32x4 u, const f32x2 (&x2)[8]) {
    f32x2 d = {0.f, 0.f};
#pragma unroll
    for (int i = 0; i < 4; ++i) { const f32x2 a = __builtin_amdgcn_cvt_pk_f32_fp8((int)u[i], false), b = __builtin_amdgcn_cvt_pk_f32_fp8((int)u[i], true);
        d = __builtin_elementwise_fma(a, x2[2 * i], d); d = __builtin_elementwise_fma(b, x2[2 * i + 1], d); }
    return d.x + d.y;
}
__device__ __forceinline__ void axpy16_fp8(f32x2 (&o2)[8], const float h, const u32x4 v) {
    const f32x2 h2 = {h, h};
#pragma unroll
    for (int i = 0; i < 4; ++i) { const f32x2 a = __builtin_amdgcn_cvt_pk_f32_fp8((int)v[i], false), b = __builtin_amdgcn_cvt_pk_f32_fp8((int)v[i], true);
        o2[2 * i] = __builtin_elementwise_fma(a, h2, o2[2 * i]); o2[2 * i + 1] = __builtin_elementwise_fma(b, h2, o2[2 * i + 1]); }
}
__device__ __forceinline__ float reduce8(const float (&p)[8], int lane) {
    float s[4];
#pragma unroll
    for (int i = 0; i < 4; ++i) { auto rr = __builtin_amdgcn_permlane32_swap(__float_as_uint(p[2 * i]), __float_as_uint(p[2 * i + 1]), false, false); s[i] = __uint_as_float(rr[0]) + __uint_as_float(rr[1]); }
    float t[2];
#pragma unroll
    for (int i = 0; i < 2; ++i) { const bool hi = lane & 16; const float u = hi ? s[2 * i + 1] : s[2 * i], o = hi ? s[2 * i] : s[2 * i + 1]; t[i] = u + shx_f<16>(o); }
    const bool h8 = lane & 8; const float u = h8 ? t[1] : t[0], o = h8 ? t[0] : t[1]; float w = u + dpp_f<0x128>(o);
    w += dpp_f<0x141>(w); w += dpp_f<0x1B>(w); w += dpp_f<0xB1>(w);
    return w;
}
constexpr int qgrp(int q) { return 2 * ((q & 3) == 1 ? 2 : (q & 3) == 2 ? 1 : (q & 3)) + (q >> 2); }

template <int K, int J> __device__ __forceinline__ void sort128_stage(unsigned& lo, unsigned& hi, int lane) {
    const unsigned plo = shx_u<J>(lo), phi = shx_u<J>(hi);
    const bool up_lo = (K >= 64) ? true : ((lane & K) == 0), up_hi = (K == 64) ? false : up_lo, lower = (lane & J) == 0;
    lo = (lower == up_lo) ? min(lo, plo) : max(lo, plo); hi = (lower == up_hi) ? min(hi, phi) : max(hi, phi);
    if constexpr (J > 1) sort128_stage<K, J / 2>(lo, hi, lane);
}
template <int K> __device__ __forceinline__ void sort128_level(unsigned& lo, unsigned& hi, int lane) { sort128_stage<K, K / 2>(lo, hi, lane); if constexpr (K < 64) sort128_level<K * 2>(lo, hi, lane); }
__device__ __forceinline__ void sort128(unsigned& lo, unsigned& hi, int lane) {
    sort128_level<2>(lo, hi, lane);
    { const unsigned a = min(lo, hi), b = max(lo, hi); lo = a; hi = b; }
    sort128_stage<128, 32>(lo, hi, lane);
}
template <bool FINAL, bool DRY = false>
__device__ __forceinline__ void peer_gather(const Args& a, Frame& F, int layer) {
    const unsigned char* UB = a.ws + WS_UB + (size_t)layer * NEXP * DM; const unsigned char* VB = a.ws + WS_VB + (size_t)layer * NEXP * DM;
    const float* USC = (const float*)(a.ws + WS_USC) + layer * NEXP; const float* VSC = (const float*)(a.ws + WS_VSC) + layer * NEXP;
    const unsigned short* EXPi = (const unsigned short*)(a.ws + WS_EXP); const float* GATEi = (const float*)(a.ws + WS_GATE);
    float* X = a.out; bf16* XB = (bf16*)(a.ws + WS_XB); float* RSTD2 = (float*)(a.ws + WS_RSTD2); const float* gfin = a.in[15];
    const int lane = fresh_tid() & 63, gw = F.vcu * NWAVES + F.wave, NGW = F.G * NWAVES;
    const unsigned lane16 = (unsigned)lane * 16u;
    const int grp = lane >> 3; const int jperm = 8 * (lane & 7) + ((grp >> 1) == 1 ? 2 : (grp >> 1) == 2 ? 1 : (grp >> 1)) + 4 * (grp & 1);
    for (int t = gw; t < T; t += NGW) {
        __syncthreads();
        bf16* xbr = XB + (size_t)t * DM + 16 * lane;
        float x[16];
        { const u32x4 v0 = *(const u32x4*)xbr, v1 = *(const u32x4*)(xbr + 8);
          x[0] = bflo(v0.x); x[1] = bfhi(v0.x); x[2] = bflo(v0.y); x[3] = bfhi(v0.y); x[4] = bflo(v0.z); x[5] = bfhi(v0.z); x[6] = bflo(v0.w); x[7] = bfhi(v0.w);
          x[8] = bflo(v1.x); x[9] = bfhi(v1.x); x[10] = bflo(v1.y); x[11] = bfhi(v1.y); x[12] = bflo(v1.z); x[13] = bfhi(v1.z); x[14] = bflo(v1.w); x[15] = bfhi(v1.w); }
        f32x2 x2[8];
#pragma unroll
        for (int i = 0; i < 8; ++i) { x2[i].x = x[2 * i]; x2[i].y = x[2 * i + 1]; }
        float ss = 0.f;
#pragma unroll
        for (int i = 0; i < 16; ++i) ss = fmaf(x[i], x[i], ss);
        ss = wave_sum(ss);
        const float rstd = 1.0f / sqrtf(ss * (1.0f / DM) + EPS);
        const unsigned short* et = EXPi + (size_t)t * 128; const float* gt_ = GATEi + (size_t)t * 128;
        unsigned k_lo = ((unsigned)et[lane] << 7) | (unsigned)lane, k_hi = ((unsigned)et[64 + lane] << 7) | (unsigned)(64 + lane);
        sort128(k_lo, k_hi, lane);
        const int e_lo = (int)(k_lo >> 7), e_hi = (int)(k_hi >> 7);
        const float gs_lo = gt_[k_lo & 127u], gs_hi = gt_[k_hi & 127u];
        const int ep_lo = __shfl(e_lo, jperm), ep_hi = __shfl(e_hi, jperm);
        const float gl = __shfl(gs_lo, jperm) * VSC[ep_lo], gh = __shfl(gs_hi, jperm) * VSC[ep_hi];
        const float ul = USC[ep_lo] * rstd, uh = USC[ep_hi] * rstd;
        float a_lo = 0.f, a_hi = 0.f;
        u32x4 b0[8], b1[8], b2[8];
#define ROWLD(dst, tab, e_) dst = *(const u32x4*)((tab) + (size_t)(e_) * DM + lane16)
#define ULOAD(buf, B) do { const int ev_ = ((B) >> 3) ? e_hi : e_lo; _Pragma("unroll") for (int q = 0; q < 8; ++q) { const int e = __builtin_amdgcn_readlane(ev_, 8 * ((B) & 7) + q); ROWLD(buf[q], UB, e); } } while (0)
#define VLOAD(buf, B) do { const int ev_ = ((B) >> 3) ? e_hi : e_lo; _Pragma("unroll") for (int q = 0; q < 8; ++q) { const int e = __builtin_amdgcn_readlane(ev_, 8 * ((B) & 7) + q); ROWLD(buf[q], VB, e); } } while (0)
#define UCOMP(buf, B) do { float p[8]; _Pragma("unroll") for (int q = 0; q < 8; ++q) p[q] = dot16_fp8(buf[q], x2); const float w = reduce8(p, lane); const bool mine = (lane & 7) == ((B) & 7); \
        if ((B) >> 3) a_hi = mine ? w : a_hi; else a_lo = mine ? w : a_lo; } while (0)
        ULOAD(b0, 0); ULOAD(b1, 1);
#pragma unroll 1
        for (int B = 0; B < 12; B += 3) {
            if (B > 0) __syncthreads();
            ULOAD(b2, B + 2); UCOMP(b0, B);
            ULOAD(b0, B + 3); UCOMP(b1, B + 1);
            ULOAD(b1, B + 4); UCOMP(b2, B + 2); }
        ULOAD(b2, 14); UCOMP(b0, 12);
        ULOAD(b0, 15); UCOMP(b1, 13);
        VLOAD(b1, 0);  UCOMP(b2, 14);
        VLOAD(b2, 1);  UCOMP(b0, 15);
#undef ULOAD
#undef UCOMP
        __syncthreads();
        const float h_lo = gelu_exact(a_lo * ul) * gl, h_hi = gelu_exact(a_hi * uh) * gh;
        f32x2 o2[8];
#pragma unroll
        for (int i = 0; i < 8; ++i) o2[i] = (f32x2){0.f, 0.f};
#define VCOMP(buf, B) do { const int hv_ = __builtin_bit_cast(int, ((B) >> 3) ? h_hi : h_lo); _Pragma("unroll") for (int q = 0; q < 8; ++q) { const float hq = __builtin_bit_cast(float, __builtin_amdgcn_readlane(hv_, 8 * qgrp(q) + ((B) & 7))); axpy16_fp8(o2, hq, buf[q]); } } while (0)
#pragma unroll 1
        for (int B = 0; B < 12; B += 3) {
            if (B > 0) __syncthreads();
            VLOAD(b0, B + 2); VCOMP(b1, B);
            VLOAD(b1, B + 3); VCOMP(b2, B + 1);
            VLOAD(b2, B + 4); VCOMP(b0, B + 2); }
        VLOAD(b0, 14); VCOMP(b1, 12);
        VLOAD(b1, 15); VCOMP(b2, 13);
        VCOMP(b0, 14);
        VCOMP(b1, 15);
#undef VLOAD
#undef VCOMP
#undef ROWLD
        float o[16]; float s2 = 0.f;
#pragma unroll
        for (int i = 0; i < 8; ++i) { o[2 * i] = o2[i].x; o[2 * i + 1] = o2[i].y; }
        { const u32x4 v0 = *(const u32x4*)xbr, v1 = *(const u32x4*)(xbr + 8);
          o[0] += bflo(v0.x); o[1] += bfhi(v0.x); o[2] += bflo(v0.y); o[3] += bfhi(v0.y); o[4] += bflo(v0.z); o[5] += bfhi(v0.z); o[6] += bflo(v0.w); o[7] += bfhi(v0.w);
          o[8] += bflo(v1.x); o[9] += bfhi(v1.x); o[10] += bflo(v1.y); o[11] += bfhi(v1.y); o[12] += bflo(v1.z); o[13] += bfhi(v1.z); o[14] += bflo(v1.w); o[15] += bfhi(v1.w); }
#pragma unroll
        for (int i = 0; i < 16; ++i) s2 = fmaf(o[i], o[i], s2);
        s2 = wave_sum(s2);
        const float r2 = 1.0f / sqrtf(s2 * (1.0f / DM) + EPS);
        if constexpr (FINAL) {
            float* xw = (DRY ? (float*)(a.ws + WS_RB) : X) + (size_t)t * DM;
#pragma unroll
            for (int i = 0; i < 4; ++i) { const f32x4 g = *(const f32x4*)(gfin + 16 * lane + 4 * i); f32x4 y = {o[4 * i] * r2 * g[0], o[4 * i + 1] * r2 * g[1], o[4 * i + 2] * r2 * g[2], o[4 * i + 3] * r2 * g[3]}; *(f32x4*)(xw + 16 * lane + 4 * i) = y; }
        } else {
            bf16* xo = DRY ? (bf16*)(a.ws + WS_RB) + (size_t)t * DM + 16 * lane : xbr;
            u32x4 wa = {pk2(o[0], o[1]), pk2(o[2], o[3]), pk2(o[4], o[5]), pk2(o[6], o[7])}, wb = {pk2(o[8], o[9]), pk2(o[10], o[11]), pk2(o[12], o[13]), pk2(o[14], o[15])};
            *(u32x4*)xo = wa; *(u32x4*)(xo + 8) = wb;
            if (!DRY && lane == 0) RSTD2[t] = r2;
        }
    }
}

#define XB_TMO      128
#define XB_XCNT(j)  (256  + 64 * (j))
#define XB_XSUB(j)  (1280 + 64 * (j))
#define XB_XGEN(j)  (2304 + 64 * (j))
#define XB_TOP      3328
#define XB_TOPGEN   3392
#define XCD_BAR_WORDS 3456
#define XB_SPIN_CAP (1u << 22)
__device__ __forceinline__ unsigned xb_ld(unsigned* p)              { return __hip_atomic_load(p, __ATOMIC_RELAXED, __HIP_MEMORY_SCOPE_AGENT); }
__device__ __forceinline__ unsigned xb_add(unsigned* p, unsigned v) { return __hip_atomic_fetch_add(p, v, __ATOMIC_RELAXED, __HIP_MEMORY_SCOPE_AGENT); }
__device__ __forceinline__ unsigned xb_xcc_id() { return (unsigned)__builtin_amdgcn_s_getreg((3 << 11) | 20) & 0xFu; }
#define XB_SPIN(cond, bar) do { unsigned _sp = 0; while (cond) { __builtin_amdgcn_s_sleep(1); \
    if ((++_sp & 255u) == 0u) { if (xb_ld(&(bar)[XB_TMO])) break; if (_sp > XB_SPIN_CAP) { atomicAdd(&(bar)[XB_TMO], 1u); break; } } } } while (0)
struct XcdBarrier { unsigned* bar; unsigned x; volatile LAS unsigned* st; };
__device__ __forceinline__ XcdBarrier xcd_barrier_post(unsigned* bar, volatile LAS unsigned* st) {
    XcdBarrier b; b.bar = bar; b.x = xb_xcc_id(); b.st = st;
    if (threadIdx.x == 0) (void)xb_add(&bar[XB_XCNT(b.x)], 1u);
    return b;
}
__device__ __forceinline__ void xcd_barrier_complete(unsigned* bar, unsigned x, unsigned& nloc, unsigned& nx) {
    const unsigned G = gridDim.x * gridDim.y * gridDim.z;
    unsigned sum, cnt, mine, sp = 0u;
    for (;;) {
        sum = 0u; cnt = 0u; mine = 0u;
#pragma unroll
        for (unsigned j = 0; j < 16; ++j) { const unsigned c = xb_ld(&bar[XB_XCNT(j)]); sum += c; cnt += (c > 0u) ? 1u : 0u; mine = (j == x) ? c : mine; }
        if (sum == G) break;
        __builtin_amdgcn_s_sleep(1);
        if ((++sp & 255u) == 0u) { if (xb_ld(&bar[XB_TMO])) break; if (sp > XB_SPIN_CAP) { atomicAdd(&bar[XB_TMO], 1u); break; } }
    }
    nloc = mine > 0u ? mine : 1u; nx = cnt > 0u ? cnt : 1u;
}
__device__ __forceinline__ void xcd_barrier(const XcdBarrier& b) {
    asm volatile("s_waitcnt vmcnt(0)" ::: "memory");
    __syncthreads();
    if (threadIdx.x == 0) {
        unsigned* bar = b.bar;
        __builtin_amdgcn_s_waitcnt(0);
        unsigned nloc = b.st[0], nx = b.st[1];
        if (nloc == 0u) { xcd_barrier_complete(bar, b.x, nloc, nx); b.st[0] = nloc; b.st[1] = nx; }
        const unsigned old = xb_add(&bar[XB_XSUB(b.x)], 1u);
        const unsigned gen = old / nloc;
        if (old + 1u == (gen + 1u) * nloc) {
            __builtin_amdgcn_fence(__ATOMIC_RELEASE, "agent");
            asm volatile("s_waitcnt vmcnt(0)" ::: "memory");
            const unsigned og = xb_add(&bar[XB_TOP], 1u);
            const unsigned tg = og / nx;
            if (og + 1u == (tg + 1u) * nx) xb_add(&bar[XB_TOPGEN], 1u);
            else XB_SPIN(xb_ld(&bar[XB_TOPGEN]) == tg, bar);
            __builtin_amdgcn_fence(__ATOMIC_ACQUIRE, "agent");
            xb_add(&bar[XB_XGEN(b.x)], 1u);
            asm volatile("s_waitcnt vmcnt(0)" ::: "memory");
        } else {
            XB_SPIN(xb_ld(&bar[XB_XGEN(b.x)]) == gen, bar);
            __builtin_amdgcn_fence(__ATOMIC_ACQUIRE, "agent");
            asm volatile("s_waitcnt vmcnt(0)" ::: "memory");
        }
    }
    __syncthreads();
}

__global__ void __launch_bounds__(NTHR, 2) yoco_fwd(Args args) {
    extern __shared__ __attribute__((aligned(16))) unsigned char lds_raw[];
    cg::grid_group grid = cg::this_grid();
    Frame F;
    F.lds = (LAS unsigned char*)lds_raw; F.ldsg = (char*)lds_raw;
    F.wave = __builtin_amdgcn_readfirstlane(threadIdx.x >> 6);
    F.G = gridDim.x; { const int bx = blockIdx.x; F.vcu = (F.G % 8 == 0) ? (bx % 8) * (F.G / 8) + bx / 8 : bx; }
    unsigned char* ws = args.ws;
    const int lo = args.ph_lo, hi = args.ph_hi;
    volatile LAS unsigned* bst = (volatile LAS unsigned*)(F.lds + 131072 + 320);
    if (threadIdx.x < 2) bst[threadIdx.x] = 0u;
    __syncthreads();
    XcdBarrier xbar; xbar.bar = (unsigned*)ws; xbar.x = 0; xbar.st = bst;
    if (hi - lo > 1) xbar = xcd_barrier_post((unsigned*)ws, bst);
#ifndef PH_MASK
#define PH_MASK 0x1fff
#endif
#define IN(k) (((PH_MASK >> (k)) & 1) && lo <= (k) && (k) < hi)
#define SEAM(k) do { if (IN(k) && IN((k) + 1)) { if ((k) == 0) grid.sync(); else xcd_barrier(xbar); } } while (0)
#define GSYNC() xcd_barrier(xbar)
#ifndef REP_MASK
#define REP_MASK 0
#endif
#define NREP(k) (((REP_MASK >> (k)) & 1) ? 2 : 1)
    typedef pg8::bf16_t pb;

    for (int rep_ = 0; rep_ < NREP(0); ++rep_) { if (rep_) GSYNC();
    if (IN(0)) { phase0(args, F); } } SEAM(0);

    for (int rep_ = 0; rep_ < NREP(1); ++rep_) { if (rep_) GSYNC();
    if (IN(1)) {
        { pg8::Gemm g{(const pb*)(ws + WS_XB), (const pb*)(ws + WS_WIN0), T, MIXW, DM}; pg8::StaticOrder S; S.init(T, MIXW, F.G, (int)blockIdx.x);
          pg8::EpiRowBf16 E{(pb*)(ws + WS_P0MAIN), DM, (pb*)(ws + WS_A2) + 1024, MIXW, 1024, (const float*)(ws + WS_RSTD0), nullptr};
          pg8::gemm_phase<pg8::EpiRowBf16, pg8::StaticOrder>(F.lds, g, S, E); }
        { pg8::Gemm g{(const pb*)(ws + WS_MEMB), (const pb*)(ws + WS_WMKV), 2048, 2048, DM}; pg8::StaticOrder S; S.init(2048, 2048, F.G, (int)blockIdx.x);
          pg8::EpiRowBf16 E{(pb*)(ws + WS_MEMKV), 2048, (pb*)(ws + WS_MEMKV), 2048, 1 << 30, nullptr, nullptr};
          pg8::gemm_phase<pg8::EpiRowBf16, pg8::StaticOrder>(F.lds, g, S, E); }
    } } SEAM(1);

    if (IN(2)) { if (NREP(2) > 1) { pool_diff(args, F); mem_attn(args, F, (bf16*)(ws + WS_A2), 0, true); GSYNC(); }
        pool_diff(args, F); mem_attn(args, F, (bf16*)(ws + WS_A2), 0); } SEAM(2);

    for (int rep_ = 0; rep_ < NREP(3); ++rep_) { if (rep_) GSYNC();
    if (IN(3)) {
        pg8::Gemm g{(const pb*)(ws + WS_A2), (const pb*)(ws + WS_WC0), T, DM, MIXW}; pg8::StaticOrder S; S.init(T, DM, F.G, (int)blockIdx.x);
        pg8::EpiRes E{(pb*)(ws + WS_XB), (float*)(ws + WS_SSQ)};
        pg8::gemm_phase<pg8::EpiRes, pg8::StaticOrder>(F.lds, g, S, E);
    } } SEAM(3);

    for (int rep_ = 0; rep_ < NREP(4); ++rep_) { if (rep_) GSYNC();
    if (IN(4)) {
        pg8::Gemm g{(const pb*)(ws + WS_XB), (const pb*)(ws + WS_WQ0), T, 2048, DM}; pg8::StaticOrder S; S.init(T, 2048, F.G, (int)blockIdx.x);
        pg8::EpiRowBf16 E{(pb*)(ws + WS_PQ), 2048, (pb*)(ws + WS_PQ), 2048, 1 << 30, nullptr, (const float*)(ws + WS_SSQ)};
        pg8::gemm_phase<pg8::EpiRowBf16, pg8::StaticOrder>(F.lds, g, S, E);
    } } SEAM(4);

    for (int rep_ = 0; rep_ < NREP(5); ++rep_) { if (rep_) GSYNC();
    if (IN(5)) { peer_topk(args, F, 0); } } SEAM(5);
    if (IN(6)) {
#ifdef PROBE_PEER
        peer_gather<false, true>(args, F, 0); GSYNC();
#endif
        peer_gather<false>(args, F, 0); } SEAM(6);

    for (int rep_ = 0; rep_ < NREP(7); ++rep_) { if (rep_) GSYNC();
    if (IN(7)) {
        pg8::Gemm g{(const pb*)(ws + WS_XB), (const pb*)(ws + WS_WC4), T, 3584, DM}; pg8::StaticOrder S; S.init(T, 3584, F.G, (int)blockIdx.x);
        pg8::EpiKVQ E{(pb*)(ws + WS_KR), (pb*)(ws + WS_VV), (pb*)(ws + WS_A3), (float*)(ws + WS_KMP), (const float*)(ws + WS_RSTD2), (const float*)(ws + WS_ROPE)};
        pg8::gemm_phase<pg8::EpiKVQ, pg8::StaticOrder>(F.lds, g, S, E);
    } } SEAM(7);

    if (IN(8)) {
        bf16* A3 = (bf16*)(ws + WS_A3); const bf16* KR = (const bf16*)(ws + WS_KR); const bf16* VV = (const bf16*)(ws + WS_VV); const float* KMP = (const float*)(ws + WS_KMP);
        for (int rep_ = 0; rep_ < NREP(8); ++rep_) { const bool dry8 = (NREP(8) > 1) && rep_ == 0;
        for (int P = F.vcu; P < 512; P += F.G) { const int bh = P >> 3, p = P & 7, b = bh >> 3, h = bh & 7;
#pragma unroll 1
            for (int half = 0; half < 2; ++half) { const int j = half ? p : 15 - p;
                bf16* Q = A3 + ((size_t)b * SEQ + j * 256) * MIXW + h * 128;
                const bf16* K = KR + (size_t)bh * SEQ * 128; const bf16* V = VV + (size_t)bh * SEQ * 128;
                att::attn_unit<MIXW, 128, true, ATT_SD_MOBA>(Q, K, V, dry8 ? (bf16*)(ws + WS_XB) : Q, j, KMP + (size_t)b * 16 * 2048 + h * 128, F.ldsg); } }
        if (dry8) { mem_attn(args, F, A3, 1, true); GSYNC(); } }
        mem_attn(args, F, A3, 1);
    } SEAM(8);

    if (IN(9)) {
        pg8::Gemm g{(const pb*)(ws + WS_A3), (const pb*)(ws + WS_WOUT1), T, DM, MIXW}; pg8::StaticOrder S; S.init(T, DM, F.G, (int)blockIdx.x);
        pg8::EpiRes E{(pb*)(ws + WS_XB), (float*)(ws + WS_SSQ)};
        pg8::gemm_phase<pg8::EpiRes, pg8::StaticOrder>(F.lds, g, S, E);
    } SEAM(9);

    for (int rep_ = 0; rep_ < NREP(10); ++rep_) { if (rep_) GSYNC();
    if (IN(10)) {
        pg8::Gemm g{(const pb*)(ws + WS_XB), (const pb*)(ws + WS_WQ1), T, 2048, DM}; pg8::StaticOrder S; S.init(T, 2048, F.G, (int)blockIdx.x);
        pg8::EpiRowBf16 E{(pb*)(ws + WS_PQ), 2048, (pb*)(ws + WS_PQ), 2048, 1 << 30, nullptr, (const float*)(ws + WS_SSQ)};
        pg8::gemm_phase<pg8::EpiRowBf16, pg8::StaticOrder>(F.lds, g, S, E);
    } } SEAM(10);

    for (int rep_ = 0; rep_ < NREP(11); ++rep_) { if (rep_) GSYNC();
    if (IN(11)) { peer_topk(args, F, 1); } } SEAM(11);
    if (IN(12)) {
#ifdef PROBE_PEER
        peer_gather<true, true>(args, F, 1); GSYNC();
#endif
        peer_gather<true>(args, F, 1); }
#undef IN
#undef SEAM
}

extern "C" void kernel_launch(void* const* d_in, const int* in_sizes, int n_in, void* d_out, int out_size, void* d_ws, size_t ws_size, hipStream_t stream) {
    static int grid = 0;
    if (grid == 0) {
        if (n_in != 16 || out_size != T * DM || ws_size < WS_END) { fprintf(stderr, "kernel_launch: unexpected shapes: n_in %d out %d ws %zu (need %zu)\n", n_in, out_size, ws_size, (size_t)WS_END); grid = -1; return; }
        int dev = 0, cus = 0, per_cu = 0;
        if (hipGetDevice(&dev) != hipSuccess || hipDeviceGetAttribute(&cus, hipDeviceAttributeMultiprocessorCount, dev) != hipSuccess) { grid = -1; return; }
        if (hipFuncSetAttribute((const void*)yoco_fwd, hipFuncAttributeMaxDynamicSharedMemorySize, LDS_BYTES) != hipSuccess) { fprintf(stderr, "kernel_launch: hipFuncSetAttribute failed\n"); grid = -1; return; }
        if (hipOccupancyMaxActiveBlocksPerMultiprocessor(&per_cu, (const void*)yoco_fwd, NTHR, LDS_BYTES) != hipSuccess || per_cu < 1) { fprintf(stderr, "kernel_launch: occupancy query says %d\n", per_cu); per_cu = 1; }
        (void)hipGetLastError();
        grid = cus;
        fprintf(stderr, "kernel_launch: grid %d, per_cu %d, ws %zu\n", grid, per_cu, ws_size);
    }
    if (grid < 0) return;
    if (hipMemsetAsync(d_ws, 0, 16384, stream) != hipSuccess) { fprintf(stderr, "kernel_launch: memset failed\n"); return; }
    Args a{};
    for (int i = 0; i < 16; ++i) a.in[i] = (const float*)d_in[i];
    a.out = (float*)d_out; a.ws = (unsigned char*)d_ws;
#if MK_LAUNCHES == 1
    a.ph_lo = 0; a.ph_hi = 13;
    void* kargs[] = {&a};
    hipError_t e = hipLaunchCooperativeKernel((const void*)yoco_fwd, dim3(grid), dim3(NTHR), kargs, LDS_BYTES, stream);
    if (e != hipSuccess) fprintf(stderr, "kernel_launch: cooperative launch failed: %s (grid %d)\n", hipGetErrorString(e), grid);
#else
    for (int p = 0; p < 13; ++p) { a.ph_lo = p; a.ph_hi = p + 1;
        hipLaunchKernelGGL(yoco_fwd, dim3(grid), dim3(NTHR), LDS_BYTES, stream, a);
        const hipError_t le = hipPeekAtLastError(); if (le != hipSuccess) { fprintf(stderr, "kernel_launch: launch %d failed: %s\n", p, hipGetErrorName(le)); break; } }
#endif
}
```

```cpp
#include <hip/hip_runtime.h>
#include <hip/hip_cooperative_groups.h>
#include <cstdio>
#include <cstdint>
namespace cg = cooperative_groups;

#ifndef MK_LAUNCHES
#define MK_LAUNCHES 1
#endif

#define GAS __attribute__((address_space(1)))
#define LAS __attribute__((address_space(3)))
typedef unsigned short bf16;
typedef unsigned u32x4 __attribute__((ext_vector_type(4)));
typedef unsigned u32x2 __attribute__((ext_vector_type(2)));
typedef float f32x4 __attribute__((ext_vector_type(4)));
typedef float f32x2 __attribute__((ext_vector_type(2)));
typedef float f32x16 __attribute__((ext_vector_type(16)));
typedef short bf16x8 __attribute__((ext_vector_type(8)));
typedef short s16x4 __attribute__((ext_vector_type(4)));
typedef __bf16 bf16x2_t __attribute__((ext_vector_type(2)));

constexpr int NB = 8, SEQ = 4096, DM = 1024, T = NB * SEQ, MIXW = 1536, MEMT = 256;
constexpr int NEXP = 16384, NWAVES = 8, NTHR = 512;
constexpr float EPS = 1e-6f;

constexpr size_t MiB = 1u << 20;
constexpr size_t WS_RSTD0 = 1 * MiB;
constexpr size_t WS_RSTD2 = WS_RSTD0 + 128 * 1024;
constexpr size_t WS_USC   = WS_RSTD0 + 256 * 1024;
constexpr size_t WS_VSC   = WS_RSTD0 + 384 * 1024;
constexpr size_t WS_SSQ   = 2 * MiB;
constexpr size_t WS_KMP   = 4 * MiB;
constexpr size_t WS_ROPE  = 5 * MiB;
constexpr size_t WS_WIN0  = 8 * MiB;
constexpr size_t WS_WC4   = 11 * MiB;
constexpr size_t WS_WC0   = 18 * MiB;
constexpr size_t WS_WOUT1 = 21 * MiB;
constexpr size_t WS_WMKV  = 24 * MiB;
constexpr size_t WS_WQ0   = 28 * MiB;
constexpr size_t WS_WQ1   = 32 * MiB;
constexpr size_t WS_SUBK  = 36 * MiB;
constexpr size_t WS_MEMB  = 37 * MiB;
constexpr size_t WS_MEMKV = 41 * MiB;
constexpr size_t WS_EXP   = 49 * MiB;
constexpr size_t WS_GATE  = 57 * MiB;
constexpr size_t WS_UB    = 73 * MiB;
constexpr size_t WS_VB    = 105 * MiB;
constexpr size_t WS_XB    = 201 * MiB;
constexpr size_t WS_RB    = 265 * MiB;
constexpr size_t WS_P0MAIN = WS_RB;
constexpr size_t WS_A2    = WS_RB + 64 * MiB;
constexpr size_t WS_PQ    = WS_RB;
constexpr size_t WS_KR    = WS_RB;
constexpr size_t WS_VV    = WS_RB + 64 * MiB;
constexpr size_t WS_A3    = WS_RB + 128 * MiB;
constexpr size_t WS_END   = WS_RB + 224 * MiB;

constexpr int LDS_BYTES = 147456;

__device__ __forceinline__ unsigned f2bf(float f) { unsigned u = __builtin_bit_cast(unsigned, f); return (u + 0x7fffu + ((u >> 16) & 1u)) >> 16; }
__device__ __forceinline__ unsigned pk2(float lo, float hi) { return f2bf(lo) | (f2bf(hi) << 16); }
__device__ __forceinline__ unsigned cvtpk(float lo, float hi) { unsigned r; asm volatile("v_cvt_pk_bf16_f32 %0, %1, %2" : "=v"(r) : "v"(lo), "v"(hi)); return r; }
__device__ __forceinline__ float bflo(unsigned w) { return __builtin_bit_cast(float, w << 16); }
__device__ __forceinline__ float bfhi(unsigned w) { return __builtin_bit_cast(float, w & 0xffff0000u); }
template <int J> __device__ __forceinline__ unsigned shx_u(unsigned v) {
    if constexpr (J == 32) { auto rr = __builtin_amdgcn_permlane32_swap(v, v, false, false); return ((threadIdx.x & 32) ? rr[0] : rr[1]); }
    else return (unsigned)__builtin_amdgcn_ds_swizzle((int)v, (J << 10) | 0x1f);
}
template <int J> __device__ __forceinline__ float shx_f(float v) { return __uint_as_float(shx_u<J>(__float_as_uint(v))); }
template <int CTRL> __device__ __forceinline__ float dpp_f(float v) { return __uint_as_float((unsigned)__builtin_amdgcn_update_dpp(0, (int)__float_as_uint(v), CTRL, 0xF, 0xF, false)); }
__device__ __forceinline__ float wave_sum(float v) {
    v += dpp_f<0xB1>(v); v += dpp_f<0x4E>(v); v += dpp_f<0x141>(v); v += dpp_f<0x128>(v);
    v += shx_f<16>(v);
    { auto rr = __builtin_amdgcn_permlane32_swap(__float_as_uint(v), __float_as_uint(v), false, false); v = __uint_as_float(rr[0]) + __uint_as_float(rr[1]); }
    return v;
}
__device__ __forceinline__ float dot2(unsigned w, unsigned x, float acc) { return __builtin_amdgcn_fdot2_f32_bf16(__builtin_bit_cast(bf16x2_t, w), __builtin_bit_cast(bf16x2_t, x), acc, false); }
#define LDS_WAIT() asm volatile("s_waitcnt lgkmcnt(0)" ::: "memory")
#define VM_WAIT() asm volatile("s_waitcnt vmcnt(0)" ::: "memory")

namespace pg8 {
#define PG8_LAS __attribute__((address_space(3)))
typedef unsigned short bf16_t;
constexpr int BM = 256, BK = 64, HALF = 128, HTB = HALF * BK * 2, STAGE_BYTES = 8 * HTB, NXCD = 8, WGM = 8;
__host__ __device__ __forceinline__ int lds_byte(int r, int c) { const int st = (r >> 4) * 2 + (c >> 5), rr = r & 15, cc = c & 31, ob = rr * 64 + cc * 2; return st * 1024 + (ob ^ (((ob >> 9) & 1) << 5)); }
__host__ __device__ __forceinline__ void stage_rc(int b, int& R, int& C) { const int st = b / 1024, sb = b % 1024, swz = sb ^ (((sb >> 9) & 1) << 5); R = (st >> 1) * 16 + swz / 64; C = (st & 1) * 32 + (swz % 64) / 2; }
__host__ __device__ __forceinline__ int perm32(int rho) { const int n = rho >> 4, i = rho & 15; return 8 * (i >> 2) + 4 * n + (i & 3); }
struct Unit { int pm, pn; };
struct Gemm { const bf16_t* A; const bf16_t* Bt; int M, N, K; };
struct StaticOrder {
    int nM, nN, nwg, G, c;
    __host__ __device__ void init(int M, int N, int G_, int c_) { nM = M / BM; nN = N / BM; nwg = nM * nN; G = G_; c = c_; }
    __host__ __device__ bool next(int i, Unit& u) const {
        const long L = (long)i * G + c; if (L >= nwg) return false;
        int wgid = (int)L; { const int q = nwg / NXCD, r = nwg % NXCD, xcd = wgid % NXCD, off = wgid / NXCD; wgid = (xcd < r ? xcd * (q + 1) : r * (q + 1) + (xcd - r) * q) + off; }
        const int nig = WGM * nN, gid = wgid / nig, fm = gid * WGM, gsz = (nM - fm) < WGM ? (nM - fm) : WGM;
        u.pm = fm + ((wgid % nig) % gsz); u.pn = (wgid % nig) / gsz; return true;
    }
    __device__ __forceinline__ void a_ready(const Unit&) const {}
    __device__ __forceinline__ void done(const Unit&) const {}
};

struct EpiRowBf16 {
    static constexpr bool PERM = true, AFTER_DRAIN = false;
    bf16_t* O0; int ld0; bf16_t* O1; int ld1; int split; const float* rs; const float* ssq;
    __device__ __forceinline__ void operator()(const f32x4 (&acc)[2][2][4][2], const Unit& u, int wr, int wc, int fr, int fq) const {
        const int row0 = u.pm * BM + wr * 64 + fr; int colt = u.pn * BM; bf16_t* base = O0; int ldc = ld0;
        if (colt >= split) { base = O1; ldc = ld1; colt -= split; }
        const int col0 = colt + wc * 32 + 8 * fq;
#pragma unroll
        for (int ai = 0; ai < 2; ++ai)
#pragma unroll
            for (int m = 0; m < 4; ++m) { const int row = row0 + ai * HALF + m * 16; float sc = 1.f;
                if (rs) sc = rs[row];
                else if (ssq) { const f32x4* q = (const f32x4*)(ssq + (size_t)row * 16); const f32x4 a = q[0], b = q[1], c = q[2], d = q[3];
                    const float s = ((a[0] + a[1]) + (a[2] + a[3])) + ((b[0] + b[1]) + (b[2] + b[3])) + ((c[0] + c[1]) + (c[2] + c[3])) + ((d[0] + d[1]) + (d[2] + d[3]));
                    sc = __builtin_amdgcn_rsqf(s * (1.0f / 1024.0f) + EPS); }
                bf16_t* rowp = base + (size_t)row * ldc + col0;
#pragma unroll
                for (int bj = 0; bj < 2; ++bj) { const f32x4 v0 = acc[ai][bj][m][0] * sc, v1 = acc[ai][bj][m][1] * sc;
                    u32x4 w; w.x = cvtpk(v0[0], v0[1]); w.y = cvtpk(v0[2], v0[3]); w.z = cvtpk(v1[0], v1[1]); w.w = cvtpk(v1[2], v1[3]);
                    *(u32x4*)(rowp + bj * HALF) = w; } }
    }
};
struct EpiRes {
    static constexpr bool PERM = true, AFTER_DRAIN = false;
    bf16_t* xb; float* ssq;
    __device__ __forceinline__ void operator()(const f32x4 (&acc)[2][2][4][2], const Unit& u, int wr, int wc, int fr, int fq) const {
        const int row0 = u.pm * BM + wr * 64 + fr, col0 = u.pn * BM + wc * 32 + 8 * fq;
#pragma unroll
        for (int ai = 0; ai < 2; ++ai)
#pragma unroll
            for (int m = 0; m < 4; ++m) { const int row = row0 + ai * HALF + m * 16; bf16_t* p = xb + (size_t)row * DM + col0; float ss = 0.f;
#pragma unroll
                for (int bj = 0; bj < 2; ++bj) { const u32x4 r = *(const u32x4*)(p + bj * HALF); const f32x4 a0 = acc[ai][bj][m][0], a1 = acc[ai][bj][m][1];
                    const float o0 = bflo(r.x) + a0[0], o1 = bfhi(r.x) + a0[1], o2 = bflo(r.y) + a0[2], o3 = bfhi(r.y) + a0[3], o4 = bflo(r.z) + a1[0], o5 = bfhi(r.z) + a1[1], o6 = bflo(r.w) + a1[2], o7 = bfhi(r.w) + a1[3];
                    u32x4 w; w.x = cvtpk(o0, o1); w.y = cvtpk(o2, o3); w.z = cvtpk(o4, o5); w.w = cvtpk(o6, o7); *(u32x4*)(p + bj * HALF) = w;
                    ss += ((o0 * o0 + o1 * o1) + (o2 * o2 + o3 * o3)) + ((o4 * o4 + o5 * o5) + (o6 * o6 + o7 * o7)); }
                ss += __shfl_xor(ss, 16); ss += __shfl_xor(ss, 32);
                if (fq == 0) ssq[(size_t)row * 16 + u.pn * 4 + wc] = ss; }
    }
};
struct EpiKVQ {
    static constexpr bool PERM = true, AFTER_DRAIN = false;
    bf16_t* KR; bf16_t* VV; bf16_t* A3; float* KMP; const float* rs; const float* rope;
    __device__ __forceinline__ void operator()(const f32x4 (&acc)[2][2][4][2], const Unit& u, int wr, int wc, int fr, int fq) const {
        const int pn = u.pn, pm = u.pm, b = pm >> 4, s0 = (pm & 15) * 256, rl0 = wr * 64 + fr, g0 = 32 * wc + 8 * fq;
        float rsv[2][4];
#pragma unroll
        for (int ai = 0; ai < 2; ++ai)
#pragma unroll
            for (int m = 0; m < 4; ++m) rsv[ai][m] = rs[pm * BM + rl0 + ai * HALF + m * 16];
        if (pn < 4 || (pn >= 8 && pn < 12)) {
            const bool isK = pn < 4; const int hp = isK ? pn : pn - 8; const int i0 = 16 * wc + 4 * fq;
            f32x4 klo[2] = {{0.f, 0.f, 0.f, 0.f}, {0.f, 0.f, 0.f, 0.f}}, khi[2] = {{0.f, 0.f, 0.f, 0.f}, {0.f, 0.f, 0.f, 0.f}};
#pragma unroll
            for (int ai = 0; ai < 2; ++ai)
#pragma unroll
                for (int m = 0; m < 4; ++m) { const int rl = rl0 + ai * HALF + m * 16, s = s0 + rl;
                    const f32x4 cs0 = *(const f32x4*)(rope + ((size_t)s * 64 + i0) * 2), cs1 = *(const f32x4*)(rope + ((size_t)s * 64 + i0) * 2 + 4);
                    const f32x4 c = {cs0[0], cs0[2], cs1[0], cs1[2]}, sn = {cs0[1], cs0[3], cs1[1], cs1[3]};
#pragma unroll
                    for (int bj = 0; bj < 2; ++bj) { const int head = 2 * hp + bj;
                        const f32x4 v1 = acc[ai][bj][m][0] * rsv[ai][m], v2 = acc[ai][bj][m][1] * rsv[ai][m];
                        const f32x4 lo = v1 * c - v2 * sn, hi = v2 * c + v1 * sn;
                        u32x4 w; w.x = cvtpk(lo[0], lo[1]); w.y = cvtpk(lo[2], lo[3]); w.z = cvtpk(hi[0], hi[1]); w.w = cvtpk(hi[2], hi[3]);
                        bf16_t* dst = isK ? KR + ((size_t)(b * 8 + head) * SEQ + s) * 128 + g0 : A3 + (size_t)(pm * BM + rl) * MIXW + head * 128 + g0;
                        *(u32x4*)dst = w;
                        klo[bj] += lo; khi[bj] += hi; } }
            if (isK) {
#pragma unroll
                for (int bj = 0; bj < 2; ++bj) {
#pragma unroll
                    for (int j = 0; j < 4; ++j) {
#pragma unroll
                        for (int o = 1; o < 16; o <<= 1) { klo[bj][j] += __shfl_xor(klo[bj][j], o); khi[bj][j] += __shfl_xor(khi[bj][j], o); } }
                    if (fr == 0) { float* kp = KMP + ((size_t)pm * 2 + wr) * 1024 + (2 * hp + bj) * 128 + g0; *(f32x4*)kp = klo[bj]; *(f32x4*)(kp + 4) = khi[bj]; } } }
        } else {
            const bool isV = pn < 8;
#pragma unroll
            for (int bj = 0; bj < 2; ++bj)
#pragma unroll
                for (int ai = 0; ai < 2; ++ai)
#pragma unroll
                    for (int m = 0; m < 4; ++m) { const int rl = rl0 + ai * HALF + m * 16, s = s0 + rl;
                        const f32x4 v0 = acc[ai][bj][m][0] * rsv[ai][m], v1 = acc[ai][bj][m][1] * rsv[ai][m];
                        u32x4 w; w.x = cvtpk(v0[0], v0[1]); w.y = cvtpk(v0[2], v0[3]); w.z = cvtpk(v1[0], v1[1]); w.w = cvtpk(v1[2], v1[3]);
                        bf16_t* dst = isV ? VV + ((size_t)(b * 8 + 2 * (pn - 4) + bj) * SEQ + s) * 128 + g0 : A3 + (size_t)(pm * BM + rl) * MIXW + 1024 + (pn - 12) * 256 + bj * HALF + g0;
                        *(u32x4*)dst = w; }
        }
    }
};

template <class Epi, class Sched, bool ALIGN_EPI = true, bool SP2 = true>
__device__ __forceinline__ void gemm_phase(PG8_LAS unsigned char* lds, const Gemm g, const Sched& S, const Epi& E) {
    int tid = threadIdx.x; asm volatile("" : "+v"(tid));
    const int wid = __builtin_amdgcn_readfirstlane(tid >> 6), lane = tid & 63, wr = wid >> 2, wc = wid & 3, fr = lane & 15, fq = lane >> 4;
    const int K = g.K, nt = K / BK;
    unsigned voffA[2], voffB[2];
#pragma unroll
    for (int i = 0; i < 2; ++i) { int R, C; stage_rc(tid * 16 + i * 8192, R, C); const int Rb = Epi::PERM ? ((R & ~31) + perm32(R & 31)) : R;
        voffA[i] = (unsigned)(R * K + C) * 2u; voffB[i] = (unsigned)(Rb * K + C) * 2u; }
    const size_t kstep = (size_t)(BK * 2);
    const size_t hstep = (size_t)HALF * K * 2;
    const size_t tstep = 2 * hstep;
    const unsigned ldsw = (unsigned)wid * 1024u;
    const int aoff = lds_byte(wr * 64 + fr, fq * 8), boff = lds_byte(wc * 32 + fr, fq * 8);
#define PG8_SA(b, h) (((b) * 2 + (h)) * HTB)
#define PG8_SB(b, h) ((4 + (b) * 2 + (h)) * HTB)
#define PG8_STAGE(bufoff, gbase, voff) do { _Pragma("unroll") for (int _i = 0; _i < 2; ++_i) \
        __builtin_amdgcn_global_load_lds((const unsigned*)((const char*)(gbase) + (voff)[_i]), (PG8_LAS unsigned*)(lds + (bufoff) + ldsw + _i * 8192), 16, 0, 0); } while (0)
#define PG8_LDA(dst, b, h) do { _Pragma("unroll") for (int m = 0; m < 4; ++m) _Pragma("unroll") for (int k = 0; k < 2; ++k) dst[m][k] = *(const PG8_LAS bf16x8*)(lds + PG8_SA(b, h) + aoff + m * 2048 + k * 1024); } while (0)
#define PG8_LDB(dst, b, h) do { _Pragma("unroll") for (int n = 0; n < 2; ++n) _Pragma("unroll") for (int k = 0; k < 2; ++k) dst[n][k] = *(const PG8_LAS bf16x8*)(lds + PG8_SB(b, h) + boff + n * 2048 + k * 1024); } while (0)
#define PG8_MMA(ai, bj, At, Bt) do { __builtin_amdgcn_s_setprio(1); _Pragma("unroll") for (int m = 0; m < 4; ++m) _Pragma("unroll") for (int n = 0; n < 2; ++n) _Pragma("unroll") for (int k = 0; k < 2; ++k) \
        acc[ai][bj][m][n] = __builtin_amdgcn_mfma_f32_16x16x32_bf16(Bt[n][k], At[m][k], acc[ai][bj][m][n], 0, 0, 0); __builtin_amdgcn_s_setprio(0); } while (0)
#define PG8_WAIT_V(n) asm volatile("s_waitcnt vmcnt(" #n ")" ::: "memory")
#define PG8_WAIT_L(n) asm volatile("s_waitcnt lgkmcnt(" #n ")" ::: "memory")
#define PG8_BAR __builtin_amdgcn_s_barrier()
#define PG8_SCHED __builtin_amdgcn_sched_barrier(0)
    Unit cur, nxt; int ui = 0;
    if (!S.next(0, cur)) return;
    f32x4 acc[2][2][4][2];
#pragma unroll
    for (int a = 0; a < 2; ++a)
#pragma unroll
        for (int b = 0; b < 2; ++b)
#pragma unroll
            for (int m = 0; m < 4; ++m)
#pragma unroll
                for (int n = 0; n < 2; ++n) acc[a][b][m][n] = (f32x4){0.f, 0.f, 0.f, 0.f};
    bf16x8 At[4][2], B0[2][2], B1[2][2];
    const char* cA = (const char*)g.A + (size_t)cur.pm * tstep; const char* cB = (const char*)g.Bt + (size_t)cur.pn * tstep;
    S.a_ready(cur);
    if constexpr (SP2) {
        PG8_STAGE(PG8_SB(0, 0), cB, voffB); PG8_STAGE(PG8_SB(0, 1), cB + hstep, voffB); PG8_STAGE(PG8_SA(0, 0), cA, voffA); PG8_STAGE(PG8_SA(0, 1), cA + hstep, voffA);
        if (wr == 1) PG8_BAR;
        PG8_WAIT_V(2); PG8_BAR;
        PG8_STAGE(PG8_SB(1, 0), cB + kstep, voffB); PG8_STAGE(PG8_SA(1, 0), cA + kstep, voffA); PG8_STAGE(PG8_SB(1, 1), cB + hstep + kstep, voffB);
        PG8_WAIT_V(6); PG8_BAR;
    } else {
        PG8_STAGE(PG8_SB(0, 0), cB, voffB); PG8_STAGE(PG8_SA(0, 0), cA, voffA); PG8_STAGE(PG8_SB(0, 1), cB + hstep, voffB); PG8_STAGE(PG8_SA(0, 1), cA + hstep, voffA);
        if (wr == 1) PG8_BAR;
        PG8_WAIT_V(4); PG8_BAR;
        PG8_STAGE(PG8_SB(1, 0), cB + kstep, voffB); PG8_STAGE(PG8_SA(1, 0), cA + kstep, voffA); PG8_STAGE(PG8_SB(1, 1), cB + hstep + kstep, voffB);
        PG8_WAIT_V(6); PG8_BAR;
    }
    for (;;) {
        const bool has_next = S.next(ui + 1, nxt);
        const char* nA = has_next ? (const char*)g.A + (size_t)nxt.pm * tstep : cA; const char* nB = has_next ? (const char*)g.Bt + (size_t)nxt.pn * tstep : cB;
        for (int t = 0; t < nt; t += 2) {
            const bool last = (t == nt - 2);
            const char* a1 = cA + (size_t)(t + 1) * kstep;
            const char* a2 = last ? nA : cA + (size_t)(t + 2) * kstep; const char* b2 = last ? nB : cB + (size_t)(t + 2) * kstep;
            const char* a3 = a2 + kstep; const char* b3 = b2 + kstep;
            if (last && has_next) S.a_ready(nxt);
            if constexpr (SP2) {
            PG8_LDB(B0, 0, 0); PG8_LDB(B1, 0, 1); PG8_SCHED; PG8_LDA(At, 0, 0); PG8_STAGE(PG8_SA(1, 1), a1 + hstep, voffA);
            PG8_WAIT_V(8); PG8_WAIT_L(0); PG8_BAR; PG8_MMA(0, 0, At, B0); PG8_MMA(0, 1, At, B1); PG8_BAR; PG8_SCHED;
            PG8_LDA(At, 0, 1); PG8_STAGE(PG8_SB(0, 0), b2, voffB); PG8_STAGE(PG8_SB(0, 1), b2 + hstep, voffB); PG8_STAGE(PG8_SA(0, 0), a2, voffA);
            PG8_WAIT_V(8); PG8_WAIT_L(0); PG8_BAR; PG8_MMA(1, 0, At, B0); PG8_MMA(1, 1, At, B1); PG8_BAR; PG8_SCHED;
            PG8_LDB(B0, 1, 0); PG8_LDB(B1, 1, 1); PG8_SCHED; PG8_LDA(At, 1, 0); PG8_STAGE(PG8_SA(0, 1), a2 + hstep, voffA);
            PG8_WAIT_V(8); PG8_WAIT_L(0); PG8_BAR; PG8_MMA(0, 0, At, B0); PG8_MMA(0, 1, At, B1); PG8_BAR; PG8_SCHED;
            PG8_LDA(At, 1, 1); PG8_STAGE(PG8_SB(1, 0), b3, voffB); PG8_STAGE(PG8_SB(1, 1), b3 + hstep, voffB); PG8_STAGE(PG8_SA(1, 0), a3, voffA);
            PG8_WAIT_V(8); PG8_WAIT_L(0); PG8_BAR; PG8_MMA(1, 0, At, B0); PG8_MMA(1, 1, At, B1); PG8_BAR; PG8_SCHED;
            } else {
            PG8_LDB(B0, 0, 0); PG8_SCHED; PG8_LDA(At, 0, 0); PG8_STAGE(PG8_SA(1, 1), a1 + hstep, voffA);
            PG8_WAIT_L(8); PG8_BAR; PG8_WAIT_L(0); PG8_MMA(0, 0, At, B0); PG8_BAR; PG8_SCHED;
            PG8_LDB(B1, 0, 1); PG8_STAGE(PG8_SB(0, 0), b2, voffB);
            PG8_BAR; PG8_WAIT_L(0); PG8_MMA(0, 1, At, B1); PG8_BAR;
            PG8_LDA(At, 0, 1); PG8_STAGE(PG8_SA(0, 0), a2, voffA);
            PG8_BAR; PG8_WAIT_L(0); PG8_MMA(1, 0, At, B0); PG8_BAR; PG8_SCHED;
            PG8_STAGE(PG8_SB(0, 1), b2 + hstep, voffB);
            PG8_WAIT_V(6); PG8_BAR; PG8_MMA(1, 1, At, B1); PG8_BAR;
            PG8_LDB(B0, 1, 0); PG8_SCHED; PG8_LDA(At, 1, 0); PG8_STAGE(PG8_SA(0, 1), a2 + hstep, voffA);
            PG8_WAIT_L(8); PG8_BAR; PG8_WAIT_L(0); PG8_MMA(0, 0, At, B0); PG8_BAR; PG8_SCHED;
            PG8_LDB(B1, 1, 1); PG8_STAGE(PG8_SB(1, 0), b3, voffB);
            PG8_BAR; PG8_WAIT_L(0); PG8_MMA(0, 1, At, B1); PG8_BAR;
            PG8_LDA(At, 1, 1); PG8_STAGE(PG8_SA(1, 0), a3, voffA);
            PG8_BAR; PG8_WAIT_L(0); PG8_MMA(1, 0, At, B0); PG8_BAR; PG8_SCHED;
            PG8_STAGE(PG8_SB(1, 1), b3 + hstep, voffB);
            PG8_WAIT_V(6); PG8_BAR; PG8_MMA(1, 1, At, B1); PG8_BAR;
            }
        }
        if constexpr (ALIGN_EPI) { if (wr == 0) PG8_BAR; }
        if constexpr (!Epi::AFTER_DRAIN) { E(acc, cur, wr, wc, fr, fq); S.done(cur); }
        if (!has_next) break;
#pragma unroll
        for (int a = 0; a < 2; ++a)
#pragma unroll
            for (int b = 0; b < 2; ++b)
#pragma unroll
                for (int m = 0; m < 4; ++m)
#pragma unroll
                    for (int n = 0; n < 2; ++n) acc[a][b][m][n] = (f32x4){0.f, 0.f, 0.f, 0.f};
        cur = nxt; cA = nA; cB = nB; ++ui;
        if constexpr (ALIGN_EPI) { if (wr == 1) PG8_BAR; }
    }
    PG8_WAIT_V(0);
    if constexpr (!ALIGN_EPI) { if (wr == 0) PG8_BAR; }
    PG8_BAR;
#undef PG8_SA
#undef PG8_SB
#undef PG8_STAGE
#undef PG8_LDA
#undef PG8_LDB
#undef PG8_MMA
#undef PG8_WAIT_V
#undef PG8_WAIT_L
#undef PG8_BAR
#undef PG8_SCHED
}
}

namespace att {
constexpr int D = 128, NW = 8, QBLK = 32, KVBLK = 64;
constexpr float SCALE = 0.088388347648318440f;
constexpr float THR = 8.f;
constexpr size_t SHM_V = KVBLK * D * 2, SHM_K = KVBLK * D * 2, SHM_ATTN = 2 * SHM_V + 2 * SHM_K + NW * 64 * 4;
#define KSWZ(row, colB) ((row) * 256 + ((colB) ^ (((row) & 7) << 4)))
#define SBAR() __builtin_amdgcn_sched_barrier(0)
__device__ __forceinline__ int crow(int r, int hi) { return (r & 3) + 8 * (r >> 2) + 4 * hi; }

template <bool MOBA>
__device__ __forceinline__ void partialSM(f32x16& p0, f32x16& p1, float& m_reg, float& mn, float& alpha, int t, int qrow, int hi, unsigned selmask) {
  constexpr float C = SCALE * 1.4426950408889634f;
  if constexpr (MOBA) {
    if (t < 4) { const int kb = t * 64 + 4 * hi;
#pragma unroll
      for (int r = 0; r < 16; ++r) { const int kk = kb + (r & 3) + 8 * (r >> 2); p0[r] = (kk > qrow) ? -1e30f : p0[r]; p1[r] = (kk + 32 > qrow) ? -1e30f : p1[r]; }
    } else { const bool keep = (selmask >> ((t - 4) >> 2)) & 1u;
#pragma unroll
      for (int r = 0; r < 16; ++r) { p0[r] = keep ? p0[r] : -1e30f; p1[r] = keep ? p1[r] : -1e30f; } }
  }
  float pmax = p0[0];
#pragma unroll
  for (int r = 1; r < 16; ++r) pmax = fmaxf(pmax, p0[r]);
#pragma unroll
  for (int r = 0; r < 16; ++r) pmax = fmaxf(pmax, p1[r]);
  { auto rr = __builtin_amdgcn_permlane32_swap(__float_as_uint(pmax), __float_as_uint(pmax), false, false);
    pmax = fmaxf(__uint_as_float(rr[0]), __uint_as_float(rr[1])); }
  if (__builtin_expect(__all(pmax - m_reg <= THR / SCALE), 1)) { mn = m_reg; alpha = 1.f; }
  else { mn = fmaxf(m_reg, pmax); alpha = __builtin_amdgcn_exp2f((m_reg - mn) * C); m_reg = mn; }
  float mnC = -mn * C;
#pragma unroll
  for (int r = 0; r < 16; ++r) p0[r] = fmaf(p0[r], C, mnC);
#pragma unroll
  for (int r = 0; r < 16; ++r) p1[r] = fmaf(p1[r], C, mnC);
#pragma unroll
  for (int r = 0; r < 16; ++r) p0[r] = __builtin_amdgcn_exp2f(p0[r]);
}
__device__ __forceinline__ void finishSM(f32x16& p0, f32x16& p1, float alpha, float& l_reg, bf16x8& pa0, bf16x8& pa1, bf16x8& pa2, bf16x8& pa3) {
#pragma unroll
  for (int r = 0; r < 16; ++r) p1[r] = __builtin_amdgcn_exp2f(p1[r]);
  float ps = 0;
#pragma unroll
  for (int r = 0; r < 16; ++r) ps += p0[r];
#pragma unroll
  for (int r = 0; r < 16; ++r) ps += p1[r];
  { auto rr = __builtin_amdgcn_permlane32_swap(__float_as_uint(ps), __float_as_uint(ps), false, false);
    ps = __uint_as_float(rr[0]) + __uint_as_float(rr[1]); }
  l_reg = l_reg * alpha + ps;
#define PK4(P, BASE, OUT) do { unsigned a0 = cvtpk(P[BASE + 0], P[BASE + 1]), a1 = cvtpk(P[BASE + 2], P[BASE + 3]);   \
    unsigned b0 = cvtpk(P[BASE + 4], P[BASE + 5]), b1 = cvtpk(P[BASE + 6], P[BASE + 7]);                              \
    auto r0 = __builtin_amdgcn_permlane32_swap(a0, b0, false, false); auto r1 = __builtin_amdgcn_permlane32_swap(a1, b1, false, false); \
    u32x4 w = {r0[0], r1[0], r0[1], r1[1]}; OUT = *reinterpret_cast<bf16x8*>(&w); } while (0)
  PK4(p0, 0, pa0); PK4(p0, 8, pa1); PK4(p1, 0, pa2); PK4(p1, 8, pa3);
#undef PK4
}
__device__ __forceinline__ void qkt(f32x16& p0, f32x16& p1, const char* Ks, const bf16x8* qr, const int (&ka)[4]) {
  p0 = f32x16{}; p1 = f32x16{};
#pragma unroll
  for (int d0 = 0; d0 < 8; ++d0) {
    bf16x8 b0 = *reinterpret_cast<const bf16x8*>(Ks + ka[d0 & 3] + (d0 >> 2) * 128);
    bf16x8 b1 = *reinterpret_cast<const bf16x8*>(Ks + ka[d0 & 3] + (d0 >> 2) * 128 + 8192);
    p0 = __builtin_amdgcn_mfma_f32_32x32x16_bf16(b0, qr[d0], p0, 0, 0, 0);
    p1 = __builtin_amdgcn_mfma_f32_32x32x16_bf16(b1, qr[d0], p1, 0, 0, 0); }
}
__device__ __forceinline__ void qkt1(f32x16& p0, const char* Ks, const bf16x8* qr, const int (&ka)[4]) {
  p0 = f32x16{};
#pragma unroll
  for (int d0 = 0; d0 < 8; ++d0) {
    bf16x8 b0 = *reinterpret_cast<const bf16x8*>(Ks + ka[d0 & 3] + (d0 >> 2) * 128);
    p0 = __builtin_amdgcn_mfma_f32_32x32x16_bf16(b0, qr[d0], p0, 0, 0, 0); }
}
__device__ __forceinline__ int v_st(int k, int c) { const int kk = (k & ~0xC) | ((k & 4) << 1) | ((k & 8) >> 1); return ((kk >> 3) * 4 + (c >> 5)) * 512 + ((kk & 7) * 32 + (c & 31)) * 2; }
__device__ __forceinline__ int v_rd_base(int lane) { return ((lane & 3) << 3) | (((lane >> 2) & 3) << 6) | (((lane >> 4) & 1) << 5) | (((lane >> 5) & 1) << 8); }
constexpr int v_rd_off(int d0, int ks, int half) { return d0 * 512 + ks * 4096 + half * 2048; }
template <int OFF> __device__ __forceinline__ s16x4 tr_read(int vb) {
  s16x4 r; asm volatile("ds_read_b64_tr_b16 %0, %1 offset:%2" : "=&v"(r) : "v"(vb), "i"(OFF) : "memory"); return r;
}
template <int D0> __device__ __forceinline__ void pv_one(f32x16& od, int vb, bf16x8 pa0, bf16x8 pa1, bf16x8 pa2, bf16x8 pa3) {
  const s16x4 l0 = tr_read<v_rd_off(D0, 0, 0)>(vb), h0 = tr_read<v_rd_off(D0, 0, 1)>(vb), l1 = tr_read<v_rd_off(D0, 1, 0)>(vb), h1 = tr_read<v_rd_off(D0, 1, 1)>(vb);
  const s16x4 l2 = tr_read<v_rd_off(D0, 2, 0)>(vb), h2 = tr_read<v_rd_off(D0, 2, 1)>(vb), l3 = tr_read<v_rd_off(D0, 3, 0)>(vb), h3 = tr_read<v_rd_off(D0, 3, 1)>(vb);
  asm volatile("s_waitcnt lgkmcnt(0)" ::: "memory"); SBAR();
#define PK(L, H) (bf16x8){L[0], L[1], L[2], L[3], H[0], H[1], H[2], H[3]}
  od = __builtin_amdgcn_mfma_f32_32x32x16_bf16(pa0, PK(l0, h0), od, 0, 0, 0);
  od = __builtin_amdgcn_mfma_f32_32x32x16_bf16(pa1, PK(l1, h1), od, 0, 0, 0);
  od = __builtin_amdgcn_mfma_f32_32x32x16_bf16(pa2, PK(l2, h2), od, 0, 0, 0);
  od = __builtin_amdgcn_mfma_f32_32x32x16_bf16(pa3, PK(l3, h3), od, 0, 0, 0);
#undef PK
}
__device__ __forceinline__ void pv_d0(f32x16* o, int vb, bf16x8 pa0, bf16x8 pa1, bf16x8 pa2, bf16x8 pa3) {
  pv_one<0>(o[0], vb, pa0, pa1, pa2, pa3); pv_one<1>(o[1], vb, pa0, pa1, pa2, pa3); pv_one<2>(o[2], vb, pa0, pa1, pa2, pa3); pv_one<3>(o[3], vb, pa0, pa1, pa2, pa3);
}

template <int LDQ, int LDK, bool MOBA, int SDEPTH>
__device__ __forceinline__ void attn_unit(const bf16* Qb, const bf16* Kh, const bf16* Vh, bf16* Ob, int jblk, const float* kmp, char* lds) {
  int tid = threadIdx.x; asm volatile("" : "+v"(tid));
  const int wid = __builtin_amdgcn_readfirstlane(tid >> 6), lane = tid & 63, r32 = lane & 31, hi = lane >> 5;
  char* V_lds = lds; char* K_lds = lds + 2 * SHM_V;
  float* ws = (float*)(lds + 2 * SHM_V + 2 * SHM_K) + wid * 64; float* li_l = ws; float* al_l = ws + 32;
  float m_reg = -1e30f, l_reg = 0; f32x16 o[4] = {}; bf16x8 qr[8];
  const bf16* Qw = Qb + (long)(wid * QBLK + r32) * LDQ + hi * 8;
#pragma unroll
  for (int d0 = 0; d0 < 8; ++d0) qr[d0] = *reinterpret_cast<const bf16x8*>(Qw + d0 * 16);
  const int sr = tid >> 4, sc = (tid & 15) * 8, vst0 = v_st(sr, sc), vst1 = v_st(32 + sr, sc);
  const unsigned goff = (unsigned)(sr * LDK + sc) * 2u;
  const int vb0 = (int)(uintptr_t)V_lds + v_rd_base(lane);
  const int qrow = wid * QBLK + r32;
  int ka[4];
#pragma unroll
  for (int i = 0; i < 4; ++i) ka[i] = r32 * 256 + (((2 * i + hi) ^ (r32 & 7)) << 4);
  unsigned selmask = 0;
  struct { bf16x8 vs0, vs1, ks0, ks1; } sr_[SDEPTH];
  const int NT = MOBA ? 4 * (jblk + 1) : 4;
#define KOFF(t) (MOBA ? ((t) < 4 ? jblk * 256 + (t) * 64 : ((t) - 4) * 64) : (t) * 64)
#define SLOAD(i, k0) do { const char* kb_ = (const char*)Kh + (size_t)(k0) * (LDK * 2); const char* vb_ = (const char*)Vh + (size_t)(k0) * (LDK * 2); \
    sr_[i].vs0 = *reinterpret_cast<const bf16x8*>(vb_ + goff); sr_[i].vs1 = *reinterpret_cast<const bf16x8*>(vb_ + 32 * LDK * 2 + goff); \
    sr_[i].ks0 = *reinterpret_cast<const bf16x8*>(kb_ + goff); sr_[i].ks1 = *reinterpret_cast<const bf16x8*>(kb_ + 32 * LDK * 2 + goff); } while (0)
#define SWRITE(b, i) do { *(bf16x8*)(V_lds + (b) * SHM_V + vst0) = sr_[i].vs0;          \
    *(bf16x8*)(V_lds + (b) * SHM_V + vst1) = sr_[i].vs1; int kc = sc * 2;               \
    *(bf16x8*)(K_lds + (b) * SHM_K + KSWZ(sr, kc)) = sr_[i].ks0;                       \
    *(bf16x8*)(K_lds + (b) * SHM_K + KSWZ(32 + sr, kc)) = sr_[i].ks1; } while (0)
#define SWAIT() do { if constexpr (SDEPTH == 2) asm volatile("s_waitcnt vmcnt(4)" ::: "memory"); else asm volatile("s_waitcnt vmcnt(0)" ::: "memory"); } while (0)
#define RESC(a) do { if (__any((a) < 1.f)) { if (hi == 0) al_l[r32] = (a); asm volatile("s_waitcnt lgkmcnt(0)" ::: "memory"); \
    _Pragma("unroll") for (int d = 0; d < 4; ++d) _Pragma("unroll") for (int r = 0; r < 16; ++r) o[d][r] *= al_l[crow(r, hi)]; } } while (0)
  f32x16 pA0, pA1, pB0, pB1; float mnA, mnB, alA, alB; bf16x8 pa0, pa1, pa2, pa3;
  constexpr int SE = 0, SO = SDEPTH - 1;
  SLOAD(SE, KOFF(0));
  if constexpr (MOBA) {
    const int gr = tid >> 4, gc = (tid & 15) * 8; f32x4 a = {0.f, 0.f, 0.f, 0.f}, b = {0.f, 0.f, 0.f, 0.f};
    if (gr < jblk) { const float* p0_ = kmp + (size_t)gr * 2048 + gc; const f32x4 a0 = *(const f32x4*)p0_, a1 = *(const f32x4*)(p0_ + 4), b0 = *(const f32x4*)(p0_ + 1024), b1 = *(const f32x4*)(p0_ + 1028);
      a = (a0 + b0) * (1.0f / 256.0f); b = (a1 + b1) * (1.0f / 256.0f); }
    u32x4 w = {pk2(a[0], a[1]), pk2(a[2], a[3]), pk2(b[0], b[1]), pk2(b[2], b[3])};
    *(u32x4*)(K_lds + SHM_K + KSWZ(gr, gc * 2)) = w;
  }
  asm volatile("s_waitcnt vmcnt(0)" ::: "memory"); SWRITE(0, SE); __syncthreads();
  qkt(pA0, pA1, K_lds, qr, ka);
  if constexpr (MOBA) {
    f32x16 g; qkt1(g, K_lds + SHM_K, qr, ka);
    float gv[16];
#pragma unroll
    for (int r = 0; r < 8; ++r) { auto rr = __builtin_amdgcn_permlane32_swap(__float_as_uint(g[r]), __float_as_uint(g[r]), false, false);
      const float lo_ = __uint_as_float(rr[0]), hi_ = __uint_as_float(rr[1]);
      const int n0 = (r & 3) + 8 * (r >> 2); gv[n0] = lo_; gv[n0 + 4] = hi_; }
#pragma unroll
    for (int n = 0; n < 16; ++n) gv[n] = (n < jblk) ? gv[n] : -3e38f;
#pragma unroll
    for (int k = 0; k < 3; ++k) { float best = gv[0];
#pragma unroll
      for (int n = 1; n < 16; ++n) best = fmaxf(best, gv[n]);
      int idx = 16;
#pragma unroll
      for (int n = 15; n >= 0; --n) idx = (gv[n] == best) ? n : idx;
      if (best > -1e38f) selmask |= 1u << idx;
#pragma unroll
      for (int n = 0; n < 16; ++n) gv[n] = (n == idx) ? -3e38f : gv[n]; }
  }
  partialSM<MOBA>(pA0, pA1, m_reg, mnA, alA, 0, qrow, hi, selmask);
  SLOAD(SO, KOFF(1)); if constexpr (SDEPTH == 2) { if (2 < NT) SLOAD(SE, KOFF(2)); }
  if constexpr (MOBA) __syncthreads();
  SWAIT(); SWRITE(1, SO); __syncthreads();
  for (int j = 1; j + 1 < NT; j += 2) {
    SBAR(); qkt(pB0, pB1, K_lds + SHM_K, qr, ka);
    finishSM(pA0, pA1, alA, l_reg, pa0, pa1, pa2, pa3); SBAR();
    SLOAD(SO, KOFF(j + SDEPTH)); SBAR();
    pv_d0(o, vb0, pa0, pa1, pa2, pa3); partialSM<MOBA>(pB0, pB1, m_reg, mnB, alB, j, qrow, hi, selmask);
    __syncthreads(); SWAIT(); SWRITE(0, SE);
    RESC(alB); __syncthreads();
    SBAR(); qkt(pA0, pA1, K_lds, qr, ka);
    finishSM(pB0, pB1, alB, l_reg, pa0, pa1, pa2, pa3); SBAR();
    if (SDEPTH == 1 || j + 3 < NT) SLOAD(SE, KOFF(j + 1 + SDEPTH)); SBAR();
    pv_d0(o, vb0 + (int)SHM_V, pa0, pa1, pa2, pa3); partialSM<MOBA>(pA0, pA1, m_reg, mnA, alA, j + 1, qrow, hi, selmask);
    __syncthreads(); SWAIT(); SWRITE(1, SO);
    RESC(alA); __syncthreads();
  }
  SBAR(); qkt(pB0, pB1, K_lds + SHM_K, qr, ka);
  finishSM(pA0, pA1, alA, l_reg, pa0, pa1, pa2, pa3); SBAR();
  pv_d0(o, vb0, pa0, pa1, pa2, pa3); partialSM<MOBA>(pB0, pB1, m_reg, mnB, alB, NT - 1, qrow, hi, selmask);
  __syncthreads(); RESC(alB);
  finishSM(pB0, pB1, alB, l_reg, pa0, pa1, pa2, pa3); SBAR();
  pv_d0(o, vb0 + (int)SHM_V, pa0, pa1, pa2, pa3);
  if (hi == 0) li_l[r32] = l_reg; asm volatile("s_waitcnt lgkmcnt(0)" ::: "memory");
  float rli[16];
#pragma unroll
  for (int r = 0; r < 16; ++r) rli[r] = __builtin_amdgcn_rcpf(li_l[crow(r, hi)]);
  __syncthreads();
  char* ost = lds + wid * 8192;
#pragma unroll
  for (int r = 0; r < 16; ++r) { const int orow = crow(r, hi);
#pragma unroll
    for (int d0 = 0; d0 < 4; ++d0) *(unsigned short*)(ost + orow * 256 + (d0 * 32 + r32) * 2) = (unsigned short)f2bf(o[d0][r] * rli[r]); }
  asm volatile("s_waitcnt lgkmcnt(0)" ::: "memory");
  bf16* Ow = Ob + (long)(wid * QBLK) * LDQ;
#pragma unroll
  for (int i = 0; i < 8; ++i) { const int row = i * 4 + (lane >> 4), ch = lane & 15; const u32x4 v = *(const u32x4*)(ost + row * 256 + ch * 16);
    *(u32x4*)(Ow + (long)row * LDQ + ch * 8) = v; }
  __syncthreads();
#undef KOFF
#undef SLOAD
#undef SWRITE
#undef SWAIT
#undef RESC
}
}

#ifndef ATT_SD_MEM
#define ATT_SD_MEM 1
#endif
#ifndef ATT_SD_MOBA
#define ATT_SD_MOBA 1
#endif
struct Args {
    const float* in[16]; float* out; unsigned char* ws; int ph_lo, ph_hi;
};
struct Frame {
    LAS unsigned char* lds; char* ldsg;
    int wave, vcu, G;
};
__device__ __forceinline__ int fresh_tid() { int t = threadIdx.x; asm volatile("" : "+v"(t)); return t; }

template <int MAP>
__device__ __forceinline__ void transpose_item(const float* W, int ldw, bf16* dst, int ldd, int row_off, int koff, const float* sc, LAS float* scr, int kb, int nb, int lane) {
    const int k0 = 64 * kb, n0 = 32 * nb;
#pragma unroll 8
    for (int i = 0; i < 32; ++i) { const int kk = 2 * i + (lane >> 5); float v = W[(size_t)(k0 + kk) * ldw + n0 + (lane & 31)]; if (sc) v *= sc[k0 + kk]; scr[kk * 33 + (lane & 31)] = v; }
    LDS_WAIT(); asm volatile("" ::: "memory");
    const int c = lane & 7;
#pragma unroll
    for (int j = 0; j < 4; ++j) { const int n = (lane >> 3) + 8 * j; const LAS float* s = scr + (8 * c) * 33 + n;
        u32x4 o; o.x = pk2(s[0 * 33], s[1 * 33]); o.y = pk2(s[2 * 33], s[3 * 33]); o.z = pk2(s[4 * 33], s[5 * 33]); o.w = pk2(s[6 * 33], s[7 * 33]);
        const int ns = n0 + n; int row;
        if (MAP == 1 && ns < 1024) { const int d = ns & 127; row = row_off + (ns & ~127) + 32 * ((d >> 4) & 3) + 8 * ((d >> 2) & 3) + 4 * (d >> 6) + (d & 3); } else row = row_off + ns;
        *(u32x4*)(dst + (size_t)row * ldd + koff + k0 + 8 * c) = o; }
    LDS_WAIT(); asm volatile("" ::: "memory");
}

__device__ __forceinline__ void phase0(const Args& a, Frame& F) {
    unsigned char* ws = a.ws;
    const int lane = fresh_tid() & 63;
    const int gw = F.vcu * NWAVES + F.wave, NGW = F.G * NWAVES;
    const int gt = gw * 64 + lane, NGT = NGW * 64;
    LAS float* scr = (LAS float*)(F.lds + F.wave * 16384);
    const float* x = a.in[0]; const float* mem = a.in[1]; const float* g_mix = a.in[2]; const float* w_in = a.in[3]; const float* w_out = a.in[4]; const float* w_mkv = a.in[5];
    const float* pool_w = a.in[6]; const float* pool_sc = a.in[7]; const float* g_kv = a.in[8]; const float* w_kv = a.in[9]; const float* g_ffn = a.in[10]; const float* wq = a.in[11];
    const float* subk = a.in[12]; const float* pu = a.in[13]; const float* pv = a.in[14];
    constexpr int I1 = 16 * 48, I2 = 16 * 48, I3 = 16 * 64, I4 = 8 * 32, I5 = 24 * 32, I6 = 2 * 16 * 32, I7 = 2 * 16 * 64;
    constexpr int NIT = I1 + I2 + I3 + I4 + I5 + I6 + I7;
    for (int it = gw; it < NIT; it += NGW) {
        int r = it;
        if (r < I1) { transpose_item<0>(w_in, MIXW, (bf16*)(ws + WS_WIN0), DM, 0, 0, g_mix, scr, r / 48, r % 48, lane); continue; } r -= I1;
        if (r < I2) { transpose_item<1>(w_in + (size_t)DM * MIXW, MIXW, (bf16*)(ws + WS_WC4), DM, 2048, 0, g_mix + DM, scr, r / 48, r % 48, lane); continue; } r -= I2;
        if (r < I3) { transpose_item<1>(w_kv, 2048, (bf16*)(ws + WS_WC4), DM, 0, 0, g_kv, scr, r / 64, r % 64, lane); continue; } r -= I3;
        if (r < I4) { transpose_item<0>(w_out + (size_t)1024 * DM, DM, (bf16*)(ws + WS_WC0), MIXW, 0, 1024, nullptr, scr, r / 32, r % 32, lane); continue; } r -= I4;
        if (r < I5) { transpose_item<0>(w_out + (size_t)MIXW * DM, DM, (bf16*)(ws + WS_WOUT1), MIXW, 0, 0, nullptr, scr, r / 32, r % 32, lane); continue; } r -= I5;
        if (r < I6) { const int l = r / 512, q = r % 512; transpose_item<0>(w_mkv + (size_t)l * DM * 1024, 1024, (bf16*)(ws + WS_WMKV), DM, l * 1024, 0, nullptr, scr, q / 32, q % 32, lane); continue; } r -= I6;
        { const int l = r / 1024, q = r % 1024; transpose_item<0>(wq + (size_t)l * DM * 2048, 2048, (bf16*)(ws + (l ? WS_WQ1 : WS_WQ0)), DM, 0, 0, g_ffn + l * DM, scr, q / 64, q % 64, lane); }
    }
    for (int it = gw; it < 2048; it += NGW) {
        const int itu = __builtin_amdgcn_readfirstlane(it); const int g = itu >> 9, cg8 = (itu >> 4) & 31, nch = itu & 15; const int n = nch * 64 + lane;
        float acc[8];
#pragma unroll
        for (int i = 0; i < 8; ++i) acc[i] = 0.f;
        const float* pw = pool_w + ((size_t)g * 256 + cg8 * 8) * 256;
#pragma unroll 1
        for (int k = 0; k < 4; ++k) { float cf[8]; const float sc = pool_sc[g * 256 + k * 64 + lane];
#pragma unroll
            for (int i = 0; i < 8; ++i) cf[i] = pw[i * 256 + k * 64 + lane] * sc;
            float wv[64];
#pragma unroll
            for (int l = 0; l < 64; ++l) wv[l] = w_out[(size_t)(g * 256 + k * 64 + l) * DM + n];
#pragma unroll
            for (int l = 0; l < 64; ++l) {
#pragma unroll
                for (int i = 0; i < 8; ++i) acc[i] = fmaf(__builtin_bit_cast(float, __builtin_amdgcn_readlane(__builtin_bit_cast(int, cf[i]), l)), wv[l], acc[i]); } }
        u32x4 o; o.x = pk2(acc[0], acc[1]); o.y = pk2(acc[2], acc[3]); o.z = pk2(acc[4], acc[5]); o.w = pk2(acc[6], acc[7]);
        *(u32x4*)((bf16*)(ws + WS_WC0) + (size_t)n * MIXW + g * 256 + cg8 * 8) = o;
    }
    {
        const size_t n8a = (size_t)2 * 16 * 128 * 128 / 8, n8b = (size_t)2048 * 1024 / 8;
        for (size_t i = gt; i < n8a + n8b; i += NGT) { const bool A = i < n8a; const size_t j = A ? i : i - n8a; const float* src = (A ? subk : mem) + j * 8; bf16* dst = (bf16*)(ws + (A ? WS_SUBK : WS_MEMB)) + j * 8;
            const f32x4 v0 = *(const f32x4*)src, v1 = *(const f32x4*)(src + 4); u32x4 o = {pk2(v0[0], v0[1]), pk2(v0[2], v0[3]), pk2(v1[0], v1[1]), pk2(v1[2], v1[3])}; *(u32x4*)dst = o; }
    }
    for (int r = gw; r < 4 * NEXP; r += NGW) { const int tb = r / (2 * NEXP), rr = r % (2 * NEXP), l = rr / NEXP;
        const f32x4* src = (const f32x4*)((tb ? pv : pu) + (size_t)rr * DM) + lane; f32x4 v[4];
#pragma unroll
        for (int i = 0; i < 4; ++i) v[i] = src[64 * i];
        if (!tb) { const f32x4* gp = (const f32x4*)(g_ffn + l * DM) + lane;
#pragma unroll
            for (int i = 0; i < 4; ++i) v[i] *= gp[64 * i]; }
        float am = 0.f;
#pragma unroll
        for (int i = 0; i < 4; ++i) am = fmaxf(fmaxf(fmaxf(am, fabsf(v[i][0])), fmaxf(fabsf(v[i][1]), fabsf(v[i][2]))), fabsf(v[i][3]));
#pragma unroll
        for (int o = 1; o < 64; o <<= 1) am = fmaxf(am, __shfl_xor(am, o));
        const int eb = (int)((__builtin_bit_cast(unsigned, am) >> 23) & 0xffu);
        const float sc = (eb < 16) ? 1.0f : __builtin_bit_cast(float, (unsigned)(127 + 7 + 127 - eb) << 23);
        const float isc = (eb < 16) ? 1.0f : __builtin_bit_cast(float, (unsigned)(eb - 7) << 23);
        unsigned* dst = (unsigned*)(ws + (tb ? WS_VB : WS_UB) + (size_t)rr * DM) + lane;
#pragma unroll
        for (int i = 0; i < 4; ++i) { int w = __builtin_amdgcn_cvt_pk_fp8_f32(v[i][0] * sc, v[i][1] * sc, 0, false); w = __builtin_amdgcn_cvt_pk_fp8_f32(v[i][2] * sc, v[i][3] * sc, w, true); dst[64 * i] = (unsigned)w; }
        if (lane == 0) ((float*)(ws + (tb ? WS_VSC : WS_USC)))[rr] = isc; }
    for (int i = gt; i < SEQ * 64; i += NGT) { const int pos = i >> 6, fi = i & 63; const float inv = exp2f(-(float)fi * 0.20762050593046015f);
        float sn, cs_; sincosf((float)pos * inv, &sn, &cs_); f32x2 cs = {cs_, sn}; *(f32x2*)((float*)(ws + WS_ROPE) + (size_t)i * 2) = cs; }
    for (int t = gw; t < T; t += NGW) { const f32x4* xr = (const f32x4*)(x + (size_t)t * DM) + lane; f32x4 v[4]; float s = 0.f;
#pragma unroll
        for (int j = 0; j < 4; ++j) { v[j] = xr[64 * j]; s += (v[j][0] * v[j][0] + v[j][1] * v[j][1]) + (v[j][2] * v[j][2] + v[j][3] * v[j][3]); }
        s = wave_sum(s);
        u32x2* o8 = (u32x2*)((bf16*)(ws + WS_XB) + (size_t)t * DM) + lane;
#pragma unroll
        for (int j = 0; j < 4; ++j) { u32x2 w = {pk2(v[j][0], v[j][1]), pk2(v[j][2], v[j][3])}; o8[64 * j] = w; }
        if (lane == 0) ((float*)(ws + WS_RSTD0))[t] = 1.0f / sqrtf(s * (1.0f / DM) + EPS); }
}

__device__ __forceinline__ void pool_diff(const Args& a, Frame& F) {
    const bf16* pm = (const bf16*)(a.ws + WS_P0MAIN); bf16* A2 = (bf16*)(a.ws + WS_A2);
    const int gt = (F.vcu * NWAVES + F.wave) * 64 + (fresh_tid() & 63), NGT = F.G * NTHR;
    for (int it = gt; it < (T / 16) * 128; it += NGT) {
        const int cc = it & 127, tg = it >> 7, t0 = tg * 16, s0 = t0 & (SEQ - 1), w = 2 << (cc >> 5), c0 = cc * 8;
        float sum[8];
#pragma unroll
        for (int i = 0; i < 8; ++i) sum[i] = 0.f;
        const int hist = (w - 1) < s0 ? (w - 1) : s0;
        for (int i = 1; i <= hist; ++i) { const u32x4 v = *(const u32x4*)(pm + (size_t)(t0 - i) * DM + c0);
            sum[0] += bflo(v.x); sum[1] += bfhi(v.x); sum[2] += bflo(v.y); sum[3] += bfhi(v.y); sum[4] += bflo(v.z); sum[5] += bfhi(v.z); sum[6] += bflo(v.w); sum[7] += bfhi(v.w); }
        for (int k = 0; k < 16; ++k) { const int t = t0 + k, s = s0 + k; const u32x4 v = *(const u32x4*)(pm + (size_t)t * DM + c0);
            float xv[8] = {bflo(v.x), bfhi(v.x), bflo(v.y), bfhi(v.y), bflo(v.z), bfhi(v.z), bflo(v.w), bfhi(v.w)};
#pragma unroll
            for (int i = 0; i < 8; ++i) sum[i] += xv[i];
            const float inv = 1.0f / (float)((s + 1) < w ? (s + 1) : w);
            u32x4 o = {pk2(sum[0] * inv - xv[0], sum[1] * inv - xv[1]), pk2(sum[2] * inv - xv[2], sum[3] * inv - xv[3]), pk2(sum[4] * inv - xv[4], sum[5] * inv - xv[5]), pk2(sum[6] * inv - xv[6], sum[7] * inv - xv[7])};
            *(u32x4*)(A2 + (size_t)t * MIXW + c0) = o;
            if (s >= w - 1) { const u32x4 q = *(const u32x4*)(pm + (size_t)(t - w + 1) * DM + c0);
                sum[0] -= bflo(q.x); sum[1] -= bfhi(q.x); sum[2] -= bflo(q.y); sum[3] -= bfhi(q.y); sum[4] -= bflo(q.z); sum[5] -= bfhi(q.z); sum[6] -= bflo(q.w); sum[7] -= bfhi(q.w); } }
    }
}

__device__ __forceinline__ void mem_attn(const Args& a, Frame& F, bf16* Abuf, int layer, bool dry = false) {
    const bf16* MKV = (const bf16*)(a.ws + WS_MEMKV);
    for (int U = F.vcu; U < 512; U += F.G) { const int b = U >> 6, h = (U >> 4) & 3, qt = U & 15;
        bf16* Q = Abuf + ((size_t)b * SEQ + qt * 256) * MIXW + 1024 + h * 128;
        const bf16* K = MKV + (size_t)b * MEMT * 2048 + layer * 1024 + h * 128;
        att::attn_unit<MIXW, 2048, false, ATT_SD_MEM>(Q, K, K + 512, dry ? (bf16*)(a.ws + WS_EXP) : Q, 0, nullptr, F.ldsg); }
}

__device__ __forceinline__ int ord_enc(float x) { const int b = __builtin_bit_cast(int, x); return b ^ ((b >> 31) & 0x7fffffff); }
__device__ __forceinline__ float ord_dec(int k) { return __builtin_bit_cast(float, k ^ ((k >> 31) & 0x7fffffff)); }
template <int N> __device__ __forceinline__ void bitonic_desc(int (&a)[N]) {
#pragma unroll
    for (int k = 2; k <= N; k <<= 1)
#pragma unroll
        for (int j = k >> 1; j > 0; j >>= 1)
#pragma unroll
            for (int i = 0; i < N; ++i) { const int l = i ^ j; if (l > i) { const bool desc = ((i & k) == 0) || (k == N);
                const int hi = max(a[i], a[l]), lo = min(a[i], a[l]); a[i] = desc ? hi : lo; a[l] = desc ? lo : hi; } }
}
__device__ __forceinline__ void merge16(int (&a)[16], const int (&b)[16]) {
#pragma unroll
    for (int i = 0; i < 16; ++i) a[i] = max(a[i], b[15 - i]);
#pragma unroll
    for (int j = 8; j > 0; j >>= 1)
#pragma unroll
        for (int i = 0; i < 16; ++i) { const int l = i ^ j; if (l > i) { const int hi = max(a[i], a[l]), lo = min(a[i], a[l]); a[i] = hi; a[l] = lo; } }
}
constexpr int cand_i(int s) { int c = 0; for (int a = 0; a < 16; ++a) for (int b = 0; b < 16; ++b) { if ((a + 1) * (b + 1) > 16) continue; if (c == s) return a; ++c; } return 0; }
constexpr int cand_j(int s) { int c = 0; for (int a = 0; a < 16; ++a) for (int b = 0; b < 16; ++b) { if ((a + 1) * (b + 1) > 16) continue; if (c == s) return b; ++c; } return 0; }
constexpr int cand_slot(int i, int j) { int s = 0; for (int a = 0; a < 16; ++a) for (int b = 0; b < 16; ++b) { if ((a + 1) * (b + 1) > 16) continue; if (a == i && b == j) return s; ++s; } return -1; }

__device__ __forceinline__ void peer_topk(const Args& a, Frame& F, int layer) {
    const bf16* PQ = (const bf16*)(a.ws + WS_PQ); const bf16* SUBK = (const bf16*)(a.ws + WS_SUBK) + (size_t)layer * 16 * 128 * 128;
    unsigned short* EXPo = (unsigned short*)(a.ws + WS_EXP); float* GATEo = (float*)(a.ws + WS_GATE);
    const int tid = fresh_tid(), lane = tid & 63, wid = F.wave, r32 = lane & 31, hi = lane >> 5;
    const int h = F.vcu & 7;
    int ka[4];
#pragma unroll
    for (int i = 0; i < 4; ++i) ka[i] = r32 * 256 + (((2 * i + hi) ^ (r32 & 7)) << 4);
    char* Ks = F.ldsg;
    LAS unsigned char* ib = F.lds + 65536 + tid * 36;
    for (int i = tid; i < 2 * 128 * 16; i += NTHR) { const int row = i >> 4, ch = i & 15; const u32x4 v = *(const u32x4*)(SUBK + ((size_t)h * 256 + row) * 128 + ch * 8);
        *(u32x4*)(Ks + (row >> 7) * 32768 + KSWZ(row & 127, ch * 16)) = v; }
    __syncthreads();
    for (int tt = (F.vcu >> 3); tt < T / 256; tt += (F.G >> 3)) {
        const int t = tt * 256 + wid * 32 + r32;
        int top[2][16];
#pragma unroll
        for (int p = 0; p < 2; ++p) {
            bf16x8 qr[8]; const bf16* qp = PQ + (size_t)t * 2048 + h * 256 + p * 128 + hi * 8;
#pragma unroll
            for (int d0 = 0; d0 < 8; ++d0) qr[d0] = *reinterpret_cast<const bf16x8*>(qp + d0 * 16);
            int cur[16];
#pragma unroll
            for (int kt = 0; kt < 4; ++kt) { f32x16 sacc; att::qkt1(sacc, Ks + p * 32768 + kt * 32 * 256, qr, ka);
                int grp[16];
#pragma unroll
                for (int r = 0; r < 16; ++r) grp[r] = (ord_enc(sacc[r]) & ~0x7F) | (kt * 32 + (r & 3) + 8 * (r >> 2) + 4 * hi);
                bitonic_desc<16>(grp);
                if (kt == 0) {
#pragma unroll
                    for (int r = 0; r < 16; ++r) cur[r] = grp[r];
                } else merge16(cur, grp); }
            int oth[16];
#pragma unroll
            for (int r = 0; r < 16; ++r) { auto rr = __builtin_amdgcn_permlane32_swap((unsigned)cur[r], (unsigned)cur[r], false, false); cur[r] = (int)rr[0]; oth[r] = (int)rr[1]; }
            merge16(cur, oth);
#pragma unroll
            for (int r = 0; r < 16; ++r) top[p][r] = cur[r];
        }
        float v0[16], v1[16];
#pragma unroll
        for (int r = 0; r < 16; ++r) { v0[r] = ord_dec(top[0][r] & ~0x7F); v1[r] = ord_dec(top[1][r] & ~0x7F); }
#pragma unroll
        for (int q = 0; q < 4; ++q) { *(LAS unsigned*)(ib + q * 4) = (top[0][4 * q] & 0x7F) | ((top[0][4 * q + 1] & 0x7F) << 8) | ((top[0][4 * q + 2] & 0x7F) << 16) | ((top[0][4 * q + 3] & 0x7F) << 24);
            *(LAS unsigned*)(ib + 16 + q * 4) = (top[1][4 * q] & 0x7F) | ((top[1][4 * q + 1] & 0x7F) << 8) | ((top[1][4 * q + 2] & 0x7F) << 16) | ((top[1][4 * q + 3] & 0x7F) << 24); }
        int best[16], g1[16];
#pragma unroll
        for (int r = 0; r < 32; ++r) { int key = (int)0x80000000;
            if (r < 25) {
                const int iA = cand_i(r), jA = cand_j(r), iB = cand_i(25 + r), jB = cand_j(25 + r);
                const float sA = v0[iA] + v1[jA], sB = v0[iB] + v1[jB]; const int code = hi ? (iB * 16 + jB) : (iA * 16 + jA);
                key = (ord_enc(hi ? sB : sA) & ~0xFF) | code; }
            if (r < 16) best[r] = key; else g1[r - 16] = key; }
        bitonic_desc<16>(best); bitonic_desc<16>(g1); merge16(best, g1);
#pragma unroll
        for (int r = 0; r < 16; ++r) { auto rr = __builtin_amdgcn_permlane32_swap((unsigned)best[r], (unsigned)best[r], false, false); best[r] = (int)rr[0]; g1[r] = (int)rr[1]; }
        merge16(best, g1);
        float cv[16], ex[16]; float sum = 0.f;
#pragma unroll
        for (int r = 0; r < 16; ++r) cv[r] = ord_dec(best[r] & ~0xFF);
#pragma unroll
        for (int r = 0; r < 16; ++r) { ex[r] = __builtin_amdgcn_exp2f((cv[r] - cv[0]) * 1.4426950408889634f); sum += ex[r]; }
        const float rs = 1.0f / sum;
        LDS_WAIT();
        unsigned ee[16];
#pragma unroll
        for (int r = 0; r < 16; ++r) { const int code = best[r] & 0xFF; const unsigned e1 = ib[code >> 4], e2 = ib[16 + (code & 15)]; ee[r] = e1 * 128u + e2; }
        const size_t ob = ((size_t)t * 8 + h) * 16;
        if (hi == 0) { u32x4 w0 = {ee[0] | (ee[1] << 16), ee[2] | (ee[3] << 16), ee[4] | (ee[5] << 16), ee[6] | (ee[7] << 16)}, w1 = {ee[8] | (ee[9] << 16), ee[10] | (ee[11] << 16), ee[12] | (ee[13] << 16), ee[14] | (ee[15] << 16)};
            *(u32x4*)(EXPo + ob) = w0; *(u32x4*)(EXPo + ob + 8) = w1; }
        else {
#pragma unroll
            for (int q = 0; q < 4; ++q) { f32x4 gq = {ex[4 * q] * rs, ex[4 * q + 1] * rs, ex[4 * q + 2] * rs, ex[4 * q + 3] * rs}; *(f32x4*)(GATEo + ob + 4 * q) = gq; } }
        LDS_WAIT();
    }
    __syncthreads();
}

__device__ __forceinline__ float gelu_exact(float v) {
    const float av = fabsf(v), t = __builtin_amdgcn_rcpf(fmaf(av, 0.2316418882f, 1.0f));
    float q = fmaf(t, 0.5307027145f, -0.7265760135f); q = fmaf(q, t, 0.7107068705f); q = fmaf(q, t, -0.142248368f); q = fmaf(q, t, 0.127414796f); q = q * t;
    const float e = __builtin_amdgcn_exp2f(v * v * -0.72134752044f), m = v * (q * e);
    return v < 0.f ? m : v - m;
}
__device__ __forceinline__ float dot16_fp8(const u32x4 u, const f32x2 (&x2)[8]) {
    f32x2 d = {0.f, 0.f};
#pragma unroll
    for (int i = 0; i < 4; ++i) { const f32x2 a = __builtin_amdgcn_cvt_pk_f32_fp8((int)u[i], false), b = __builtin_amdgcn_cvt_pk_f32_fp8((int)u[i], true);
        d = __builtin_elementwise_fma(a, x2[2 * i], d); d = __builtin_elementwise_fma(b, x2[2 * i + 1], d); }
    return d.x + d.y;
}
__device__ __forceinline__ void axpy16_fp8(f32x2 (&o2)[8], const float h, const u32x4 v) {
    const f32x2 h2 = {h, h};
#pragma unroll
    for (int i = 0; i < 4; ++i) { const f32x2 a = __builtin_amdgcn_cvt_pk_f32_fp8((int)v[i], false), b = __builtin_amdgcn_cvt_pk_f32_fp8((int)v[i], true);
        o2[2 * i] = __builtin_elementwise_fma(a, h2, o2[2 * i]); o2[2 * i + 1] = __builtin_elementwise_fma(b, h2, o2[2 * i + 1]); }
}
__device__ __forceinline__ float reduce8(const float (&p)[8], int lane) {
    float s[4];
#pragma unroll
    for (int i = 0; i < 4; ++i) { auto rr = __builtin_amdgcn_permlane32_swap(__float_as_uint(p[2 * i]), __float_as_uint(p[2 * i + 1]), false, false); s[i] = __uint_as_float(rr[0]) + __uint_as_float(rr[1]); }
    float t[2];
#pragma unroll
    for (int i = 0; i < 2; ++i) { const bool hi = lane & 16; const float u = hi ? s[2 * i + 1] : s[2 * i], o = hi ? s[2 * i] : s[2 * i + 1]; t[i] = u + shx_f<16>(o); }
    const bool h8 = lane & 8; const float u = h8 ? t[1] : t[0], o = h8 ? t[0] : t[1]; float w = u + dpp_f<0x128>(o);
    w += dpp_f<0x141>(w); w += dpp_f<0x1B>(w); w += dpp_f<0xB1>(w);
    return w;
}
constexpr int qgrp(int q) { return 2 * ((q & 3) == 1 ? 2 : (q & 3) == 2 ? 1 : (q & 3)) + (q >> 2); }

template <int K, int J> __device__ __forceinline__ void sort128_stage(unsigned& lo, unsigned& hi, int lane) {
    const unsigned plo = shx_u<J>(lo), phi = shx_u<J>(hi);
    const bool up_lo = (K >= 64) ? true : ((lane & K) == 0), up_hi = (K == 64) ? false : up_lo, lower = (lane & J) == 0;
    lo = (lower == up_lo) ? min(lo, plo) : max(lo, plo); hi = (lower == up_hi) ? min(hi, phi) : max(hi, phi);
    if constexpr (J > 1) sort128_stage<K, J / 2>(lo, hi, lane);
}
template <int K> __device__ __forceinline__ void sort128_level(unsigned& lo, unsigned& hi, int lane) { sort128_stage<K, K / 2>(lo, hi, lane); if constexpr (K < 64) sort128_level<K * 2>(lo, hi, lane); }
__device__ __forceinline__ void sort128(unsigned& lo, unsigned& hi, int lane) {
    sort128_level<2>(lo, hi, lane);
    { const unsigned a = min(lo, hi), b = max(lo, hi); lo = a; hi = b; }
    sort128_stage<128, 32>(lo, hi, lane);
}
template <bool FINAL, bool DRY = false>
__device__ __forceinline__ void peer_gather(const Args& a, Frame& F, int layer) {
    const unsigned char* UB = a.ws + WS_UB + (size_t)layer * NEXP * DM; const unsigned char* VB = a.ws + WS_VB + (size_t)layer * NEXP * DM;
    const float* USC = (const float*)(a.ws + WS_USC) + layer * NEXP; const float* VSC = (const float*)(a.ws + WS_VSC) + layer * NEXP;
    const unsigned short* EXPi = (const unsigned short*)(a.ws + WS_EXP); const float* GATEi = (const float*)(a.ws + WS_GATE);
    float* X = a.out; bf16* XB = (bf16*)(a.ws + WS_XB); float* RSTD2 = (float*)(a.ws + WS_RSTD2); const float* gfin = a.in[15];
    const int lane = fresh_tid() & 63, gw = F.vcu * NWAVES + F.wave, NGW = F.G * NWAVES;
    const unsigned lane16 = (unsigned)lane * 16u;
    const int grp = lane >> 3; const int jperm = 8 * (lane & 7) + ((grp >> 1) == 1 ? 2 : (grp >> 1) == 2 ? 1 : (grp >> 1)) + 4 * (grp & 1);
    for (int t = gw; t < T; t += NGW) {
        __syncthreads();
        bf16* xbr = XB + (size_t)t * DM + 16 * lane;
        float x[16];
        { const u32x4 v0 = *(const u32x4*)xbr, v1 = *(const u32x4*)(xbr + 8);
          x[0] = bflo(v0.x); x[1] = bfhi(v0.x); x[2] = bflo(v0.y); x[3] = bfhi(v0.y); x[4] = bflo(v0.z); x[5] = bfhi(v0.z); x[6] = bflo(v0.w); x[7] = bfhi(v0.w);
          x[8] = bflo(v1.x); x[9] = bfhi(v1.x); x[10] = bflo(v1.y); x[11] = bfhi(v1.y); x[12] = bflo(v1.z); x[13] = bfhi(v1.z); x[14] = bflo(v1.w); x[15] = bfhi(v1.w); }
        f32x2 x2[8];
#pragma unroll
        for (int i = 0; i < 8; ++i) { x2[i].x = x[2 * i]; x2[i].y = x[2 * i + 1]; }
        float ss = 0.f;
#pragma unroll
        for (int i = 0; i < 16; ++i) ss = fmaf(x[i], x[i], ss);
        ss = wave_sum(ss);
        const float rstd = 1.0f / sqrtf(ss * (1.0f / DM) + EPS);
        const unsigned short* et = EXPi + (size_t)t * 128; const float* gt_ = GATEi + (size_t)t * 128;
        unsigned k_lo = ((unsigned)et[lane] << 7) | (unsigned)lane, k_hi = ((unsigned)et[64 + lane] << 7) | (unsigned)(64 + lane);
        sort128(k_lo, k_hi, lane);
        const int e_lo = (int)(k_lo >> 7), e_hi = (int)(k_hi >> 7);
        const float gs_lo = gt_[k_lo & 127u], gs_hi = gt_[k_hi & 127u];
        const int ep_lo = __shfl(e_lo, jperm), ep_hi = __shfl(e_hi, jperm);
        const float gl = __shfl(gs_lo, jperm) * VSC[ep_lo], gh = __shfl(gs_hi, jperm) * VSC[ep_hi];
        const float ul = USC[ep_lo] * rstd, uh = USC[ep_hi] * rstd;
        float a_lo = 0.f, a_hi = 0.f;
        u32x4 b0[8], b1[8], b2[8];
#define ROWLD(dst, tab, e_) dst = *(const u32x4*)((tab) + (size_t)(e_) * DM + lane16)
#define ULOAD(buf, B) do { const int ev_ = ((B) >> 3) ? e_hi : e_lo; _Pragma("unroll") for (int q = 0; q < 8; ++q) { const int e = __builtin_amdgcn_readlane(ev_, 8 * ((B) & 7) + q); ROWLD(buf[q], UB, e); } } while (0)
#define VLOAD(buf, B) do { const int ev_ = ((B) >> 3) ? e_hi : e_lo; _Pragma("unroll") for (int q = 0; q < 8; ++q) { const int e = __builtin_amdgcn_readlane(ev_, 8 * ((B) & 7) + q); ROWLD(buf[q], VB, e); } } while (0)
#define UCOMP(buf, B) do { float p[8]; _Pragma("unroll") for (int q = 0; q < 8; ++q) p[q] = dot16_fp8(buf[q], x2); const float w = reduce8(p, lane); const bool mine = (lane & 7) == ((B) & 7); \
        if ((B) >> 3) a_hi = mine ? w : a_hi; else a_lo = mine ? w : a_lo; } while (0)
        ULOAD(b0, 0); ULOAD(b1, 1);
#pragma unroll 1
        for (int B = 0; B < 12; B += 3) {
            if (B > 0) __syncthreads();
            ULOAD(b2, B + 2); UCOMP(b0, B);
            ULOAD(b0, B + 3); UCOMP(b1, B + 1);
            ULOAD(b1, B + 4); UCOMP(b2, B + 2); }
        ULOAD(b2, 14); UCOMP(b0, 12);
        ULOAD(b0, 15); UCOMP(b1, 13);
        VLOAD(b1, 0);  UCOMP(b2, 14);
        VLOAD(b2, 1);  UCOMP(b0, 15);
#undef ULOAD
#undef UCOMP
        __syncthreads();
        const float h_lo = gelu_exact(a_lo * ul) * gl, h_hi = gelu_exact(a_hi * uh) * gh;
        f32x2 o2[8];
#pragma unroll
        for (int i = 0; i < 8; ++i) o2[i] = (f32x2){0.f, 0.f};
#define VCOMP(buf, B) do { const int hv_ = __builtin_bit_cast(int, ((B) >> 3) ? h_hi : h_lo); _Pragma("unroll") for (int q = 0; q < 8; ++q) { const float hq = __builtin_bit_cast(float, __builtin_amdgcn_readlane(hv_, 8 * qgrp(q) + ((B) & 7))); axpy16_fp8(o2, hq, buf[q]); } } while (0)
#pragma unroll 1
        for (int B = 0; B < 12; B += 3) {
            if (B > 0) __syncthreads();
            VLOAD(b0, B + 2); VCOMP(b1, B);
            VLOAD(b1, B + 3); VCOMP(b2, B + 1);
            VLOAD(b2, B + 4); VCOMP(b0, B + 2); }
        VLOAD(b0, 14); VCOMP(b1, 12);
        VLOAD(b1, 15); VCOMP(b2, 13);
        VCOMP(b0, 14);
        VCOMP(b1, 15);
#undef VLOAD
#undef VCOMP
#undef ROWLD
        float o[16]; float s2 = 0.f;
#pragma unroll
        for (int i = 0; i < 8; ++i) { o[2 * i] = o2[i].x; o[2 * i + 1] = o2[i].y; }
        { const u32x4 v0 = *(const u32x4*)xbr, v1 = *(const u32x4*)(xbr + 8);
          o[0] += bflo(v0.x); o[1] += bfhi(v0.x); o[2] += bflo(v0.y); o[3] += bfhi(v0.y); o[4] += bflo(v0.z); o[5] += bfhi(v0.z); o[6] += bflo(v0.w); o[7] += bfhi(v0.w);
          o[8] += bflo(v1.x); o[9] += bfhi(v1.x); o[10] += bflo(v1.y); o[11] += bfhi(v1.y); o[12] += bflo(v1.z); o[13] += bfhi(v1.z); o[14] += bflo(v1.w); o[15] += bfhi(v1.w); }
#pragma unroll
        for (int i = 0; i < 16; ++i) s2 = fmaf(o[i], o[i], s2);
        s2 = wave_sum(s2);
        const float r2 = 1.0f / sqrtf(s2 * (1.0f / DM) + EPS);
        if constexpr (FINAL) {
            float* xw = (DRY ? (float*)(a.ws + WS_RB) : X) + (size_t)t * DM;
#pragma unroll
            for (int i = 0; i < 4; ++i) { const f32x4 g = *(const f32x4*)(gfin + 16 * lane + 4 * i); f32x4 y = {o[4 * i] * r2 * g[0], o[4 * i + 1] * r2 * g[1], o[4 * i + 2] * r2 * g[2], o[4 * i + 3] * r2 * g[3]}; *(f32x4*)(xw + 16 * lane + 4 * i) = y; }
        } else {
            bf16* xo = DRY ? (bf16*)(a.ws + WS_RB) + (size_t)t * DM + 16 * lane : xbr;
            u32x4 wa = {pk2(o[0], o[1]), pk2(o[2], o[3]), pk2(o[4], o[5]), pk2(o[6], o[7])}, wb = {pk2(o[8], o[9]), pk2(o[10], o[11]), pk2(o[12], o[13]), pk2(o[14], o[15])};
            *(u32x4*)xo = wa; *(u32x4*)(xo + 8) = wb;
            if (!DRY && lane == 0) RSTD2[t] = r2;
        }
    }
}

#define XB_TMO      128
#define XB_XCNT(j)  (256  + 64 * (j))
#define XB_XSUB(j)  (1280 + 64 * (j))
#define XB_XGEN(j)  (2304 + 64 * (j))
#define XB_TOP      3328
#define XB_TOPGEN   3392
#define XCD_BAR_WORDS 3456
#define XB_SPIN_CAP (1u << 22)
__device__ __forceinline__ unsigned xb_ld(unsigned* p)              { return __hip_atomic_load(p, __ATOMIC_RELAXED, __HIP_MEMORY_SCOPE_AGENT); }
__device__ __forceinline__ unsigned xb_add(unsigned* p, unsigned v) { return __hip_atomic_fetch_add(p, v, __ATOMIC_RELAXED, __HIP_MEMORY_SCOPE_AGENT); }
__device__ __forceinline__ unsigned xb_xcc_id() { return (unsigned)__builtin_amdgcn_s_getreg((3 << 11) | 20) & 0xFu; }
#define XB_SPIN(cond, bar) do { unsigned _sp = 0; while (cond) { __builtin_amdgcn_s_sleep(1); \
    if ((++_sp & 255u) == 0u) { if (xb_ld(&(bar)[XB_TMO])) break; if (_sp > XB_SPIN_CAP) { atomicAdd(&(bar)[XB_TMO], 1u); break; } } } } while (0)
struct XcdBarrier { unsigned* bar; unsigned x; volatile LAS unsigned* st; };
__device__ __forceinline__ XcdBarrier xcd_barrier_post(unsigned* bar, volatile LAS unsigned* st) {
    XcdBarrier b; b.bar = bar; b.x = xb_xcc_id(); b.st = st;
    if (threadIdx.x == 0) (void)xb_add(&bar[XB_XCNT(b.x)], 1u);
    return b;
}
__device__ __forceinline__ void xcd_barrier_complete(unsigned* bar, unsigned x, unsigned& nloc, unsigned& nx) {
    const unsigned G = gridDim.x * gridDim.y * gridDim.z;
    unsigned sum, cnt, mine, sp = 0u;
    for (;;) {
        sum = 0u; cnt = 0u; mine = 0u;
#pragma unroll
        for (unsigned j = 0; j < 16; ++j) { const unsigned c = xb_ld(&bar[XB_XCNT(j)]); sum += c; cnt += (c > 0u) ? 1u : 0u; mine = (j == x) ? c : mine; }
        if (sum == G) break;
        __builtin_amdgcn_s_sleep(1);
        if ((++sp & 255u) == 0u) { if (xb_ld(&bar[XB_TMO])) break; if (sp > XB_SPIN_CAP) { atomicAdd(&bar[XB_TMO], 1u); break; } }
    }
    nloc = mine > 0u ? mine : 1u; nx = cnt > 0u ? cnt : 1u;
}
__device__ __forceinline__ void xcd_barrier(const XcdBarrier& b) {
    asm volatile("s_waitcnt vmcnt(0)" ::: "memory");
    __syncthreads();
    if (threadIdx.x == 0) {
        unsigned* bar = b.bar;
        __builtin_amdgcn_s_waitcnt(0);
        unsigned nloc = b.st[0], nx = b.st[1];
        if (nloc == 0u) { xcd_barrier_complete(bar, b.x, nloc, nx); b.st[0] = nloc; b.st[1] = nx; }
        const unsigned old = xb_add(&bar[XB_XSUB(b.x)], 1u);
        const unsigned gen = old / nloc;
        if (old + 1u == (gen + 1u) * nloc) {
            __builtin_amdgcn_fence(__ATOMIC_RELEASE, "agent");
            asm volatile("s_waitcnt vmcnt(0)" ::: "memory");
            const unsigned og = xb_add(&bar[XB_TOP], 1u);
            const unsigned tg = og / nx;
            if (og + 1u == (tg + 1u) * nx) xb_add(&bar[XB_TOPGEN], 1u);
            else XB_SPIN(xb_ld(&bar[XB_TOPGEN]) == tg, bar);
            __builtin_amdgcn_fence(__ATOMIC_ACQUIRE, "agent");
            xb_add(&bar[XB_XGEN(b.x)], 1u);
            asm volatile("s_waitcnt vmcnt(0)" ::: "memory");
        } else {
            XB_SPIN(xb_ld(&bar[XB_XGEN(b.x)]) == gen, bar);
            __builtin_amdgcn_fence(__ATOMIC_ACQUIRE, "agent");
            asm volatile("s_waitcnt vmcnt(0)" ::: "memory");
        }
    }
    __syncthreads();
}

__global__ void __launch_bounds__(NTHR, 2) yoco_fwd(Args args) {
    extern __shared__ __attribute__((aligned(16))) unsigned char lds_raw[];
    cg::grid_group grid = cg::this_grid();
    Frame F;
    F.lds = (LAS unsigned char*)lds_raw; F.ldsg = (char*)lds_raw;
    F.wave = __builtin_amdgcn_readfirstlane(threadIdx.x >> 6);
    F.G = gridDim.x; { const int bx = blockIdx.x; F.vcu = (F.G % 8 == 0) ? (bx % 8) * (F.G / 8) + bx / 8 : bx; }
    unsigned char* ws = args.ws;
    const int lo = args.ph_lo, hi = args.ph_hi;
    volatile LAS unsigned* bst = (volatile LAS unsigned*)(F.lds + 131072 + 320);
    if (threadIdx.x < 2) bst[threadIdx.x] = 0u;
    __syncthreads();
    XcdBarrier xbar; xbar.bar = (unsigned*)ws; xbar.x = 0; xbar.st = bst;
    if (hi - lo > 1) xbar = xcd_barrier_post((unsigned*)ws, bst);
#ifndef PH_MASK
#define PH_MASK 0x1fff
#endif
#define IN(k) (((PH_MASK >> (k)) & 1) && lo <= (k) && (k) < hi)
#define SEAM(k) do { if (IN(k) && IN((k) + 1)) { if ((k) == 0) grid.sync(); else xcd_barrier(xbar); } } while (0)
#define GSYNC() xcd_barrier(xbar)
#ifndef REP_MASK
#define REP_MASK 0
#endif
#define NREP(k) (((REP_MASK >> (k)) & 1) ? 2 : 1)
    typedef pg8::bf16_t pb;

    for (int rep_ = 0; rep_ < NREP(0); ++rep_) { if (rep_) GSYNC();
    if (IN(0)) { phase0(args, F); } } SEAM(0);

    for (int rep_ = 0; rep_ < NREP(1); ++rep_) { if (rep_) GSYNC();
    if (IN(1)) {
        { pg8::Gemm g{(const pb*)(ws + WS_XB), (const pb*)(ws + WS_WIN0), T, MIXW, DM}; pg8::StaticOrder S; S.init(T, MIXW, F.G, (int)blockIdx.x);
          pg8::EpiRowBf16 E{(pb*)(ws + WS_P0MAIN), DM, (pb*)(ws + WS_A2) + 1024, MIXW, 1024, (const float*)(ws + WS_RSTD0), nullptr};
          pg8::gemm_phase<pg8::EpiRowBf16, pg8::StaticOrder>(F.lds, g, S, E); }
        { pg8::Gemm g{(const pb*)(ws + WS_MEMB), (const pb*)(ws + WS_WMKV), 2048, 2048, DM}; pg8::StaticOrder S; S.init(2048, 2048, F.G, (int)blockIdx.x);
          pg8::EpiRowBf16 E{(pb*)(ws + WS_MEMKV), 2048, (pb*)(ws + WS_MEMKV), 2048, 1 << 30, nullptr, nullptr};
          pg8::gemm_phase<pg8::EpiRowBf16, pg8::StaticOrder>(F.lds, g, S, E); }
    } } SEAM(1);

    if (IN(2)) { if (NREP(2) > 1) { pool_diff(args, F); mem_attn(args, F, (bf16*)(ws + WS_A2), 0, true); GSYNC(); }
        pool_diff(args, F); mem_attn(args, F, (bf16*)(ws + WS_A2), 0); } SEAM(2);

    for (int rep_ = 0; rep_ < NREP(3); ++rep_) { if (rep_) GSYNC();
    if (IN(3)) {
        pg8::Gemm g{(const pb*)(ws + WS_A2), (const pb*)(ws + WS_WC0), T, DM, MIXW}; pg8::StaticOrder S; S.init(T, DM, F.G, (int)blockIdx.x);
        pg8::EpiRes E{(pb*)(ws + WS_XB), (float*)(ws + WS_SSQ)};
        pg8::gemm_phase<pg8::EpiRes, pg8::StaticOrder>(F.lds, g, S, E);
    } } SEAM(3);

    for (int rep_ = 0; rep_ < NREP(4); ++rep_) { if (rep_) GSYNC();
    if (IN(4)) {
        pg8::Gemm g{(const pb*)(ws + WS_XB), (const pb*)(ws + WS_WQ0), T, 2048, DM}; pg8::StaticOrder S; S.init(T, 2048, F.G, (int)blockIdx.x);
        pg8::EpiRowBf16 E{(pb*)(ws + WS_PQ), 2048, (pb*)(ws + WS_PQ), 2048, 1 << 30, nullptr, (const float*)(ws + WS_SSQ)};
        pg8::gemm_phase<pg8::EpiRowBf16, pg8::StaticOrder>(F.lds, g, S, E);
    } } SEAM(4);

    for (int rep_ = 0; rep_ < NREP(5); ++rep_) { if (rep_) GSYNC();
    if (IN(5)) { peer_topk(args, F, 0); } } SEAM(5);
    if (IN(6)) {
#ifdef PROBE_PEER
        peer_gather<false, true>(args, F, 0); GSYNC();
#endif
        peer_gather<false>(args, F, 0); } SEAM(6);

    for (int rep_ = 0; rep_ < NREP(7); ++rep_) { if (rep_) GSYNC();
    if (IN(7)) {
        pg8::Gemm g{(const pb*)(ws + WS_XB), (const pb*)(ws + WS_WC4), T, 3584, DM}; pg8::StaticOrder S; S.init(T, 3584, F.G, (int)blockIdx.x);
        pg8::EpiKVQ E{(pb*)(ws + WS_KR), (pb*)(ws + WS_VV), (pb*)(ws + WS_A3), (float*)(ws + WS_KMP), (const float*)(ws + WS_RSTD2), (const float*)(ws + WS_ROPE)};
        pg8::gemm_phase<pg8::EpiKVQ, pg8::StaticOrder>(F.lds, g, S, E);
    } } SEAM(7);

    if (IN(8)) {
        bf16* A3 = (bf16*)(ws + WS_A3); const bf16* KR = (const bf16*)(ws + WS_KR); const bf16* VV = (const bf16*)(ws + WS_VV); const float* KMP = (const float*)(ws + WS_KMP);
        for (int rep_ = 0; rep_ < NREP(8); ++rep_) { const bool dry8 = (NREP(8) > 1) && rep_ == 0;
        for (int P = F.vcu; P < 512; P += F.G) { const int bh = P >> 3, p = P & 7, b = bh >> 3, h = bh & 7;
#pragma unroll 1
            for (int half = 0; half < 2; ++half) { const int j = half ? p : 15 - p;
                bf16* Q = A3 + ((size_t)b * SEQ + j * 256) * MIXW + h * 128;
                const bf16* K = KR + (size_t)bh * SEQ * 128; const bf16* V = VV + (size_t)bh * SEQ * 128;
                att::attn_unit<MIXW, 128, true, ATT_SD_MOBA>(Q, K, V, dry8 ? (bf16*)(ws + WS_XB) : Q, j, KMP + (size_t)b * 16 * 2048 + h * 128, F.ldsg); } }
        if (dry8) { mem_attn(args, F, A3, 1, true); GSYNC(); } }
        mem_attn(args, F, A3, 1);
    } SEAM(8);

    if (IN(9)) {
        pg8::Gemm g{(const pb*)(ws + WS_A3), (const pb*)(ws + WS_WOUT1), T, DM, MIXW}; pg8::StaticOrder S; S.init(T, DM, F.G, (int)blockIdx.x);
        pg8::EpiRes E{(pb*)(ws + WS_XB), (float*)(ws + WS_SSQ)};
        pg8::gemm_phase<pg8::EpiRes, pg8::StaticOrder>(F.lds, g, S, E);
    } SEAM(9);

    for (int rep_ = 0; rep_ < NREP(10); ++rep_) { if (rep_) GSYNC();
    if (IN(10)) {
        pg8::Gemm g{(const pb*)(ws + WS_XB), (const pb*)(ws + WS_WQ1), T, 2048, DM}; pg8::StaticOrder S; S.init(T, 2048, F.G, (int)blockIdx.x);
        pg8::EpiRowBf16 E{(pb*)(ws + WS_PQ), 2048, (pb*)(ws + WS_PQ), 2048, 1 << 30, nullptr, (const float*)(ws + WS_SSQ)};
        pg8::gemm_phase<pg8::EpiRowBf16, pg8::StaticOrder>(F.lds, g, S, E);
    } } SEAM(10);

    for (int rep_ = 0; rep_ < NREP(11); ++rep_) { if (rep_) GSYNC();
    if (IN(11)) { peer_topk(args, F, 1); } } SEAM(11);
    if (IN(12)) {
#ifdef PROBE_PEER
        peer_gather<true, true>(args, F, 1); GSYNC();
#endif
        peer_gather<true>(args, F, 1); }
#undef IN
#undef SEAM
}

extern "C" void kernel_launch(void* const* d_in, const int* in_sizes, int n_in, void* d_out, int out_size, void* d_ws, size_t ws_size, hipStream_t stream) {
    static int grid = 0;
    if (grid == 0) {
        if (n_in != 16 || out_size != T * DM || ws_size < WS_END) { fprintf(stderr, "kernel_launch: unexpected shapes: n_in %d out %d ws %zu (need %zu)\n", n_in, out_size, ws_size, (size_t)WS_END); grid = -1; return; }
        int dev = 0, cus = 0, per_cu = 0;
        if (hipGetDevice(&dev) != hipSuccess || hipDeviceGetAttribute(&cus, hipDeviceAttributeMultiprocessorCount, dev) != hipSuccess) { grid = -1; return; }
        if (hipFuncSetAttribute((const void*)yoco_fwd, hipFuncAttributeMaxDynamicSharedMemorySize, LDS_BYTES) != hipSuccess) { fprintf(stderr, "kernel_launch: hipFuncSetAttribute failed\n"); grid = -1; return; }
        if (hipOccupancyMaxActiveBlocksPerMultiprocessor(&per_cu, (const void*)yoco_fwd, NTHR, LDS_BYTES) != hipSuccess || per_cu < 1) { fprintf(stderr, "kernel_launch: occupancy query says %d\n", per_cu); per_cu = 1; }
        (void)hipGetLastError();
        grid = cus;
        fprintf(stderr, "kernel_launch: grid %d, per_cu %d, ws %zu\n", grid, per_cu, ws_size);
    }
    if (grid < 0) return;
    if (hipMemsetAsync(d_ws, 0, 16384, stream) != hipSuccess) { fprintf(stderr, "kernel_launch: memset failed\n"); return; }
    Args a{};
    for (int i = 0; i < 16; ++i) a.in[i] = (const float*)d_in[i];
    a.out = (float*)d_out; a.ws = (unsigned char*)d_ws;
#if MK_LAUNCHES == 1
    a.ph_lo = 0; a.ph_hi = 13;
    void* kargs[] = {&a};
    hipError_t e = hipLaunchCooperativeKernel((const void*)yoco_fwd, dim3(grid), dim3(NTHR), kargs, LDS_BYTES, stream);
    if (e != hipSuccess) fprintf(stderr, "kernel_launch: cooperative launch failed: %s (grid %d)\n", hipGetErrorString(e), grid);
#else
    for (int p = 0; p < 13; ++p) { a.ph_lo = p; a.ph_hi = p + 1;
        hipLaunchKernelGGL(yoco_fwd, dim3(grid), dim3(NTHR), LDS_BYTES, stream, a);
        const hipError_t le = hipPeekAtLastError(); if (le != hipSuccess) { fprintf(stderr, "kernel_launch: launch %d failed: %s\n", p, hipGetErrorName(le)); break; } }
#endif
}
```

```cpp
#include <hip/hip_runtime.h>
#include <hip/hip_cooperative_groups.h>
#include <cstdio>
#include <cstdint>
namespace cg = cooperative_groups;

#ifndef MK_LAUNCHES
#define MK_LAUNCHES 1
#endif

#define GAS __attribute__((address_space(1)))
#define LAS __attribute__((address_space(3)))
typedef unsigned short bf16;
typedef unsigned u32x4 __attribute__((ext_vector_type(4)));
typedef unsigned u32x2 __attribute__((ext_vector_type(2)));
typedef float f32x4 __attribute__((ext_vector_type(4)));
typedef float f32x2 __attribute__((ext_vector_type(2)));
typedef float f32x16 __attribute__((ext_vector_type(16)));
typedef short bf16x8 __attribute__((ext_vector_type(8)));
typedef short s16x4 __attribute__((ext_vector_type(4)));
typedef __bf16 bf16x2_t __attribute__((ext_vector_type(2)));

constexpr int NB = 8, SEQ = 4096, DM = 1024, T = NB * SEQ, MIXW = 1536, MEMT = 256;
constexpr int NEXP = 16384, NWAVES = 8, NTHR = 512;
constexpr float EPS = 1e-6f;

constexpr size_t MiB = 1u << 20;
constexpr size_t WS_RSTD0 = 1 * MiB;
constexpr size_t WS_RSTD2 = WS_RSTD0 + 128 * 1024;
constexpr size_t WS_USC   = WS_RSTD0 + 256 * 1024;
constexpr size_t WS_VSC   = WS_RSTD0 + 384 * 1024;
constexpr size_t WS_SSQ   = 2 * MiB;
constexpr size_t WS_KMP   = 4 * MiB;
constexpr size_t WS_ROPE  = 5 * MiB;
constexpr size_t WS_WIN0  = 8 * MiB;
constexpr size_t WS_WC4   = 11 * MiB;
constexpr size_t WS_WC0   = 18 * MiB;
constexpr size_t WS_WOUT1 = 21 * MiB;
constexpr size_t WS_WMKV  = 24 * MiB;
constexpr size_t WS_WQ0   = 28 * MiB;
constexpr size_t WS_WQ1   = 32 * MiB;
constexpr size_t WS_SUBK  = 36 * MiB;
constexpr size_t WS_MEMB  = 37 * MiB;
constexpr size_t WS_MEMKV = 41 * MiB;
constexpr size_t WS_EXP   = 49 * MiB;
constexpr size_t WS_GATE  = 57 * MiB;
constexpr size_t WS_UB    = 73 * MiB;
constexpr size_t WS_VB    = 105 * MiB;
constexpr size_t WS_XB    = 201 * MiB;
constexpr size_t WS_RB    = 265 * MiB;
constexpr size_t WS_P0MAIN = WS_RB;
constexpr size_t WS_A2    = WS_RB + 64 * MiB;
constexpr size_t WS_PQ    = WS_RB;
constexpr size_t WS_KR    = WS_RB;
constexpr size_t WS_VV    = WS_RB + 64 * MiB;
constexpr size_t WS_A3    = WS_RB + 128 * MiB;
constexpr size_t WS_END   = WS_RB + 224 * MiB;

constexpr int LDS_BYTES = 147456;

__device__ __forceinline__ unsigned f2bf(float f) { unsigned u = __builtin_bit_cast(unsigned, f); return (u + 0x7fffu + ((u >> 16) & 1u)) >> 16; }
__device__ __forceinline__ unsigned pk2(float lo, float hi) { return f2bf(lo) | (f2bf(hi) << 16); }
__device__ __forceinline__ unsigned cvtpk(float lo, float hi) { unsigned r; asm volatile("v_cvt_pk_bf16_f32 %0, %1, %2" : "=v"(r) : "v"(lo), "v"(hi)); return r; }
__device__ __forceinline__ float bflo(unsigned w) { return __builtin_bit_cast(float, w << 16); }
__device__ __forceinline__ float bfhi(unsigned w) { return __builtin_bit_cast(float, w & 0xffff0000u); }
template <int J> __device__ __forceinline__ unsigned shx_u(unsigned v) {
    if constexpr (J == 32) { auto rr = __builtin_amdgcn_permlane32_swap(v, v, false, false); return ((threadIdx.x & 32) ? rr[0] : rr[1]); }
    else return (unsigned)__builtin_amdgcn_ds_swizzle((int)v, (J << 10) | 0x1f);
}
template <int J> __device__ __forceinline__ float shx_f(float v) { return __uint_as_float(shx_u<J>(__float_as_uint(v))); }
template <int CTRL> __device__ __forceinline__ float dpp_f(float v) { return __uint_as_float((unsigned)__builtin_amdgcn_update_dpp(0, (int)__float_as_uint(v), CTRL, 0xF, 0xF, false)); }
__device__ __forceinline__ float wave_sum(float v) {
    v += dpp_f<0xB1>(v); v += dpp_f<0x4E>(v); v += dpp_f<0x141>(v); v += dpp_f<0x128>(v);
    v += shx_f<16>(v);
    { auto rr = __builtin_amdgcn_permlane32_swap(__float_as_uint(v), __float_as_uint(v), false, false); v = __uint_as_float(rr[0]) + __uint_as_float(rr[1]); }
    return v;
}
__device__ __forceinline__ float dot2(unsigned w, unsigned x, float acc) { return __builtin_amdgcn_fdot2_f32_bf16(__builtin_bit_cast(bf16x2_t, w), __builtin_bit_cast(bf16x2_t, x), acc, false); }
#define LDS_WAIT() asm volatile("s_waitcnt lgkmcnt(0)" ::: "memory")
#define VM_WAIT() asm volatile("s_waitcnt vmcnt(0)" ::: "memory")

namespace pg8 {
#define PG8_LAS __attribute__((address_space(3)))
typedef unsigned short bf16_t;
constexpr int BM = 256, BK = 64, HALF = 128, HTB = HALF * BK * 2, STAGE_BYTES = 8 * HTB, NXCD = 8, WGM = 8;
__host__ __device__ __forceinline__ int lds_byte(int r, int c) { const int st = (r >> 4) * 2 + (c >> 5), rr = r & 15, cc = c & 31, ob = rr * 64 + cc * 2; return st * 1024 + (ob ^ (((ob >> 9) & 1) << 5)); }
__host__ __device__ __forceinline__ void stage_rc(int b, int& R, int& C) { const int st = b / 1024, sb = b % 1024, swz = sb ^ (((sb >> 9) & 1) << 5); R = (st >> 1) * 16 + swz / 64; C = (st & 1) * 32 + (swz % 64) / 2; }
__host__ __device__ __forceinline__ int perm32(int rho) { const int n = rho >> 4, i = rho & 15; return 8 * (i >> 2) + 4 * n + (i & 3); }
struct Unit { int pm, pn; };
struct Gemm { const bf16_t* A; const bf16_t* Bt; int M, N, K; };
struct StaticOrder {
    int nM, nN, nwg, G, c;
    __host__ __device__ void init(int M, int N, int G_, int c_) { nM = M / BM; nN = N / BM; nwg = nM * nN; G = G_; c = c_; }
    __host__ __device__ bool next(int i, Unit& u) const {
        const long L = (long)i * G + c; if (L >= nwg) return false;
        int wgid = (int)L; { const int q = nwg / NXCD, r = nwg % NXCD, xcd = wgid % NXCD, off = wgid / NXCD; wgid = (xcd < r ? xcd * (q + 1) : r * (q + 1) + (xcd - r) * q) + off; }
        const int nig = WGM * nN, gid = wgid / nig, fm = gid * WGM, gsz = (nM - fm) < WGM ? (nM - fm) : WGM;
        u.pm = fm + ((wgid % nig) % gsz); u.pn = (wgid % nig) / gsz; return true;
    }
    __device__ __forceinline__ void a_ready(const Unit&) const {}
    __device__ __forceinline__ void done(const Unit&) const {}
};

struct EpiRowBf16 {
    static constexpr bool PERM = true, AFTER_DRAIN = false;
    bf16_t* O0; int ld0; bf16_t* O1; int ld1; int split; const float* rs; const float* ssq;
    __device__ __forceinline__ void operator()(const f32x4 (&acc)[2][2][4][2], const Unit& u, int wr, int wc, int fr, int fq) const {
        const int row0 = u.pm * BM + wr * 64 + fr; int colt = u.pn * BM; bf16_t* base = O0; int ldc = ld0;
        if (colt >= split) { base = O1; ldc = ld1; colt -= split; }
        const int col0 = colt + wc * 32 + 8 * fq;
#pragma unroll
        for (int ai = 0; ai < 2; ++ai)
#pragma unroll
            for (int m = 0; m < 4; ++m) { const int row = row0 + ai * HALF + m * 16; float sc = 1.f;
                if (rs) sc = rs[row];
                else if (ssq) { const f32x4* q = (const f32x4*)(ssq + (size_t)row * 16); const f32x4 a = q[0], b = q[1], c = q[2], d = q[3];
                    const float s = ((a[0] + a[1]) + (a[2] + a[3])) + ((b[0] + b[1]) + (b[2] + b[3])) + ((c[0] + c[1]) + (c[2] + c[3])) + ((d[0] + d[1]) + (d[2] + d[3]));
                    sc = __builtin_amdgcn_rsqf(s * (1.0f / 1024.0f) + EPS); }
                bf16_t* rowp = base + (size_t)row * ldc + col0;
#pragma unroll
                for (int bj = 0; bj < 2; ++bj) { const f32x4 v0 = acc[ai][bj][m][0] * sc, v1 = acc[ai][bj][m][1] * sc;
                    u32x4 w; w.x = cvtpk(v0[0], v0[1]); w.y = cvtpk(v0[2], v0[3]); w.z = cvtpk(v1[0], v1[1]); w.w = cvtpk(v1[2], v1[3]);
                    *(u32x4*)(rowp + bj * HALF) = w; } }
    }
};
struct EpiRes {
    static constexpr bool PERM = true, AFTER_DRAIN = false;
    bf16_t* xb; float* ssq;
    __device__ __forceinline__ void operator()(const f32x4 (&acc)[2][2][4][2], const Unit& u, int wr, int wc, int fr, int fq) const {
        const int row0 = u.pm * BM + wr * 64 + fr, col0 = u.pn * BM + wc * 32 + 8 * fq;
#pragma unroll
        for (int ai = 0; ai < 2; ++ai)
#pragma unroll
            for (int m = 0; m < 4; ++m) { const int row = row0 + ai * HALF + m * 16; bf16_t* p = xb + (size_t)row * DM + col0; float ss = 0.f;
#pragma unroll
                for (int bj = 0; bj < 2; ++bj) { const u32x4 r = *(const u32x4*)(p + bj * HALF); const f32x4 a0 = acc[ai][bj][m][0], a1 = acc[ai][bj][m][1];
                    const float o0 = bflo(r.x) + a0[0], o1 = bfhi(r.x) + a0[1], o2 = bflo(r.y) + a0[2], o3 = bfhi(r.y) + a0[3], o4 = bflo(r.z) + a1[0], o5 = bfhi(r.z) + a1[1], o6 = bflo(r.w) + a1[2], o7 = bfhi(r.w) + a1[3];
                    u32x4 w; w.x = cvtpk(o0, o1); w.y = cvtpk(o2, o3); w.z = cvtpk(o4, o5); w.w = cvtpk(o6, o7); *(u32x4*)(p + bj * HALF) = w;
                    ss += ((o0 * o0 + o1 * o1) + (o2 * o2 + o3 * o3)) + ((o4 * o4 + o5 * o5) + (o6 * o6 + o7 * o7)); }
                ss += __shfl_xor(ss, 16); ss += __shfl_xor(ss, 32);
                if (fq == 0) ssq[(size_t)row * 16 + u.pn * 4 + wc] = ss; }
    }
};
struct EpiKVQ {
    static constexpr bool PERM = true, AFTER_DRAIN = false;
    bf16_t* KR; bf16_t* VV; bf16_t* A3; float* KMP; const float* rs; const float* rope;
    __device__ __forceinline__ void operator()(const f32x4 (&acc)[2][2][4][2], const Unit& u, int wr, int wc, int fr, int fq) const {
        const int pn = u.pn, pm = u.pm, b = pm >> 4, s0 = (pm & 15) * 256, rl0 = wr * 64 + fr, g0 = 32 * wc + 8 * fq;
        float rsv[2][4];
#pragma unroll
        for (int ai = 0; ai < 2; ++ai)
#pragma unroll
            for (int m = 0; m < 4; ++m) rsv[ai][m] = rs[pm * BM + rl0 + ai * HALF + m * 16];
        if (pn < 4 || (pn >= 8 && pn < 12)) {
            const bool isK = pn < 4; const int hp = isK ? pn : pn - 8; const int i0 = 16 * wc + 4 * fq;
            f32x4 klo[2] = {{0.f, 0.f, 0.f, 0.f}, {0.f, 0.f, 0.f, 0.f}}, khi[2] = {{0.f, 0.f, 0.f, 0.f}, {0.f, 0.f, 0.f, 0.f}};
#pragma unroll
            for (int ai = 0; ai < 2; ++ai)
#pragma unroll
                for (int m = 0; m < 4; ++m) { const int rl = rl0 + ai * HALF + m * 16, s = s0 + rl;
                    const f32x4 cs0 = *(const f32x4*)(rope + ((size_t)s * 64 + i0) * 2), cs1 = *(const f32x4*)(rope + ((size_t)s * 64 + i0) * 2 + 4);
                    const f32x4 c = {cs0[0], cs0[2], cs1[0], cs1[2]}, sn = {cs0[1], cs0[3], cs1[1], cs1[3]};
#pragma unroll
                    for (int bj = 0; bj < 2; ++bj) { const int head = 2 * hp + bj;
                        const f32x4 v1 = acc[ai][bj][m][0] * rsv[ai][m], v2 = acc[ai][bj][m][1] * rsv[ai][m];
                        const f32x4 lo = v1 * c - v2 * sn, hi = v2 * c + v1 * sn;
                        u32x4 w; w.x = cvtpk(lo[0], lo[1]); w.y = cvtpk(lo[2], lo[3]); w.z = cvtpk(hi[0], hi[1]); w.w = cvtpk(hi[2], hi[3]);
                        bf16_t* dst = isK ? KR + ((size_t)(b * 8 + head) * SEQ + s) * 128 + g0 : A3 + (size_t)(pm * BM + rl) * MIXW + head * 128 + g0;
                        *(u32x4*)dst = w;
                        klo[bj] += lo; khi[bj] += hi; } }
            if (isK) {
#pragma unroll
                for (int bj = 0; bj < 2; ++bj) {
#pragma unroll
                    for (int j = 0; j < 4; ++j) {
#pragma unroll
                        for (int o = 1; o < 16; o <<= 1) { klo[bj][j] += __shfl_xor(klo[bj][j], o); khi[bj][j] += __shfl_xor(khi[bj][j], o); } }
                    if (fr == 0) { float* kp = KMP + ((size_t)pm * 2 + wr) * 1024 + (2 * hp + bj) * 128 + g0; *(f32x4*)kp = klo[bj]; *(f32x4*)(kp + 4) = khi[bj]; } } }
        } else {
            const bool isV = pn < 8;
#pragma unroll
            for (int bj = 0; bj < 2; ++bj)
#pragma unroll
                for (int ai = 0; ai < 2; ++ai)
#pragma unroll
                    for (int m = 0; m < 4; ++m) { const int rl = rl0 + ai * HALF + m * 16, s = s0 + rl;
                        const f32x4 v0 = acc[ai][bj][m][0] * rsv[ai][m], v1 = acc[ai][bj][m][1] * rsv[ai][m];
                        u32x4 w; w.x = cvtpk(v0[0], v0[1]); w.y = cvtpk(v0[2], v0[3]); w.z = cvtpk(v1[0], v1[1]); w.w = cvtpk(v1[2], v1[3]);
                        bf16_t* dst = isV ? VV + ((size_t)(b * 8 + 2 * (pn - 4) + bj) * SEQ + s) * 128 + g0 : A3 + (size_t)(pm * BM + rl) * MIXW + 1024 + (pn - 12) * 256 + bj * HALF + g0;
                        *(u32x4*)dst = w; }
        }
    }
};

template <class Epi, class Sched, bool ALIGN_EPI = true, bool SP2 = true>
__device__ __forceinline__ void gemm_phase(PG8_LAS unsigned char* lds, const Gemm g, const Sched& S, const Epi& E) {
    int tid = threadIdx.x; asm volatile("" : "+v"(tid));
    const int wid = __builtin_amdgcn_readfirstlane(tid >> 6), lane = tid & 63, wr = wid >> 2, wc = wid & 3, fr = lane & 15, fq = lane >> 4;
    const int K = g.K, nt = K / BK;
    unsigned voffA[2], voffB[2];
#pragma unroll
    for (int i = 0; i < 2; ++i) { int R, C; stage_rc(tid * 16 + i * 8192, R, C); const int Rb = Epi::PERM ? ((R & ~31) + perm32(R & 31)) : R;
        voffA[i] = (unsigned)(R * K + C) * 2u; voffB[i] = (unsigned)(Rb * K + C) * 2u; }
    const size_t kstep = (size_t)(BK * 2);
    const size_t hstep = (size_t)HALF * K * 2;
    const size_t tstep = 2 * hstep;
    const unsigned ldsw = (unsigned)wid * 1024u;
    const int aoff = lds_byte(wr * 64 + fr, fq * 8), boff = lds_byte(wc * 32 + fr, fq * 8);
#define PG8_SA(b, h) (((b) * 2 + (h)) * HTB)
#define PG8_SB(b, h) ((4 + (b) * 2 + (h)) * HTB)
#define PG8_STAGE(bufoff, gbase, voff) do { _Pragma("unroll") for (int _i = 0; _i < 2; ++_i) \
        __builtin_amdgcn_global_load_lds((const unsigned*)((const char*)(gbase) + (voff)[_i]), (PG8_LAS unsigned*)(lds + (bufoff) + ldsw + _i * 8192), 16, 0, 0); } while (0)
#define PG8_LDA(dst, b, h) do { _Pragma("unroll") for (int m = 0; m < 4; ++m) _Pragma("unroll") for (int k = 0; k < 2; ++k) dst[m][k] = *(const PG8_LAS bf16x8*)(lds + PG8_SA(b, h) + aoff + m * 2048 + k * 1024); } while (0)
#define PG8_LDB(dst, b, h) do { _Pragma("unroll") for (int n = 0; n < 2; ++n) _Pragma("unroll") for (int k = 0; k < 2; ++k) dst[n][k] = *(const PG8_LAS bf16x8*)(lds + PG8_SB(b, h) + boff + n * 2048 + k * 1024); } while (0)
#define PG8_MMA(ai, bj, At, Bt) do { __builtin_amdgcn_s_setprio(1); _Pragma("unroll") for (int m = 0; m < 4; ++m) _Pragma("unroll") for (int n = 0; n < 2; ++n) _Pragma("unroll") for (int k = 0; k < 2; ++k) \
        acc[ai][bj][m][n] = __builtin_amdgcn_mfma_f32_16x16x32_bf16(Bt[n][k], At[m][k], acc[ai][bj][m][n], 0, 0, 0); __builtin_amdgcn_s_setprio(0); } while (0)
#define PG8_WAIT_V(n) asm volatile("s_waitcnt vmcnt(" #n ")" ::: "memory")
#define PG8_WAIT_L(n) asm volatile("s_waitcnt lgkmcnt(" #n ")" ::: "memory")
#define PG8_BAR __builtin_amdgcn_s_barrier()
#define PG8_SCHED __builtin_amdgcn_sched_barrier(0)
    Unit cur, nxt; int ui = 0;
    if (!S.next(0, cur)) return;
    f32x4 acc[2][2][4][2];
#pragma unroll
    for (int a = 0; a < 2; ++a)
#pragma unroll
        for (int b = 0; b < 2; ++b)
#pragma unroll
            for (int m = 0; m < 4; ++m)
#pragma unroll
                for (int n = 0; n < 2; ++n) acc[a][b][m][n] = (f32x4){0.f, 0.f, 0.f, 0.f};
    bf16x8 At[4][2], B0[2][2], B1[2][2];
    const char* cA = (const char*)g.A + (size_t)cur.pm * tstep; const char* cB = (const char*)g.Bt + (size_t)cur.pn * tstep;
    S.a_ready(cur);
    if constexpr (SP2) {
        PG8_STAGE(PG8_SB(0, 0), cB, voffB); PG8_STAGE(PG8_SB(0, 1), cB + hstep, voffB); PG8_STAGE(PG8_SA(0, 0), cA, voffA); PG8_STAGE(PG8_SA(0, 1), cA + hstep, voffA);
        if (wr == 1) PG8_BAR;
        PG8_WAIT_V(2); PG8_BAR;
        PG8_STAGE(PG8_SB(1, 0), cB + kstep, voffB); PG8_STAGE(PG8_SA(1, 0), cA + kstep, voffA); PG8_STAGE(PG8_SB(1, 1), cB + hstep + kstep, voffB);
        PG8_WAIT_V(6); PG8_BAR;
    } else {
        PG8_STAGE(PG8_SB(0, 0), cB, voffB); PG8_STAGE(PG8_SA(0, 0), cA, voffA); PG8_STAGE(PG8_SB(0, 1), cB + hstep, voffB); PG8_STAGE(PG8_SA(0, 1), cA + hstep, voffA);
        if (wr == 1) PG8_BAR;
        PG8_WAIT_V(4); PG8_BAR;
        PG8_STAGE(PG8_SB(1, 0), cB + kstep, voffB); PG8_STAGE(PG8_SA(1, 0), cA + kstep, voffA); PG8_STAGE(PG8_SB(1, 1), cB + hstep + kstep, voffB);
        PG8_WAIT_V(6); PG8_BAR;
    }
    for (;;) {
        const bool has_next = S.next(ui + 1, nxt);
        const char* nA = has_next ? (const char*)g.A + (size_t)nxt.pm * tstep : cA; const char* nB = has_next ? (const char*)g.Bt + (size_t)nxt.pn * tstep : cB;
        for (int t = 0; t < nt; t += 2) {
            const bool last = (t == nt - 2);
            const char* a1 = cA + (size_t)(t + 1) * kstep;
            const char* a2 = last ? nA : cA + (size_t)(t + 2) * kstep; const char* b2 = last ? nB : cB + (size_t)(t + 2) * kstep;
            const char* a3 = a2 + kstep; const char* b3 = b2 + kstep;
            if (last && has_next) S.a_ready(nxt);
            if constexpr (SP2) {
            PG8_LDB(B0, 0, 0); PG8_LDB(B1, 0, 1); PG8_SCHED; PG8_LDA(At, 0, 0); PG8_STAGE(PG8_SA(1, 1), a1 + hstep, voffA);
            PG8_WAIT_V(8); PG8_WAIT_L(0); PG8_BAR; PG8_MMA(0, 0, At, B0); PG8_MMA(0, 1, At, B1); PG8_BAR; PG8_SCHED;
            PG8_LDA(At, 0, 1); PG8_STAGE(PG8_SB(0, 0), b2, voffB); PG8_STAGE(PG8_SB(0, 1), b2 + hstep, voffB); PG8_STAGE(PG8_SA(0, 0), a2, voffA);
            PG8_WAIT_V(8); PG8_WAIT_L(0); PG8_BAR; PG8_MMA(1, 0, At, B0); PG8_MMA(1, 1, At, B1); PG8_BAR; PG8_SCHED;
            PG8_LDB(B0, 1, 0); PG8_LDB(B1, 1, 1); PG8_SCHED; PG8_LDA(At, 1, 0); PG8_STAGE(PG8_SA(0, 1), a2 + hstep, voffA);
            PG8_WAIT_V(8); PG8_WAIT_L(0); PG8_BAR; PG8_MMA(0, 0, At, B0); PG8_MMA(0, 1, At, B1); PG8_BAR; PG8_SCHED;
            PG8_LDA(At, 1, 1); PG8_STAGE(PG8_SB(1, 0), b3, voffB); PG8_STAGE(PG8_SB(1, 1), b3 + hstep, voffB); PG8_STAGE(PG8_SA(1, 0), a3, voffA);
            PG8_WAIT_V(8); PG8_WAIT_L(0); PG8_BAR; PG8_MMA(1, 0, At, B0); PG8_MMA(1, 1, At, B1); PG8_BAR; PG8_SCHED;
            } else {
            PG8_LDB(B0, 0, 0); PG8_SCHED; PG8_LDA(At, 0, 0); PG8_STAGE(PG8_SA(1, 1), a1 + hstep, voffA);
            PG8_WAIT_L(8); PG8_BAR; PG8_WAIT_L(0); PG8_MMA(0, 0, At, B0); PG8_BAR; PG8_SCHED;
            PG8_LDB(B1, 0, 1); PG8_STAGE(PG8_SB(0, 0), b2, voffB);
            PG8_BAR; PG8_WAIT_L(0); PG8_MMA(0, 1, At, B1); PG8_BAR;
            PG8_LDA(At, 0, 1); PG8_STAGE(PG8_SA(0, 0), a2, voffA);
            PG8_BAR; PG8_WAIT_L(0); PG8_MMA(1, 0, At, B0); PG8_BAR; PG8_SCHED;
            PG8_STAGE(PG8_SB(0, 1), b2 + hstep, voffB);
            PG8_WAIT_V(6); PG8_BAR; PG8_MMA(1, 1, At, B1); PG8_BAR;
            PG8_LDB(B0, 1, 0); PG8_SCHED; PG8_LDA(At, 1, 0); PG8_STAGE(PG8_SA(0, 1), a2 + hstep, voffA);
            PG8_WAIT_L(8); PG8_BAR; PG8_WAIT_L(0); PG8_MMA(0, 0, At, B0); PG8_BAR; PG8_SCHED;
            PG8_LDB(B1, 1, 1); PG8_STAGE(PG8_SB(1, 0), b3, voffB);
            PG8_BAR; PG8_WAIT_L(0); PG8_MMA(0, 1, At, B1); PG8_BAR;
            PG8_LDA(At, 1, 1); PG8_STAGE(PG8_SA(1, 0), a3, voffA);
            PG8_BAR; PG8_WAIT_L(0); PG8_MMA(1, 0, At, B0); PG8_BAR; PG8_SCHED;
            PG8_STAGE(PG8_SB(1, 1), b3 + hstep, voffB);
            PG8_WAIT_V(6); PG8_BAR; PG8_MMA(1, 1, At, B1); PG8_BAR;
            }
        }
        if constexpr (ALIGN_EPI) { if (wr == 0) PG8_BAR; }
        if constexpr (!Epi::AFTER_DRAIN) { E(acc, cur, wr, wc, fr, fq); S.done(cur); }
        if (!has_next) break;
#pragma unroll
        for (int a = 0; a < 2; ++a)
#pragma unroll
            for (int b = 0; b < 2; ++b)
#pragma unroll
                for (int m = 0; m < 4; ++m)
#pragma unroll
                    for (int n = 0; n < 2; ++n) acc[a][b][m][n] = (f32x4){0.f, 0.f, 0.f, 0.f};
        cur = nxt; cA = nA; cB = nB; ++ui;
        if constexpr (ALIGN_EPI) { if (wr == 1) PG8_BAR; }
    }
    PG8_WAIT_V(0);
    if constexpr (!ALIGN_EPI) { if (wr == 0) PG8_BAR; }
    PG8_BAR;
#undef PG8_SA
#undef PG8_SB
#undef PG8_STAGE
#undef PG8_LDA
#undef PG8_LDB
#undef PG8_MMA
#undef PG8_WAIT_V
#undef PG8_WAIT_L
#undef PG8_BAR
#undef PG8_SCHED
}
}

namespace att {
constexpr int D = 128, NW = 8, QBLK = 32, KVBLK = 64;
constexpr float SCALE = 0.088388347648318440f;
constexpr float THR = 8.f;
constexpr size_t SHM_V = KVBLK * D * 2, SHM_K = KVBLK * D * 2, SHM_ATTN = 2 * SHM_V + 2 * SHM_K + NW * 64 * 4;
#define KSWZ(row, colB) ((row) * 256 + ((colB) ^ (((row) & 7) << 4)))
#define SBAR() __builtin_amdgcn_sched_barrier(0)
__device__ __forceinline__ int crow(int r, int hi) { return (r & 3) + 8 * (r >> 2) + 4 * hi; }

template <bool MOBA>
__device__ __forceinline__ void partialSM(f32x16& p0, f32x16& p1, float& m_reg, float& mn, float& alpha, int t, int qrow, int hi, unsigned selmask) {
  constexpr float C = SCALE * 1.4426950408889634f;
  if constexpr (MOBA) {
    if (t < 4) { const int kb = t * 64 + 4 * hi;
#pragma unroll
      for (int r = 0; r < 16; ++r) { const int kk = kb + (r & 3) + 8 * (r >> 2); p0[r] = (kk > qrow) ? -1e30f : p0[r]; p1[r] = (kk + 32 > qrow) ? -1e30f : p1[r]; }
    } else { const bool keep = (selmask >> ((t - 4) >> 2)) & 1u;
#pragma unroll
      for (int r = 0; r < 16; ++r) { p0[r] = keep ? p0[r] : -1e30f; p1[r] = keep ? p1[r] : -1e30f; } }
  }
  float pmax = p0[0];
#pragma unroll
  for (int r = 1; r < 16; ++r) pmax = fmaxf(pmax, p0[r]);
#pragma unroll
  for (int r = 0; r < 16; ++r) pmax = fmaxf(pmax, p1[r]);
  { auto rr = __builtin_amdgcn_permlane32_swap(__float_as_uint(pmax), __float_as_uint(pmax), false, false);
    pmax = fmaxf(__uint_as_float(rr[0]), __uint_as_float(rr[1])); }
  if (__builtin_expect(__all(pmax - m_reg <= THR / SCALE), 1)) { mn = m_reg; alpha = 1.f; }
  else { mn = fmaxf(m_reg, pmax); alpha = __builtin_amdgcn_exp2f((m_reg - mn) * C); m_reg = mn; }
  float mnC = -mn * C;
#pragma unroll
  for (int r = 0; r < 16; ++r) p0[r] = fmaf(p0[r], C, mnC);
#pragma unroll
  for (int r = 0; r < 16; ++r) p1[r] = fmaf(p1[r], C, mnC);
#pragma unroll
  for (int r = 0; r < 16; ++r) p0[r] = __builtin_amdgcn_exp2f(p0[r]);
}
__device__ __forceinline__ void finishSM(f32x16& p0, f32x16& p1, float alpha, float& l_reg, bf16x8& pa0, bf16x8& pa1, bf16x8& pa2, bf16x8& pa3) {
#pragma unroll
  for (int r = 0; r < 16; ++r) p1[r] = __builtin_amdgcn_exp2f(p1[r]);
  float ps = 0;
#pragma unroll
  for (int r = 0; r < 16; ++r) ps += p0[r];
#pragma unroll
  for (int r = 0; r < 16; ++r) ps += p1[r];
  { auto rr = __builtin_amdgcn_permlane32_swap(__float_as_uint(ps), __float_as_uint(ps), false, false);
    ps = __uint_as_float(rr[0]) + __uint_as_float(rr[1]); }
  l_reg = l_reg * alpha + ps;
#define PK4(P, BASE, OUT) do { unsigned a0 = cvtpk(P[BASE + 0], P[BASE + 1]), a1 = cvtpk(P[BASE + 2], P[BASE + 3]);   \
    unsigned b0 = cvtpk(P[BASE + 4], P[BASE + 5]), b1 = cvtpk(P[BASE + 6], P[BASE + 7]);                              \
    auto r0 = __builtin_amdgcn_permlane32_swap(a0, b0, false, false); auto r1 = __builtin_amdgcn_permlane32_swap(a1, b1, false, false); \
    u32x4 w = {r0[0], r1[0], r0[1], r1[1]}; OUT = *reinterpret_cast<bf16x8*>(&w); } while (0)
  PK4(p0, 0, pa0); PK4(p0, 8, pa1); PK4(p1, 0, pa2); PK4(p1, 8, pa3);
#undef PK4
}
__device__ __forceinline__ void qkt(f32x16& p0, f32x16& p1, const char* Ks, const bf16x8* qr, const int (&ka)[4]) {
  p0 = f32x16{}; p1 = f32x16{};
#pragma unroll
  for (int d0 = 0; d0 < 8; ++d0) {
    bf16x8 b0 = *reinterpret_cast<const bf16x8*>(Ks + ka[d0 & 3] + (d0 >> 2) * 128);
    bf16x8 b1 = *reinterpret_cast<const bf16x8*>(Ks + ka[d0 & 3] + (d0 >> 2) * 128 + 8192);
    p0 = __builtin_amdgcn_mfma_f32_32x32x16_bf16(b0, qr[d0], p0, 0, 0, 0);
    p1 = __builtin_amdgcn_mfma_f32_32x32x16_bf16(b1, qr[d0], p1, 0, 0, 0); }
}
__device__ __forceinline__ void qkt1(f32x16& p0, const char* Ks, const bf16x8* qr, const int (&ka)[4]) {
  p0 = f32x16{};
#pragma unroll
  for (int d0 = 0; d0 < 8; ++d0) {
    bf16x8 b0 = *reinterpret_cast<const bf16x8*>(Ks + ka[d0 & 3] + (d0 >> 2) * 128);
    p0 = __builtin_amdgcn_mfma_f32_32x32x16_bf16(b0, qr[d0], p0, 0, 0, 0); }
}
__device__ __forceinline__ int v_st(int k, int c) { const int kk = (k & ~0xC) | ((k & 4) << 1) | ((k & 8) >> 1); return ((kk >> 3) * 4 + (c >> 5)) * 512 + ((kk & 7) * 32 + (c & 31)) * 2; }
__device__ __forceinline__ int v_rd_base(int lane) { return ((lane & 3) << 3) | (((lane >> 2) & 3) << 6) | (((lane >> 4) & 1) << 5) | (((lane >> 5) & 1) << 8); }
constexpr int v_rd_off(int d0, int ks, int half) { return d0 * 512 + ks * 4096 + half * 2048; }
template <int OFF> __device__ __forceinline__ s16x4 tr_read(int vb) {
  s16x4 r; asm volatile("ds_read_b64_tr_b16 %0, %1 offset:%2" : "=&v"(r) : "v"(vb), "i"(OFF) : "memory"); return r;
}
template <int D0> __device__ __forceinline__ void pv_one(f32x16& od, int vb, bf16x8 pa0, bf16x8 pa1, bf16x8 pa2, bf16x8 pa3) {
  const s16x4 l0 = tr_read<v_rd_off(D0, 0, 0)>(vb), h0 = tr_read<v_rd_off(D0, 0, 1)>(vb), l1 = tr_read<v_rd_off(D0, 1, 0)>(vb), h1 = tr_read<v_rd_off(D0, 1, 1)>(vb);
  const s16x4 l2 = tr_read<v_rd_off(D0, 2, 0)>(vb), h2 = tr_read<v_rd_off(D0, 2, 1)>(vb), l3 = tr_read<v_rd_off(D0, 3, 0)>(vb), h3 = tr_read<v_rd_off(D0, 3, 1)>(vb);
  asm volatile("s_waitcnt lgkmcnt(0)" ::: "memory"); SBAR();
#define PK(L, H) (bf16x8){L[0], L[1], L[2], L[3], H[0], H[1], H[2], H[3]}
  od = __builtin_amdgcn_mfma_f32_32x32x16_bf16(pa0, PK(l0, h0), od, 0, 0, 0);
  od = __builtin_amdgcn_mfma_f32_32x32x16_bf16(pa1, PK(l1, h1), od, 0, 0, 0);
  od = __builtin_amdgcn_mfma_f32_32x32x16_bf16(pa2, PK(l2, h2), od, 0, 0, 0);
  od = __builtin_amdgcn_mfma_f32_32x32x16_bf16(pa3, PK(l3, h3), od, 0, 0, 0);
#undef PK
}
__device__ __forceinline__ void pv_d0(f32x16* o, int vb, bf16x8 pa0, bf16x8 pa1, bf16x8 pa2, bf16x8 pa3) {
  pv_one<0>(o[0], vb, pa0, pa1, pa2, pa3); pv_one<1>(o[1], vb, pa0, pa1, pa2, pa3); pv_one<2>(o[2], vb, pa0, pa1, pa2, pa3); pv_one<3>(o[3], vb, pa0, pa1, pa2, pa3);
}

template <int LDQ, int LDK, bool MOBA, int SDEPTH>
__device__ __forceinline__ void attn_unit(const bf16* Qb, const bf16* Kh, const bf16* Vh, bf16* Ob, int jblk, const float* kmp, char* lds) {
  int tid = threadIdx.x; asm volatile("" : "+v"(tid));
  const int wid = __builtin_amdgcn_readfirstlane(tid >> 6), lane = tid & 63, r32 = lane & 31, hi = lane >> 5;
  char* V_lds = lds; char* K_lds = lds + 2 * SHM_V;
  float* ws = (float*)(lds + 2 * SHM_V + 2 * SHM_K) + wid * 64; float* li_l = ws; float* al_l = ws + 32;
  float m_reg = -1e30f, l_reg = 0; f32x16 o[4] = {}; bf16x8 qr[8];
  const bf16* Qw = Qb + (long)(wid * QBLK + r32) * LDQ + hi * 8;
#pragma unroll
  for (int d0 = 0; d0 < 8; ++d0) qr[d0] = *reinterpret_cast<const bf16x8*>(Qw + d0 * 16);
  const int sr = tid >> 4, sc = (tid & 15) * 8, vst0 = v_st(sr, sc), vst1 = v_st(32 + sr, sc);
  const unsigned goff = (unsigned)(sr * LDK + sc) * 2u;
  const int vb0 = (int)(uintptr_t)V_lds + v_rd_base(lane);
  const int qrow = wid * QBLK + r32;
  int ka[4];
#pragma unroll
  for (int i = 0; i < 4; ++i) ka[i] = r32 * 256 + (((2 * i + hi) ^ (r32 & 7)) << 4);
  unsigned selmask = 0;
  struct { bf16x8 vs0, vs1, ks0, ks1; } sr_[SDEPTH];
  const int NT = MOBA ? 4 * (jblk + 1) : 4;
#define KOFF(t) (MOBA ? ((t) < 4 ? jblk * 256 + (t) * 64 : ((t) - 4) * 64) : (t) * 64)
#define SLOAD(i, k0) do { const char* kb_ = (const char*)Kh + (size_t)(k0) * (LDK * 2); const char* vb_ = (const char*)Vh + (size_t)(k0) * (LDK * 2); \
    sr_[i].vs0 = *reinterpret_cast<const bf16x8*>(vb_ + goff); sr_[i].vs1 = *reinterpret_cast<const bf16x8*>(vb_ + 32 * LDK * 2 + goff); \
    sr_[i].ks0 = *reinterpret_cast<const bf16x8*>(kb_ + goff); sr_[i].ks1 = *reinterpret_cast<const bf16x8*>(kb_ + 32 * LDK * 2 + goff); } while (0)
#define SWRITE(b, i) do { *(bf16x8*)(V_lds + (b) * SHM_V + vst0) = sr_[i].vs0;          \
    *(bf16x8*)(V_lds + (b) * SHM_V + vst1) = sr_[i].vs1; int kc = sc * 2;               \
    *(bf16x8*)(K_lds + (b) * SHM_K + KSWZ(sr, kc)) = sr_[i].ks0;                       \
    *(bf16x8*)(K_lds + (b) * SHM_K + KSWZ(32 + sr, kc)) = sr_[i].ks1; } while (0)
#define SWAIT() do { if constexpr (SDEPTH == 2) asm volatile("s_waitcnt vmcnt(4)" ::: "memory"); else asm volatile("s_waitcnt vmcnt(0)" ::: "memory"); } while (0)
#define RESC(a) do { if (__any((a) < 1.f)) { if (hi == 0) al_l[r32] = (a); asm volatile("s_waitcnt lgkmcnt(0)" ::: "memory"); \
    _Pragma("unroll") for (int d = 0; d < 4; ++d) _Pragma("unroll") for (int r = 0; r < 16; ++r) o[d][r] *= al_l[crow(r, hi)]; } } while (0)
  f32x16 pA0, pA1, pB0, pB1; float mnA, mnB, alA, alB; bf16x8 pa0, pa1, pa2, pa3;
  constexpr int SE = 0, SO = SDEPTH - 1;
  SLOAD(SE, KOFF(0));
  if constexpr (MOBA) {
    const int gr = tid >> 4, gc = (tid & 15) * 8; f32x4 a = {0.f, 0.f, 0.f, 0.f}, b = {0.f, 0.f, 0.f, 0.f};
    if (gr < jblk) { const float* p0_ = kmp + (size_t)gr * 2048 + gc; const f32x4 a0 = *(const f32x4*)p0_, a1 = *(const f32x4*)(p0_ + 4), b0 = *(const f32x4*)(p0_ + 1024), b1 = *(const f32x4*)(p0_ + 1028);
      a = (a0 + b0) * (1.0f / 256.0f); b = (a1 + b1) * (1.0f / 256.0f); }
    u32x4 w = {pk2(a[0], a[1]), pk2(a[2], a[3]), pk2(b[0], b[1]), pk2(b[2], b[3])};
    *(u32x4*)(K_lds + SHM_K + KSWZ(gr, gc * 2)) = w;
  }
  asm volatile("s_waitcnt vmcnt(0)" ::: "memory"); SWRITE(0, SE); __syncthreads();
  qkt(pA0, pA1, K_lds, qr, ka);
  if constexpr (MOBA) {
    f32x16 g; qkt1(g, K_lds + SHM_K, qr, ka);
    float gv[16];
#pragma unroll
    for (int r = 0; r < 8; ++r) { auto rr = __builtin_amdgcn_permlane32_swap(__float_as_uint(g[r]), __float_as_uint(g[r]), false, false);
      const float lo_ = __uint_as_float(rr[0]), hi_ = __uint_as_float(rr[1]);
      const int n0 = (r & 3) + 8 * (r >> 2); gv[n0] = lo_; gv[n0 + 4] = hi_; }
#pragma unroll
    for (int n = 0; n < 16; ++n) gv[n] = (n < jblk) ? gv[n] : -3e38f;
#pragma unroll
    for (int k = 0; k < 3; ++k) { float best = gv[0];
#pragma unroll
      for (int n = 1; n < 16; ++n) best = fmaxf(best, gv[n]);
      int idx = 16;
#pragma unroll
      for (int n = 15; n >= 0; --n) idx = (gv[n] == best) ? n : idx;
      if (best > -1e38f) selmask |= 1u << idx;
#pragma unroll
      for (int n = 0; n < 16; ++n) gv[n] = (n == idx) ? -3e38f : gv[n]; }
  }
  partialSM<MOBA>(pA0, pA1, m_reg, mnA, alA, 0, qrow, hi, selmask);
  SLOAD(SO, KOFF(1)); if constexpr (SDEPTH == 2) { if (2 < NT) SLOAD(SE, KOFF(2)); }
  if constexpr (MOBA) __syncthreads();
  SWAIT(); SWRITE(1, SO); __syncthreads();
  for (int j = 1; j + 1 < NT; j += 2) {
    SBAR(); qkt(pB0, pB1, K_lds + SHM_K, qr, ka);
    finishSM(pA0, pA1, alA, l_reg, pa0, pa1, pa2, pa3); SBAR();
    SLOAD(SO, KOFF(j + SDEPTH)); SBAR();
    pv_d0(o, vb0, pa0, pa1, pa2, pa3); partialSM<MOBA>(pB0, pB1, m_reg, mnB, alB, j, qrow, hi, selmask);
    __syncthreads(); SWAIT(); SWRITE(0, SE);
    RESC(alB); __syncthreads();
    SBAR(); qkt(pA0, pA1, K_lds, qr, ka);
    finishSM(pB0, pB1, alB, l_reg, pa0, pa1, pa2, pa3); SBAR();
    if (SDEPTH == 1 || j + 3 < NT) SLOAD(SE, KOFF(j + 1 + SDEPTH)); SBAR();
    pv_d0(o, vb0 + (int)SHM_V, pa0, pa1, pa2, pa3); partialSM<MOBA>(pA0, pA1, m_reg, mnA, alA, j + 1, qrow, hi, selmask);
    __syncthreads(); SWAIT(); SWRITE(1, SO);
    RESC(alA); __syncthreads();
  }
  SBAR(); qkt(pB0, pB1, K_lds + SHM_K, qr, ka);
  finishSM(pA0, pA1, alA, l_reg, pa0, pa1, pa2, pa3); SBAR();
  pv_d0(o, vb0, pa0, pa1, pa2, pa3); partialSM<MOBA>(pB0, pB1, m_reg, mnB, alB, NT - 1, qrow, hi, selmask);
  __syncthreads(); RESC(alB);
  finishSM(pB0, pB1, alB, l_reg, pa0, pa1, pa2, pa3); SBAR();
  pv_d0(o, vb0 + (int)SHM_V, pa0, pa1, pa2, pa3);
  if (hi == 0) li_l[r32] = l_reg; asm volatile("s_waitcnt lgkmcnt(0)" ::: "memory");
  float rli[16];
#pragma unroll
  for (int r = 0; r < 16; ++r) rli[r] = __builtin_amdgcn_rcpf(li_l[crow(r, hi)]);
  __syncthreads();
  char* ost = lds + wid * 8192;
#pragma unroll
  for (int r = 0; r < 16; ++r) { const int orow = crow(r, hi);
#pragma unroll
    for (int d0 = 0; d0 < 4; ++d0) *(unsigned short*)(ost + orow * 256 + (d0 * 32 + r32) * 2) = (unsigned short)f2bf(o[d0][r] * rli[r]); }
  asm volatile("s_waitcnt lgkmcnt(0)" ::: "memory");
  bf16* Ow = Ob + (long)(wid * QBLK) * LDQ;
#pragma unroll
  for (int i = 0; i < 8; ++i) { const int row = i * 4 + (lane >> 4), ch = lane & 15; const u32x4 v = *(const u32x4*)(ost + row * 256 + ch * 16);
    *(u32x4*)(Ow + (long)row * LDQ + ch * 8) = v; }
  __syncthreads();
#undef KOFF
#undef SLOAD
#undef SWRITE
#undef SWAIT
#undef RESC
}
}

#ifndef ATT_SD_MEM
#define ATT_SD_MEM 1
#endif
#ifndef ATT_SD_MOBA
#define ATT_SD_MOBA 1
#endif
struct Args {
    const float* in[16]; float* out; unsigned char* ws; int ph_lo, ph_hi;
};
struct Frame {
    LAS unsigned char* lds; char* ldsg;
    int wave, vcu, G;
};
__device__ __forceinline__ int fresh_tid() { int t = threadIdx.x; asm volatile("" : "+v"(t)); return t; }

template <int MAP>
__device__ __forceinline__ void transpose_item(const float* W, int ldw, bf16* dst, int ldd, int row_off, int koff, const float* sc, LAS float* scr, int kb, int nb, int lane) {
    const int k0 = 64 * kb, n0 = 32 * nb;
#pragma unroll 8
    for (int i = 0; i < 32; ++i) { const int kk = 2 * i + (lane >> 5); float v = W[(size_t)(k0 + kk) * ldw + n0 + (lane & 31)]; if (sc) v *= sc[k0 + kk]; scr[kk * 33 + (lane & 31)] = v; }
    LDS_WAIT(); asm volatile("" ::: "memory");
    const int c = lane & 7;
#pragma unroll
    for (int j = 0; j < 4; ++j) { const int n = (lane >> 3) + 8 * j; const LAS float* s = scr + (8 * c) * 33 + n;
        u32x4 o; o.x = pk2(s[0 * 33], s[1 * 33]); o.y = pk2(s[2 * 33], s[3 * 33]); o.z = pk2(s[4 * 33], s[5 * 33]); o.w = pk2(s[6 * 33], s[7 * 33]);
        const int ns = n0 + n; int row;
        if (MAP == 1 && ns < 1024) { const int d = ns & 127; row = row_off + (ns & ~127) + 32 * ((d >> 4) & 3) + 8 * ((d >> 2) & 3) + 4 * (d >> 6) + (d & 3); } else row = row_off + ns;
        *(u32x4*)(dst + (size_t)row * ldd + koff + k0 + 8 * c) = o; }
    LDS_WAIT(); asm volatile("" ::: "memory");
}

__device__ __forceinline__ void phase0(const Args& a, Frame& F) {
    unsigned char* ws = a.ws;
    const int lane = fresh_tid() & 63;
    const int gw = F.vcu * NWAVES + F.wave, NGW = F.G * NWAVES;
    const int gt = gw * 64 + lane, NGT = NGW * 64;
    LAS float* scr = (LAS float*)(F.lds + F.wave * 16384);
    const float* x = a.in[0]; const float* mem = a.in[1]; const float* g_mix = a.in[2]; const float* w_in = a.in[3]; const float* w_out = a.in[4]; const float* w_mkv = a.in[5];
    const float* pool_w = a.in[6]; const float* pool_sc = a.in[7]; const float* g_kv = a.in[8]; const float* w_kv = a.in[9]; const float* g_ffn = a.in[10]; const float* wq = a.in[11];
    const float* subk = a.in[12]; const float* pu = a.in[13]; const float* pv = a.in[14];
    constexpr int I1 = 16 * 48, I2 = 16 * 48, I3 = 16 * 64, I4 = 8 * 32, I5 = 24 * 32, I6 = 2 * 16 * 32, I7 = 2 * 16 * 64;
    constexpr int NIT = I1 + I2 + I3 + I4 + I5 + I6 + I7;
    for (int it = gw; it < NIT; it += NGW) {
        int r = it;
        if (r < I1) { transpose_item<0>(w_in, MIXW, (bf16*)(ws + WS_WIN0), DM, 0, 0, g_mix, scr, r / 48, r % 48, lane); continue; } r -= I1;
        if (r < I2) { transpose_item<1>(w_in + (size_t)DM * MIXW, MIXW, (bf16*)(ws + WS_WC4), DM, 2048, 0, g_mix + DM, scr, r / 48, r % 48, lane); continue; } r -= I2;
        if (r < I3) { transpose_item<1>(w_kv, 2048, (bf16*)(ws + WS_WC4), DM, 0, 0, g_kv, scr, r / 64, r % 64, lane); continue; } r -= I3;
        if (r < I4) { transpose_item<0>(w_out + (size_t)1024 * DM, DM, (bf16*)(ws + WS_WC0), MIXW, 0, 1024, nullptr, scr, r / 32, r % 32, lane); continue; } r -= I4;
        if (r < I5) { transpose_item<0>(w_out + (size_t)MIXW * DM, DM, (bf16*)(ws + WS_WOUT1), MIXW, 0, 0, nullptr, scr, r / 32, r % 32, lane); continue; } r -= I5;
        if (r < I6) { const int l = r / 512, q = r % 512; transpose_item<0>(w_mkv + (size_t)l * DM * 1024, 1024, (bf16*)(ws + WS_WMKV), DM, l * 1024, 0, nullptr, scr, q / 32, q % 32, lane); continue; } r -= I6;
        { const int l = r / 1024, q = r % 1024; transpose_item<0>(wq + (size_t)l * DM * 2048, 2048, (bf16*)(ws + (l ? WS_WQ1 : WS_WQ0)), DM, 0, 0, g_ffn + l * DM, scr, q / 64, q % 64, lane); }
    }
    for (int it = gw; it < 2048; it += NGW) {
        const int itu = __builtin_amdgcn_readfirstlane(it); const int g = itu >> 9, cg8 = (itu >> 4) & 31, nch = itu & 15; const int n = nch * 64 + lane;
        float acc[8];
#pragma unroll
        for (int i = 0; i < 8; ++i) acc[i] = 0.f;
        const float* pw = pool_w + ((size_t)g * 256 + cg8 * 8) * 256;
#pragma unroll 1
        for (int k = 0; k < 4; ++k) { float cf[8]; const float sc = pool_sc[g * 256 + k * 64 + lane];
#pragma unroll
            for (int i = 0; i < 8; ++i) cf[i] = pw[i * 256 + k * 64 + lane] * sc;
            float wv[64];
#pragma unroll
            for (int l = 0; l < 64; ++l) wv[l] = w_out[(size_t)(g * 256 + k * 64 + l) * DM + n];
#pragma unroll
            for (int l = 0; l < 64; ++l) {
#pragma unroll
                for (int i = 0; i < 8; ++i) acc[i] = fmaf(__builtin_bit_cast(float, __builtin_amdgcn_readlane(__builtin_bit_cast(int, cf[i]), l)), wv[l], acc[i]); } }
        u32x4 o; o.x = pk2(acc[0], acc[1]); o.y = pk2(acc[2], acc[3]); o.z = pk2(acc[4], acc[5]); o.w = pk2(acc[6], acc[7]);
        *(u32x4*)((bf16*)(ws + WS_WC0) + (size_t)n * MIXW + g * 256 + cg8 * 8) = o;
    }
    {
        const size_t n8a = (size_t)2 * 16 * 128 * 128 / 8, n8b = (size_t)2048 * 1024 / 8;
        for (size_t i = gt; i < n8a + n8b; i += NGT) { const bool A = i < n8a; const size_t j = A ? i : i - n8a; const float* src = (A ? subk : mem) + j * 8; bf16* dst = (bf16*)(ws + (A ? WS_SUBK : WS_MEMB)) + j * 8;
            const f32x4 v0 = *(const f32x4*)src, v1 = *(const f32x4*)(src + 4); u32x4 o = {pk2(v0[0], v0[1]), pk2(v0[2], v0[3]), pk2(v1[0], v1[1]), pk2(v1[2], v1[3])}; *(u32x4*)dst = o; }
    }
    for (int r = gw; r < 4 * NEXP; r += NGW) { const int tb = r / (2 * NEXP), rr = r % (2 * NEXP), l = rr / NEXP;
        const f32x4* src = (const f32x4*)((tb ? pv : pu) + (size_t)rr * DM) + lane; f32x4 v[4];
#pragma unroll
        for (int i = 0; i < 4; ++i) v[i] = src[64 * i];
        if (!tb) { const f32x4* gp = (const f32x4*)(g_ffn + l * DM) + lane;
#pragma unroll
            for (int i = 0; i < 4; ++i) v[i] *= gp[64 * i]; }
        float am = 0.f;
#pragma unroll
        for (int i = 0; i < 4; ++i) am = fmaxf(fmaxf(fmaxf(am, fabsf(v[i][0])), fmaxf(fabsf(v[i][1]), fabsf(v[i][2]))), fabsf(v[i][3]));
#pragma unroll
        for (int o = 1; o < 64; o <<= 1) am = fmaxf(am, __shfl_xor(am, o));
        const int eb = (int)((__builtin_bit_cast(unsigned, am) >> 23) & 0xffu);
        const float sc = (eb < 16) ? 1.0f : __builtin_bit_cast(float, (unsigned)(127 + 7 + 127 - eb) << 23);
        const float isc = (eb < 16) ? 1.0f : __builtin_bit_cast(float, (unsigned)(eb - 7) << 23);
        unsigned* dst = (unsigned*)(ws + (tb ? WS_VB : WS_UB) + (size_t)rr * DM) + lane;
#pragma unroll
        for (int i = 0; i < 4; ++i) { int w = __builtin_amdgcn_cvt_pk_fp8_f32(v[i][0] * sc, v[i][1] * sc, 0, false); w = __builtin_amdgcn_cvt_pk_fp8_f32(v[i][2] * sc, v[i][3] * sc, w, true); dst[64 * i] = (unsigned)w; }
        if (lane == 0) ((float*)(ws + (tb ? WS_VSC : WS_USC)))[rr] = isc; }
    for (int i = gt; i < SEQ * 64; i += NGT) { const int pos = i >> 6, fi = i & 63; const float inv = exp2f(-(float)fi * 0.20762050593046015f);
        float sn, cs_; sincosf((float)pos * inv, &sn, &cs_); f32x2 cs = {cs_, sn}; *(f32x2*)((float*)(ws + WS_ROPE) + (size_t)i * 2) = cs; }
    for (int t = gw; t < T; t += NGW) { const f32x4* xr = (const f32x4*)(x + (size_t)t * DM) + lane; f32x4 v[4]; float s = 0.f;
#pragma unroll
        for (int j = 0; j < 4; ++j) { v[j] = xr[64 * j]; s += (v[j][0] * v[j][0] + v[j][1] * v[j][1]) + (v[j][2] * v[j][2] + v[j][3] * v[j][3]); }
        s = wave_sum(s);
        u32x2* o8 = (u32x2*)((bf16*)(ws + WS_XB) + (size_t)t * DM) + lane;
#pragma unroll
        for (int j = 0; j < 4; ++j) { u32x2 w = {pk2(v[j][0], v[j][1]), pk2(v[j][2], v[j][3])}; o8[64 * j] = w; }
        if (lane == 0) ((float*)(ws + WS_RSTD0))[t] = 1.0f / sqrtf(s * (1.0f / DM) + EPS); }
}

__device__ __forceinline__ void pool_diff(const Args& a, Frame& F) {
    const bf16* pm = (const bf16*)(a.ws + WS_P0MAIN); bf16* A2 = (bf16*)(a.ws + WS_A2);
    const int gt = (F.vcu * NWAVES + F.wave) * 64 + (fresh_tid() & 63), NGT = F.G * NTHR;
    for (int it = gt; it < (T / 16) * 128; it += NGT) {
        const int cc = it & 127, tg = it >> 7, t0 = tg * 16, s0 = t0 & (SEQ - 1), w = 2 << (cc >> 5), c0 = cc * 8;
        float sum[8];
#pragma unroll
        for (int i = 0; i < 8; ++i) sum[i] = 0.f;
        const int hist = (w - 1) < s0 ? (w - 1) : s0;
        for (int i = 1; i <= hist; ++i) { const u32x4 v = *(const u32x4*)(pm + (size_t)(t0 - i) * DM + c0);
            sum[0] += bflo(v.x); sum[1] += bfhi(v.x); sum[2] += bflo(v.y); sum[3] += bfhi(v.y); sum[4] += bflo(v.z); sum[5] += bfhi(v.z); sum[6] += bflo(v.w); sum[7] += bfhi(v.w); }
        for (int k = 0; k < 16; ++k) { const int t = t0 + k, s = s0 + k; const u32x4 v = *(const u32x4*)(pm + (size_t)t * DM + c0);
            float xv[8] = {bflo(v.x), bfhi(v.x), bflo(v.y), bfhi(v.y), bflo(v.z), bfhi(v.z), bflo(v.w), bfhi(v.w)};
#pragma unroll
            for (int i = 0; i < 8; ++i) sum[i] += xv[i];
            const float inv = 1.0f / (float)((s + 1) < w ? (s + 1) : w);
            u32x4 o = {pk2(sum[0] * inv - xv[0], sum[1] * inv - xv[1]), pk2(sum[2] * inv - xv[2], sum[3] * inv - xv[3]), pk2(sum[4] * inv - xv[4], sum[5] * inv - xv[5]), pk2(sum[6] * inv - xv[6], sum[7] * inv - xv[7])};
            *(u32x4*)(A2 + (size_t)t * MIXW + c0) = o;
            if (s >= w - 1) { const u32x4 q = *(const u32x4*)(pm + (size_t)(t - w + 1) * DM + c0);
                sum[0] -= bflo(q.x); sum[1] -= bfhi(q.x); sum[2] -= bflo(q.y); sum[3] -= bfhi(q.y); sum[4] -= bflo(q.z); sum[5] -= bfhi(q.z); sum[6] -= bflo(q.w); sum[7] -= bfhi(q.w); } }
    }
}

__device__ __forceinline__ void mem_attn(const Args& a, Frame& F, bf16* Abuf, int layer, bool dry = false) {
    const bf16* MKV = (const bf16*)(a.ws + WS_MEMKV);
    for (int U = F.vcu; U < 512; U += F.G) { const int b = U >> 6, h = (U >> 4) & 3, qt = U & 15;
        bf16* Q = Abuf + ((size_t)b * SEQ + qt * 256) * MIXW + 1024 + h * 128;
        const bf16* K = MKV + (size_t)b * MEMT * 2048 + layer * 1024 + h * 128;
        att::attn_unit<MIXW, 2048, false, ATT_SD_MEM>(Q, K, K + 512, dry ? (bf16*)(a.ws + WS_EXP) : Q, 0, nullptr, F.ldsg); }
}

__device__ __forceinline__ int ord_enc(float x) { const int b = __builtin_bit_cast(int, x); return b ^ ((b >> 31) & 0x7fffffff); }
__device__ __forceinline__ float ord_dec(int k) { return __builtin_bit_cast(float, k ^ ((k >> 31) & 0x7fffffff)); }
template <int N> __device__ __forceinline__ void bitonic_desc(int (&a)[N]) {
#pragma unroll
    for (int k = 2; k <= N; k <<= 1)
#pragma unroll
        for (int j = k >> 1; j > 0; j >>= 1)
#pragma unroll
            for (int i = 0; i < N; ++i) { const int l = i ^ j; if (l > i) { const bool desc = ((i & k) == 0) || (k == N);
                const int hi = max(a[i], a[l]), lo = min(a[i], a[l]); a[i] = desc ? hi : lo; a[l] = desc ? lo : hi; } }
}
__device__ __forceinline__ void sort16_desc(int (&a)[16]) {
#define CE_(i, j) { const int hi_ = max(a[i], a[j]), lo_ = min(a[i], a[j]); a[i] = hi_; a[j] = lo_; }
    CE_(0, 13) CE_(1, 12) CE_(2, 15) CE_(3, 14) CE_(4, 8) CE_(5, 6) CE_(7, 11) CE_(9, 10)
    CE_(0, 5) CE_(1, 7) CE_(2, 9) CE_(3, 4) CE_(6, 13) CE_(8, 14) CE_(10, 15) CE_(11, 12)
    CE_(0, 1) CE_(2, 3) CE_(4, 5) CE_(6, 8) CE_(7, 9) CE_(10, 11) CE_(12, 13) CE_(14, 15)
    CE_(0, 2) CE_(1, 3) CE_(4, 10) CE_(5, 11) CE_(6, 7) CE_(8, 9) CE_(12, 14) CE_(13, 15)
    CE_(1, 2) CE_(3, 12) CE_(4, 6) CE_(5, 7) CE_(8, 10) CE_(9, 11) CE_(13, 14)
    CE_(1, 4) CE_(2, 6) CE_(5, 8) CE_(7, 10) CE_(9, 13) CE_(11, 14)
    CE_(2, 4) CE_(3, 6) CE_(9, 12) CE_(11, 13)
    CE_(3, 5) CE_(6, 8) CE_(7, 9) CE_(10, 12)
    CE_(3, 4) CE_(5, 6) CE_(7, 8) CE_(9, 10) CE_(11, 12)
    CE_(6, 7) CE_(8, 9)
#undef CE_
}
__device__ __forceinline__ void merge16(int (&a)[16], const int (&b)[16]) {
#pragma unroll
    for (int i = 0; i < 16; ++i) a[i] = max(a[i], b[15 - i]);
#pragma unroll
    for (int j = 8; j > 0; j >>= 1)
#pragma unroll
        for (int i = 0; i < 16; ++i) { const int l = i ^ j; if (l > i) { const int hi = max(a[i], a[l]), lo = min(a[i], a[l]); a[i] = hi; a[l] = lo; } }
}
constexpr int cand_i(int s) { int c = 0; for (int a = 0; a < 16; ++a) for (int b = 0; b < 16; ++b) { if ((a + 1) * (b + 1) > 16) continue; if (c == s) return a; ++c; } return 0; }
constexpr int cand_j(int s) { int c = 0; for (int a = 0; a < 16; ++a) for (int b = 0; b < 16; ++b) { if ((a + 1) * (b + 1) > 16) continue; if (c == s) return b; ++c; } return 0; }
constexpr int cand_slot(int i, int j) { int s = 0; for (int a = 0; a < 16; ++a) for (int b = 0; b < 16; ++b) { if ((a + 1) * (b + 1) > 16) continue; if (a == i && b == j) return s; ++s; } return -1; }

__device__ __forceinline__ void peer_topk(const Args& a, Frame& F, int layer) {
    const bf16* PQ = (const bf16*)(a.ws + WS_PQ); const bf16* SUBK = (const bf16*)(a.ws + WS_SUBK) + (size_t)layer * 16 * 128 * 128;
    unsigned short* EXPo = (unsigned short*)(a.ws + WS_EXP); float* GATEo = (float*)(a.ws + WS_GATE);
    const int tid = fresh_tid(), lane = tid & 63, wid = F.wave, r32 = lane & 31, hi = lane >> 5;
    const int h = F.vcu & 7;
    int ka[4];
#pragma unroll
    for (int i = 0; i < 4; ++i) ka[i] = r32 * 256 + (((2 * i + hi) ^ (r32 & 7)) << 4);
    char* Ks = F.ldsg;
    LAS unsigned char* ib = F.lds + 65536 + tid * 36;
    for (int i = tid; i < 2 * 128 * 16; i += NTHR) { const int row = i >> 4, ch = i & 15; const u32x4 v = *(const u32x4*)(SUBK + ((size_t)h * 256 + row) * 128 + ch * 8);
        *(u32x4*)(Ks + (row >> 7) * 32768 + KSWZ(row & 127, ch * 16)) = v; }
    __syncthreads();
    for (int tt = (F.vcu >> 3); tt < T / 256; tt += (F.G >> 3)) {
        const int t = tt * 256 + wid * 32 + r32;
        int top[2][16];
#pragma unroll
        for (int p = 0; p < 2; ++p) {
            bf16x8 qr[8]; const bf16* qp = PQ + (size_t)t * 2048 + h * 256 + p * 128 + hi * 8;
#pragma unroll
            for (int d0 = 0; d0 < 8; ++d0) qr[d0] = *reinterpret_cast<const bf16x8*>(qp + d0 * 16);
            int cur[16];
#pragma unroll
            for (int kt = 0; kt < 4; ++kt) { f32x16 sacc; att::qkt1(sacc, Ks + p * 32768 + kt * 32 * 256, qr, ka);
                int grp[16];
#pragma unroll
                for (int r = 0; r < 16; ++r) grp[r] = (ord_enc(sacc[r]) & ~0x7F) | (kt * 32 + (r & 3) + 8 * (r >> 2) + 4 * hi);
                sort16_desc(grp);
                if (kt == 0) {
#pragma unroll
                    for (int r = 0; r < 16; ++r) cur[r] = grp[r];
                } else merge16(cur, grp); }
            int oth[16];
#pragma unroll
            for (int r = 0; r < 16; ++r) { auto rr = __builtin_amdgcn_permlane32_swap((unsigned)cur[r], (unsigned)cur[r], false, false); cur[r] = (int)rr[0]; oth[r] = (int)rr[1]; }
            merge16(cur, oth);
#pragma unroll
            for (int r = 0; r < 16; ++r) top[p][r] = cur[r];
        }
        float v0[16], v1[16];
#pragma unroll
        for (int r = 0; r < 16; ++r) { v0[r] = ord_dec(top[0][r] & ~0x7F); v1[r] = ord_dec(top[1][r] & ~0x7F); }
#pragma unroll
        for (int q = 0; q < 4; ++q) { *(LAS unsigned*)(ib + q * 4) = (top[0][4 * q] & 0x7F) | ((top[0][4 * q + 1] & 0x7F) << 8) | ((top[0][4 * q + 2] & 0x7F) << 16) | ((top[0][4 * q + 3] & 0x7F) << 24);
            *(LAS unsigned*)(ib + 16 + q * 4) = (top[1][4 * q] & 0x7F) | ((top[1][4 * q + 1] & 0x7F) << 8) | ((top[1][4 * q + 2] & 0x7F) << 16) | ((top[1][4 * q + 3] & 0x7F) << 24); }
        int best[16], g1[16];
#pragma unroll
        for (int r = 0; r < 32; ++r) { int key = (int)0x80000000;
            if (r < 25) {
                const int iA = cand_i(r), jA = cand_j(r), iB = cand_i(25 + r), jB = cand_j(25 + r);
                const float sA = v0[iA] + v1[jA], sB = v0[iB] + v1[jB]; const int code = hi ? (iB * 16 + jB) : (iA * 16 + jA);
                key = (ord_enc(hi ? sB : sA) & ~0xFF) | code; }
            if (r < 16) best[r] = key; else g1[r - 16] = key; }
        sort16_desc(best); sort16_desc(g1); merge16(best, g1);
#pragma unroll
        for (int r = 0; r < 16; ++r) { auto rr = __builtin_amdgcn_permlane32_swap((unsigned)best[r], (unsigned)best[r], false, false); best[r] = (int)rr[0]; g1[r] = (int)rr[1]; }
        merge16(best, g1);
        float cv[16], ex[16]; float sum = 0.f;
#pragma unroll
        for (int r = 0; r < 16; ++r) cv[r] = ord_dec(best[r] & ~0xFF);
#pragma unroll
        for (int r = 0; r < 16; ++r) { ex[r] = __builtin_amdgcn_exp2f((cv[r] - cv[0]) * 1.4426950408889634f); sum += ex[r]; }
        const float rs = 1.0f / sum;
        LDS_WAIT();
        unsigned ee[16];
#pragma unroll
        for (int r = 0; r < 16; ++r) { const int code = best[r] & 0xFF; const unsigned e1 = ib[code >> 4], e2 = ib[16 + (code & 15)]; ee[r] = e1 * 128u + e2; }
        const size_t ob = ((size_t)t * 8 + h) * 16;
        if (hi == 0) { u32x4 w0 = {ee[0] | (ee[1] << 16), ee[2] | (ee[3] << 16), ee[4] | (ee[5] << 16), ee[6] | (ee[7] << 16)}, w1 = {ee[8] | (ee[9] << 16), ee[10] | (ee[11] << 16), ee[12] | (ee[13] << 16), ee[14] | (ee[15] << 16)};
            *(u32x4*)(EXPo + ob) = w0; *(u32x4*)(EXPo + ob + 8) = w1; }
        else {
#pragma unroll
            for (int q = 0; q < 4; ++q) { f32x4 gq = {ex[4 * q] * rs, ex[4 * q + 1] * rs, ex[4 * q + 2] * rs, ex[4 * q + 3] * rs}; *(f32x4*)(GATEo + ob + 4 * q) = gq; } }
        LDS_WAIT();
    }
    __syncthreads();
}

__device__ __forceinline__ float gelu_exact(float v) {
    const float av = fabsf(v), t = __builtin_amdgcn_rcpf(fmaf(av, 0.2316418882f, 1.0f));
    float q = fmaf(t, 0.5307027145f, -0.7265760135f); q = fmaf(q, t, 0.7107068705f); q = fmaf(q, t, -0.142248368f); q = fmaf(q, t, 0.127414796f); q = q * t;
    const float e = __builtin_amdgcn_exp2f(v * v * -0.72134752044f), m = v * (q * e);
    return v < 0.f ? m : v - m;
}
__device__ __forceinline__ float dot16_fp8(const u32x4 u, const f32x2 (&x2)[8]) {
    f32x2 d = {0.f, 0.f};
#pragma unroll
    for (int i = 0; i < 4; ++i) { const f32x2 a = __builtin_amdgcn_cvt_pk_f32_fp8((int)u[i], false), b = __builtin_amdgcn_cvt_pk_f32_fp8((int)u[i], true);
        d = __builtin_elementwise_fma(a, x2[2 * i], d); d = __builtin_elementwise_fma(b, x2[2 * i + 1], d); }
    return d.x + d.y;
}
__device__ __forceinline__ void axpy16_fp8(f32x2 (&o2)[8], const float h, const u32x4 v) {
    const f32x2 h2 = {h, h};
#pragma unroll
    for (int i = 0; i < 4; ++i) { const f32x2 a = __builtin_amdgcn_cvt_pk_f32_fp8((int)v[i], false), b = __builtin_amdgcn_cvt_pk_f32_fp8((int)v[i], true);
        o2[2 * i] = __builtin_elementwise_fma(a, h2, o2[2 * i]); o2[2 * i + 1] = __builtin_elementwise_fma(b, h2, o2[2 * i + 1]); }
}
__device__ __forceinline__ float reduce8(const float (&p)[8], int lane) {
    float s[4];
#pragma unroll
    for (int i = 0; i < 4; ++i) { auto rr = __builtin_amdgcn_permlane32_swap(__float_as_uint(p[2 * i]), __float_as_uint(p[2 * i + 1]), false, false); s[i] = __uint_as_float(rr[0]) + __uint_as_float(rr[1]); }
    float t[2];
#pragma unroll
    for (int i = 0; i < 2; ++i) { const bool hi = lane & 16; const float u = hi ? s[2 * i + 1] : s[2 * i], o = hi ? s[2 * i] : s[2 * i + 1]; t[i] = u + shx_f<16>(o); }
    const bool h8 = lane & 8; const float u = h8 ? t[1] : t[0], o = h8 ? t[0] : t[1]; float w = u + dpp_f<0x128>(o);
    w += dpp_f<0x141>(w); w += dpp_f<0x1B>(w); w += dpp_f<0xB1>(w);
    return w;
}
constexpr int qgrp(int q) { return 2 * ((q & 3) == 1 ? 2 : (q & 3) == 2 ? 1 : (q & 3)) + (q >> 2); }

template <int K, int J> __device__ __forceinline__ void sort128_stage(unsigned& lo, unsigned& hi, int lane) {
    const unsigned plo = shx_u<J>(lo), phi = shx_u<J>(hi);
    const bool up_lo = (K >= 64) ? true : ((lane & K) == 0), up_hi = (K == 64) ? false : up_lo, lower = (lane & J) == 0;
    lo = (lower == up_lo) ? min(lo, plo) : max(lo, plo); hi = (lower == up_hi) ? min(hi, phi) : max(hi, phi);
    if constexpr (J > 1) sort128_stage<K, J / 2>(lo, hi, lane);
}
template <int K> __device__ __forceinline__ void sort128_level(unsigned& lo, unsigned& hi, int lane) { sort128_stage<K, K / 2>(lo, hi, lane); if constexpr (K < 64) sort128_level<K * 2>(lo, hi, lane); }
__device__ __forceinline__ void sort128(unsigned& lo, unsigned& hi, int lane) {
    sort128_level<2>(lo, hi, lane);
    { const unsigned a = min(lo, hi), b = max(lo, hi); lo = a; hi = b; }
    sort128_stage<128, 32>(lo, hi, lane);
}
template <bool FINAL, bool DRY = false>
__device__ __forceinline__ void peer_gather(const Args& a, Frame& F, int layer) {
    const unsigned char* UB = a.ws + WS_UB + (size_t)layer * NEXP * DM; const unsigned char* VB = a.ws + WS_VB + (size_t)layer * NEXP * DM;
    const float* USC = (const float*)(a.ws + WS_USC) + layer * NEXP; const float* VSC = (const float*)(a.ws + WS_VSC) + layer * NEXP;
    const unsigned short* EXPi = (const unsigned short*)(a.ws + WS_EXP); const float* GATEi = (const float*)(a.ws + WS_GATE);
    float* X = a.out; bf16* XB = (bf16*)(a.ws + WS_XB); float* RSTD2 = (float*)(a.ws + WS_RSTD2); const float* gfin = a.in[15];
    const int lane = fresh_tid() & 63, gw = F.vcu * NWAVES + F.wave, NGW = F.G * NWAVES;
    const unsigned lane16 = (unsigned)lane * 16u;
    const int grp = lane >> 3; const int jperm = 8 * (lane & 7) + ((grp >> 1) == 1 ? 2 : (grp >> 1) == 2 ? 1 : (grp >> 1)) + 4 * (grp & 1);
    for (int t = gw; t < T; t += NGW) {
        __syncthreads();
        bf16* xbr = XB + (size_t)t * DM + 16 * lane;
        float x[16];
        { const u32x4 v0 = *(const u32x4*)xbr, v1 = *(const u32x4*)(xbr + 8);
          x[0] = bflo(v0.x); x[1] = bfhi(v0.x); x[2] = bflo(v0.y); x[3] = bfhi(v0.y); x[4] = bflo(v0.z); x[5] = bfhi(v0.z); x[6] = bflo(v0.w); x[7] = bfhi(v0.w);
          x[8] = bflo(v1.x); x[9] = bfhi(v1.x); x[10] = bflo(v1.y); x[11] = bfhi(v1.y); x[12] = bflo(v1.z); x[13] = bfhi(v1.z); x[14] = bflo(v1.w); x[15] = bfhi(v1.w); }
        f32x2 x2[8];
#pragma unroll
        for (int i = 0; i < 8; ++i) { x2[i].x = x[2 * i]; x2[i].y = x[2 * i + 1]; }
        float ss = 0.f;
#pragma unroll
        for (int i = 0; i < 16; ++i) ss = fmaf(x[i], x[i], ss);
        ss = wave_sum(ss);
        const float rstd = 1.0f / sqrtf(ss * (1.0f / DM) + EPS);
        const unsigned short* et = EXPi + (size_t)t * 128; const float* gt_ = GATEi + (size_t)t * 128;
        unsigned k_lo = ((unsigned)et[lane] << 7) | (unsigned)lane, k_hi = ((unsigned)et[64 + lane] << 7) | (unsigned)(64 + lane);
        sort128(k_lo, k_hi, lane);
        const int e_lo = (int)(k_lo >> 7), e_hi = (int)(k_hi >> 7);
        const float gs_lo = gt_[k_lo & 127u], gs_hi = gt_[k_hi & 127u];
        const int ep_lo = __shfl(e_lo, jperm), ep_hi = __shfl(e_hi, jperm);
        const float gl = __shfl(gs_lo, jperm) * VSC[ep_lo], gh = __shfl(gs_hi, jperm) * VSC[ep_hi];
        const float ul = USC[ep_lo] * rstd, uh = USC[ep_hi] * rstd;
        float a_lo = 0.f, a_hi = 0.f;
        u32x4 b0[8], b1[8], b2[8];
#define ROWLD(dst, tab, e_) dst = *(const u32x4*)((tab) + (size_t)(e_) * DM + lane16)
#define ULOAD(buf, B) do { const int ev_ = ((B) >> 3) ? e_hi : e_lo; _Pragma("unroll") for (int q = 0; q < 8; ++q) { const int e = __builtin_amdgcn_readlane(ev_, 8 * ((B) & 7) + q); ROWLD(buf[q], UB, e); } } while (0)
#define VLOAD(buf, B) do { const int ev_ = ((B) >> 3) ? e_hi : e_lo; _Pragma("unroll") for (int q = 0; q < 8; ++q) { const int e = __builtin_amdgcn_readlane(ev_, 8 * ((B) & 7) + q); ROWLD(buf[q], VB, e); } } while (0)
#define UCOMP(buf, B) do { float p[8]; _Pragma("unroll") for (int q = 0; q < 8; ++q) p[q] = dot16_fp8(buf[q], x2); const float w = reduce8(p, lane); const bool mine = (lane & 7) == ((B) & 7); \
        if ((B) >> 3) a_hi = mine ? w : a_hi; else a_lo = mine ? w : a_lo; } while (0)
        ULOAD(b0, 0); ULOAD(b1, 1);
#pragma unroll 1
        for (int B = 0; B < 12; B += 3) {
            if (B > 0) __syncthreads();
            ULOAD(b2, B + 2); UCOMP(b0, B);
            ULOAD(b0, B + 3); UCOMP(b1, B + 1);
            ULOAD(b1, B + 4); UCOMP(b2, B + 2); }
        ULOAD(b2, 14); UCOMP(b0, 12);
        ULOAD(b0, 15); UCOMP(b1, 13);
        VLOAD(b1, 0);  UCOMP(b2, 14);
        VLOAD(b2, 1);  UCOMP(b0, 15);
#undef ULOAD
#undef UCOMP
        __syncthreads();
        const float h_lo = gelu_exact(a_lo * ul) * gl, h_hi = gelu_exact(a_hi * uh) * gh;
        f32x2 o2[8];
#pragma unroll
        for (int i = 0; i < 8; ++i) o2[i] = (f32x2){0.f, 0.f};
#define VCOMP(buf, B) do { const int hv_ = __builtin_bit_cast(int, ((B) >> 3) ? h_hi : h_lo); _Pragma("unroll") for (int q = 0; q < 8; ++q) { const float hq = __builtin_bit_cast(float, __builtin_amdgcn_readlane(hv_, 8 * qgrp(q) + ((B) & 7))); axpy16_fp8(o2, hq, buf[q]); } } while (0)
#pragma unroll 1
        for (int B = 0; B < 12; B += 3) {
            if (B > 0) __syncthreads();
            VLOAD(b0, B + 2); VCOMP(b1, B);
            VLOAD(b1, B + 3); VCOMP(b2, B + 1);
            VLOAD(b2, B + 4); VCOMP(b0, B + 2); }
        VLOAD(b0, 14); VCOMP(b1, 12);
        VLOAD(b1, 15); VCOMP(b2, 13);
        VCOMP(b0, 14);
        VCOMP(b1, 15);
#undef VLOAD
#undef VCOMP
#undef ROWLD
        float o[16]; float s2 = 0.f;
#pragma unroll
        for (int i = 0; i < 8; ++i) { o[2 * i] = o2[i].x; o[2 * i + 1] = o2[i].y; }
        { const u32x4 v0 = *(const u32x4*)xbr, v1 = *(const u32x4*)(xbr + 8);
          o[0] += bflo(v0.x); o[1] += bfhi(v0.x); o[2] += bflo(v0.y); o[3] += bfhi(v0.y); o[4] += bflo(v0.z); o[5] += bfhi(v0.z); o[6] += bflo(v0.w); o[7] += bfhi(v0.w);
          o[8] += bflo(v1.x); o[9] += bfhi(v1.x); o[10] += bflo(v1.y); o[11] += bfhi(v1.y); o[12] += bflo(v1.z); o[13] += bfhi(v1.z); o[14] += bflo(v1.w); o[15] += bfhi(v1.w); }
#pragma unroll
        for (int i = 0; i < 16; ++i) s2 = fmaf(o[i], o[i], s2);
        s2 = wave_sum(s2);
        const float r2 = 1.0f / sqrtf(s2 * (1.0f / DM) + EPS);
        if constexpr (FINAL) {
            float* xw = (DRY ? (float*)(a.ws + WS_RB) : X) + (size_t)t * DM;
#pragma unroll
            for (int i = 0; i < 4; ++i) { const f32x4 g = *(const f32x4*)(gfin + 16 * lane + 4 * i); f32x4 y = {o[4 * i] * r2 * g[0], o[4 * i + 1] * r2 * g[1], o[4 * i + 2] * r2 * g[2], o[4 * i + 3] * r2 * g[3]}; *(f32x4*)(xw + 16 * lane + 4 * i) = y; }
        } else {
            bf16* xo = DRY ? (bf16*)(a.ws + WS_RB) + (size_t)t * DM + 16 * lane : xbr;
            u32x4 wa = {pk2(o[0], o[1]), pk2(o[2], o[3]), pk2(o[4], o[5]), pk2(o[6], o[7])}, wb = {pk2(o[8], o[9]), pk2(o[10], o[11]), pk2(o[12], o[13]), pk2(o[14], o[15])};
            *(u32x4*)xo = wa; *(u32x4*)(xo + 8) = wb;
            if (!DRY && lane == 0) RSTD2[t] = r2;
        }
    }
}

#define XB_TMO      128
#define XB_XCNT(j)  (256  + 64 * (j))
#define XB_XSUB(j)  (1280 + 64 * (j))
#define XB_XGEN(j)  (2304 + 64 * (j))
#define XB_TOP      3328
#define XB_TOPGEN   3392
#define XCD_BAR_WORDS 3456
#define XB_SPIN_CAP (1u << 22)
__device__ __forceinline__ unsigned xb_ld(unsigned* p)              { return __hip_atomic_load(p, __ATOMIC_RELAXED, __HIP_MEMORY_SCOPE_AGENT); }
__device__ __forceinline__ unsigned xb_add(unsigned* p, unsigned v) { return __hip_atomic_fetch_add(p, v, __ATOMIC_RELAXED, __HIP_MEMORY_SCOPE_AGENT); }
__device__ __forceinline__ unsigned xb_xcc_id() { return (unsigned)__builtin_amdgcn_s_getreg((3 << 11) | 20) & 0xFu; }
#define XB_SPIN(cond, bar) do { unsigned _sp = 0; while (cond) { __builtin_amdgcn_s_sleep(1); \
    if ((++_sp & 255u) == 0u) { if (xb_ld(&(bar)[XB_TMO])) break; if (_sp > XB_SPIN_CAP) { atomicAdd(&(bar)[XB_TMO], 1u); break; } } } } while (0)
struct XcdBarrier { unsigned* bar; unsigned x; volatile LAS unsigned* st; };
__device__ __forceinline__ XcdBarrier xcd_barrier_post(unsigned* bar, volatile LAS unsigned* st) {
    XcdBarrier b; b.bar = bar; b.x = xb_xcc_id(); b.st = st;
    if (threadIdx.x == 0) (void)xb_add(&bar[XB_XCNT(b.x)], 1u);
    return b;
}
__device__ __forceinline__ void xcd_barrier_complete(unsigned* bar, unsigned x, unsigned& nloc, unsigned& nx) {
    const unsigned G = gridDim.x * gridDim.y * gridDim.z;
    unsigned sum, cnt, mine, sp = 0u;
    for (;;) {
        sum = 0u; cnt = 0u; mine = 0u;
#pragma unroll
        for (unsigned j = 0; j < 16; ++j) { const unsigned c = xb_ld(&bar[XB_XCNT(j)]); sum += c; cnt += (c > 0u) ? 1u : 0u; mine = (j == x) ? c : mine; }
        if (sum == G) break;
        __builtin_amdgcn_s_sleep(1);
        if ((++sp & 255u) == 0u) { if (xb_ld(&bar[XB_TMO])) break; if (sp > XB_SPIN_CAP) { atomicAdd(&bar[XB_TMO], 1u); break; } }
    }
    nloc = mine > 0u ? mine : 1u; nx = cnt > 0u ? cnt : 1u;
}
__device__ __forceinline__ void xcd_barrier(const XcdBarrier& b) {
    asm volatile("s_waitcnt vmcnt(0)" ::: "memory");
    __syncthreads();
    if (threadIdx.x == 0) {
        unsigned* bar = b.bar;
        __builtin_amdgcn_s_waitcnt(0);
        unsigned nloc = b.st[0], nx = b.st[1];
        if (nloc == 0u) { xcd_barrier_complete(bar, b.x, nloc, nx); b.st[0] = nloc; b.st[1] = nx; }
        const unsigned old = xb_add(&bar[XB_XSUB(b.x)], 1u);
        const unsigned gen = old / nloc;
        if (old + 1u == (gen + 1u) * nloc) {
            __builtin_amdgcn_fence(__ATOMIC_RELEASE, "agent");
            asm volatile("s_waitcnt vmcnt(0)" ::: "memory");
            const unsigned og = xb_add(&bar[XB_TOP], 1u);
            const unsigned tg = og / nx;
            if (og + 1u == (tg + 1u) * nx) xb_add(&bar[XB_TOPGEN], 1u);
            else XB_SPIN(xb_ld(&bar[XB_TOPGEN]) == tg, bar);
            __builtin_amdgcn_fence(__ATOMIC_ACQUIRE, "agent");
            xb_add(&bar[XB_XGEN(b.x)], 1u);
            asm volatile("s_waitcnt vmcnt(0)" ::: "memory");
        } else {
            XB_SPIN(xb_ld(&bar[XB_XGEN(b.x)]) == gen, bar);
            __builtin_amdgcn_fence(__ATOMIC_ACQUIRE, "agent");
            asm volatile("s_waitcnt vmcnt(0)" ::: "memory");
        }
    }
    __syncthreads();
}

__global__ void __launch_bounds__(NTHR, 2) yoco_fwd(Args args) {
    extern __shared__ __attribute__((aligned(16))) unsigned char lds_raw[];
    cg::grid_group grid = cg::this_grid();
    Frame F;
    F.lds = (LAS unsigned char*)lds_raw; F.ldsg = (char*)lds_raw;
    F.wave = __builtin_amdgcn_readfirstlane(threadIdx.x >> 6);
    F.G = gridDim.x; { const int bx = blockIdx.x; F.vcu = (F.G % 8 == 0) ? (bx % 8) * (F.G / 8) + bx / 8 : bx; }
    unsigned char* ws = args.ws;
    const int lo = args.ph_lo, hi = args.ph_hi;
    volatile LAS unsigned* bst = (volatile LAS unsigned*)(F.lds + 131072 + 320);
    if (threadIdx.x < 2) bst[threadIdx.x] = 0u;
    __syncthreads();
    XcdBarrier xbar; xbar.bar = (unsigned*)ws; xbar.x = 0; xbar.st = bst;
    if (hi - lo > 1) xbar = xcd_barrier_post((unsigned*)ws, bst);
#ifndef PH_MASK
#define PH_MASK 0x1fff
#endif
#define IN(k) (((PH_MASK >> (k)) & 1) && lo <= (k) && (k) < hi)
#define SEAM(k) do { if (IN(k) && IN((k) + 1)) { if ((k) == 0) grid.sync(); else xcd_barrier(xbar); } } while (0)
#define GSYNC() xcd_barrier(xbar)
#ifndef REP_MASK
#define REP_MASK 0
#endif
#define NREP(k) (((REP_MASK >> (k)) & 1) ? 2 : 1)
    typedef pg8::bf16_t pb;

    for (int rep_ = 0; rep_ < NREP(0); ++rep_) { if (rep_) GSYNC();
    if (IN(0)) { phase0(args, F); } } SEAM(0);

    for (int rep_ = 0; rep_ < NREP(1); ++rep_) { if (rep_) GSYNC();
    if (IN(1)) {
        { pg8::Gemm g{(const pb*)(ws + WS_XB), (const pb*)(ws + WS_WIN0), T, MIXW, DM}; pg8::StaticOrder S; S.init(T, MIXW, F.G, (int)blockIdx.x);
          pg8::EpiRowBf16 E{(pb*)(ws + WS_P0MAIN), DM, (pb*)(ws + WS_A2) + 1024, MIXW, 1024, (const float*)(ws + WS_RSTD0), nullptr};
          pg8::gemm_phase<pg8::EpiRowBf16, pg8::StaticOrder>(F.lds, g, S, E); }
        { pg8::Gemm g{(const pb*)(ws + WS_MEMB), (const pb*)(ws + WS_WMKV), 2048, 2048, DM}; pg8::StaticOrder S; S.init(2048, 2048, F.G, (int)blockIdx.x);
          pg8::EpiRowBf16 E{(pb*)(ws + WS_MEMKV), 2048, (pb*)(ws + WS_MEMKV), 2048, 1 << 30, nullptr, nullptr};
          pg8::gemm_phase<pg8::EpiRowBf16, pg8::StaticOrder>(F.lds, g, S, E); }
    } } SEAM(1);

    if (IN(2)) { if (NREP(2) > 1) { pool_diff(args, F); mem_attn(args, F, (bf16*)(ws + WS_A2), 0, true); GSYNC(); }
        pool_diff(args, F); mem_attn(args, F, (bf16*)(ws + WS_A2), 0); } SEAM(2);

    for (int rep_ = 0; rep_ < NREP(3); ++rep_) { if (rep_) GSYNC();
    if (IN(3)) {
        pg8::Gemm g{(const pb*)(ws + WS_A2), (const pb*)(ws + WS_WC0), T, DM, MIXW}; pg8::StaticOrder S; S.init(T, DM, F.G, (int)blockIdx.x);
        pg8::EpiRes E{(pb*)(ws + WS_XB), (float*)(ws + WS_SSQ)};
        pg8::gemm_phase<pg8::EpiRes, pg8::StaticOrder>(F.lds, g, S, E);
    } } SEAM(3);

    for (int rep_ = 0; rep_ < NREP(4); ++rep_) { if (rep_) GSYNC();
    if (IN(4)) {
        pg8::Gemm g{(const pb*)(ws + WS_XB), (const pb*)(ws + WS_WQ0), T, 2048, DM}; pg8::StaticOrder S; S.init(T, 2048, F.G, (int)blockIdx.x);
        pg8::EpiRowBf16 E{(pb*)(ws + WS_PQ), 2048, (pb*)(ws + WS_PQ), 2048, 1 << 30, nullptr, (const float*)(ws + WS_SSQ)};
        pg8::gemm_phase<pg8::EpiRowBf16, pg8::StaticOrder>(F.lds, g, S, E);
    } } SEAM(4);

    for (int rep_ = 0; rep_ < NREP(5); ++rep_) { if (rep_) GSYNC();
    if (IN(5)) { peer_topk(args, F, 0); } } SEAM(5);
    if (IN(6)) {
#ifdef PROBE_PEER
        peer_gather<false, true>(args, F, 0); GSYNC();
#endif
        peer_gather<false>(args, F, 0); } SEAM(6);

    for (int rep_ = 0; rep_ < NREP(7); ++rep_) { if (rep_) GSYNC();
    if (IN(7)) {
        pg8::Gemm g{(const pb*)(ws + WS_XB), (const pb*)(ws + WS_WC4), T, 3584, DM}; pg8::StaticOrder S; S.init(T, 3584, F.G, (int)blockIdx.x);
        pg8::EpiKVQ E{(pb*)(ws + WS_KR), (pb*)(ws + WS_VV), (pb*)(ws + WS_A3), (float*)(ws + WS_KMP), (const float*)(ws + WS_RSTD2), (const float*)(ws + WS_ROPE)};
        pg8::gemm_phase<pg8::EpiKVQ, pg8::StaticOrder>(F.lds, g, S, E);
    } } SEAM(7);

    if (IN(8)) {
        bf16* A3 = (bf16*)(ws + WS_A3); const bf16* KR = (const bf16*)(ws + WS_KR); const bf16* VV = (const bf16*)(ws + WS_VV); const float* KMP = (const float*)(ws + WS_KMP);
        for (int rep_ = 0; rep_ < NREP(8); ++rep_) { const bool dry8 = (NREP(8) > 1) && rep_ == 0;
        for (int P = F.vcu; P < 512; P += F.G) { const int bh = P >> 3, p = P & 7, b = bh >> 3, h = bh & 7;
#pragma unroll 1
            for (int half = 0; half < 2; ++half) { const int j = half ? p : 15 - p;
                bf16* Q = A3 + ((size_t)b * SEQ + j * 256) * MIXW + h * 128;
                const bf16* K = KR + (size_t)bh * SEQ * 128; const bf16* V = VV + (size_t)bh * SEQ * 128;
                att::attn_unit<MIXW, 128, true, ATT_SD_MOBA>(Q, K, V, dry8 ? (bf16*)(ws + WS_XB) : Q, j, KMP + (size_t)b * 16 * 2048 + h * 128, F.ldsg); } }
        if (dry8) { mem_attn(args, F, A3, 1, true); GSYNC(); } }
        mem_attn(args, F, A3, 1);
    } SEAM(8);

    if (IN(9)) {
        pg8::Gemm g{(const pb*)(ws + WS_A3), (const pb*)(ws + WS_WOUT1), T, DM, MIXW}; pg8::StaticOrder S; S.init(T, DM, F.G, (int)blockIdx.x);
        pg8::EpiRes E{(pb*)(ws + WS_XB), (float*)(ws + WS_SSQ)};
        pg8::gemm_phase<pg8::EpiRes, pg8::StaticOrder>(F.lds, g, S, E);
    } SEAM(9);

    for (int rep_ = 0; rep_ < NREP(10); ++rep_) { if (rep_) GSYNC();
    if (IN(10)) {
        pg8::Gemm g{(const pb*)(ws + WS_XB), (const pb*)(ws + WS_WQ1), T, 2048, DM}; pg8::StaticOrder S; S.init(T, 2048, F.G, (int)blockIdx.x);
        pg8::EpiRowBf16 E{(pb*)(ws + WS_PQ), 2048, (pb*)(ws + WS_PQ), 2048, 1 << 30, nullptr, (const float*)(ws + WS_SSQ)};
        pg8::gemm_phase<pg8::EpiRowBf16, pg8::StaticOrder>(F.lds, g, S, E);
    } } SEAM(10);

    for (int rep_ = 0; rep_ < NREP(11); ++rep_) { if (rep_) GSYNC();
    if (IN(11)) { peer_topk(args, F, 1); } } SEAM(11);
    if (IN(12)) {
#ifdef PROBE_PEER
        peer_gather<true, true>(args, F, 1); GSYNC();
#endif
        peer_gather<true>(args, F, 1); }
#undef IN
#undef SEAM
}

extern "C" void kernel_launch(void* const* d_in, const int* in_sizes, int n_in, void* d_out, int out_size, void* d_ws, size_t ws_size, hipStream_t stream) {
    static int grid = 0;
    if (grid == 0) {
        if (n_in != 16 || out_size != T * DM || ws_size < WS_END) { fprintf(stderr, "kernel_launch: unexpected shapes: n_in %d out %d ws %zu (need %zu)\n", n_in, out_size, ws_size, (size_t)WS_END); grid = -1; return; }
        int dev = 0, cus = 0, per_cu = 0;
        if (hipGetDevice(&dev) != hipSuccess || hipDeviceGetAttribute(&cus, hipDeviceAttributeMultiprocessorCount, dev) != hipSuccess) { grid = -1; return; }
        if (hipFuncSetAttribute((const void*)yoco_fwd, hipFuncAttributeMaxDynamicSharedMemorySize, LDS_BYTES) != hipSuccess) { fprintf(stderr, "kernel_launch: hipFuncSetAttribute failed\n"); grid = -1; return; }
        if (hipOccupancyMaxActiveBlocksPerMultiprocessor(&per_cu, (const void*)yoco_fwd, NTHR, LDS_BYTES) != hipSuccess || per_cu < 1) { fprintf(stderr, "kernel_launch: occupancy query says %d\n", per_cu); per_cu = 1; }
        (void)hipGetLastError();
        grid = cus;
        fprintf(stderr, "kernel_launch: grid %d, per_cu %d, ws %zu\n", grid, per_cu, ws_size);
    }
    if (grid < 0) return;
    if (hipMemsetAsync(d_ws, 0, 16384, stream) != hipSuccess) { fprintf(stderr, "kernel_launch: memset failed\n"); return; }
    Args a{};
    for (int i = 0; i < 16; ++i) a.in[i] = (const float*)d_in[i];
    a.out = (float*)d_out; a.ws = (unsigned char*)d_ws;
#if MK_LAUNCHES == 1
    a.ph_lo = 0; a.ph_hi = 13;
    void* kargs[] = {&a};
    hipError_t e = hipLaunchCooperativeKernel((const void*)yoco_fwd, dim3(grid), dim3(NTHR), kargs, LDS_BYTES, stream);
    if (e != hipSuccess) fprintf(stderr, "kernel_launch: cooperative launch failed: %s (grid %d)\n", hipGetErrorString(e), grid);
#else
    for (int p = 0; p < 13; ++p) { a.ph_lo = p; a.ph_hi = p + 1;
        hipLaunchKernelGGL(yoco_fwd, dim3(grid), dim3(NTHR), LDS_BYTES, stream, a);
        const hipError_t le = hipPeekAtLastError(); if (le != hipSuccess) { fprintf(stderr, "kernel_launch: launch %d failed: %s\n", p, hipGetErrorName(le)); break; } }
#endif
}
```

```cpp
#include <hip/hip_runtime.h>
#include <hip/hip_cooperative_groups.h>
#include <cstdio>
#include <cstdint>
namespace cg = cooperative_groups;

#ifndef MK_LAUNCHES
#define MK_LAUNCHES 1
#endif

#define GAS __attribute__((address_space(1)))
#define LAS __attribute__((address_space(3)))
typedef unsigned short bf16;
typedef unsigned u32x4 __attribute__((ext_vector_type(4)));
typedef unsigned u32x2 __attribute__((ext_vector_type(2)));
typedef float f32x4 __attribute__((ext_vector_type(4)));
typedef float f32x2 __attribute__((ext_vector_type(2)));
typedef float f32x16 __attribute__((ext_vector_type(16)));
typedef short bf16x8 __attribute__((ext_vector_type(8)));
typedef short s16x4 __attribute__((ext_vector_type(4)));
typedef __bf16 bf16x2_t __attribute__((ext_vector_type(2)));

constexpr int NB = 8, SEQ = 4096, DM = 1024, T = NB * SEQ, MIXW = 1536, MEMT = 256;
constexpr int NEXP = 16384, NWAVES = 8, NTHR = 512;
constexpr float EPS = 1e-6f;

constexpr size_t MiB = 1u << 20;
constexpr size_t WS_RSTD0 = 1 * MiB;
constexpr size_t WS_RSTD2 = WS_RSTD0 + 128 * 1024;
constexpr size_t WS_USC   = WS_RSTD0 + 256 * 1024;
constexpr size_t WS_VSC   = WS_RSTD0 + 384 * 1024;
constexpr size_t WS_SSQ   = 2 * MiB;
constexpr size_t WS_KMP   = 4 * MiB;
constexpr size_t WS_ROPE  = 5 * MiB;
constexpr size_t WS_WIN0  = 8 * MiB;
constexpr size_t WS_WC4   = 11 * MiB;
constexpr size_t WS_WC0   = 18 * MiB;
constexpr size_t WS_WOUT1 = 21 * MiB;
constexpr size_t WS_WMKV  = 24 * MiB;
constexpr size_t WS_WQ0   = 28 * MiB;
constexpr size_t WS_WQ1   = 32 * MiB;
constexpr size_t WS_SUBK  = 36 * MiB;
constexpr size_t WS_MEMB  = 37 * MiB;
constexpr size_t WS_MEMKV = 41 * MiB;
constexpr size_t WS_EXP   = 49 * MiB;
constexpr size_t WS_GATE  = 57 * MiB;
constexpr size_t WS_UB    = 73 * MiB;
constexpr size_t WS_VB    = 105 * MiB;
constexpr size_t WS_XB    = 201 * MiB;
constexpr size_t WS_RB    = 265 * MiB;
constexpr size_t WS_P0MAIN = WS_RB;
constexpr size_t WS_A2    = WS_RB + 64 * MiB;
constexpr size_t WS_PQ    = WS_RB;
constexpr size_t WS_KR    = WS_RB;
constexpr size_t WS_VV    = WS_RB + 64 * MiB;
constexpr size_t WS_A3    = WS_RB + 128 * MiB;
constexpr size_t WS_END   = WS_RB + 224 * MiB;

constexpr int LDS_BYTES = 147456;

__device__ __forceinline__ unsigned f2bf(float f) { unsigned u = __builtin_bit_cast(unsigned, f); return (u + 0x7fffu + ((u >> 16) & 1u)) >> 16; }
__device__ __forceinline__ unsigned pk2(float lo, float hi) { return f2bf(lo) | (f2bf(hi) << 16); }
__device__ __forceinline__ unsigned cvtpk(float lo, float hi) { unsigned r; asm volatile("v_cvt_pk_bf16_f32 %0, %1, %2" : "=v"(r) : "v"(lo), "v"(hi)); return r; }
__device__ __forceinline__ float bflo(unsigned w) { return __builtin_bit_cast(float, w << 16); }
__device__ __forceinline__ float bfhi(unsigned w) { return __builtin_bit_cast(float, w & 0xffff0000u); }
template <int J> __device__ __forceinline__ unsigned shx_u(unsigned v) {
    if constexpr (J == 32) { auto rr = __builtin_amdgcn_permlane32_swap(v, v, false, false); return ((threadIdx.x & 32) ? rr[0] : rr[1]); }
    else return (unsigned)__builtin_amdgcn_ds_swizzle((int)v, (J << 10) | 0x1f);
}
template <int J> __device__ __forceinline__ float shx_f(float v) { return __uint_as_float(shx_u<J>(__float_as_uint(v))); }
template <int CTRL> __device__ __forceinline__ float dpp_f(float v) { return __uint_as_float((unsigned)__builtin_amdgcn_update_dpp(0, (int)__float_as_uint(v), CTRL, 0xF, 0xF, false)); }
__device__ __forceinline__ float wave_sum(float v) {
    v += dpp_f<0xB1>(v); v += dpp_f<0x4E>(v); v += dpp_f<0x141>(v); v += dpp_f<0x128>(v);
    v += shx_f<16>(v);
    { auto rr = __builtin_amdgcn_permlane32_swap(__float_as_uint(v), __float_as_uint(v), false, false); v = __uint_as_float(rr[0]) + __uint_as_float(rr[1]); }
    return v;
}
__device__ __forceinline__ float dot2(unsigned w, unsigned x, float acc) { return __builtin_amdgcn_fdot2_f32_bf16(__builtin_bit_cast(bf16x2_t, w), __builtin_bit_cast(bf16x2_t, x), acc, false); }
#define LDS_WAIT() asm volatile("s_waitcnt lgkmcnt(0)" ::: "memory")
#define VM_WAIT() asm volatile("s_waitcnt vmcnt(0)" ::: "memory")

namespace pg8 {
#define PG8_LAS __attribute__((address_space(3)))
typedef unsigned short bf16_t;
constexpr int BM = 256, BK = 64, HALF = 128, HTB = HALF * BK * 2, STAGE_BYTES = 8 * HTB, NXCD = 8, WGM = 8;
__host__ __device__ __forceinline__ int lds_byte(int r, int c) { const int st = (r >> 4) * 2 + (c >> 5), rr = r & 15, cc = c & 31, ob = rr * 64 + cc * 2; return st * 1024 + (ob ^ (((ob >> 9) & 1) << 5)); }
__host__ __device__ __forceinline__ void stage_rc(int b, int& R, int& C) { const int st = b / 1024, sb = b % 1024, swz = sb ^ (((sb >> 9) & 1) << 5); R = (st >> 1) * 16 + swz / 64; C = (st & 1) * 32 + (swz % 64) / 2; }
__host__ __device__ __forceinline__ int perm32(int rho) { const int n = rho >> 4, i = rho & 15; return 8 * (i >> 2) + 4 * n + (i & 3); }
struct Unit { int pm, pn; };
struct Gemm { const bf16_t* A; const bf16_t* Bt; int M, N, K; };
struct StaticOrder {
    int nM, nN, nwg, G, c;
    __host__ __device__ void init(int M, int N, int G_, int c_) { nM = M / BM; nN = N / BM; nwg = nM * nN; G = G_; c = c_; }
    __host__ __device__ bool next(int i, Unit& u) const {
        const long L = (long)i * G + c; if (L >= nwg) return false;
        int wgid = (int)L; { const int q = nwg / NXCD, r = nwg % NXCD, xcd = wgid % NXCD, off = wgid / NXCD; wgid = (xcd < r ? xcd * (q + 1) : r * (q + 1) + (xcd - r) * q) + off; }
        const int nig = WGM * nN, gid = wgid / nig, fm = gid * WGM, gsz = (nM - fm) < WGM ? (nM - fm) : WGM;
        u.pm = fm + ((wgid % nig) % gsz); u.pn = (wgid % nig) / gsz; return true;
    }
    __device__ __forceinline__ void a_ready(const Unit&) const {}
    __device__ __forceinline__ void done(const Unit&) const {}
};

struct EpiRowBf16 {
    static constexpr bool PERM = true, AFTER_DRAIN = false;
    bf16_t* O0; int ld0; bf16_t* O1; int ld1; int split; const float* rs; const float* ssq;
    __device__ __forceinline__ void operator()(const f32x4 (&acc)[2][2][4][2], const Unit& u, int wr, int wc, int fr, int fq) const {
        const int row0 = u.pm * BM + wr * 64 + fr; int colt = u.pn * BM; bf16_t* base = O0; int ldc = ld0;
        if (colt >= split) { base = O1; ldc = ld1; colt -= split; }
        const int col0 = colt + wc * 32 + 8 * fq;
#pragma unroll
        for (int ai = 0; ai < 2; ++ai)
#pragma unroll
            for (int m = 0; m < 4; ++m) { const int row = row0 + ai * HALF + m * 16; float sc = 1.f;
                if (rs) sc = rs[row];
                else if (ssq) { const f32x4* q = (const f32x4*)(ssq + (size_t)row * 16); const f32x4 a = q[0], b = q[1], c = q[2], d = q[3];
                    const float s = ((a[0] + a[1]) + (a[2] + a[3])) + ((b[0] + b[1]) + (b[2] + b[3])) + ((c[0] + c[1]) + (c[2] + c[3])) + ((d[0] + d[1]) + (d[2] + d[3]));
                    sc = __builtin_amdgcn_rsqf(s * (1.0f / 1024.0f) + EPS); }
                bf16_t* rowp = base + (size_t)row * ldc + col0;
#pragma unroll
                for (int bj = 0; bj < 2; ++bj) { const f32x4 v0 = acc[ai][bj][m][0] * sc, v1 = acc[ai][bj][m][1] * sc;
                    u32x4 w; w.x = cvtpk(v0[0], v0[1]); w.y = cvtpk(v0[2], v0[3]); w.z = cvtpk(v1[0], v1[1]); w.w = cvtpk(v1[2], v1[3]);
                    *(u32x4*)(rowp + bj * HALF) = w; } }
    }
};
struct EpiRes {
    static constexpr bool PERM = true, AFTER_DRAIN = false;
    bf16_t* xb; float* ssq;
    __device__ __forceinline__ void operator()(const f32x4 (&acc)[2][2][4][2], const Unit& u, int wr, int wc, int fr, int fq) const {
        const int row0 = u.pm * BM + wr * 64 + fr, col0 = u.pn * BM + wc * 32 + 8 * fq;
#pragma unroll
        for (int ai = 0; ai < 2; ++ai)
#pragma unroll
            for (int m = 0; m < 4; ++m) { const int row = row0 + ai * HALF + m * 16; bf16_t* p = xb + (size_t)row * DM + col0; float ss = 0.f;
#pragma unroll
                for (int bj = 0; bj < 2; ++bj) { const u32x4 r = *(const u32x4*)(p + bj * HALF); const f32x4 a0 = acc[ai][bj][m][0], a1 = acc[ai][bj][m][1];
                    const float o0 = bflo(r.x) + a0[0], o1 = bfhi(r.x) + a0[1], o2 = bflo(r.y) + a0[2], o3 = bfhi(r.y) + a0[3], o4 = bflo(r.z) + a1[0], o5 = bfhi(r.z) + a1[1], o6 = bflo(r.w) + a1[2], o7 = bfhi(r.w) + a1[3];
                    u32x4 w; w.x = cvtpk(o0, o1); w.y = cvtpk(o2, o3); w.z = cvtpk(o4, o5); w.w = cvtpk(o6, o7); *(u32x4*)(p + bj * HALF) = w;
                    ss += ((o0 * o0 + o1 * o1) + (o2 * o2 + o3 * o3)) + ((o4 * o4 + o5 * o5) + (o6 * o6 + o7 * o7)); }
                ss += __shfl_xor(ss, 16); ss += __shfl_xor(ss, 32);
                if (fq == 0) ssq[(size_t)row * 16 + u.pn * 4 + wc] = ss; }
    }
};
struct EpiKVQ {
    static constexpr bool PERM = true, AFTER_DRAIN = false;
    bf16_t* KR; bf16_t* VV; bf16_t* A3; float* KMP; const float* rs; const float* rope;
    __device__ __forceinline__ void operator()(const f32x4 (&acc)[2][2][4][2], const Unit& u, int wr, int wc, int fr, int fq) const {
        const int pn = u.pn, pm = u.pm, b = pm >> 4, s0 = (pm & 15) * 256, rl0 = wr * 64 + fr, g0 = 32 * wc + 8 * fq;
        float rsv[2][4];
#pragma unroll
        for (int ai = 0; ai < 2; ++ai)
#pragma unroll
            for (int m = 0; m < 4; ++m) rsv[ai][m] = rs[pm * BM + rl0 + ai * HALF + m * 16];
        if (pn < 4 || (pn >= 8 && pn < 12)) {
            const bool isK = pn < 4; const int hp = isK ? pn : pn - 8; const int i0 = 16 * wc + 4 * fq;
            f32x4 klo[2] = {{0.f, 0.f, 0.f, 0.f}, {0.f, 0.f, 0.f, 0.f}}, khi[2] = {{0.f, 0.f, 0.f, 0.f}, {0.f, 0.f, 0.f, 0.f}};
#pragma unroll
            for (int ai = 0; ai < 2; ++ai)
#pragma unroll
                for (int m = 0; m < 4; ++m) { const int rl = rl0 + ai * HALF + m * 16, s = s0 + rl;
                    const f32x4 cs0 = *(const f32x4*)(rope + ((size_t)s * 64 + i0) * 2), cs1 = *(const f32x4*)(rope + ((size_t)s * 64 + i0) * 2 + 4);
                    const f32x4 c = {cs0[0], cs0[2], cs1[0], cs1[2]}, sn = {cs0[1], cs0[3], cs1[1], cs1[3]};
#pragma unroll
                    for (int bj = 0; bj < 2; ++bj) { const int head = 2 * hp + bj;
                        const f32x4 v1 = acc[ai][bj][m][0] * rsv[ai][m], v2 = acc[ai][bj][m][1] * rsv[ai][m];
                        const f32x4 lo = v1 * c - v2 * sn, hi = v2 * c + v1 * sn;
                        u32x4 w; w.x = cvtpk(lo[0], lo[1]); w.y = cvtpk(lo[2], lo[3]); w.z = cvtpk(hi[0], hi[1]); w.w = cvtpk(hi[2], hi[3]);
                        bf16_t* dst = isK ? KR + ((size_t)(b * 8 + head) * SEQ + s) * 128 + g0 : A3 + (size_t)(pm * BM + rl) * MIXW + head * 128 + g0;
                        *(u32x4*)dst = w;
                        klo[bj] += lo; khi[bj] += hi; } }
            if (isK) {
#pragma unroll
                for (int bj = 0; bj < 2; ++bj) {
#pragma unroll
                    for (int j = 0; j < 4; ++j) {
#pragma unroll
                        for (int o = 1; o < 16; o <<= 1) { klo[bj][j] += __shfl_xor(klo[bj][j], o); khi[bj][j] += __shfl_xor(khi[bj][j], o); } }
                    if (fr == 0) { float* kp = KMP + ((size_t)pm * 2 + wr) * 1024 + (2 * hp + bj) * 128 + g0; *(f32x4*)kp = klo[bj]; *(f32x4*)(kp + 4) = khi[bj]; } } }
        } else {
            const bool isV = pn < 8;
#pragma unroll
            for (int bj = 0; bj < 2; ++bj)
#pragma unroll
                for (int ai = 0; ai < 2; ++ai)
#pragma unroll
                    for (int m = 0; m < 4; ++m) { const int rl = rl0 + ai * HALF + m * 16, s = s0 + rl;
                        const f32x4 v0 = acc[ai][bj][m][0] * rsv[ai][m], v1 = acc[ai][bj][m][1] * rsv[ai][m];
                        u32x4 w; w.x = cvtpk(v0[0], v0[1]); w.y = cvtpk(v0[2], v0[3]); w.z = cvtpk(v1[0], v1[1]); w.w = cvtpk(v1[2], v1[3]);
                        bf16_t* dst = isV ? VV + ((size_t)(b * 8 + 2 * (pn - 4) + bj) * SEQ + s) * 128 + g0 : A3 + (size_t)(pm * BM + rl) * MIXW + 1024 + (pn - 12) * 256 + bj * HALF + g0;
                        *(u32x4*)dst = w; }
        }
    }
};

template <class Epi, class Sched, bool ALIGN_EPI = true, bool SP2 = true>
__device__ __forceinline__ void gemm_phase(PG8_LAS unsigned char* lds, const Gemm g, const Sched& S, const Epi& E) {
    int tid = threadIdx.x; asm volatile("" : "+v"(tid));
    const int wid = __builtin_amdgcn_readfirstlane(tid >> 6), lane = tid & 63, wr = wid >> 2, wc = wid & 3, fr = lane & 15, fq = lane >> 4;
    const int K = g.K, nt = K / BK;
    unsigned voffA[2], voffB[2];
#pragma unroll
    for (int i = 0; i < 2; ++i) { int R, C; stage_rc(tid * 16 + i * 8192, R, C); const int Rb = Epi::PERM ? ((R & ~31) + perm32(R & 31)) : R;
        voffA[i] = (unsigned)(R * K + C) * 2u; voffB[i] = (unsigned)(Rb * K + C) * 2u; }
    const size_t kstep = (size_t)(BK * 2);
    const size_t hstep = (size_t)HALF * K * 2;
    const size_t tstep = 2 * hstep;
    const unsigned ldsw = (unsigned)wid * 1024u;
    const int aoff = lds_byte(wr * 64 + fr, fq * 8), boff = lds_byte(wc * 32 + fr, fq * 8);
#define PG8_SA(b, h) (((b) * 2 + (h)) * HTB)
#define PG8_SB(b, h) ((4 + (b) * 2 + (h)) * HTB)
#define PG8_STAGE(bufoff, gbase, voff) do { _Pragma("unroll") for (int _i = 0; _i < 2; ++_i) \
        __builtin_amdgcn_global_load_lds((const unsigned*)((const char*)(gbase) + (voff)[_i]), (PG8_LAS unsigned*)(lds + (bufoff) + ldsw + _i * 8192), 16, 0, 0); } while (0)
#define PG8_LDA(dst, b, h) do { _Pragma("unroll") for (int m = 0; m < 4; ++m) _Pragma("unroll") for (int k = 0; k < 2; ++k) dst[m][k] = *(const PG8_LAS bf16x8*)(lds + PG8_SA(b, h) + aoff + m * 2048 + k * 1024); } while (0)
#define PG8_LDB(dst, b, h) do { _Pragma("unroll") for (int n = 0; n < 2; ++n) _Pragma("unroll") for (int k = 0; k < 2; ++k) dst[n][k] = *(const PG8_LAS bf16x8*)(lds + PG8_SB(b, h) + boff + n * 2048 + k * 1024); } while (0)
#define PG8_MMA(ai, bj, At, Bt) do { __builtin_amdgcn_s_setprio(1); _Pragma("unroll") for (int m = 0; m < 4; ++m) _Pragma("unroll") for (int n = 0; n < 2; ++n) _Pragma("unroll") for (int k = 0; k < 2; ++k) \
        acc[ai][bj][m][n] = __builtin_amdgcn_mfma_f32_16x16x32_bf16(Bt[n][k], At[m][k], acc[ai][bj][m][n], 0, 0, 0); __builtin_amdgcn_s_setprio(0); } while (0)
#define PG8_WAIT_V(n) asm volatile("s_waitcnt vmcnt(" #n ")" ::: "memory")
#define PG8_WAIT_L(n) asm volatile("s_waitcnt lgkmcnt(" #n ")" ::: "memory")
#define PG8_BAR __builtin_amdgcn_s_barrier()
#define PG8_SCHED __builtin_amdgcn_sched_barrier(0)
    Unit cur, nxt; int ui = 0;
    if (!S.next(0, cur)) return;
    f32x4 acc[2][2][4][2];
#pragma unroll
    for (int a = 0; a < 2; ++a)
#pragma unroll
        for (int b = 0; b < 2; ++b)
#pragma unroll
            for (int m = 0; m < 4; ++m)
#pragma unroll
                for (int n = 0; n < 2; ++n) acc[a][b][m][n] = (f32x4){0.f, 0.f, 0.f, 0.f};
    bf16x8 At[4][2], B0[2][2], B1[2][2];
    const char* cA = (const char*)g.A + (size_t)cur.pm * tstep; const char* cB = (const char*)g.Bt + (size_t)cur.pn * tstep;
    S.a_ready(cur);
    if constexpr (SP2) {
        PG8_STAGE(PG8_SB(0, 0), cB, voffB); PG8_STAGE(PG8_SB(0, 1), cB + hstep, voffB); PG8_STAGE(PG8_SA(0, 0), cA, voffA); PG8_STAGE(PG8_SA(0, 1), cA + hstep, voffA);
        if (wr == 1) PG8_BAR;
        PG8_WAIT_V(2); PG8_BAR;
        PG8_STAGE(PG8_SB(1, 0), cB + kstep, voffB); PG8_STAGE(PG8_SA(1, 0), cA + kstep, voffA); PG8_STAGE(PG8_SB(1, 1), cB + hstep + kstep, voffB);
        PG8_WAIT_V(6); PG8_BAR;
    } else {
        PG8_STAGE(PG8_SB(0, 0), cB, voffB); PG8_STAGE(PG8_SA(0, 0), cA, voffA); PG8_STAGE(PG8_SB(0, 1), cB + hstep, voffB); PG8_STAGE(PG8_SA(0, 1), cA + hstep, voffA);
        if (wr == 1) PG8_BAR;
        PG8_WAIT_V(4); PG8_BAR;
        PG8_STAGE(PG8_SB(1, 0), cB + kstep, voffB); PG8_STAGE(PG8_SA(1, 0), cA + kstep, voffA); PG8_STAGE(PG8_SB(1, 1), cB + hstep + kstep, voffB);
        PG8_WAIT_V(6); PG8_BAR;
    }
    for (;;) {
        const bool has_next = S.next(ui + 1, nxt);
        const char* nA = has_next ? (const char*)g.A + (size_t)nxt.pm * tstep : cA; const char* nB = has_next ? (const char*)g.Bt + (size_t)nxt.pn * tstep : cB;
        for (int t = 0; t < nt; t += 2) {
            const bool last = (t == nt - 2);
            const char* a1 = cA + (size_t)(t + 1) * kstep;
            const char* a2 = last ? nA : cA + (size_t)(t + 2) * kstep; const char* b2 = last ? nB : cB + (size_t)(t + 2) * kstep;
            const char* a3 = a2 + kstep; const char* b3 = b2 + kstep;
            if (last && has_next) S.a_ready(nxt);
            if constexpr (SP2) {
            PG8_LDB(B0, 0, 0); PG8_LDB(B1, 0, 1); PG8_SCHED; PG8_LDA(At, 0, 0); PG8_STAGE(PG8_SA(1, 1), a1 + hstep, voffA);
            PG8_WAIT_V(8); PG8_WAIT_L(0); PG8_BAR; PG8_MMA(0, 0, At, B0); PG8_MMA(0, 1, At, B1); PG8_BAR; PG8_SCHED;
            PG8_LDA(At, 0, 1); PG8_STAGE(PG8_SB(0, 0), b2, voffB); PG8_STAGE(PG8_SB(0, 1), b2 + hstep, voffB); PG8_STAGE(PG8_SA(0, 0), a2, voffA);
            PG8_WAIT_V(8); PG8_WAIT_L(0); PG8_BAR; PG8_MMA(1, 0, At, B0); PG8_MMA(1, 1, At, B1); PG8_BAR; PG8_SCHED;
            PG8_LDB(B0, 1, 0); PG8_LDB(B1, 1, 1); PG8_SCHED; PG8_LDA(At, 1, 0); PG8_STAGE(PG8_SA(0, 1), a2 + hstep, voffA);
            PG8_WAIT_V(8); PG8_WAIT_L(0); PG8_BAR; PG8_MMA(0, 0, At, B0); PG8_MMA(0, 1, At, B1); PG8_BAR; PG8_SCHED;
            PG8_LDA(At, 1, 1); PG8_STAGE(PG8_SB(1, 0), b3, voffB); PG8_STAGE(PG8_SB(1, 1), b3 + hstep, voffB); PG8_STAGE(PG8_SA(1, 0), a3, voffA);
            PG8_WAIT_V(8); PG8_WAIT_L(0); PG8_BAR; PG8_MMA(1, 0, At, B0); PG8_MMA(1, 1, At, B1); PG8_BAR; PG8_SCHED;
            } else {
            PG8_LDB(B0, 0, 0); PG8_SCHED; PG8_LDA(At, 0, 0); PG8_STAGE(PG8_SA(1, 1), a1 + hstep, voffA);
            PG8_WAIT_L(8); PG8_BAR; PG8_WAIT_L(0); PG8_MMA(0, 0, At, B0); PG8_BAR; PG8_SCHED;
            PG8_LDB(B1, 0, 1); PG8_STAGE(PG8_SB(0, 0), b2, voffB);
            PG8_BAR; PG8_WAIT_L(0); PG8_MMA(0, 1, At, B1); PG8_BAR;
            PG8_LDA(At, 0, 1); PG8_STAGE(PG8_SA(0, 0), a2, voffA);
            PG8_BAR; PG8_WAIT_L(0); PG8_MMA(1, 0, At, B0); PG8_BAR; PG8_SCHED;
            PG8_STAGE(PG8_SB(0, 1), b2 + hstep, voffB);
            PG8_WAIT_V(6); PG8_BAR; PG8_MMA(1, 1, At, B1); PG8_BAR;
            PG8_LDB(B0, 1, 0); PG8_SCHED; PG8_LDA(At, 1, 0); PG8_STAGE(PG8_SA(0, 1), a2 + hstep, voffA);
            PG8_WAIT_L(8); PG8_BAR; PG8_WAIT_L(0); PG8_MMA(0, 0, At, B0); PG8_BAR; PG8_SCHED;
            PG8_LDB(B1, 1, 1); PG8_STAGE(PG8_SB(1, 0), b3, voffB);
            PG8_BAR; PG8_WAIT_L(0); PG8_MMA(0, 1, At, B1); PG8_BAR;
            PG8_LDA(At, 1, 1); PG8_STAGE(PG8_SA(1, 0), a3, voffA);
            PG8_BAR; PG8_WAIT_L(0); PG8_MMA(1, 0, At, B0); PG8_BAR; PG8_SCHED;
            PG8_STAGE(PG8_SB(1, 1), b3 + hstep, voffB);
            PG8_WAIT_V(6); PG8_BAR; PG8_MMA(1, 1, At, B1); PG8_BAR;
            }
        }
        if constexpr (ALIGN_EPI) { if (wr == 0) PG8_BAR; }
        if constexpr (!Epi::AFTER_DRAIN) { E(acc, cur, wr, wc, fr, fq); S.done(cur); }
        if (!has_next) break;
#pragma unroll
        for (int a = 0; a < 2; ++a)
#pragma unroll
            for (int b = 0; b < 2; ++b)
#pragma unroll
                for (int m = 0; m < 4; ++m)
#pragma unroll
                    for (int n = 0; n < 2; ++n) acc[a][b][m][n] = (f32x4){0.f, 0.f, 0.f, 0.f};
        cur = nxt; cA = nA; cB = nB; ++ui;
        if constexpr (ALIGN_EPI) { if (wr == 1) PG8_BAR; }
    }
    PG8_WAIT_V(0);
    if constexpr (!ALIGN_EPI) { if (wr == 0) PG8_BAR; }
    PG8_BAR;
#undef PG8_SA
#undef PG8_SB
#undef PG8_STAGE
#undef PG8_LDA
#undef PG8_LDB
#undef PG8_MMA
#undef PG8_WAIT_V
#undef PG8_WAIT_L
#undef PG8_BAR
#undef PG8_SCHED
}
}

namespace att {
constexpr int D = 128, NW = 8, QBLK = 32, KVBLK = 64;
constexpr float SCALE = 0.088388347648318440f;
constexpr float THR = 8.f;
constexpr size_t SHM_V = KVBLK * D * 2, SHM_K = KVBLK * D * 2, SHM_ATTN = 2 * SHM_V + 2 * SHM_K + NW * 64 * 4;
#define KSWZ(row, colB) ((row) * 256 + ((colB) ^ (((row) & 7) << 4)))
#define SBAR() __builtin_amdgcn_sched_barrier(0)
__device__ __forceinline__ int crow(int r, int hi) { return (r & 3) + 8 * (r >> 2) + 4 * hi; }

template <bool MOBA>
__device__ __forceinline__ void partialSM(f32x16& p0, f32x16& p1, float& m_reg, float& mn, float& alpha, int t, int qrow, int hi, unsigned selmask) {
  constexpr float C = SCALE * 1.4426950408889634f;
  if constexpr (MOBA) {
    if (t < 4) { const int kb = t * 64 + 4 * hi;
#pragma unroll
      for (int r = 0; r < 16; ++r) { const int kk = kb + (r & 3) + 8 * (r >> 2); p0[r] = (kk > qrow) ? -1e30f : p0[r]; p1[r] = (kk + 32 > qrow) ? -1e30f : p1[r]; }
    } else { const bool keep = (selmask >> ((t - 4) >> 2)) & 1u;
#pragma unroll
      for (int r = 0; r < 16; ++r) { p0[r] = keep ? p0[r] : -1e30f; p1[r] = keep ? p1[r] : -1e30f; } }
  }
  float pmax = p0[0];
#pragma unroll
  for (int r = 1; r < 16; ++r) pmax = fmaxf(pmax, p0[r]);
#pragma unroll
  for (int r = 0; r < 16; ++r) pmax = fmaxf(pmax, p1[r]);
  { auto rr = __builtin_amdgcn_permlane32_swap(__float_as_uint(pmax), __float_as_uint(pmax), false, false);
    pmax = fmaxf(__uint_as_float(rr[0]), __uint_as_float(rr[1])); }
  if (__builtin_expect(__all(pmax - m_reg <= THR / SCALE), 1)) { mn = m_reg; alpha = 1.f; }
  else { mn = fmaxf(m_reg, pmax); alpha = __builtin_amdgcn_exp2f((m_reg - mn) * C); m_reg = mn; }
  float mnC = -mn * C;
#pragma unroll
  for (int r = 0; r < 16; ++r) p0[r] = fmaf(p0[r], C, mnC);
#pragma unroll
  for (int r = 0; r < 16; ++r) p1[r] = fmaf(p1[r], C, mnC);
#pragma unroll
  for (int r = 0; r < 16; ++r) p0[r] = __builtin_amdgcn_exp2f(p0[r]);
}
__device__ __forceinline__ void finishSM(f32x16& p0, f32x16& p1, float alpha, float& l_reg, bf16x8& pa0, bf16x8& pa1, bf16x8& pa2, bf16x8& pa3) {
#pragma unroll
  for (int r = 0; r < 16; ++r) p1[r] = __builtin_amdgcn_exp2f(p1[r]);
  float ps = 0;
#pragma unroll
  for (int r = 0; r < 16; ++r) ps += p0[r];
#pragma unroll
  for (int r = 0; r < 16; ++r) ps += p1[r];
  { auto rr = __builtin_amdgcn_permlane32_swap(__float_as_uint(ps), __float_as_uint(ps), false, false);
    ps = __uint_as_float(rr[0]) + __uint_as_float(rr[1]); }
  l_reg = l_reg * alpha + ps;
#define PK4(P, BASE, OUT) do { unsigned a0 = cvtpk(P[BASE + 0], P[BASE + 1]), a1 = cvtpk(P[BASE + 2], P[BASE + 3]);   \
    unsigned b0 = cvtpk(P[BASE + 4], P[BASE + 5]), b1 = cvtpk(P[BASE + 6], P[BASE + 7]);                              \
    auto r0 = __builtin_amdgcn_permlane32_swap(a0, b0, false, false); auto r1 = __builtin_amdgcn_permlane32_swap(a1, b1, false, false); \
    u32x4 w = {r0[0], r1[0], r0[1], r1[1]}; OUT = *reinterpret_cast<bf16x8*>(&w); } while (0)
  PK4(p0, 0, pa0); PK4(p0, 8, pa1); PK4(p1, 0, pa2); PK4(p1, 8, pa3);
#undef PK4
}
__device__ __forceinline__ void qkt(f32x16& p0, f32x16& p1, const char* Ks, const bf16x8* qr, const int (&ka)[4]) {
  p0 = f32x16{}; p1 = f32x16{};
#pragma unroll
  for (int d0 = 0; d0 < 8; ++d0) {
    bf16x8 b0 = *reinterpret_cast<const bf16x8*>(Ks + ka[d0 & 3] + (d0 >> 2) * 128);
    bf16x8 b1 = *reinterpret_cast<const bf16x8*>(Ks + ka[d0 & 3] + (d0 >> 2) * 128 + 8192);
    p0 = __builtin_amdgcn_mfma_f32_32x32x16_bf16(b0, qr[d0], p0, 0, 0, 0);
    p1 = __builtin_amdgcn_mfma_f32_32x32x16_bf16(b1, qr[d0], p1, 0, 0, 0); }
}
__device__ __forceinline__ void qkt1(f32x16& p0, const char* Ks, const bf16x8* qr, const int (&ka)[4]) {
  p0 = f32x16{};
#pragma unroll
  for (int d0 = 0; d0 < 8; ++d0) {
    bf16x8 b0 = *reinterpret_cast<const bf16x8*>(Ks + ka[d0 & 3] + (d0 >> 2) * 128);
    p0 = __builtin_amdgcn_mfma_f32_32x32x16_bf16(b0, qr[d0], p0, 0, 0, 0); }
}
__device__ __forceinline__ int v_st(int k, int c) { const int kk = (k & ~0xC) | ((k & 4) << 1) | ((k & 8) >> 1); return ((kk >> 3) * 4 + (c >> 5)) * 512 + ((kk & 7) * 32 + (c & 31)) * 2; }
__device__ __forceinline__ int v_rd_base(int lane) { return ((lane & 3) << 3) | (((lane >> 2) & 3) << 6) | (((lane >> 4) & 1) << 5) | (((lane >> 5) & 1) << 8); }
constexpr int v_rd_off(int d0, int ks, int half) { return d0 * 512 + ks * 4096 + half * 2048; }
template <int OFF> __device__ __forceinline__ s16x4 tr_read(int vb) {
  s16x4 r; asm volatile("ds_read_b64_tr_b16 %0, %1 offset:%2" : "=&v"(r) : "v"(vb), "i"(OFF) : "memory"); return r;
}
template <int D0> __device__ __forceinline__ void pv_one(f32x16& od, int vb, bf16x8 pa0, bf16x8 pa1, bf16x8 pa2, bf16x8 pa3) {
  const s16x4 l0 = tr_read<v_rd_off(D0, 0, 0)>(vb), h0 = tr_read<v_rd_off(D0, 0, 1)>(vb), l1 = tr_read<v_rd_off(D0, 1, 0)>(vb), h1 = tr_read<v_rd_off(D0, 1, 1)>(vb);
  const s16x4 l2 = tr_read<v_rd_off(D0, 2, 0)>(vb), h2 = tr_read<v_rd_off(D0, 2, 1)>(vb), l3 = tr_read<v_rd_off(D0, 3, 0)>(vb), h3 = tr_read<v_rd_off(D0, 3, 1)>(vb);
  asm volatile("s_waitcnt lgkmcnt(0)" ::: "memory"); SBAR();
#define PK(L, H) (bf16x8){L[0], L[1], L[2], L[3], H[0], H[1], H[2], H[3]}
  od = __builtin_amdgcn_mfma_f32_32x32x16_bf16(pa0, PK(l0, h0), od, 0, 0, 0);
  od = __builtin_amdgcn_mfma_f32_32x32x16_bf16(pa1, PK(l1, h1), od, 0, 0, 0);
  od = __builtin_amdgcn_mfma_f32_32x32x16_bf16(pa2, PK(l2, h2), od, 0, 0, 0);
  od = __builtin_amdgcn_mfma_f32_32x32x16_bf16(pa3, PK(l3, h3), od, 0, 0, 0);
#undef PK
}
__device__ __forceinline__ void pv_d0(f32x16* o, int vb, bf16x8 pa0, bf16x8 pa1, bf16x8 pa2, bf16x8 pa3) {
  pv_one<0>(o[0], vb, pa0, pa1, pa2, pa3); pv_one<1>(o[1], vb, pa0, pa1, pa2, pa3); pv_one<2>(o[2], vb, pa0, pa1, pa2, pa3); pv_one<3>(o[3], vb, pa0, pa1, pa2, pa3);
}

template <int LDQ, int LDK, bool MOBA, int SDEPTH>
__device__ __forceinline__ void attn_unit(const bf16* Qb, const bf16* Kh, const bf16* Vh, bf16* Ob, int jblk, const float* kmp, char* lds) {
  int tid = threadIdx.x; asm volatile("" : "+v"(tid));
  const int wid = __builtin_amdgcn_readfirstlane(tid >> 6), lane = tid & 63, r32 = lane & 31, hi = lane >> 5;
  char* V_lds = lds; char* K_lds = lds + 2 * SHM_V;
  float* ws = (float*)(lds + 2 * SHM_V + 2 * SHM_K) + wid * 64; float* li_l = ws; float* al_l = ws + 32;
  float m_reg = -1e30f, l_reg = 0; f32x16 o[4] = {}; bf16x8 qr[8];
  const bf16* Qw = Qb + (long)(wid * QBLK + r32) * LDQ + hi * 8;
#pragma unroll
  for (int d0 = 0; d0 < 8; ++d0) qr[d0] = *reinterpret_cast<const bf16x8*>(Qw + d0 * 16);
  const int sr = tid >> 4, sc = (tid & 15) * 8, vst0 = v_st(sr, sc), vst1 = v_st(32 + sr, sc);
  const unsigned goff = (unsigned)(sr * LDK + sc) * 2u;
  const int vb0 = (int)(uintptr_t)V_lds + v_rd_base(lane);
  const int qrow = wid * QBLK + r32;
  int ka[4];
#pragma unroll
  for (int i = 0; i < 4; ++i) ka[i] = r32 * 256 + (((2 * i + hi) ^ (r32 & 7)) << 4);
  unsigned selmask = 0;
  struct { bf16x8 vs0, vs1, ks0, ks1; } sr_[SDEPTH];
  const int NT = MOBA ? 4 * (jblk + 1) : 4;
#define KOFF(t) (MOBA ? ((t) < 4 ? jblk * 256 + (t) * 64 : ((t) - 4) * 64) : (t) * 64)
#define SLOAD(i, k0) do { const char* kb_ = (const char*)Kh + (size_t)(k0) * (LDK * 2); const char* vb_ = (const char*)Vh + (size_t)(k0) * (LDK * 2); \
    sr_[i].vs0 = *reinterpret_cast<const bf16x8*>(vb_ + goff); sr_[i].vs1 = *reinterpret_cast<const bf16x8*>(vb_ + 32 * LDK * 2 + goff); \
    sr_[i].ks0 = *reinterpret_cast<const bf16x8*>(kb_ + goff); sr_[i].ks1 = *reinterpret_cast<const bf16x8*>(kb_ + 32 * LDK * 2 + goff); } while (0)
#define SWRITE(b, i) do { *(bf16x8*)(V_lds + (b) * SHM_V + vst0) = sr_[i].vs0;          \
    *(bf16x8*)(V_lds + (b) * SHM_V + vst1) = sr_[i].vs1; int kc = sc * 2;               \
    *(bf16x8*)(K_lds + (b) * SHM_K + KSWZ(sr, kc)) = sr_[i].ks0;                       \
    *(bf16x8*)(K_lds + (b) * SHM_K + KSWZ(32 + sr, kc)) = sr_[i].ks1; } while (0)
#define SWAIT() do { if constexpr (SDEPTH == 2) asm volatile("s_waitcnt vmcnt(4)" ::: "memory"); else asm volatile("s_waitcnt vmcnt(0)" ::: "memory"); } while (0)
#define RESC(a) do { if (__any((a) < 1.f)) { if (hi == 0) al_l[r32] = (a); asm volatile("s_waitcnt lgkmcnt(0)" ::: "memory"); \
    _Pragma("unroll") for (int d = 0; d < 4; ++d) _Pragma("unroll") for (int r = 0; r < 16; ++r) o[d][r] *= al_l[crow(r, hi)]; } } while (0)
  f32x16 pA0, pA1, pB0, pB1; float mnA, mnB, alA, alB; bf16x8 pa0, pa1, pa2, pa3;
  constexpr int SE = 0, SO = SDEPTH - 1;
  SLOAD(SE, KOFF(0));
  if constexpr (MOBA) {
    const int gr = tid >> 4, gc = (tid & 15) * 8; f32x4 a = {0.f, 0.f, 0.f, 0.f}, b = {0.f, 0.f, 0.f, 0.f};
    if (gr < jblk) { const float* p0_ = kmp + (size_t)gr * 2048 + gc; const f32x4 a0 = *(const f32x4*)p0_, a1 = *(const f32x4*)(p0_ + 4), b0 = *(const f32x4*)(p0_ + 1024), b1 = *(const f32x4*)(p0_ + 1028);
      a = (a0 + b0) * (1.0f / 256.0f); b = (a1 + b1) * (1.0f / 256.0f); }
    u32x4 w = {pk2(a[0], a[1]), pk2(a[2], a[3]), pk2(b[0], b[1]), pk2(b[2], b[3])};
    *(u32x4*)(K_lds + SHM_K + KSWZ(gr, gc * 2)) = w;
  }
  asm volatile("s_waitcnt vmcnt(0)" ::: "memory"); SWRITE(0, SE); __syncthreads();
  qkt(pA0, pA1, K_lds, qr, ka);
  if constexpr (MOBA) {
    f32x16 g; qkt1(g, K_lds + SHM_K, qr, ka);
    float gv[16];
#pragma unroll
    for (int r = 0; r < 8; ++r) { auto rr = __builtin_amdgcn_permlane32_swap(__float_as_uint(g[r]), __float_as_uint(g[r]), false, false);
      const float lo_ = __uint_as_float(rr[0]), hi_ = __uint_as_float(rr[1]);
      const int n0 = (r & 3) + 8 * (r >> 2); gv[n0] = lo_; gv[n0 + 4] = hi_; }
#pragma unroll
    for (int n = 0; n < 16; ++n) gv[n] = (n < jblk) ? gv[n] : -3e38f;
#pragma unroll
    for (int k = 0; k < 3; ++k) { float best = gv[0];
#pragma unroll
      for (int n = 1; n < 16; ++n) best = fmaxf(best, gv[n]);
      int idx = 16;
#pragma unroll
      for (int n = 15; n >= 0; --n) idx = (gv[n] == best) ? n : idx;
      if (best > -1e38f) selmask |= 1u << idx;
#pragma unroll
      for (int n = 0; n < 16; ++n) gv[n] = (n == idx) ? -3e38f : gv[n]; }
  }
  partialSM<MOBA>(pA0, pA1, m_reg, mnA, alA, 0, qrow, hi, selmask);
  SLOAD(SO, KOFF(1)); if constexpr (SDEPTH == 2) { if (2 < NT) SLOAD(SE, KOFF(2)); }
  if constexpr (MOBA) __syncthreads();
  SWAIT(); SWRITE(1, SO); __syncthreads();
  for (int j = 1; j + 1 < NT; j += 2) {
    SBAR(); qkt(pB0, pB1, K_lds + SHM_K, qr, ka);
    finishSM(pA0, pA1, alA, l_reg, pa0, pa1, pa2, pa3); SBAR();
    SLOAD(SO, KOFF(j + SDEPTH)); SBAR();
    pv_d0(o, vb0, pa0, pa1, pa2, pa3); partialSM<MOBA>(pB0, pB1, m_reg, mnB, alB, j, qrow, hi, selmask);
    __syncthreads(); SWAIT(); SWRITE(0, SE);
    RESC(alB); __syncthreads();
    SBAR(); qkt(pA0, pA1, K_lds, qr, ka);
    finishSM(pB0, pB1, alB, l_reg, pa0, pa1, pa2, pa3); SBAR();
    if (SDEPTH == 1 || j + 3 < NT) SLOAD(SE, KOFF(j + 1 + SDEPTH)); SBAR();
    pv_d0(o, vb0 + (int)SHM_V, pa0, pa1, pa2, pa3); partialSM<MOBA>(pA0, pA1, m_reg, mnA, alA, j + 1, qrow, hi, selmask);
    __syncthreads(); SWAIT(); SWRITE(1, SO);
    RESC(alA); __syncthreads();
  }
  SBAR(); qkt(pB0, pB1, K_lds + SHM_K, qr, ka);
  finishSM(pA0, pA1, alA, l_reg, pa0, pa1, pa2, pa3); SBAR();
  pv_d0(o, vb0, pa0, pa1, pa2, pa3); partialSM<MOBA>(pB0, pB1, m_reg, mnB, alB, NT - 1, qrow, hi, selmask);
  __syncthreads(); RESC(alB);
  finishSM(pB0, pB1, alB, l_reg, pa0, pa1, pa2, pa3); SBAR();
  pv_d0(o, vb0 + (int)SHM_V, pa0, pa1, pa2, pa3);
  if (hi == 0) li_l[r32] = l_reg; asm volatile("s_waitcnt lgkmcnt(0)" ::: "memory");
  float rli[16];
#pragma unroll
  for (int r = 0; r < 16; ++r) rli[r] = __builtin_amdgcn_rcpf(li_l[crow(r, hi)]);
  __syncthreads();
  char* ost = lds + wid * 8192;
#pragma unroll
  for (int r = 0; r < 16; ++r) { const int orow = crow(r, hi);
#pragma unroll
    for (int d0 = 0; d0 < 4; ++d0) *(unsigned short*)(ost + orow * 256 + (d0 * 32 + r32) * 2) = (unsigned short)f2bf(o[d0][r] * rli[r]); }
  asm volatile("s_waitcnt lgkmcnt(0)" ::: "memory");
  bf16* Ow = Ob + (long)(wid * QBLK) * LDQ;
#pragma unroll
  for (int i = 0; i < 8; ++i) { const int row = i * 4 + (lane >> 4), ch = lane & 15; const u32x4 v = *(const u32x4*)(ost + row * 256 + ch * 16);
    *(u32x4*)(Ow + (long)row * LDQ + ch * 8) = v; }
  __syncthreads();
#undef KOFF
#undef SLOAD
#undef SWRITE
#undef SWAIT
#undef RESC
}
}

#ifndef ATT_SD_MEM
#define ATT_SD_MEM 1
#endif
#ifndef ATT_SD_MOBA
#define ATT_SD_MOBA 1
#endif
struct Args {
    const float* in[16]; float* out; unsigned char* ws; int ph_lo, ph_hi;
};
struct Frame {
    LAS unsigned char* lds; char* ldsg;
    int wave, vcu, G;
};
__device__ __forceinline__ int fresh_tid() { int t = threadIdx.x; asm volatile("" : "+v"(t)); return t; }

template <int MAP>
__device__ __forceinline__ void transpose_item(const float* W, int ldw, bf16* dst, int ldd, int row_off, int koff, const float* sc, LAS float* scr, int kb, int nb, int lane) {
    const int k0 = 64 * kb, n0 = 32 * nb;
#pragma unroll 8
    for (int i = 0; i < 32; ++i) { const int kk = 2 * i + (lane >> 5); float v = W[(size_t)(k0 + kk) * ldw + n0 + (lane & 31)]; if (sc) v *= sc[k0 + kk]; scr[kk * 33 + (lane & 31)] = v; }
    LDS_WAIT(); asm volatile("" ::: "memory");
    const int c = lane & 7;
#pragma unroll
    for (int j = 0; j < 4; ++j) { const int n = (lane >> 3) + 8 * j; const LAS float* s = scr + (8 * c) * 33 + n;
        u32x4 o; o.x = pk2(s[0 * 33], s[1 * 33]); o.y = pk2(s[2 * 33], s[3 * 33]); o.z = pk2(s[4 * 33], s[5 * 33]); o.w = pk2(s[6 * 33], s[7 * 33]);
        const int ns = n0 + n; int row;
        if (MAP == 1 && ns < 1024) { const int d = ns & 127; row = row_off + (ns & ~127) + 32 * ((d >> 4) & 3) + 8 * ((d >> 2) & 3) + 4 * (d >> 6) + (d & 3); } else row = row_off + ns;
        *(u32x4*)(dst + (size_t)row * ldd + koff + k0 + 8 * c) = o; }
    LDS_WAIT(); asm volatile("" ::: "memory");
}

__device__ __forceinline__ void phase0(const Args& a, Frame& F) {
    unsigned char* ws = a.ws;
    const int lane = fresh_tid() & 63;
    const int gw = F.vcu * NWAVES + F.wave, NGW = F.G * NWAVES;
    const int gt = gw * 64 + lane, NGT = NGW * 64;
    LAS float* scr = (LAS float*)(F.lds + F.wave * 16384);
    const float* x = a.in[0]; const float* mem = a.in[1]; const float* g_mix = a.in[2]; const float* w_in = a.in[3]; const float* w_out = a.in[4]; const float* w_mkv = a.in[5];
    const float* pool_w = a.in[6]; const float* pool_sc = a.in[7]; const float* g_kv = a.in[8]; const float* w_kv = a.in[9]; const float* g_ffn = a.in[10]; const float* wq = a.in[11];
    const float* subk = a.in[12]; const float* pu = a.in[13]; const float* pv = a.in[14];
    constexpr int I1 = 16 * 48, I2 = 16 * 48, I3 = 16 * 64, I4 = 8 * 32, I5 = 24 * 32, I6 = 2 * 16 * 32, I7 = 2 * 16 * 64;
    constexpr int NIT = I1 + I2 + I3 + I4 + I5 + I6 + I7;
    for (int it = gw; it < NIT; it += NGW) {
        int r = it;
        if (r < I1) { transpose_item<0>(w_in, MIXW, (bf16*)(ws + WS_WIN0), DM, 0, 0, g_mix, scr, r / 48, r % 48, lane); continue; } r -= I1;
        if (r < I2) { transpose_item<1>(w_in + (size_t)DM * MIXW, MIXW, (bf16*)(ws + WS_WC4), DM, 2048, 0, g_mix + DM, scr, r / 48, r % 48, lane); continue; } r -= I2;
        if (r < I3) { transpose_item<1>(w_kv, 2048, (bf16*)(ws + WS_WC4), DM, 0, 0, g_kv, scr, r / 64, r % 64, lane); continue; } r -= I3;
        if (r < I4) { transpose_item<0>(w_out + (size_t)1024 * DM, DM, (bf16*)(ws + WS_WC0), MIXW, 0, 1024, nullptr, scr, r / 32, r % 32, lane); continue; } r -= I4;
        if (r < I5) { transpose_item<0>(w_out + (size_t)MIXW * DM, DM, (bf16*)(ws + WS_WOUT1), MIXW, 0, 0, nullptr, scr, r / 32, r % 32, lane); continue; } r -= I5;
        if (r < I6) { const int l = r / 512, q = r % 512; transpose_item<0>(w_mkv + (size_t)l * DM * 1024, 1024, (bf16*)(ws + WS_WMKV), DM, l * 1024, 0, nullptr, scr, q / 32, q % 32, lane); continue; } r -= I6;
        { const int l = r / 1024, q = r % 1024; transpose_item<0>(wq + (size_t)l * DM * 2048, 2048, (bf16*)(ws + (l ? WS_WQ1 : WS_WQ0)), DM, 0, 0, g_ffn + l * DM, scr, q / 64, q % 64, lane); }
    }
    for (int it = gw; it < 2048; it += NGW) {
        const int itu = __builtin_amdgcn_readfirstlane(it); const int g = itu >> 9, cg8 = (itu >> 4) & 31, nch = itu & 15; const int n = nch * 64 + lane;
        float acc[8];
#pragma unroll
        for (int i = 0; i < 8; ++i) acc[i] = 0.f;
        const float* pw = pool_w + ((size_t)g * 256 + cg8 * 8) * 256;
#pragma unroll 1
        for (int k = 0; k < 4; ++k) { float cf[8]; const float sc = pool_sc[g * 256 + k * 64 + lane];
#pragma unroll
            for (int i = 0; i < 8; ++i) cf[i] = pw[i * 256 + k * 64 + lane] * sc;
            float wv[64];
#pragma unroll
            for (int l = 0; l < 64; ++l) wv[l] = w_out[(size_t)(g * 256 + k * 64 + l) * DM + n];
#pragma unroll
            for (int l = 0; l < 64; ++l) {
#pragma unroll
                for (int i = 0; i < 8; ++i) acc[i] = fmaf(__builtin_bit_cast(float, __builtin_amdgcn_readlane(__builtin_bit_cast(int, cf[i]), l)), wv[l], acc[i]); } }
        u32x4 o; o.x = pk2(acc[0], acc[1]); o.y = pk2(acc[2], acc[3]); o.z = pk2(acc[4], acc[5]); o.w = pk2(acc[6], acc[7]);
        *(u32x4*)((bf16*)(ws + WS_WC0) + (size_t)n * MIXW + g * 256 + cg8 * 8) = o;
    }
    {
        const size_t n8a = (size_t)2 * 16 * 128 * 128 / 8, n8b = (size_t)2048 * 1024 / 8;
        for (size_t i = gt; i < n8a + n8b; i += NGT) { const bool A = i < n8a; const size_t j = A ? i : i - n8a; const float* src = (A ? subk : mem) + j * 8; bf16* dst = (bf16*)(ws + (A ? WS_SUBK : WS_MEMB)) + j * 8;
            const f32x4 v0 = *(const f32x4*)src, v1 = *(const f32x4*)(src + 4); u32x4 o = {pk2(v0[0], v0[1]), pk2(v0[2], v0[3]), pk2(v1[0], v1[1]), pk2(v1[2], v1[3])}; *(u32x4*)dst = o; }
    }
    for (int r = gw; r < 4 * NEXP; r += NGW) { const int tb = r / (2 * NEXP), rr = r % (2 * NEXP), l = rr / NEXP;
        const f32x4* src = (const f32x4*)((tb ? pv : pu) + (size_t)rr * DM) + lane; f32x4 v[4];
#pragma unroll
        for (int i = 0; i < 4; ++i) v[i] = src[64 * i];
        if (!tb) { const f32x4* gp = (const f32x4*)(g_ffn + l * DM) + lane;
#pragma unroll
            for (int i = 0; i < 4; ++i) v[i] *= gp[64 * i]; }
        float am = 0.f;
#pragma unroll
        for (int i = 0; i < 4; ++i) am = fmaxf(fmaxf(fmaxf(am, fabsf(v[i][0])), fmaxf(fabsf(v[i][1]), fabsf(v[i][2]))), fabsf(v[i][3]));
#pragma unroll
        for (int o = 1; o < 64; o <<= 1) am = fmaxf(am, __shfl_xor(am, o));
        const int eb = (int)((__builtin_bit_cast(unsigned, am) >> 23) & 0xffu);
        const float sc = (eb < 16) ? 1.0f : __builtin_bit_cast(float, (unsigned)(127 + 7 + 127 - eb) << 23);
        const float isc = (eb < 16) ? 1.0f : __builtin_bit_cast(float, (unsigned)(eb - 7) << 23);
        unsigned* dst = (unsigned*)(ws + (tb ? WS_VB : WS_UB) + (size_t)rr * DM) + lane;
#pragma unroll
        for (int i = 0; i < 4; ++i) { int w = __builtin_amdgcn_cvt_pk_fp8_f32(v[i][0] * sc, v[i][1] * sc, 0, false); w = __builtin_amdgcn_cvt_pk_fp8_f32(v[i][2] * sc, v[i][3] * sc, w, true); dst[64 * i] = (unsigned)w; }
        if (lane == 0) ((float*)(ws + (tb ? WS_VSC : WS_USC)))[rr] = isc; }
    for (int i = gt; i < SEQ * 64; i += NGT) { const int pos = i >> 6, fi = i & 63; const float inv = exp2f(-(float)fi * 0.20762050593046015f);
        float sn, cs_; sincosf((float)pos * inv, &sn, &cs_); f32x2 cs = {cs_, sn}; *(f32x2*)((float*)(ws + WS_ROPE) + (size_t)i * 2) = cs; }
    for (int t = gw; t < T; t += NGW) { const f32x4* xr = (const f32x4*)(x + (size_t)t * DM) + lane; f32x4 v[4]; float s = 0.f;
#pragma unroll
        for (int j = 0; j < 4; ++j) { v[j] = xr[64 * j]; s += (v[j][0] * v[j][0] + v[j][1] * v[j][1]) + (v[j][2] * v[j][2] + v[j][3] * v[j][3]); }
        s = wave_sum(s);
        u32x2* o8 = (u32x2*)((bf16*)(ws + WS_XB) + (size_t)t * DM) + lane;
#pragma unroll
        for (int j = 0; j < 4; ++j) { u32x2 w = {pk2(v[j][0], v[j][1]), pk2(v[j][2], v[j][3])}; o8[64 * j] = w; }
        if (lane == 0) ((float*)(ws + WS_RSTD0))[t] = 1.0f / sqrtf(s * (1.0f / DM) + EPS); }
}

__device__ __forceinline__ void pool_diff(const Args& a, Frame& F) {
    const bf16* pm = (const bf16*)(a.ws + WS_P0MAIN); bf16* A2 = (bf16*)(a.ws + WS_A2);
    const int gt = (F.vcu * NWAVES + F.wave) * 64 + (fresh_tid() & 63), NGT = F.G * NTHR;
    for (int it = gt; it < (T / 16) * 128; it += NGT) {
        const int cc = it & 127, tg = it >> 7, t0 = tg * 16, s0 = t0 & (SEQ - 1), w = 2 << (cc >> 5), c0 = cc * 8;
        float sum[8];
#pragma unroll
        for (int i = 0; i < 8; ++i) sum[i] = 0.f;
        const int hist = (w - 1) < s0 ? (w - 1) : s0;
        for (int i = 1; i <= hist; ++i) { const u32x4 v = *(const u32x4*)(pm + (size_t)(t0 - i) * DM + c0);
            sum[0] += bflo(v.x); sum[1] += bfhi(v.x); sum[2] += bflo(v.y); sum[3] += bfhi(v.y); sum[4] += bflo(v.z); sum[5] += bfhi(v.z); sum[6] += bflo(v.w); sum[7] += bfhi(v.w); }
        for (int k = 0; k < 16; ++k) { const int t = t0 + k, s = s0 + k; const u32x4 v = *(const u32x4*)(pm + (size_t)t * DM + c0);
            float xv[8] = {bflo(v.x), bfhi(v.x), bflo(v.y), bfhi(v.y), bflo(v.z), bfhi(v.z), bflo(v.w), bfhi(v.w)};
#pragma unroll
            for (int i = 0; i < 8; ++i) sum[i] += xv[i];
            const float inv = 1.0f / (float)((s + 1) < w ? (s + 1) : w);
            u32x4 o = {pk2(sum[0] * inv - xv[0], sum[1] * inv - xv[1]), pk2(sum[2] * inv - xv[2], sum[3] * inv - xv[3]), pk2(sum[4] * inv - xv[4], sum[5] * inv - xv[5]), pk2(sum[6] * inv - xv[6], sum[7] * inv - xv[7])};
            *(u32x4*)(A2 + (size_t)t * MIXW + c0) = o;
            if (s >= w - 1) { const u32x4 q = *(const u32x4*)(pm + (size_t)(t - w + 1) * DM + c0);
                sum[0] -= bflo(q.x); sum[1] -= bfhi(q.x); sum[2] -= bflo(q.y); sum[3] -= bfhi(q.y); sum[4] -= bflo(q.z); sum[5] -= bfhi(q.z); sum[6] -= bflo(q.w); sum[7] -= bfhi(q.w); } }
    }
}

__device__ __forceinline__ void mem_attn(const Args& a, Frame& F, bf16* Abuf, int layer, bool dry = false) {
    const bf16* MKV = (const bf16*)(a.ws + WS_MEMKV);
    for (int U = F.vcu; U < 512; U += F.G) { const int b = U >> 6, h = (U >> 4) & 3, qt = U & 15;
        bf16* Q = Abuf + ((size_t)b * SEQ + qt * 256) * MIXW + 1024 + h * 128;
        const bf16* K = MKV + (size_t)b * MEMT * 2048 + layer * 1024 + h * 128;
        att::attn_unit<MIXW, 2048, false, ATT_SD_MEM>(Q, K, K + 512, dry ? (bf16*)(a.ws + WS_EXP) : Q, 0, nullptr, F.ldsg); }
}

__device__ __forceinline__ int ord_enc(float x) { const int b = __builtin_bit_cast(int, x); return b ^ ((b >> 31) & 0x7fffffff); }
__device__ __forceinline__ float ord_dec(int k) { return __builtin_bit_cast(float, k ^ ((k >> 31) & 0x7fffffff)); }
template <int N> __device__ __forceinline__ void bitonic_desc(int (&a)[N]) {
#pragma unroll
    for (int k = 2; k <= N; k <<= 1)
#pragma unroll
        for (int j = k >> 1; j > 0; j >>= 1)
#pragma unroll
            for (int i = 0; i < N; ++i) { const int l = i ^ j; if (l > i) { const bool desc = ((i & k) == 0) || (k == N);
                const int hi = max(a[i], a[l]), lo = min(a[i], a[l]); a[i] = desc ? hi : lo; a[l] = desc ? lo : hi; } }
}
__device__ __forceinline__ int kmax(int x, int y) { int r; asm("v_max_f32 %0, %1, %2" : "=v"(r) : "v"(x), "v"(y)); return r; }
__device__ __forceinline__ int kmin(int x, int y) { int r; asm("v_min_f32 %0, %1, %2" : "=v"(r) : "v"(x), "v"(y)); return r; }
__device__ __forceinline__ void ksettle(int (&a)[16]) {
    asm volatile("s_nop 3" : "+v"(a[0]), "+v"(a[1]), "+v"(a[2]), "+v"(a[3]), "+v"(a[4]), "+v"(a[5]), "+v"(a[6]), "+v"(a[7]));
    asm volatile("s_nop 3" : "+v"(a[8]), "+v"(a[9]), "+v"(a[10]), "+v"(a[11]), "+v"(a[12]), "+v"(a[13]), "+v"(a[14]), "+v"(a[15]));
}
__device__ __forceinline__ void sort16_desc(int (&a)[16]) {
#define CE_(i, j) { const int hi_ = kmax(a[i], a[j]), lo_ = kmin(a[i], a[j]); a[i] = hi_; a[j] = lo_; }
    CE_(0, 13) CE_(1, 12) CE_(2, 15) CE_(3, 14) CE_(4, 8) CE_(5, 6) CE_(7, 11) CE_(9, 10)
    CE_(0, 5) CE_(1, 7) CE_(2, 9) CE_(3, 4) CE_(6, 13) CE_(8, 14) CE_(10, 15) CE_(11, 12)
    CE_(0, 1) CE_(2, 3) CE_(4, 5) CE_(6, 8) CE_(7, 9) CE_(10, 11) CE_(12, 13) CE_(14, 15)
    CE_(0, 2) CE_(1, 3) CE_(4, 10) CE_(5, 11) CE_(6, 7) CE_(8, 9) CE_(12, 14) CE_(13, 15)
    CE_(1, 2) CE_(3, 12) CE_(4, 6) CE_(5, 7) CE_(8, 10) CE_(9, 11) CE_(13, 14)
    CE_(1, 4) CE_(2, 6) CE_(5, 8) CE_(7, 10) CE_(9, 13) CE_(11, 14)
    CE_(2, 4) CE_(3, 6) CE_(9, 12) CE_(11, 13)
    CE_(3, 5) CE_(6, 8) CE_(7, 9) CE_(10, 12)
    CE_(3, 4) CE_(5, 6) CE_(7, 8) CE_(9, 10) CE_(11, 12)
    CE_(6, 7) CE_(8, 9)
#undef CE_
}
__device__ __forceinline__ void merge16(int (&a)[16], const int (&b)[16]) {
#pragma unroll
    for (int i = 0; i < 16; ++i) a[i] = kmax(a[i], b[15 - i]);
#pragma unroll
    for (int j = 8; j > 0; j >>= 1)
#pragma unroll
        for (int i = 0; i < 16; ++i) { const int l = i ^ j; if (l > i) { const int hi = kmax(a[i], a[l]), lo = kmin(a[i], a[l]); a[i] = hi; a[l] = lo; } }
}
constexpr int cand_i(int s) { int c = 0; for (int a = 0; a < 16; ++a) for (int b = 0; b < 16; ++b) { if ((a + 1) * (b + 1) > 16) continue; if (c == s) return a; ++c; } return 0; }
constexpr int cand_j(int s) { int c = 0; for (int a = 0; a < 16; ++a) for (int b = 0; b < 16; ++b) { if ((a + 1) * (b + 1) > 16) continue; if (c == s) return b; ++c; } return 0; }
constexpr int cand_slot(int i, int j) { int s = 0; for (int a = 0; a < 16; ++a) for (int b = 0; b < 16; ++b) { if ((a + 1) * (b + 1) > 16) continue; if (a == i && b == j) return s; ++s; } return -1; }

__device__ __forceinline__ void peer_topk(const Args& a, Frame& F, int layer) {
    const bf16* PQ = (const bf16*)(a.ws + WS_PQ); const bf16* SUBK = (const bf16*)(a.ws + WS_SUBK) + (size_t)layer * 16 * 128 * 128;
    unsigned short* EXPo = (unsigned short*)(a.ws + WS_EXP); float* GATEo = (float*)(a.ws + WS_GATE);
    const int tid = fresh_tid(), lane = tid & 63, wid = F.wave, r32 = lane & 31, hi = lane >> 5;
    const int h = F.vcu & 7;
    int ka[4];
#pragma unroll
    for (int i = 0; i < 4; ++i) ka[i] = r32 * 256 + (((2 * i + hi) ^ (r32 & 7)) << 4);
    char* Ks = F.ldsg;
    LAS unsigned char* ib = F.lds + 65536 + tid * 36;
    for (int i = tid; i < 2 * 128 * 16; i += NTHR) { const int row = i >> 4, ch = i & 15; const u32x4 v = *(const u32x4*)(SUBK + ((size_t)h * 256 + row) * 128 + ch * 8);
        *(u32x4*)(Ks + (row >> 7) * 32768 + KSWZ(row & 127, ch * 16)) = v; }
    __syncthreads();
    const int tt0 = F.vcu >> 3, tts = F.G >> 3;
    bf16x8 qn[8];
    { const bf16* qp = PQ + (size_t)(tt0 * 256 + wid * 32 + r32) * 2048 + h * 256 + hi * 8;
#pragma unroll
      for (int d0 = 0; d0 < 8; ++d0) qn[d0] = *reinterpret_cast<const bf16x8*>(qp + d0 * 16); }
    for (int tt = tt0; tt < T / 256; tt += tts) {
        const int t = tt * 256 + wid * 32 + r32;
        int top[2][16];
#pragma unroll
        for (int p = 0; p < 2; ++p) {
            bf16x8 qr[8];
#pragma unroll
            for (int d0 = 0; d0 < 8; ++d0) qr[d0] = qn[d0];
            { const int ttn = (p == 0) ? tt : ((tt + tts < T / 256) ? tt + tts : tt);
              const bf16* qp = PQ + (size_t)(ttn * 256 + wid * 32 + r32) * 2048 + h * 256 + (p ^ 1) * 128 + hi * 8;
#pragma unroll
              for (int d0 = 0; d0 < 8; ++d0) qn[d0] = *reinterpret_cast<const bf16x8*>(qp + d0 * 16); }
            int cur[16];
#pragma unroll
            for (int kt = 0; kt < 4; ++kt) { f32x16 sacc; att::qkt1(sacc, Ks + p * 32768 + kt * 32 * 256, qr, ka);
                int grp[16];
#pragma unroll
                for (int r = 0; r < 16; ++r) { const float sv_ = sacc[r]; grp[r] = (__float_as_int(sv_) & ~0x7F) | (kt * 32 + (r & 3) + 8 * (r >> 2) + 4 * hi); }
                sort16_desc(grp);
                if (kt == 0) {
#pragma unroll
                    for (int r = 0; r < 16; ++r) cur[r] = grp[r];
                } else merge16(cur, grp); }
            int oth[16]; ksettle(cur);
#pragma unroll
            for (int r = 0; r < 16; ++r) { auto rr = __builtin_amdgcn_permlane32_swap((unsigned)cur[r], (unsigned)cur[r], false, false); cur[r] = (int)rr[0]; oth[r] = (int)rr[1]; }
            ksettle(cur); ksettle(oth); merge16(cur, oth);
#pragma unroll
            for (int r = 0; r < 16; ++r) top[p][r] = cur[r];
        }
        float v0[16], v1[16];
#pragma unroll
        for (int r = 0; r < 16; ++r) { v0[r] = __builtin_bit_cast(float, top[0][r] & ~0x7F); v1[r] = __builtin_bit_cast(float, top[1][r] & ~0x7F); }
#pragma unroll
        for (int q = 0; q < 4; ++q) { *(LAS unsigned*)(ib + q * 4) = (top[0][4 * q] & 0x7F) | ((top[0][4 * q + 1] & 0x7F) << 8) | ((top[0][4 * q + 2] & 0x7F) << 16) | ((top[0][4 * q + 3] & 0x7F) << 24);
            *(LAS unsigned*)(ib + 16 + q * 4) = (top[1][4 * q] & 0x7F) | ((top[1][4 * q + 1] & 0x7F) << 8) | ((top[1][4 * q + 2] & 0x7F) << 16) | ((top[1][4 * q + 3] & 0x7F) << 24); }
        int best[16], g1[16];
#pragma unroll
        for (int r = 0; r < 32; ++r) { int key = (int)0xFF800000;
            if (r < 25) {
                const int iA = cand_i(r), jA = cand_j(r), iB = cand_i(25 + r), jB = cand_j(25 + r);
                const float sA = v0[iA] + v1[jA], sB = v0[iB] + v1[jB]; const int code = hi ? (iB * 16 + jB) : (iA * 16 + jA);
                key = (__builtin_bit_cast(int, hi ? sB : sA) & ~0xFF) | code; }
            if (r < 16) best[r] = key; else g1[r - 16] = key; }
        sort16_desc(best); sort16_desc(g1); merge16(best, g1); ksettle(best);
#pragma unroll
        for (int r = 0; r < 16; ++r) { auto rr = __builtin_amdgcn_permlane32_swap((unsigned)best[r], (unsigned)best[r], false, false); best[r] = (int)rr[0]; g1[r] = (int)rr[1]; }
        ksettle(best); ksettle(g1); merge16(best, g1);
        float cv[16], ex[16]; float sum = 0.f;
#pragma unroll
        for (int r = 0; r < 16; ++r) cv[r] = __builtin_bit_cast(float, best[r] & ~0xFF);
#pragma unroll
        for (int r = 0; r < 16; ++r) { ex[r] = __builtin_amdgcn_exp2f((cv[r] - cv[0]) * 1.4426950408889634f); sum += ex[r]; }
        const float rs = 1.0f / sum;
        LDS_WAIT();
        unsigned ee[16];
#pragma unroll
        for (int r = 0; r < 16; ++r) { const int code = best[r] & 0xFF; const unsigned e1 = ib[code >> 4], e2 = ib[16 + (code & 15)]; ee[r] = e1 * 128u + e2; }
        const size_t ob = ((size_t)t * 8 + h) * 16;
        if (hi == 0) { u32x4 w0 = {ee[0] | (ee[1] << 16), ee[2] | (ee[3] << 16), ee[4] | (ee[5] << 16), ee[6] | (ee[7] << 16)}, w1 = {ee[8] | (ee[9] << 16), ee[10] | (ee[11] << 16), ee[12] | (ee[13] << 16), ee[14] | (ee[15] << 16)};
            *(u32x4*)(EXPo + ob) = w0; *(u32x4*)(EXPo + ob + 8) = w1; }
        else {
#pragma unroll
            for (int q = 0; q < 4; ++q) { f32x4 gq = {ex[4 * q] * rs, ex[4 * q + 1] * rs, ex[4 * q + 2] * rs, ex[4 * q + 3] * rs}; *(f32x4*)(GATEo + ob + 4 * q) = gq; } }
        LDS_WAIT();
    }
    __syncthreads();
}

__device__ __forceinline__ float gelu_exact(float v) {
    const float av = fabsf(v), t = __builtin_amdgcn_rcpf(fmaf(av, 0.2316418882f, 1.0f));
    float q = fmaf(t, 0.5307027145f, -0.7265760135f); q = fmaf(q, t, 0.7107068705f); q = fmaf(q, t, -0.142248368f); q = fmaf(q, t, 0.127414796f); q = q * t;
    const float e = __builtin_amdgcn_exp2f(v * v * -0.72134752044f), m = v * (q * e);
    return v < 0.f ? m : v - m;
}
__device__ __forceinline__ float dot16_fp8(const u32x4 u, const f32x2 (&x2)[8]) {
    f32x2 d = {0.f, 0.f};
#pragma unroll
    for (int i = 0; i < 4; ++i) { const f32x2 a = __builtin_amdgcn_cvt_pk_f32_fp8((int)u[i], false), b = __builtin_amdgcn_cvt_pk_f32_fp8((int)u[i], true);
        d = __builtin_elementwise_fma(a, x2[2 * i], d); d = __builtin_elementwise_fma(b, x2[2 * i + 1], d); }
    return d.x + d.y;
}
__device__ __forceinline__ void axpy16_fp8(f32x2 (&o2)[8], const float h, const u32x4 v) {
    const f32x2 h2 = {h, h};
#pragma unroll
    for (int i = 0; i < 4; ++i) { const f32x2 a = __builtin_amdgcn_cvt_pk_f32_fp8((int)v[i], false), b = __builtin_amdgcn_cvt_pk_f32_fp8((int)v[i], true);
        o2[2 * i] = __builtin_elementwise_fma(a, h2, o2[2 * i]); o2[2 * i + 1] = __builtin_elementwise_fma(b, h2, o2[2 * i + 1]); }
}
__device__ __forceinline__ float reduce8(const float (&p)[8], int lane) {
    float s[4];
#pragma unroll
    for (int i = 0; i < 4; ++i) { auto rr = __builtin_amdgcn_permlane32_swap(__float_as_uint(p[2 * i]), __float_as_uint(p[2 * i + 1]), false, false); s[i] = __uint_as_float(rr[0]) + __uint_as_float(rr[1]); }
    float t[2];
#pragma unroll
    for (int i = 0; i < 2; ++i) { const bool hi = lane & 16; const float u = hi ? s[2 * i + 1] : s[2 * i], o = hi ? s[2 * i] : s[2 * i + 1]; t[i] = u + shx_f<16>(o); }
    const bool h8 = lane & 8; const float u = h8 ? t[1] : t[0], o = h8 ? t[0] : t[1]; float w = u + dpp_f<0x128>(o);
    w += dpp_f<0x141>(w); w += dpp_f<0x1B>(w); w += dpp_f<0xB1>(w);
    return w;
}
constexpr int qgrp(int q) { return 2 * ((q & 3) == 1 ? 2 : (q & 3) == 2 ? 1 : (q & 3)) + (q >> 2); }

template <int K, int J> __device__ __forceinline__ void sort128_stage(unsigned& lo, unsigned& hi, int lane) {
    const unsigned plo = shx_u<J>(lo), phi = shx_u<J>(hi);
    const bool up_lo = (K >= 64) ? true : ((lane & K) == 0), up_hi = (K == 64) ? false : up_lo, lower = (lane & J) == 0;
    lo = (lower == up_lo) ? min(lo, plo) : max(lo, plo); hi = (lower == up_hi) ? min(hi, phi) : max(hi, phi);
    if constexpr (J > 1) sort128_stage<K, J / 2>(lo, hi, lane);
}
template <int K> __device__ __forceinline__ void sort128_level(unsigned& lo, unsigned& hi, int lane) { sort128_stage<K, K / 2>(lo, hi, lane); if constexpr (K < 64) sort128_level<K * 2>(lo, hi, lane); }
__device__ __forceinline__ void sort128(unsigned& lo, unsigned& hi, int lane) {
    sort128_level<2>(lo, hi, lane);
    { const unsigned a = min(lo, hi), b = max(lo, hi); lo = a; hi = b; }
    sort128_stage<128, 32>(lo, hi, lane);
}
template <bool FINAL, bool DRY = false>
__device__ __forceinline__ void peer_gather(const Args& a, Frame& F, int layer) {
    const unsigned char* UB = a.ws + WS_UB + (size_t)layer * NEXP * DM; const unsigned char* VB = a.ws + WS_VB + (size_t)layer * NEXP * DM;
    const float* USC = (const float*)(a.ws + WS_USC) + layer * NEXP; const float* VSC = (const float*)(a.ws + WS_VSC) + layer * NEXP;
    const unsigned short* EXPi = (const unsigned short*)(a.ws + WS_EXP); const float* GATEi = (const float*)(a.ws + WS_GATE);
    float* X = a.out; bf16* XB = (bf16*)(a.ws + WS_XB); float* RSTD2 = (float*)(a.ws + WS_RSTD2); const float* gfin = a.in[15];
    const int lane = fresh_tid() & 63, gw = F.vcu * NWAVES + F.wave, NGW = F.G * NWAVES;
    const unsigned lane16 = (unsigned)lane * 16u;
    const int grp = lane >> 3; const int jperm = 8 * (lane & 7) + ((grp >> 1) == 1 ? 2 : (grp >> 1) == 2 ? 1 : (grp >> 1)) + 4 * (grp & 1);
    for (int t = gw; t < T; t += NGW) {
        __syncthreads();
        bf16* xbr = XB + (size_t)t * DM + 16 * lane;
        float x[16];
        { const u32x4 v0 = *(const u32x4*)xbr, v1 = *(const u32x4*)(xbr + 8);
          x[0] = bflo(v0.x); x[1] = bfhi(v0.x); x[2] = bflo(v0.y); x[3] = bfhi(v0.y); x[4] = bflo(v0.z); x[5] = bfhi(v0.z); x[6] = bflo(v0.w); x[7] = bfhi(v0.w);
          x[8] = bflo(v1.x); x[9] = bfhi(v1.x); x[10] = bflo(v1.y); x[11] = bfhi(v1.y); x[12] = bflo(v1.z); x[13] = bfhi(v1.z); x[14] = bflo(v1.w); x[15] = bfhi(v1.w); }
        f32x2 x2[8];
#pragma unroll
        for (int i = 0; i < 8; ++i) { x2[i].x = x[2 * i]; x2[i].y = x[2 * i + 1]; }
        float ss = 0.f;
#pragma unroll
        for (int i = 0; i < 16; ++i) ss = fmaf(x[i], x[i], ss);
        ss = wave_sum(ss);
        const float rstd = 1.0f / sqrtf(ss * (1.0f / DM) + EPS);
        const unsigned short* et = EXPi + (size_t)t * 128; const float* gt_ = GATEi + (size_t)t * 128;
        unsigned k_lo = ((unsigned)et[lane] << 7) | (unsigned)lane, k_hi = ((unsigned)et[64 + lane] << 7) | (unsigned)(64 + lane);
        sort128(k_lo, k_hi, lane);
        const int e_lo = (int)(k_lo >> 7), e_hi = (int)(k_hi >> 7);
        const float gs_lo = gt_[k_lo & 127u], gs_hi = gt_[k_hi & 127u];
        const int ep_lo = __shfl(e_lo, jperm), ep_hi = __shfl(e_hi, jperm);
        const float gl = __shfl(gs_lo, jperm) * VSC[ep_lo], gh = __shfl(gs_hi, jperm) * VSC[ep_hi];
        const float ul = USC[ep_lo] * rstd, uh = USC[ep_hi] * rstd;
        float a_lo = 0.f, a_hi = 0.f;
        u32x4 b0[8], b1[8], b2[8];
#define ROWLD(dst, tab, e_) dst = *(const u32x4*)((tab) + (size_t)(e_) * DM + lane16)
#define ULOAD(buf, B) do { const int ev_ = ((B) >> 3) ? e_hi : e_lo; _Pragma("unroll") for (int q = 0; q < 8; ++q) { const int e = __builtin_amdgcn_readlane(ev_, 8 * ((B) & 7) + q); ROWLD(buf[q], UB, e); } } while (0)
#define VLOAD(buf, B) do { const int ev_ = ((B) >> 3) ? e_hi : e_lo; _Pragma("unroll") for (int q = 0; q < 8; ++q) { const int e = __builtin_amdgcn_readlane(ev_, 8 * ((B) & 7) + q); ROWLD(buf[q], VB, e); } } while (0)
#define UCOMP(buf, B) do { float p[8]; _Pragma("unroll") for (int q = 0; q < 8; ++q) p[q] = dot16_fp8(buf[q], x2); const float w = reduce8(p, lane); const bool mine = (lane & 7) == ((B) & 7); \
        if ((B) >> 3) a_hi = mine ? w : a_hi; else a_lo = mine ? w : a_lo; } while (0)
        ULOAD(b0, 0); ULOAD(b1, 1);
#pragma unroll 1
        for (int B = 0; B < 12; B += 3) {
            if (B > 0) __syncthreads();
            ULOAD(b2, B + 2); UCOMP(b0, B);
            ULOAD(b0, B + 3); UCOMP(b1, B + 1);
            ULOAD(b1, B + 4); UCOMP(b2, B + 2); }
        ULOAD(b2, 14); UCOMP(b0, 12);
        ULOAD(b0, 15); UCOMP(b1, 13);
        VLOAD(b1, 0);  UCOMP(b2, 14);
        VLOAD(b2, 1);  UCOMP(b0, 15);
#undef ULOAD
#undef UCOMP
        __syncthreads();
        const float h_lo = gelu_exact(a_lo * ul) * gl, h_hi = gelu_exact(a_hi * uh) * gh;
        f32x2 o2[8];
#pragma unroll
        for (int i = 0; i < 8; ++i) o2[i] = (f32x2){0.f, 0.f};
#define VCOMP(buf, B) do { const int hv_ = __builtin_bit_cast(int, ((B) >> 3) ? h_hi : h_lo); _Pragma("unroll") for (int q = 0; q < 8; ++q) { const float hq = __builtin_bit_cast(float, __builtin_amdgcn_readlane(hv_, 8 * qgrp(q) + ((B) & 7))); axpy16_fp8(o2, hq, buf[q]); } } while (0)
#pragma unroll 1
        for (int B = 0; B < 12; B += 3) {
            if (B > 0) __syncthreads();
            VLOAD(b0, B + 2); VCOMP(b1, B);
            VLOAD(b1, B + 3); VCOMP(b2, B + 1);
            VLOAD(b2, B + 4); VCOMP(b0, B + 2); }
        VLOAD(b0, 14); VCOMP(b1, 12);
        VLOAD(b1, 15); VCOMP(b2, 13);
        VCOMP(b0, 14);
        VCOMP(b1, 15);
#undef VLOAD
#undef VCOMP
#undef ROWLD
        float o[16]; float s2 = 0.f;
#pragma unroll
        for (int i = 0; i < 8; ++i) { o[2 * i] = o2[i].x; o[2 * i + 1] = o2[i].y; }
        { const u32x4 v0 = *(const u32x4*)xbr, v1 = *(const u32x4*)(xbr + 8);
          o[0] += bflo(v0.x); o[1] += bfhi(v0.x); o[2] += bflo(v0.y); o[3] += bfhi(v0.y); o[4] += bflo(v0.z); o[5] += bfhi(v0.z); o[6] += bflo(v0.w); o[7] += bfhi(v0.w);
          o[8] += bflo(v1.x); o[9] += bfhi(v1.x); o[10] += bflo(v1.y); o[11] += bfhi(v1.y); o[12] += bflo(v1.z); o[13] += bfhi(v1.z); o[14] += bflo(v1.w); o[15] += bfhi(v1.w); }
#pragma unroll
        for (int i = 0; i < 16; ++i) s2 = fmaf(o[i], o[i], s2);
        s2 = wave_sum(s2);
        const float r2 = 1.0f / sqrtf(s2 * (1.0f / DM) + EPS);
        if constexpr (FINAL) {
            float* xw = (DRY ? (float*)(a.ws + WS_RB) : X) + (size_t)t * DM;
#pragma unroll
            for (int i = 0; i < 4; ++i) { const f32x4 g = *(const f32x4*)(gfin + 16 * lane + 4 * i); f32x4 y = {o[4 * i] * r2 * g[0], o[4 * i + 1] * r2 * g[1], o[4 * i + 2] * r2 * g[2], o[4 * i + 3] * r2 * g[3]}; *(f32x4*)(xw + 16 * lane + 4 * i) = y; }
        } else {
            bf16* xo = DRY ? (bf16*)(a.ws + WS_RB) + (size_t)t * DM + 16 * lane : xbr;
            u32x4 wa = {pk2(o[0], o[1]), pk2(o[2], o[3]), pk2(o[4], o[5]), pk2(o[6], o[7])}, wb = {pk2(o[8], o[9]), pk2(o[10], o[11]), pk2(o[12], o[13]), pk2(o[14], o[15])};
            *(u32x4*)xo = wa; *(u32x4*)(xo + 8) = wb;
            if (!DRY && lane == 0) RSTD2[t] = r2;
        }
    }
}

#define XB_TMO      128
#define XB_XCNT(j)  (256  + 64 * (j))
#define XB_XSUB(j)  (1280 + 64 * (j))
#define XB_XGEN(j)  (2304 + 64 * (j))
#define XB_TOP      3328
#define XB_TOPGEN   3392
#define XCD_BAR_WORDS 3456
#define XB_SPIN_CAP (1u << 22)
__device__ __forceinline__ unsigned xb_ld(unsigned* p)              { return __hip_atomic_load(p, __ATOMIC_RELAXED, __HIP_MEMORY_SCOPE_AGENT); }
__device__ __forceinline__ unsigned xb_add(unsigned* p, unsigned v) { return __hip_atomic_fetch_add(p, v, __ATOMIC_RELAXED, __HIP_MEMORY_SCOPE_AGENT); }
__device__ __forceinline__ unsigned xb_xcc_id() { return (unsigned)__builtin_amdgcn_s_getreg((3 << 11) | 20) & 0xFu; }
#define XB_SPIN(cond, bar) do { unsigned _sp = 0; while (cond) { __builtin_amdgcn_s_sleep(1); \
    if ((++_sp & 255u) == 0u) { if (xb_ld(&(bar)[XB_TMO])) break; if (_sp > XB_SPIN_CAP) { atomicAdd(&(bar)[XB_TMO], 1u); break; } } } } while (0)
struct XcdBarrier { unsigned* bar; unsigned x; volatile LAS unsigned* st; };
__device__ __forceinline__ XcdBarrier xcd_barrier_post(unsigned* bar, volatile LAS unsigned* st) {
    XcdBarrier b; b.bar = bar; b.x = xb_xcc_id(); b.st = st;
    if (threadIdx.x == 0) (void)xb_add(&bar[XB_XCNT(b.x)], 1u);
    return b;
}
__device__ __forceinline__ void xcd_barrier_complete(unsigned* bar, unsigned x, unsigned& nloc, unsigned& nx) {
    const unsigned G = gridDim.x * gridDim.y * gridDim.z;
    unsigned sum, cnt, mine, sp = 0u;
    for (;;) {
        sum = 0u; cnt = 0u; mine = 0u;
#pragma unroll
        for (unsigned j = 0; j < 16; ++j) { const unsigned c = xb_ld(&bar[XB_XCNT(j)]); sum += c; cnt += (c > 0u) ? 1u : 0u; mine = (j == x) ? c : mine; }
        if (sum == G) break;
        __builtin_amdgcn_s_sleep(1);
        if ((++sp & 255u) == 0u) { if (xb_ld(&bar[XB_TMO])) break; if (sp > XB_SPIN_CAP) { atomicAdd(&bar[XB_TMO], 1u); break; } }
    }
    nloc = mine > 0u ? mine : 1u; nx = cnt > 0u ? cnt : 1u;
}
__device__ __forceinline__ void xcd_barrier(const XcdBarrier& b) {
    asm volatile("s_waitcnt vmcnt(0)" ::: "memory");
    __syncthreads();
    if (threadIdx.x == 0) {
        unsigned* bar = b.bar;
        __builtin_amdgcn_s_waitcnt(0);
        unsigned nloc = b.st[0], nx = b.st[1];
        if (nloc == 0u) { xcd_barrier_complete(bar, b.x, nloc, nx); b.st[0] = nloc; b.st[1] = nx; }
        const unsigned old = xb_add(&bar[XB_XSUB(b.x)], 1u);
        const unsigned gen = old / nloc;
        if (old + 1u == (gen + 1u) * nloc) {
            __builtin_amdgcn_fence(__ATOMIC_RELEASE, "agent");
            asm volatile("s_waitcnt vmcnt(0)" ::: "memory");
            const unsigned og = xb_add(&bar[XB_TOP], 1u);
            const unsigned tg = og / nx;
            if (og + 1u == (tg + 1u) * nx) xb_add(&bar[XB_TOPGEN], 1u);
            else XB_SPIN(xb_ld(&bar[XB_TOPGEN]) == tg, bar);
            __builtin_amdgcn_fence(__ATOMIC_ACQUIRE, "agent");
            xb_add(&bar[XB_XGEN(b.x)], 1u);
            asm volatile("s_waitcnt vmcnt(0)" ::: "memory");
        } else {
            XB_SPIN(xb_ld(&bar[XB_XGEN(b.x)]) == gen, bar);
            __builtin_amdgcn_fence(__ATOMIC_ACQUIRE, "agent");
            asm volatile("s_waitcnt vmcnt(0)" ::: "memory");
        }
    }
    __syncthreads();
}

__global__ void __launch_bounds__(NTHR, 2) yoco_fwd(Args args) {
    extern __shared__ __attribute__((aligned(16))) unsigned char lds_raw[];
    cg::grid_group grid = cg::this_grid();
    Frame F;
    F.lds = (LAS unsigned char*)lds_raw; F.ldsg = (char*)lds_raw;
    F.wave = __builtin_amdgcn_readfirstlane(threadIdx.x >> 6);
    F.G = gridDim.x; { const int bx = blockIdx.x; F.vcu = (F.G % 8 == 0) ? (bx % 8) * (F.G / 8) + bx / 8 : bx; }
    unsigned char* ws = args.ws;
    const int lo = args.ph_lo, hi = args.ph_hi;
    volatile LAS unsigned* bst = (volatile LAS unsigned*)(F.lds + 131072 + 320);
    if (threadIdx.x < 2) bst[threadIdx.x] = 0u;
    __syncthreads();
    XcdBarrier xbar; xbar.bar = (unsigned*)ws; xbar.x = 0; xbar.st = bst;
    if (hi - lo > 1) xbar = xcd_barrier_post((unsigned*)ws, bst);
#ifndef PH_MASK
#define PH_MASK 0x1fff
#endif
#define IN(k) (((PH_MASK >> (k)) & 1) && lo <= (k) && (k) < hi)
#define SEAM(k) do { if (IN(k) && IN((k) + 1)) { if ((k) == 0) grid.sync(); else xcd_barrier(xbar); } } while (0)
#define GSYNC() xcd_barrier(xbar)
#ifndef REP_MASK
#define REP_MASK 0
#endif
#define NREP(k) (((REP_MASK >> (k)) & 1) ? 2 : 1)
    typedef pg8::bf16_t pb;

    for (int rep_ = 0; rep_ < NREP(0); ++rep_) { if (rep_) GSYNC();
    if (IN(0)) { phase0(args, F); } } SEAM(0);

    for (int rep_ = 0; rep_ < NREP(1); ++rep_) { if (rep_) GSYNC();
    if (IN(1)) {
        { pg8::Gemm g{(const pb*)(ws + WS_XB), (const pb*)(ws + WS_WIN0), T, MIXW, DM}; pg8::StaticOrder S; S.init(T, MIXW, F.G, (int)blockIdx.x);
          pg8::EpiRowBf16 E{(pb*)(ws + WS_P0MAIN), DM, (pb*)(ws + WS_A2) + 1024, MIXW, 1024, (const float*)(ws + WS_RSTD0), nullptr};
          pg8::gemm_phase<pg8::EpiRowBf16, pg8::StaticOrder>(F.lds, g, S, E); }
        { pg8::Gemm g{(const pb*)(ws + WS_MEMB), (const pb*)(ws + WS_WMKV), 2048, 2048, DM}; pg8::StaticOrder S; S.init(2048, 2048, F.G, (int)blockIdx.x);
          pg8::EpiRowBf16 E{(pb*)(ws + WS_MEMKV), 2048, (pb*)(ws + WS_MEMKV), 2048, 1 << 30, nullptr, nullptr};
          pg8::gemm_phase<pg8::EpiRowBf16, pg8::StaticOrder>(F.lds, g, S, E); }
    } } SEAM(1);

    if (IN(2)) { if (NREP(2) > 1) { pool_diff(args, F); mem_attn(args, F, (bf16*)(ws + WS_A2), 0, true); GSYNC(); }
        pool_diff(args, F); mem_attn(args, F, (bf16*)(ws + WS_A2), 0); } SEAM(2);

    for (int rep_ = 0; rep_ < NREP(3); ++rep_) { if (rep_) GSYNC();
    if (IN(3)) {
        pg8::Gemm g{(const pb*)(ws + WS_A2), (const pb*)(ws + WS_WC0), T, DM, MIXW}; pg8::StaticOrder S; S.init(T, DM, F.G, (int)blockIdx.x);
        pg8::EpiRes E{(pb*)(ws + WS_XB), (float*)(ws + WS_SSQ)};
        pg8::gemm_phase<pg8::EpiRes, pg8::StaticOrder>(F.lds, g, S, E);
    } } SEAM(3);

    for (int rep_ = 0; rep_ < NREP(4); ++rep_) { if (rep_) GSYNC();
    if (IN(4)) {
        pg8::Gemm g{(const pb*)(ws + WS_XB), (const pb*)(ws + WS_WQ0), T, 2048, DM}; pg8::StaticOrder S; S.init(T, 2048, F.G, (int)blockIdx.x);
        pg8::EpiRowBf16 E{(pb*)(ws + WS_PQ), 2048, (pb*)(ws + WS_PQ), 2048, 1 << 30, nullptr, (const float*)(ws + WS_SSQ)};
        pg8::gemm_phase<pg8::EpiRowBf16, pg8::StaticOrder>(F.lds, g, S, E);
    } } SEAM(4);

    for (int rep_ = 0; rep_ < NREP(5); ++rep_) { if (rep_) GSYNC();
    if (IN(5)) { peer_topk(args, F, 0); } } SEAM(5);
    if (IN(6)) {
#ifdef PROBE_PEER
        peer_gather<false, true>(args, F, 0); GSYNC();
#endif
        peer_gather<false>(args, F, 0); } SEAM(6);

    for (int rep_ = 0; rep_ < NREP(7); ++rep_) { if (rep_) GSYNC();
    if (IN(7)) {
        pg8::Gemm g{(const pb*)(ws + WS_XB), (const pb*)(ws + WS_WC4), T, 3584, DM}; pg8::StaticOrder S; S.init(T, 3584, F.G, (int)blockIdx.x);
        pg8::EpiKVQ E{(pb*)(ws + WS_KR), (pb*)(ws + WS_VV), (pb*)(ws + WS_A3), (float*)(ws + WS_KMP), (const float*)(ws + WS_RSTD2), (const float*)(ws + WS_ROPE)};
        pg8::gemm_phase<pg8::EpiKVQ, pg8::StaticOrder>(F.lds, g, S, E);
    } } SEAM(7);

    if (IN(8)) {
        bf16* A3 = (bf16*)(ws + WS_A3); const bf16* KR = (const bf16*)(ws + WS_KR); const bf16* VV = (const bf16*)(ws + WS_VV); const float* KMP = (const float*)(ws + WS_KMP);
        for (int rep_ = 0; rep_ < NREP(8); ++rep_) { const bool dry8 = (NREP(8) > 1) && rep_ == 0;
        for (int P = F.vcu; P < 512; P += F.G) { const int bh = P >> 3, p = P & 7, b = bh >> 3, h = bh & 7;
#pragma unroll 1
            for (int half = 0; half < 2; ++half) { const int j = half ? p : 15 - p;
                bf16* Q = A3 + ((size_t)b * SEQ + j * 256) * MIXW + h * 128;
                const bf16* K = KR + (size_t)bh * SEQ * 128; const bf16* V = VV + (size_t)bh * SEQ * 128;
                att::attn_unit<MIXW, 128, true, ATT_SD_MOBA>(Q, K, V, dry8 ? (bf16*)(ws + WS_XB) : Q, j, KMP + (size_t)b * 16 * 2048 + h * 128, F.ldsg); } }
        if (dry8) { mem_attn(args, F, A3, 1, true); GSYNC(); } }
        mem_attn(args, F, A3, 1);
    } SEAM(8);

    if (IN(9)) {
        pg8::Gemm g{(const pb*)(ws + WS_A3), (const pb*)(ws + WS_WOUT1), T, DM, MIXW}; pg8::StaticOrder S; S.init(T, DM, F.G, (int)blockIdx.x);
        pg8::EpiRes E{(pb*)(ws + WS_XB), (float*)(ws + WS_SSQ)};
        pg8::gemm_phase<pg8::EpiRes, pg8::StaticOrder>(F.lds, g, S, E);
    } SEAM(9);

    for (int rep_ = 0; rep_ < NREP(10); ++rep_) { if (rep_) GSYNC();
    if (IN(10)) {
        pg8::Gemm g{(const pb*)(ws + WS_XB), (const pb*)(ws + WS_WQ1), T, 2048, DM}; pg8::StaticOrder S; S.init(T, 2048, F.G, (int)blockIdx.x);
        pg8::EpiRowBf16 E{(pb*)(ws + WS_PQ), 2048, (pb*)(ws + WS_PQ), 2048, 1 << 30, nullptr, (const float*)(ws + WS_SSQ)};
        pg8::gemm_phase<pg8::EpiRowBf16, pg8::StaticOrder>(F.lds, g, S, E);
    } } SEAM(10);

    for (int rep_ = 0; rep_ < NREP(11); ++rep_) { if (rep_) GSYNC();
    if (IN(11)) { peer_topk(args, F, 1); } } SEAM(11);
    if (IN(12)) {
#ifdef PROBE_PEER
        peer_gather<true, true>(args, F, 1); GSYNC();
#endif
        peer_gather<true>(args, F, 1); }
#undef IN
#undef SEAM
}

extern "C" void kernel_launch(void* const* d_in, const int* in_sizes, int n_in, void* d_out, int out_size, void* d_ws, size_t ws_size, hipStream_t stream) {
    static int grid = 0;
    if (grid == 0) {
        if (n_in != 16 || out_size != T * DM || ws_size < WS_END) { fprintf(stderr, "kernel_launch: unexpected shapes: n_in %d out %d ws %zu (need %zu)\n", n_in, out_size, ws_size, (size_t)WS_END); grid = -1; return; }
        int dev = 0, cus = 0, per_cu = 0;
        if (hipGetDevice(&dev) != hipSuccess || hipDeviceGetAttribute(&cus, hipDeviceAttributeMultiprocessorCount, dev) != hipSuccess) { grid = -1; return; }
        if (hipFuncSetAttribute((const void*)yoco_fwd, hipFuncAttributeMaxDynamicSharedMemorySize, LDS_BYTES) != hipSuccess) { fprintf(stderr, "kernel_launch: hipFuncSetAttribute failed\n"); grid = -1; return; }
        if (hipOccupancyMaxActiveBlocksPerMultiprocessor(&per_cu, (const void*)yoco_fwd, NTHR, LDS_BYTES) != hipSuccess || per_cu < 1) { fprintf(stderr, "kernel_launch: occupancy query says %d\n", per_cu); per_cu = 1; }
        (void)hipGetLastError();
        grid = cus;
        fprintf(stderr, "kernel_launch: grid %d, per_cu %d, ws %zu\n", grid, per_cu, ws_size);
    }
    if (grid < 0) return;
    if (hipMemsetAsync(d_ws, 0, 16384, stream) != hipSuccess) { fprintf(stderr, "kernel_launch: memset failed\n"); return; }
    Args a{};
    for (int i = 0; i < 16; ++i) a.in[i] = (const float*)d_in[i];
    a.out = (float*)d_out; a.ws = (unsigned char*)d_ws;
#if MK_LAUNCHES == 1
    a.ph_lo = 0; a.ph_hi = 13;
    void* kargs[] = {&a};
    hipError_t e = hipLaunchCooperativeKernel((const void*)yoco_fwd, dim3(grid), dim3(NTHR), kargs, LDS_BYTES, stream);
    if (e != hipSuccess) fprintf(stderr, "kernel_launch: cooperative launch failed: %s (grid %d)\n", hipGetErrorString(e), grid);
#else
    for (int p = 0; p < 13; ++p) { a.ph_lo = p; a.ph_hi = p + 1;
        hipLaunchKernelGGL(yoco_fwd, dim3(grid), dim3(NTHR), LDS_BYTES, stream, a);
        const hipError_t le = hipPeekAtLastError(); if (le != hipSuccess) { fprintf(stderr, "kernel_launch: launch %d failed: %s\n", p, hipGetErrorName(le)); break; } }
#endif
}
```

```cpp
#include <hip/hip_runtime.h>
#include <hip/hip_cooperative_groups.h>
#include <cstdio>
#include <cstdint>
namespace cg = cooperative_groups;

#ifndef MK_LAUNCHES
#define MK_LAUNCHES 1
#endif

#define GAS __attribute__((address_space(1)))
#define LAS __attribute__((address_space(3)))
typedef unsigned short bf16;
typedef unsigned u32x4 __attribute__((ext_vector_type(4)));
typedef unsigned u32x2 __attribute__((ext_vector_type(2)));
typedef float f32x4 __attribute__((ext_vector_type(4)));
typedef float f32x2 __attribute__((ext_vector_type(2)));
typedef float f32x16 __attribute__((ext_vector_type(16)));
typedef short bf16x8 __attribute__((ext_vector_type(8)));
typedef short s16x4 __attribute__((ext_vector_type(4)));
typedef __bf16 bf16x2_t __attribute__((ext_vector_type(2)));

constexpr int NB = 8, SEQ = 4096, DM = 1024, T = NB * SEQ, MIXW = 1536, MEMT = 256;
constexpr int NEXP = 16384, NWAVES = 8, NTHR = 512;
constexpr float EPS = 1e-6f;

constexpr size_t MiB = 1u << 20;
constexpr size_t WS_RSTD0 = 1 * MiB;
constexpr size_t WS_RSTD2 = WS_RSTD0 + 128 * 1024;
constexpr size_t WS_USC   = WS_RSTD0 + 256 * 1024;
constexpr size_t WS_VSC   = WS_RSTD0 + 384 * 1024;
constexpr size_t WS_SSQ   = 2 * MiB;
constexpr size_t WS_KMP   = 4 * MiB;
constexpr size_t WS_ROPE  = 5 * MiB;
constexpr size_t WS_WIN0  = 8 * MiB;
constexpr size_t WS_WC4   = 11 * MiB;
constexpr size_t WS_WC0   = 18 * MiB;
constexpr size_t WS_WOUT1 = 21 * MiB;
constexpr size_t WS_WMKV  = 24 * MiB;
constexpr size_t WS_WQ0   = 28 * MiB;
constexpr size_t WS_WQ1   = 32 * MiB;
constexpr size_t WS_SUBK  = 36 * MiB;
constexpr size_t WS_MEMB  = 37 * MiB;
constexpr size_t WS_MEMKV = 41 * MiB;
constexpr size_t WS_EXP   = 49 * MiB;
constexpr size_t WS_GATE  = 57 * MiB;
constexpr size_t WS_UB    = 73 * MiB;
constexpr size_t WS_VB    = 105 * MiB;
constexpr size_t WS_XB    = 201 * MiB;
constexpr size_t WS_RB    = 265 * MiB;
constexpr size_t WS_P0MAIN = WS_RB;
constexpr size_t WS_A2    = WS_RB + 64 * MiB;
constexpr size_t WS_PQ    = WS_RB;
constexpr size_t WS_KR    = WS_RB;
constexpr size_t WS_VV    = WS_RB + 64 * MiB;
constexpr size_t WS_A3    = WS_RB + 128 * MiB;
constexpr size_t WS_END   = WS_RB + 224 * MiB;

constexpr int LDS_BYTES = 147456;

__device__ __forceinline__ unsigned f2bf(float f) { unsigned u = __builtin_bit_cast(unsigned, f); return (u + 0x7fffu + ((u >> 16) & 1u)) >> 16; }
__device__ __forceinline__ unsigned pk2(float lo, float hi) { return f2bf(lo) | (f2bf(hi) << 16); }
__device__ __forceinline__ unsigned cvtpk(float lo, float hi) { unsigned r; asm volatile("v_cvt_pk_bf16_f32 %0, %1, %2" : "=v"(r) : "v"(lo), "v"(hi)); return r; }
__device__ __forceinline__ float bflo(unsigned w) { return __builtin_bit_cast(float, w << 16); }
__device__ __forceinline__ float bfhi(unsigned w) { return __builtin_bit_cast(float, w & 0xffff0000u); }
template <int J> __device__ __forceinline__ unsigned shx_u(unsigned v) {
    if constexpr (J == 32) { auto rr = __builtin_amdgcn_permlane32_swap(v, v, false, false); return ((threadIdx.x & 32) ? rr[0] : rr[1]); }
    else return (unsigned)__builtin_amdgcn_ds_swizzle((int)v, (J << 10) | 0x1f);
}
template <int J> __device__ __forceinline__ float shx_f(float v) { return __uint_as_float(shx_u<J>(__float_as_uint(v))); }
template <int CTRL> __device__ __forceinline__ float dpp_f(float v) { return __uint_as_float((unsigned)__builtin_amdgcn_update_dpp(0, (int)__float_as_uint(v), CTRL, 0xF, 0xF, false)); }
__device__ __forceinline__ float wave_sum(float v) {
    v += dpp_f<0xB1>(v); v += dpp_f<0x4E>(v); v += dpp_f<0x141>(v); v += dpp_f<0x128>(v);
    v += shx_f<16>(v);
    { auto rr = __builtin_amdgcn_permlane32_swap(__float_as_uint(v), __float_as_uint(v), false, false); v = __uint_as_float(rr[0]) + __uint_as_float(rr[1]); }
    return v;
}
__device__ __forceinline__ float dot2(unsigned w, unsigned x, float acc) { return __builtin_amdgcn_fdot2_f32_bf16(__builtin_bit_cast(bf16x2_t, w), __builtin_bit_cast(bf16x2_t, x), acc, false); }
#define LDS_WAIT() asm volatile("s_waitcnt lgkmcnt(0)" ::: "memory")
#define VM_WAIT() asm volatile("s_waitcnt vmcnt(0)" ::: "memory")

namespace pg8 {
#define PG8_LAS __attribute__((address_space(3)))
typedef unsigned short bf16_t;
constexpr int BM = 256, BK = 64, HALF = 128, HTB = HALF * BK * 2, STAGE_BYTES = 8 * HTB, NXCD = 8, WGM = 8;
__host__ __device__ __forceinline__ int lds_byte(int r, int c) { const int st = (r >> 4) * 2 + (c >> 5), rr = r & 15, cc = c & 31, ob = rr * 64 + cc * 2; return st * 1024 + (ob ^ (((ob >> 9) & 1) << 5)); }
__host__ __device__ __forceinline__ void stage_rc(int b, int& R, int& C) { const int st = b / 1024, sb = b % 1024, swz = sb ^ (((sb >> 9) & 1) << 5); R = (st >> 1) * 16 + swz / 64; C = (st & 1) * 32 + (swz % 64) / 2; }
__host__ __device__ __forceinline__ int perm32(int rho) { const int n = rho >> 4, i = rho & 15; return 8 * (i >> 2) + 4 * n + (i & 3); }
struct Unit { int pm, pn; };
struct Gemm { const bf16_t* A; const bf16_t* Bt; int M, N, K; };
struct StaticOrder {
    int nM, nN, nwg, G, c;
    __host__ __device__ void init(int M, int N, int G_, int c_) { nM = M / BM; nN = N / BM; nwg = nM * nN; G = G_; c = c_; }
    __host__ __device__ bool next(int i, Unit& u) const {
        const long L = (long)i * G + c; if (L >= nwg) return false;
        int wgid = (int)L; { const int q = nwg / NXCD, r = nwg % NXCD, xcd = wgid % NXCD, off = wgid / NXCD; wgid = (xcd < r ? xcd * (q + 1) : r * (q + 1) + (xcd - r) * q) + off; }
        const int nig = WGM * nN, gid = wgid / nig, fm = gid * WGM, gsz = (nM - fm) < WGM ? (nM - fm) : WGM;
        u.pm = fm + ((wgid % nig) % gsz); u.pn = (wgid % nig) / gsz; return true;
    }
    __device__ __forceinline__ void a_ready(const Unit&) const {}
    __device__ __forceinline__ void done(const Unit&) const {}
};

struct EpiRowBf16 {
    static constexpr bool PERM = true, AFTER_DRAIN = false;
    bf16_t* O0; int ld0; bf16_t* O1; int ld1; int split; const float* rs; const float* ssq;
    __device__ __forceinline__ void operator()(const f32x4 (&acc)[2][2][4][2], const Unit& u, int wr, int wc, int fr, int fq) const {
        const int row0 = u.pm * BM + wr * 64 + fr; int colt = u.pn * BM; bf16_t* base = O0; int ldc = ld0;
        if (colt >= split) { base = O1; ldc = ld1; colt -= split; }
        const int col0 = colt + wc * 32 + 8 * fq;
#pragma unroll
        for (int ai = 0; ai < 2; ++ai)
#pragma unroll
            for (int m = 0; m < 4; ++m) { const int row = row0 + ai * HALF + m * 16; float sc = 1.f;
                if (rs) sc = rs[row];
                else if (ssq) { const f32x4* q = (const f32x4*)(ssq + (size_t)row * 16); const f32x4 a = q[0], b = q[1], c = q[2], d = q[3];
                    const float s = ((a[0] + a[1]) + (a[2] + a[3])) + ((b[0] + b[1]) + (b[2] + b[3])) + ((c[0] + c[1]) + (c[2] + c[3])) + ((d[0] + d[1]) + (d[2] + d[3]));
                    sc = __builtin_amdgcn_rsqf(s * (1.0f / 1024.0f) + EPS); }
                bf16_t* rowp = base + (size_t)row * ldc + col0;
#pragma unroll
                for (int bj = 0; bj < 2; ++bj) { const f32x4 v0 = acc[ai][bj][m][0] * sc, v1 = acc[ai][bj][m][1] * sc;
                    u32x4 w; w.x = cvtpk(v0[0], v0[1]); w.y = cvtpk(v0[2], v0[3]); w.z = cvtpk(v1[0], v1[1]); w.w = cvtpk(v1[2], v1[3]);
                    *(u32x4*)(rowp + bj * HALF) = w; } }
    }
};
struct EpiRes {
    static constexpr bool PERM = true, AFTER_DRAIN = false;
    bf16_t* xb; float* ssq;
    __device__ __forceinline__ void operator()(const f32x4 (&acc)[2][2][4][2], const Unit& u, int wr, int wc, int fr, int fq) const {
        const int row0 = u.pm * BM + wr * 64 + fr, col0 = u.pn * BM + wc * 32 + 8 * fq;
#pragma unroll
        for (int ai = 0; ai < 2; ++ai)
#pragma unroll
            for (int m = 0; m < 4; ++m) { const int row = row0 + ai * HALF + m * 16; bf16_t* p = xb + (size_t)row * DM + col0; float ss = 0.f;
#pragma unroll
                for (int bj = 0; bj < 2; ++bj) { const u32x4 r = *(const u32x4*)(p + bj * HALF); const f32x4 a0 = acc[ai][bj][m][0], a1 = acc[ai][bj][m][1];
                    const float o0 = bflo(r.x) + a0[0], o1 = bfhi(r.x) + a0[1], o2 = bflo(r.y) + a0[2], o3 = bfhi(r.y) + a0[3], o4 = bflo(r.z) + a1[0], o5 = bfhi(r.z) + a1[1], o6 = bflo(r.w) + a1[2], o7 = bfhi(r.w) + a1[3];
                    u32x4 w; w.x = cvtpk(o0, o1); w.y = cvtpk(o2, o3); w.z = cvtpk(o4, o5); w.w = cvtpk(o6, o7); *(u32x4*)(p + bj * HALF) = w;
                    ss += ((o0 * o0 + o1 * o1) + (o2 * o2 + o3 * o3)) + ((o4 * o4 + o5 * o5) + (o6 * o6 + o7 * o7)); }
                ss += __shfl_xor(ss, 16); ss += __shfl_xor(ss, 32);
                if (fq == 0) ssq[(size_t)row * 16 + u.pn * 4 + wc] = ss; }
    }
};
struct EpiKVQ {
    static constexpr bool PERM = true, AFTER_DRAIN = false;
    bf16_t* KR; bf16_t* VV; bf16_t* A3; float* KMP; const float* rs; const float* rope;
    __device__ __forceinline__ void operator()(const f32x4 (&acc)[2][2][4][2], const Unit& u, int wr, int wc, int fr, int fq) const {
        const int pn = u.pn, pm = u.pm, b = pm >> 4, s0 = (pm & 15) * 256, rl0 = wr * 64 + fr, g0 = 32 * wc + 8 * fq;
        float rsv[2][4];
#pragma unroll
        for (int ai = 0; ai < 2; ++ai)
#pragma unroll
            for (int m = 0; m < 4; ++m) rsv[ai][m] = rs[pm * BM + rl0 + ai * HALF + m * 16];
        if (pn < 4 || (pn >= 8 && pn < 12)) {
            const bool isK = pn < 4; const int hp = isK ? pn : pn - 8; const int i0 = 16 * wc + 4 * fq;
            f32x4 klo[2] = {{0.f, 0.f, 0.f, 0.f}, {0.f, 0.f, 0.f, 0.f}}, khi[2] = {{0.f, 0.f, 0.f, 0.f}, {0.f, 0.f, 0.f, 0.f}};
#pragma unroll
            for (int ai = 0; ai < 2; ++ai)
#pragma unroll
                for (int m = 0; m < 4; ++m) { const int rl = rl0 + ai * HALF + m * 16, s = s0 + rl;
                    const f32x4 cs0 = *(const f32x4*)(rope + ((size_t)s * 64 + i0) * 2), cs1 = *(const f32x4*)(rope + ((size_t)s * 64 + i0) * 2 + 4);
                    const f32x4 c = {cs0[0], cs0[2], cs1[0], cs1[2]}, sn = {cs0[1], cs0[3], cs1[1], cs1[3]};
#pragma unroll
                    for (int bj = 0; bj < 2; ++bj) { const int head = 2 * hp + bj;
                        const f32x4 v1 = acc[ai][bj][m][0] * rsv[ai][m], v2 = acc[ai][bj][m][1] * rsv[ai][m];
                        const f32x4 lo = v1 * c - v2 * sn, hi = v2 * c + v1 * sn;
                        u32x4 w; w.x = cvtpk(lo[0], lo[1]); w.y = cvtpk(lo[2], lo[3]); w.z = cvtpk(hi[0], hi[1]); w.w = cvtpk(hi[2], hi[3]);
                        bf16_t* dst = isK ? KR + ((size_t)(b * 8 + head) * SEQ + s) * 128 + g0 : A3 + (size_t)(pm * BM + rl) * MIXW + head * 128 + g0;
                        *(u32x4*)dst = w;
                        klo[bj] += lo; khi[bj] += hi; } }
            if (isK) {
#pragma unroll
                for (int bj = 0; bj < 2; ++bj) {
#pragma unroll
                    for (int j = 0; j < 4; ++j) {
#pragma unroll
                        for (int o = 1; o < 16; o <<= 1) { klo[bj][j] += __shfl_xor(klo[bj][j], o); khi[bj][j] += __shfl_xor(khi[bj][j], o); } }
                    if (fr == 0) { float* kp = KMP + ((size_t)pm * 2 + wr) * 1024 + (2 * hp + bj) * 128 + g0; *(f32x4*)kp = klo[bj]; *(f32x4*)(kp + 4) = khi[bj]; } } }
        } else {
            const bool isV = pn < 8;
#pragma unroll
            for (int bj = 0; bj < 2; ++bj)
#pragma unroll
                for (int ai = 0; ai < 2; ++ai)
#pragma unroll
                    for (int m = 0; m < 4; ++m) { const int rl = rl0 + ai * HALF + m * 16, s = s0 + rl;
                        const f32x4 v0 = acc[ai][bj][m][0] * rsv[ai][m], v1 = acc[ai][bj][m][1] * rsv[ai][m];
                        u32x4 w; w.x = cvtpk(v0[0], v0[1]); w.y = cvtpk(v0[2], v0[3]); w.z = cvtpk(v1[0], v1[1]); w.w = cvtpk(v1[2], v1[3]);
                        bf16_t* dst = isV ? VV + ((size_t)(b * 8 + 2 * (pn - 4) + bj) * SEQ + s) * 128 + g0 : A3 + (size_t)(pm * BM + rl) * MIXW + 1024 + (pn - 12) * 256 + bj * HALF + g0;
                        *(u32x4*)dst = w; }
        }
    }
};

template <class Epi, class Sched, bool ALIGN_EPI = true, bool SP2 = true>
__device__ __forceinline__ void gemm_phase(PG8_LAS unsigned char* lds, const Gemm g, const Sched& S, const Epi& E) {
    int tid = threadIdx.x; asm volatile("" : "+v"(tid));
    const int wid = __builtin_amdgcn_readfirstlane(tid >> 6), lane = tid & 63, wr = wid >> 2, wc = wid & 3, fr = lane & 15, fq = lane >> 4;
    const int K = g.K, nt = K / BK;
    unsigned voffA[2], voffB[2];
#pragma unroll
    for (int i = 0; i < 2; ++i) { int R, C; stage_rc(tid * 16 + i * 8192, R, C); const int Rb = Epi::PERM ? ((R & ~31) + perm32(R & 31)) : R;
        voffA[i] = (unsigned)(R * K + C) * 2u; voffB[i] = (unsigned)(Rb * K + C) * 2u; }
    const size_t kstep = (size_t)(BK * 2);
    const size_t hstep = (size_t)HALF * K * 2;
    const size_t tstep = 2 * hstep;
    const unsigned ldsw = (unsigned)wid * 1024u;
    const int aoff = lds_byte(wr * 64 + fr, fq * 8), boff = lds_byte(wc * 32 + fr, fq * 8);
#define PG8_SA(b, h) (((b) * 2 + (h)) * HTB)
#define PG8_SB(b, h) ((4 + (b) * 2 + (h)) * HTB)
#define PG8_STAGE(bufoff, gbase, voff) do { _Pragma("unroll") for (int _i = 0; _i < 2; ++_i) \
        __builtin_amdgcn_global_load_lds((const unsigned*)((const char*)(gbase) + (voff)[_i]), (PG8_LAS unsigned*)(lds + (bufoff) + ldsw + _i * 8192), 16, 0, 0); } while (0)
#define PG8_LDA(dst, b, h) do { _Pragma("unroll") for (int m = 0; m < 4; ++m) _Pragma("unroll") for (int k = 0; k < 2; ++k) dst[m][k] = *(const PG8_LAS bf16x8*)(lds + PG8_SA(b, h) + aoff + m * 2048 + k * 1024); } while (0)
#define PG8_LDB(dst, b, h) do { _Pragma("unroll") for (int n = 0; n < 2; ++n) _Pragma("unroll") for (int k = 0; k < 2; ++k) dst[n][k] = *(const PG8_LAS bf16x8*)(lds + PG8_SB(b, h) + boff + n * 2048 + k * 1024); } while (0)
#define PG8_MMA(ai, bj, At, Bt) do { __builtin_amdgcn_s_setprio(1); _Pragma("unroll") for (int m = 0; m < 4; ++m) _Pragma("unroll") for (int n = 0; n < 2; ++n) _Pragma("unroll") for (int k = 0; k < 2; ++k) \
        acc[ai][bj][m][n] = __builtin_amdgcn_mfma_f32_16x16x32_bf16(Bt[n][k], At[m][k], acc[ai][bj][m][n], 0, 0, 0); __builtin_amdgcn_s_setprio(0); } while (0)
#define PG8_WAIT_V(n) asm volatile("s_waitcnt vmcnt(" #n ")" ::: "memory")
#define PG8_WAIT_L(n) asm volatile("s_waitcnt lgkmcnt(" #n ")" ::: "memory")
#define PG8_BAR __builtin_amdgcn_s_barrier()
#define PG8_SCHED __builtin_amdgcn_sched_barrier(0)
    Unit cur, nxt; int ui = 0;
    if (!S.next(0, cur)) return;
    f32x4 acc[2][2][4][2];
#pragma unroll
    for (int a = 0; a < 2; ++a)
#pragma unroll
        for (int b = 0; b < 2; ++b)
#pragma unroll
            for (int m = 0; m < 4; ++m)
#pragma unroll
                for (int n = 0; n < 2; ++n) acc[a][b][m][n] = (f32x4){0.f, 0.f, 0.f, 0.f};
    bf16x8 At[4][2], B0[2][2], B1[2][2];
    const char* cA = (const char*)g.A + (size_t)cur.pm * tstep; const char* cB = (const char*)g.Bt + (size_t)cur.pn * tstep;
    S.a_ready(cur);
    if constexpr (SP2) {
        PG8_STAGE(PG8_SB(0, 0), cB, voffB); PG8_STAGE(PG8_SB(0, 1), cB + hstep, voffB); PG8_STAGE(PG8_SA(0, 0), cA, voffA); PG8_STAGE(PG8_SA(0, 1), cA + hstep, voffA);
        if (wr == 1) PG8_BAR;
        PG8_WAIT_V(2); PG8_BAR;
        PG8_STAGE(PG8_SB(1, 0), cB + kstep, voffB); PG8_STAGE(PG8_SA(1, 0), cA + kstep, voffA); PG8_STAGE(PG8_SB(1, 1), cB + hstep + kstep, voffB);
        PG8_WAIT_V(6); PG8_BAR;
    } else {
        PG8_STAGE(PG8_SB(0, 0), cB, voffB); PG8_STAGE(PG8_SA(0, 0), cA, voffA); PG8_STAGE(PG8_SB(0, 1), cB + hstep, voffB); PG8_STAGE(PG8_SA(0, 1), cA + hstep, voffA);
        if (wr == 1) PG8_BAR;
        PG8_WAIT_V(4); PG8_BAR;
        PG8_STAGE(PG8_SB(1, 0), cB + kstep, voffB); PG8_STAGE(PG8_SA(1, 0), cA + kstep, voffA); PG8_STAGE(PG8_SB(1, 1), cB + hstep + kstep, voffB);
        PG8_WAIT_V(6); PG8_BAR;
    }
    for (;;) {
        const bool has_next = S.next(ui + 1, nxt);
        const char* nA = has_next ? (const char*)g.A + (size_t)nxt.pm * tstep : cA; const char* nB = has_next ? (const char*)g.Bt + (size_t)nxt.pn * tstep : cB;
        for (int t = 0; t < nt; t += 2) {
            const bool last = (t == nt - 2);
            const char* a1 = cA + (size_t)(t + 1) * kstep;
            const char* a2 = last ? nA : cA + (size_t)(t + 2) * kstep; const char* b2 = last ? nB : cB + (size_t)(t + 2) * kstep;
            const char* a3 = a2 + kstep; const char* b3 = b2 + kstep;
            if (last && has_next) S.a_ready(nxt);
            if constexpr (SP2) {
            PG8_LDB(B0, 0, 0); PG8_LDB(B1, 0, 1); PG8_SCHED; PG8_LDA(At, 0, 0); PG8_STAGE(PG8_SA(1, 1), a1 + hstep, voffA);
            PG8_WAIT_V(8); PG8_WAIT_L(0); PG8_BAR; PG8_MMA(0, 0, At, B0); PG8_MMA(0, 1, At, B1); PG8_BAR; PG8_SCHED;
            PG8_LDA(At, 0, 1); PG8_STAGE(PG8_SB(0, 0), b2, voffB); PG8_STAGE(PG8_SB(0, 1), b2 + hstep, voffB); PG8_STAGE(PG8_SA(0, 0), a2, voffA);
            PG8_WAIT_V(8); PG8_WAIT_L(0); PG8_BAR; PG8_MMA(1, 0, At, B0); PG8_MMA(1, 1, At, B1); PG8_BAR; PG8_SCHED;
            PG8_LDB(B0, 1, 0); PG8_LDB(B1, 1, 1); PG8_SCHED; PG8_LDA(At, 1, 0); PG8_STAGE(PG8_SA(0, 1), a2 + hstep, voffA);
            PG8_WAIT_V(8); PG8_WAIT_L(0); PG8_BAR; PG8_MMA(0, 0, At, B0); PG8_MMA(0, 1, At, B1); PG8_BAR; PG8_SCHED;
            PG8_LDA(At, 1, 1); PG8_STAGE(PG8_SB(1, 0), b3, voffB); PG8_STAGE(PG8_SB(1, 1), b3 + hstep, voffB); PG8_STAGE(PG8_SA(1, 0), a3, voffA);
            PG8_WAIT_V(8); PG8_WAIT_L(0); PG8_BAR; PG8_MMA(1, 0, At, B0); PG8_MMA(1, 1, At, B1); PG8_BAR; PG8_SCHED;
            } else {
            PG8_LDB(B0, 0, 0); PG8_SCHED; PG8_LDA(At, 0, 0); PG8_STAGE(PG8_SA(1, 1), a1 + hstep, voffA);
            PG8_WAIT_L(8); PG8_BAR; PG8_WAIT_L(0); PG8_MMA(0, 0, At, B0); PG8_BAR; PG8_SCHED;
            PG8_LDB(B1, 0, 1); PG8_STAGE(PG8_SB(0, 0), b2, voffB);
            PG8_BAR; PG8_WAIT_L(0); PG8_MMA(0, 1, At, B1); PG8_BAR;
            PG8_LDA(At, 0, 1); PG8_STAGE(PG8_SA(0, 0), a2, voffA);
            PG8_BAR; PG8_WAIT_L(0); PG8_MMA(1, 0, At, B0); PG8_BAR; PG8_SCHED;
            PG8_STAGE(PG8_SB(0, 1), b2 + hstep, voffB);
            PG8_WAIT_V(6); PG8_BAR; PG8_MMA(1, 1, At, B1); PG8_BAR;
            PG8_LDB(B0, 1, 0); PG8_SCHED; PG8_LDA(At, 1, 0); PG8_STAGE(PG8_SA(0, 1), a2 + hstep, voffA);
            PG8_WAIT_L(8); PG8_BAR; PG8_WAIT_L(0); PG8_MMA(0, 0, At, B0); PG8_BAR; PG8_SCHED;
            PG8_LDB(B1, 1, 1); PG8_STAGE(PG8_SB(1, 0), b3, voffB);
            PG8_BAR; PG8_WAIT_L(0); PG8_MMA(0, 1, At, B1); PG8_BAR;
            PG8_LDA(At, 1, 1); PG8_STAGE(PG8_SA(1, 0), a3, voffA);
            PG8_BAR; PG8_WAIT_L(0); PG8_MMA(1, 0, At, B0); PG8_BAR; PG8_SCHED;
            PG8_STAGE(PG8_SB(1, 1), b3 + hstep, voffB);
            PG8_WAIT_V(6); PG8_BAR; PG8_MMA(1, 1, At, B1); PG8_BAR;
            }
        }
        if constexpr (ALIGN_EPI) { if (wr == 0) PG8_BAR; }
        if constexpr (!Epi::AFTER_DRAIN) { E(acc, cur, wr, wc, fr, fq); S.done(cur); }
        if (!has_next) break;
#pragma unroll
        for (int a = 0; a < 2; ++a)
#pragma unroll
            for (int b = 0; b < 2; ++b)
#pragma unroll
                for (int m = 0; m < 4; ++m)
#pragma unroll
                    for (int n = 0; n < 2; ++n) acc[a][b][m][n] = (f32x4){0.f, 0.f, 0.f, 0.f};
        cur = nxt; cA = nA; cB = nB; ++ui;
        if constexpr (ALIGN_EPI) { if (wr == 1) PG8_BAR; }
    }
    PG8_WAIT_V(0);
    if constexpr (!ALIGN_EPI) { if (wr == 0) PG8_BAR; }
    PG8_BAR;
#undef PG8_SA
#undef PG8_SB
#undef PG8_STAGE
#undef PG8_LDA
#undef PG8_LDB
#undef PG8_MMA
#undef PG8_WAIT_V
#undef PG8_WAIT_L
#undef PG8_BAR
#undef PG8_SCHED
}
}

namespace att {
constexpr int D = 128, NW = 8, QBLK = 32, KVBLK = 64;
constexpr float SCALE = 0.088388347648318440f;
constexpr float THR = 8.f;
constexpr size_t SHM_V = KVBLK * D * 2, SHM_K = KVBLK * D * 2, SHM_ATTN = 2 * SHM_V + 2 * SHM_K + NW * 64 * 4;
#define KSWZ(row, colB) ((row) * 256 + ((colB) ^ (((row) & 7) << 4)))
#define SBAR() __builtin_amdgcn_sched_barrier(0)
__device__ __forceinline__ int crow(int r, int hi) { return (r & 3) + 8 * (r >> 2) + 4 * hi; }

template <bool MOBA>
__device__ __forceinline__ void partialSM(f32x16& p0, f32x16& p1, float& m_reg, float& mn, float& alpha, int t, int qrow, int hi, unsigned selmask) {
  constexpr float C = SCALE * 1.4426950408889634f;
  if constexpr (MOBA) {
    if (t < 4) { const int kb = t * 64 + 4 * hi;
#pragma unroll
      for (int r = 0; r < 16; ++r) { const int kk = kb + (r & 3) + 8 * (r >> 2); p0[r] = (kk > qrow) ? -1e30f : p0[r]; p1[r] = (kk + 32 > qrow) ? -1e30f : p1[r]; }
    } else { const bool keep = (selmask >> ((t - 4) >> 2)) & 1u;
#pragma unroll
      for (int r = 0; r < 16; ++r) { p0[r] = keep ? p0[r] : -1e30f; p1[r] = keep ? p1[r] : -1e30f; } }
  }
  float pmax = p0[0];
#pragma unroll
  for (int r = 1; r < 16; ++r) pmax = fmaxf(pmax, p0[r]);
#pragma unroll
  for (int r = 0; r < 16; ++r) pmax = fmaxf(pmax, p1[r]);
  { auto rr = __builtin_amdgcn_permlane32_swap(__float_as_uint(pmax), __float_as_uint(pmax), false, false);
    pmax = fmaxf(__uint_as_float(rr[0]), __uint_as_float(rr[1])); }
  if (__builtin_expect(__all(pmax - m_reg <= THR / SCALE), 1)) { mn = m_reg; alpha = 1.f; }
  else { mn = fmaxf(m_reg, pmax); alpha = __builtin_amdgcn_exp2f((m_reg - mn) * C); m_reg = mn; }
  float mnC = -mn * C;
#pragma unroll
  for (int r = 0; r < 16; ++r) p0[r] = fmaf(p0[r], C, mnC);
#pragma unroll
  for (int r = 0; r < 16; ++r) p1[r] = fmaf(p1[r], C, mnC);
#pragma unroll
  for (int r = 0; r < 16; ++r) p0[r] = __builtin_amdgcn_exp2f(p0[r]);
}
__device__ __forceinline__ void finishSM(f32x16& p0, f32x16& p1, float alpha, float& l_reg, bf16x8& pa0, bf16x8& pa1, bf16x8& pa2, bf16x8& pa3) {
#pragma unroll
  for (int r = 0; r < 16; ++r) p1[r] = __builtin_amdgcn_exp2f(p1[r]);
  float ps = 0;
#pragma unroll
  for (int r = 0; r < 16; ++r) ps += p0[r];
#pragma unroll
  for (int r = 0; r < 16; ++r) ps += p1[r];
  { auto rr = __builtin_amdgcn_permlane32_swap(__float_as_uint(ps), __float_as_uint(ps), false, false);
    ps = __uint_as_float(rr[0]) + __uint_as_float(rr[1]); }
  l_reg = l_reg * alpha + ps;
#define PK4(P, BASE, OUT) do { unsigned a0 = cvtpk(P[BASE + 0], P[BASE + 1]), a1 = cvtpk(P[BASE + 2], P[BASE + 3]);   \
    unsigned b0 = cvtpk(P[BASE + 4], P[BASE + 5]), b1 = cvtpk(P[BASE + 6], P[BASE + 7]);                              \
    auto r0 = __builtin_amdgcn_permlane32_swap(a0, b0, false, false); auto r1 = __builtin_amdgcn_permlane32_swap(a1, b1, false, false); \
    u32x4 w = {r0[0], r1[0], r0[1], r1[1]}; OUT = *reinterpret_cast<bf16x8*>(&w); } while (0)
  PK4(p0, 0, pa0); PK4(p0, 8, pa1); PK4(p1, 0, pa2); PK4(p1, 8, pa3);
#undef PK4
}
__device__ __forceinline__ void qkt(f32x16& p0, f32x16& p1, const char* Ks, const bf16x8* qr, const int (&ka)[4]) {
  p0 = f32x16{}; p1 = f32x16{};
#pragma unroll
  for (int d0 = 0; d0 < 8; ++d0) {
    bf16x8 b0 = *reinterpret_cast<const bf16x8*>(Ks + ka[d0 & 3] + (d0 >> 2) * 128);
    bf16x8 b1 = *reinterpret_cast<const bf16x8*>(Ks + ka[d0 & 3] + (d0 >> 2) * 128 + 8192);
    p0 = __builtin_amdgcn_mfma_f32_32x32x16_bf16(b0, qr[d0], p0, 0, 0, 0);
    p1 = __builtin_amdgcn_mfma_f32_32x32x16_bf16(b1, qr[d0], p1, 0, 0, 0); }
}
__device__ __forceinline__ void qkt1(f32x16& p0, const char* Ks, const bf16x8* qr, const int (&ka)[4]) {
  p0 = f32x16{};
#pragma unroll
  for (int d0 = 0; d0 < 8; ++d0) {
    bf16x8 b0 = *reinterpret_cast<const bf16x8*>(Ks + ka[d0 & 3] + (d0 >> 2) * 128);
    p0 = __builtin_amdgcn_mfma_f32_32x32x16_bf16(b0, qr[d0], p0, 0, 0, 0); }
}
__device__ __forceinline__ int v_st(int k, int c) { const int kk = (k & ~0xC) | ((k & 4) << 1) | ((k & 8) >> 1); return ((kk >> 3) * 4 + (c >> 5)) * 512 + ((kk & 7) * 32 + (c & 31)) * 2; }
__device__ __forceinline__ int v_rd_base(int lane) { return ((lane & 3) << 3) | (((lane >> 2) & 3) << 6) | (((lane >> 4) & 1) << 5) | (((lane >> 5) & 1) << 8); }
constexpr int v_rd_off(int d0, int ks, int half) { return d0 * 512 + ks * 4096 + half * 2048; }
template <int OFF> __device__ __forceinline__ s16x4 tr_read(int vb) {
  s16x4 r; asm volatile("ds_read_b64_tr_b16 %0, %1 offset:%2" : "=&v"(r) : "v"(vb), "i"(OFF) : "memory"); return r;
}
template <int D0> __device__ __forceinline__ void pv_one(f32x16& od, int vb, bf16x8 pa0, bf16x8 pa1, bf16x8 pa2, bf16x8 pa3) {
  const s16x4 l0 = tr_read<v_rd_off(D0, 0, 0)>(vb), h0 = tr_read<v_rd_off(D0, 0, 1)>(vb), l1 = tr_read<v_rd_off(D0, 1, 0)>(vb), h1 = tr_read<v_rd_off(D0, 1, 1)>(vb);
  const s16x4 l2 = tr_read<v_rd_off(D0, 2, 0)>(vb), h2 = tr_read<v_rd_off(D0, 2, 1)>(vb), l3 = tr_read<v_rd_off(D0, 3, 0)>(vb), h3 = tr_read<v_rd_off(D0, 3, 1)>(vb);
  asm volatile("s_waitcnt lgkmcnt(0)" ::: "memory"); SBAR();
#define PK(L, H) (bf16x8){L[0], L[1], L[2], L[3], H[0], H[1], H[2], H[3]}
  od = __builtin_amdgcn_mfma_f32_32x32x16_bf16(pa0, PK(l0, h0), od, 0, 0, 0);
  od = __builtin_amdgcn_mfma_f32_32x32x16_bf16(pa1, PK(l1, h1), od, 0, 0, 0);
  od = __builtin_amdgcn_mfma_f32_32x32x16_bf16(pa2, PK(l2, h2), od, 0, 0, 0);
  od = __builtin_amdgcn_mfma_f32_32x32x16_bf16(pa3, PK(l3, h3), od, 0, 0, 0);
#undef PK
}
__device__ __forceinline__ void pv_d0(f32x16* o, int vb, bf16x8 pa0, bf16x8 pa1, bf16x8 pa2, bf16x8 pa3) {
  pv_one<0>(o[0], vb, pa0, pa1, pa2, pa3); pv_one<1>(o[1], vb, pa0, pa1, pa2, pa3); pv_one<2>(o[2], vb, pa0, pa1, pa2, pa3); pv_one<3>(o[3], vb, pa0, pa1, pa2, pa3);
}

template <int LDQ, int LDK, bool MOBA, int SDEPTH>
__device__ __forceinline__ void attn_unit(const bf16* Qb, const bf16* Kh, const bf16* Vh, bf16* Ob, int jblk, const float* kmp, char* lds) {
  int tid = threadIdx.x; asm volatile("" : "+v"(tid));
  const int wid = __builtin_amdgcn_readfirstlane(tid >> 6), lane = tid & 63, r32 = lane & 31, hi = lane >> 5;
  char* V_lds = lds; char* K_lds = lds + 2 * SHM_V;
  float* ws = (float*)(lds + 2 * SHM_V + 2 * SHM_K) + wid * 64; float* li_l = ws; float* al_l = ws + 32;
  float m_reg = -1e30f, l_reg = 0; f32x16 o[4] = {}; bf16x8 qr[8];
  const bf16* Qw = Qb + (long)(wid * QBLK + r32) * LDQ + hi * 8;
#pragma unroll
  for (int d0 = 0; d0 < 8; ++d0) qr[d0] = *reinterpret_cast<const bf16x8*>(Qw + d0 * 16);
  const int sr = tid >> 4, sc = (tid & 15) * 8, vst0 = v_st(sr, sc), vst1 = v_st(32 + sr, sc);
  const unsigned goff = (unsigned)(sr * LDK + sc) * 2u;
  const int vb0 = (int)(uintptr_t)V_lds + v_rd_base(lane);
  const int qrow = wid * QBLK + r32;
  int ka[4];
#pragma unroll
  for (int i = 0; i < 4; ++i) ka[i] = r32 * 256 + (((2 * i + hi) ^ (r32 & 7)) << 4);
  unsigned selmask = 0;
  struct { bf16x8 vs0, vs1, ks0, ks1; } sr_[SDEPTH];
  const int NT = MOBA ? 4 * (jblk + 1) : 4;
#define KOFF(t) (MOBA ? ((t) < 4 ? jblk * 256 + (t) * 64 : ((t) - 4) * 64) : (t) * 64)
#define SLOAD(i, k0) do { const char* kb_ = (const char*)Kh + (size_t)(k0) * (LDK * 2); const char* vb_ = (const char*)Vh + (size_t)(k0) * (LDK * 2); \
    sr_[i].vs0 = *reinterpret_cast<const bf16x8*>(vb_ + goff); sr_[i].vs1 = *reinterpret_cast<const bf16x8*>(vb_ + 32 * LDK * 2 + goff); \
    sr_[i].ks0 = *reinterpret_cast<const bf16x8*>(kb_ + goff); sr_[i].ks1 = *reinterpret_cast<const bf16x8*>(kb_ + 32 * LDK * 2 + goff); } while (0)
#define SWRITE(b, i) do { *(bf16x8*)(V_lds + (b) * SHM_V + vst0) = sr_[i].vs0;          \
    *(bf16x8*)(V_lds + (b) * SHM_V + vst1) = sr_[i].vs1; int kc = sc * 2;               \
    *(bf16x8*)(K_lds + (b) * SHM_K + KSWZ(sr, kc)) = sr_[i].ks0;                       \
    *(bf16x8*)(K_lds + (b) * SHM_K + KSWZ(32 + sr, kc)) = sr_[i].ks1; } while (0)
#define SWAIT() do { if constexpr (SDEPTH == 2) asm volatile("s_waitcnt vmcnt(4)" ::: "memory"); else asm volatile("s_waitcnt vmcnt(0)" ::: "memory"); } while (0)
#define RESC(a) do { if (__any((a) < 1.f)) { if (hi == 0) al_l[r32] = (a); asm volatile("s_waitcnt lgkmcnt(0)" ::: "memory"); \
    _Pragma("unroll") for (int d = 0; d < 4; ++d) _Pragma("unroll") for (int r = 0; r < 16; ++r) o[d][r] *= al_l[crow(r, hi)]; } } while (0)
  f32x16 pA0, pA1, pB0, pB1; float mnA, mnB, alA, alB; bf16x8 pa0, pa1, pa2, pa3;
  constexpr int SE = 0, SO = SDEPTH - 1;
  SLOAD(SE, KOFF(0));
  if constexpr (MOBA) {
    const int gr = tid >> 4, gc = (tid & 15) * 8; f32x4 a = {0.f, 0.f, 0.f, 0.f}, b = {0.f, 0.f, 0.f, 0.f};
    if (gr < jblk) { const float* p0_ = kmp + (size_t)gr * 2048 + gc; const f32x4 a0 = *(const f32x4*)p0_, a1 = *(const f32x4*)(p0_ + 4), b0 = *(const f32x4*)(p0_ + 1024), b1 = *(const f32x4*)(p0_ + 1028);
      a = (a0 + b0) * (1.0f / 256.0f); b = (a1 + b1) * (1.0f / 256.0f); }
    u32x4 w = {pk2(a[0], a[1]), pk2(a[2], a[3]), pk2(b[0], b[1]), pk2(b[2], b[3])};
    *(u32x4*)(K_lds + SHM_K + KSWZ(gr, gc * 2)) = w;
  }
  asm volatile("s_waitcnt vmcnt(0)" ::: "memory"); SWRITE(0, SE); __syncthreads();
  qkt(pA0, pA1, K_lds, qr, ka);
  if constexpr (MOBA) {
    f32x16 g; qkt1(g, K_lds + SHM_K, qr, ka);
    float gv[16];
#pragma unroll
    for (int r = 0; r < 8; ++r) { auto rr = __builtin_amdgcn_permlane32_swap(__float_as_uint(g[r]), __float_as_uint(g[r]), false, false);
      const float lo_ = __uint_as_float(rr[0]), hi_ = __uint_as_float(rr[1]);
      const int n0 = (r & 3) + 8 * (r >> 2); gv[n0] = lo_; gv[n0 + 4] = hi_; }
#pragma unroll
    for (int n = 0; n < 16; ++n) gv[n] = (n < jblk) ? gv[n] : -3e38f;
#pragma unroll
    for (int k = 0; k < 3; ++k) { float best = gv[0];
#pragma unroll
      for (int n = 1; n < 16; ++n) best = fmaxf(best, gv[n]);
      int idx = 16;
#pragma unroll
      for (int n = 15; n >= 0; --n) idx = (gv[n] == best) ? n : idx;
      if (best > -1e38f) selmask |= 1u << idx;
#pragma unroll
      for (int n = 0; n < 16; ++n) gv[n] = (n == idx) ? -3e38f : gv[n]; }
  }
  partialSM<MOBA>(pA0, pA1, m_reg, mnA, alA, 0, qrow, hi, selmask);
  SLOAD(SO, KOFF(1)); if constexpr (SDEPTH == 2) { if (2 < NT) SLOAD(SE, KOFF(2)); }
  if constexpr (MOBA) __syncthreads();
  SWAIT(); SWRITE(1, SO); __syncthreads();
  for (int j = 1; j + 1 < NT; j += 2) {
    SBAR(); qkt(pB0, pB1, K_lds + SHM_K, qr, ka);
    finishSM(pA0, pA1, alA, l_reg, pa0, pa1, pa2, pa3); SBAR();
    SLOAD(SO, KOFF(j + SDEPTH)); SBAR();
    pv_d0(o, vb0, pa0, pa1, pa2, pa3); partialSM<MOBA>(pB0, pB1, m_reg, mnB, alB, j, qrow, hi, selmask);
    __syncthreads(); SWAIT(); SWRITE(0, SE);
    RESC(alB); __syncthreads();
    SBAR(); qkt(pA0, pA1, K_lds, qr, ka);
    finishSM(pB0, pB1, alB, l_reg, pa0, pa1, pa2, pa3); SBAR();
    if (SDEPTH == 1 || j + 3 < NT) SLOAD(SE, KOFF(j + 1 + SDEPTH)); SBAR();
    pv_d0(o, vb0 + (int)SHM_V, pa0, pa1, pa2, pa3); partialSM<MOBA>(pA0, pA1, m_reg, mnA, alA, j + 1, qrow, hi, selmask);
    __syncthreads(); SWAIT(); SWRITE(1, SO);
    RESC(alA); __syncthreads();
  }
  SBAR(); qkt(pB0, pB1, K_lds + SHM_K, qr, ka);
  finishSM(pA0, pA1, alA, l_reg, pa0, pa1, pa2, pa3); SBAR();
  pv_d0(o, vb0, pa0, pa1, pa2, pa3); partialSM<MOBA>(pB0, pB1, m_reg, mnB, alB, NT - 1, qrow, hi, selmask);
  __syncthreads(); RESC(alB);
  finishSM(pB0, pB1, alB, l_reg, pa0, pa1, pa2, pa3); SBAR();
  pv_d0(o, vb0 + (int)SHM_V, pa0, pa1, pa2, pa3);
  if (hi == 0) li_l[r32] = l_reg; asm volatile("s_waitcnt lgkmcnt(0)" ::: "memory");
  float rli[16];
#pragma unroll
  for (int r = 0; r < 16; ++r) rli[r] = __builtin_amdgcn_rcpf(li_l[crow(r, hi)]);
  __syncthreads();
  char* ost = lds + wid * 8192;
#pragma unroll
  for (int r = 0; r < 16; ++r) { const int orow = crow(r, hi);
#pragma unroll
    for (int d0 = 0; d0 < 4; ++d0) *(unsigned short*)(ost + orow * 256 + (d0 * 32 + r32) * 2) = (unsigned short)f2bf(o[d0][r] * rli[r]); }
  asm volatile("s_waitcnt lgkmcnt(0)" ::: "memory");
  bf16* Ow = Ob + (long)(wid * QBLK) * LDQ;
#pragma unroll
  for (int i = 0; i < 8; ++i) { const int row = i * 4 + (lane >> 4), ch = lane & 15; const u32x4 v = *(const u32x4*)(ost + row * 256 + ch * 16);
    *(u32x4*)(Ow + (long)row * LDQ + ch * 8) = v; }
  __syncthreads();
#undef KOFF
#undef SLOAD
#undef SWRITE
#undef SWAIT
#undef RESC
}
}

#ifndef ATT_SD_MEM
#define ATT_SD_MEM 1
#endif
#ifndef ATT_SD_MOBA
#define ATT_SD_MOBA 1
#endif
struct Args {
    const float* in[16]; float* out; unsigned char* ws; int ph_lo, ph_hi;
};
struct Frame {
    LAS unsigned char* lds; char* ldsg;
    int wave, vcu, G;
};
__device__ __forceinline__ int fresh_tid() { int t = threadIdx.x; asm volatile("" : "+v"(t)); return t; }

template <int MAP>
__device__ __forceinline__ void transpose_item(const float* W, int ldw, bf16* dst, int ldd, int row_off, int koff, const float* sc, LAS float* scr, int kb, int nb, int lane) {
    const int k0 = 64 * kb, n0 = 32 * nb;
#pragma unroll 8
    for (int i = 0; i < 32; ++i) { const int kk = 2 * i + (lane >> 5); float v = W[(size_t)(k0 + kk) * ldw + n0 + (lane & 31)]; if (sc) v *= sc[k0 + kk]; scr[kk * 33 + (lane & 31)] = v; }
    LDS_WAIT(); asm volatile("" ::: "memory");
    const int c = lane & 7;
#pragma unroll
    for (int j = 0; j < 4; ++j) { const int n = (lane >> 3) + 8 * j; const LAS float* s = scr + (8 * c) * 33 + n;
        u32x4 o; o.x = pk2(s[0 * 33], s[1 * 33]); o.y = pk2(s[2 * 33], s[3 * 33]); o.z = pk2(s[4 * 33], s[5 * 33]); o.w = pk2(s[6 * 33], s[7 * 33]);
        const int ns = n0 + n; int row;
        if (MAP == 1 && ns < 1024) { const int d = ns & 127; row = row_off + (ns & ~127) + 32 * ((d >> 4) & 3) + 8 * ((d >> 2) & 3) + 4 * (d >> 6) + (d & 3); } else row = row_off + ns;
        *(u32x4*)(dst + (size_t)row * ldd + koff + k0 + 8 * c) = o; }
    LDS_WAIT(); asm volatile("" ::: "memory");
}

template <int PART> __device__ __forceinline__ void phase0(const Args& a, Frame& F, int tb_lo, int tb_hi) {
    unsigned char* ws = a.ws;
    const int lane = fresh_tid() & 63;
    const int gw = F.vcu * NWAVES + F.wave, NGW = F.G * NWAVES;
    const int gt = gw * 64 + lane, NGT = NGW * 64;
    LAS float* scr = (LAS float*)(F.lds + F.wave * 16384);
    const float* x = a.in[0]; const float* mem = a.in[1]; const float* g_mix = a.in[2]; const float* w_in = a.in[3]; const float* w_out = a.in[4]; const float* w_mkv = a.in[5];
    const float* pool_w = a.in[6]; const float* pool_sc = a.in[7]; const float* g_kv = a.in[8]; const float* w_kv = a.in[9]; const float* g_ffn = a.in[10]; const float* wq = a.in[11];
    const float* subk = a.in[12]; const float* pu = a.in[13]; const float* pv = a.in[14];
    constexpr int I1 = 16 * 48, I2 = 16 * 48, I3 = 16 * 64, I4 = 8 * 32, I5 = 24 * 32, I6 = 2 * 16 * 32, I7 = 2 * 16 * 64;
    if (PART == 0) for (int r = gw; r < I6; r += NGW) { const int l = r / 512, q = r % 512; transpose_item<0>(w_mkv + (size_t)l * DM * 1024, 1024, (bf16*)(ws + WS_WMKV), DM, l * 1024, 0, nullptr, scr, q / 32, q % 32, lane); }
    constexpr int NIT = I1 + I2 + I3 + I4 + I5 + I7;
    if (PART == 1) for (int it = gw; it < NIT; it += NGW) {
        int r = it;
        if (r < I1) { transpose_item<0>(w_in, MIXW, (bf16*)(ws + WS_WIN0), DM, 0, 0, g_mix, scr, r / 48, r % 48, lane); continue; } r -= I1;
        if (r < I2) { transpose_item<1>(w_in + (size_t)DM * MIXW, MIXW, (bf16*)(ws + WS_WC4), DM, 2048, 0, g_mix + DM, scr, r / 48, r % 48, lane); continue; } r -= I2;
        if (r < I3) { transpose_item<1>(w_kv, 2048, (bf16*)(ws + WS_WC4), DM, 0, 0, g_kv, scr, r / 64, r % 64, lane); continue; } r -= I3;
        if (r < I4) { transpose_item<0>(w_out + (size_t)1024 * DM, DM, (bf16*)(ws + WS_WC0), MIXW, 0, 1024, nullptr, scr, r / 32, r % 32, lane); continue; } r -= I4;
        if (r < I5) { transpose_item<0>(w_out + (size_t)MIXW * DM, DM, (bf16*)(ws + WS_WOUT1), MIXW, 0, 0, nullptr, scr, r / 32, r % 32, lane); continue; } r -= I5;
        { const int l = r / 1024, q = r % 1024; transpose_item<0>(wq + (size_t)l * DM * 2048, 2048, (bf16*)(ws + (l ? WS_WQ1 : WS_WQ0)), DM, 0, 0, g_ffn + l * DM, scr, q / 64, q % 64, lane); }
    }
    if (PART == 1) for (int it = gw; it < 2048; it += NGW) {
        const int itu = __builtin_amdgcn_readfirstlane(it); const int g = itu >> 9, cg8 = (itu >> 4) & 31, nch = itu & 15; const int n = nch * 64 + lane;
        float acc[8];
#pragma unroll
        for (int i = 0; i < 8; ++i) acc[i] = 0.f;
        const float* pw = pool_w + ((size_t)g * 256 + cg8 * 8) * 256;
#pragma unroll 1
        for (int k = 0; k < 4; ++k) { float cf[8]; const float sc = pool_sc[g * 256 + k * 64 + lane];
#pragma unroll
            for (int i = 0; i < 8; ++i) cf[i] = pw[i * 256 + k * 64 + lane] * sc;
            float wv[64];
#pragma unroll
            for (int l = 0; l < 64; ++l) wv[l] = w_out[(size_t)(g * 256 + k * 64 + l) * DM + n];
#pragma unroll
            for (int l = 0; l < 64; ++l) {
#pragma unroll
                for (int i = 0; i < 8; ++i) acc[i] = fmaf(__builtin_bit_cast(float, __builtin_amdgcn_readlane(__builtin_bit_cast(int, cf[i]), l)), wv[l], acc[i]); } }
        u32x4 o; o.x = pk2(acc[0], acc[1]); o.y = pk2(acc[2], acc[3]); o.z = pk2(acc[4], acc[5]); o.w = pk2(acc[6], acc[7]);
        *(u32x4*)((bf16*)(ws + WS_WC0) + (size_t)n * MIXW + g * 256 + cg8 * 8) = o;
    }
    {
        const size_t n8a = (size_t)2 * 16 * 128 * 128 / 8, n8b = (size_t)2048 * 1024 / 8;
        if (PART < 2) for (size_t i = (PART == 0 ? n8a : 0) + gt; i < (PART == 0 ? n8a + n8b : n8a); i += NGT) { const bool A = i < n8a; const size_t j = A ? i : i - n8a; const float* src = (A ? subk : mem) + j * 8; bf16* dst = (bf16*)(ws + (A ? WS_SUBK : WS_MEMB)) + j * 8;
            const f32x4 v0 = *(const f32x4*)src, v1 = *(const f32x4*)(src + 4); u32x4 o = {pk2(v0[0], v0[1]), pk2(v0[2], v0[3]), pk2(v1[0], v1[1]), pk2(v1[2], v1[3])}; *(u32x4*)dst = o; }
    }
    if (PART == 2) for (int r = tb_lo + F.wave; r < tb_hi; r += NWAVES) { const int tb = r / (2 * NEXP), rr = r % (2 * NEXP), l = rr / NEXP;
        const f32x4* src = (const f32x4*)((tb ? pv : pu) + (size_t)rr * DM) + lane; f32x4 v[4];
#pragma unroll
        for (int i = 0; i < 4; ++i) v[i] = src[64 * i];
        if (!tb) { const f32x4* gp = (const f32x4*)(g_ffn + l * DM) + lane;
#pragma unroll
            for (int i = 0; i < 4; ++i) v[i] *= gp[64 * i]; }
        float am = 0.f;
#pragma unroll
        for (int i = 0; i < 4; ++i) am = fmaxf(fmaxf(fmaxf(am, fabsf(v[i][0])), fmaxf(fabsf(v[i][1]), fabsf(v[i][2]))), fabsf(v[i][3]));
#pragma unroll
        for (int o = 1; o < 64; o <<= 1) am = fmaxf(am, __shfl_xor(am, o));
        const int eb = (int)((__builtin_bit_cast(unsigned, am) >> 23) & 0xffu);
        const float sc = (eb < 16) ? 1.0f : __builtin_bit_cast(float, (unsigned)(127 + 7 + 127 - eb) << 23);
        const float isc = (eb < 16) ? 1.0f : __builtin_bit_cast(float, (unsigned)(eb - 7) << 23);
        unsigned* dst = (unsigned*)(ws + (tb ? WS_VB : WS_UB) + (size_t)rr * DM) + lane;
#pragma unroll
        for (int i = 0; i < 4; ++i) { int w = __builtin_amdgcn_cvt_pk_fp8_f32(v[i][0] * sc, v[i][1] * sc, 0, false); w = __builtin_amdgcn_cvt_pk_fp8_f32(v[i][2] * sc, v[i][3] * sc, w, true); dst[64 * i] = (unsigned)w; }
        if (lane == 0) ((float*)(ws + (tb ? WS_VSC : WS_USC)))[rr] = isc; }
    if (PART == 2) for (int i = gt; i < SEQ * 64; i += NGT) { const int pos = i >> 6, fi = i & 63; const float inv = exp2f(-(float)fi * 0.20762050593046015f);
        float sn, cs_; sincosf((float)pos * inv, &sn, &cs_); f32x2 cs = {cs_, sn}; *(f32x2*)((float*)(ws + WS_ROPE) + (size_t)i * 2) = cs; }
    if (PART == 2) for (int t = gw; t < T; t += NGW) { const f32x4* xr = (const f32x4*)(x + (size_t)t * DM) + lane; f32x4 v[4]; float s = 0.f;
#pragma unroll
        for (int j = 0; j < 4; ++j) { v[j] = xr[64 * j]; s += (v[j][0] * v[j][0] + v[j][1] * v[j][1]) + (v[j][2] * v[j][2] + v[j][3] * v[j][3]); }
        s = wave_sum(s);
        u32x2* o8 = (u32x2*)((bf16*)(ws + WS_XB) + (size_t)t * DM) + lane;
#pragma unroll
        for (int j = 0; j < 4; ++j) { u32x2 w = {pk2(v[j][0], v[j][1]), pk2(v[j][2], v[j][3])}; o8[64 * j] = w; }
        if (lane == 0) ((float*)(ws + WS_RSTD0))[t] = 1.0f / sqrtf(s * (1.0f / DM) + EPS); }
}

__device__ __forceinline__ void pool_diff(const Args& a, Frame& F) {
    const bf16* pm = (const bf16*)(a.ws + WS_P0MAIN); bf16* A2 = (bf16*)(a.ws + WS_A2);
    const int gt = (F.vcu * NWAVES + F.wave) * 64 + (fresh_tid() & 63), NGT = F.G * NTHR;
    for (int it = gt; it < (T / 16) * 128; it += NGT) {
        const int cc = it & 127, tg = it >> 7, t0 = tg * 16, s0 = t0 & (SEQ - 1), w = 2 << (cc >> 5), c0 = cc * 8;
        float sum[8];
#pragma unroll
        for (int i = 0; i < 8; ++i) sum[i] = 0.f;
        const int hist = (w - 1) < s0 ? (w - 1) : s0;
        for (int i = 1; i <= hist; ++i) { const u32x4 v = *(const u32x4*)(pm + (size_t)(t0 - i) * DM + c0);
            sum[0] += bflo(v.x); sum[1] += bfhi(v.x); sum[2] += bflo(v.y); sum[3] += bfhi(v.y); sum[4] += bflo(v.z); sum[5] += bfhi(v.z); sum[6] += bflo(v.w); sum[7] += bfhi(v.w); }
        for (int k = 0; k < 16; ++k) { const int t = t0 + k, s = s0 + k; const u32x4 v = *(const u32x4*)(pm + (size_t)t * DM + c0);
            float xv[8] = {bflo(v.x), bfhi(v.x), bflo(v.y), bfhi(v.y), bflo(v.z), bfhi(v.z), bflo(v.w), bfhi(v.w)};
#pragma unroll
            for (int i = 0; i < 8; ++i) sum[i] += xv[i];
            const float inv = 1.0f / (float)((s + 1) < w ? (s + 1) : w);
            u32x4 o = {pk2(sum[0] * inv - xv[0], sum[1] * inv - xv[1]), pk2(sum[2] * inv - xv[2], sum[3] * inv - xv[3]), pk2(sum[4] * inv - xv[4], sum[5] * inv - xv[5]), pk2(sum[6] * inv - xv[6], sum[7] * inv - xv[7])};
            *(u32x4*)(A2 + (size_t)t * MIXW + c0) = o;
            if (s >= w - 1) { const u32x4 q = *(const u32x4*)(pm + (size_t)(t - w + 1) * DM + c0);
                sum[0] -= bflo(q.x); sum[1] -= bfhi(q.x); sum[2] -= bflo(q.y); sum[3] -= bfhi(q.y); sum[4] -= bflo(q.z); sum[5] -= bfhi(q.z); sum[6] -= bflo(q.w); sum[7] -= bfhi(q.w); } }
    }
}

__device__ __forceinline__ void mem_attn(const Args& a, Frame& F, bf16* Abuf, int layer, bool dry = false) {
    const bf16* MKV = (const bf16*)(a.ws + WS_MEMKV);
    for (int U = F.vcu; U < 512; U += F.G) { const int b = U >> 6, h = (U >> 4) & 3, qt = U & 15;
        bf16* Q = Abuf + ((size_t)b * SEQ + qt * 256) * MIXW + 1024 + h * 128;
        const bf16* K = MKV + (size_t)b * MEMT * 2048 + layer * 1024 + h * 128;
        att::attn_unit<MIXW, 2048, false, ATT_SD_MEM>(Q, K, K + 512, dry ? (bf16*)(a.ws + WS_EXP) : Q, 0, nullptr, F.ldsg); }
}

__device__ __forceinline__ int ord_enc(float x) { const int b = __builtin_bit_cast(int, x); return b ^ ((b >> 31) & 0x7fffffff); }
__device__ __forceinline__ float ord_dec(int k) { return __builtin_bit_cast(float, k ^ ((k >> 31) & 0x7fffffff)); }
template <int N> __device__ __forceinline__ void bitonic_desc(int (&a)[N]) {
#pragma unroll
    for (int k = 2; k <= N; k <<= 1)
#pragma unroll
        for (int j = k >> 1; j > 0; j >>= 1)
#pragma unroll
            for (int i = 0; i < N; ++i) { const int l = i ^ j; if (l > i) { const bool desc = ((i & k) == 0) || (k == N);
                const int hi = max(a[i], a[l]), lo = min(a[i], a[l]); a[i] = desc ? hi : lo; a[l] = desc ? lo : hi; } }
}
__device__ __forceinline__ int kmax(int x, int y) { int r; asm("v_max_f32 %0, %1, %2" : "=v"(r) : "v"(x), "v"(y)); return r; }
__device__ __forceinline__ int kmin(int x, int y) { int r; asm("v_min_f32 %0, %1, %2" : "=v"(r) : "v"(x), "v"(y)); return r; }
__device__ __forceinline__ void ksettle(int (&a)[16]) {
    asm volatile("s_nop 3" : "+v"(a[0]), "+v"(a[1]), "+v"(a[2]), "+v"(a[3]), "+v"(a[4]), "+v"(a[5]), "+v"(a[6]), "+v"(a[7]));
    asm volatile("s_nop 3" : "+v"(a[8]), "+v"(a[9]), "+v"(a[10]), "+v"(a[11]), "+v"(a[12]), "+v"(a[13]), "+v"(a[14]), "+v"(a[15]));
}
__device__ __forceinline__ void sort16_desc(int (&a)[16]) {
#define CE_(i, j) { const int hi_ = kmax(a[i], a[j]), lo_ = kmin(a[i], a[j]); a[i] = hi_; a[j] = lo_; }
    CE_(0, 13) CE_(1, 12) CE_(2, 15) CE_(3, 14) CE_(4, 8) CE_(5, 6) CE_(7, 11) CE_(9, 10)
    CE_(0, 5) CE_(1, 7) CE_(2, 9) CE_(3, 4) CE_(6, 13) CE_(8, 14) CE_(10, 15) CE_(11, 12)
    CE_(0, 1) CE_(2, 3) CE_(4, 5) CE_(6, 8) CE_(7, 9) CE_(10, 11) CE_(12, 13) CE_(14, 15)
    CE_(0, 2) CE_(1, 3) CE_(4, 10) CE_(5, 11) CE_(6, 7) CE_(8, 9) CE_(12, 14) CE_(13, 15)
    CE_(1, 2) CE_(3, 12) CE_(4, 6) CE_(5, 7) CE_(8, 10) CE_(9, 11) CE_(13, 14)
    CE_(1, 4) CE_(2, 6) CE_(5, 8) CE_(7, 10) CE_(9, 13) CE_(11, 14)
    CE_(2, 4) CE_(3, 6) CE_(9, 12) CE_(11, 13)
    CE_(3, 5) CE_(6, 8) CE_(7, 9) CE_(10, 12)
    CE_(3, 4) CE_(5, 6) CE_(7, 8) CE_(9, 10) CE_(11, 12)
    CE_(6, 7) CE_(8, 9)
#undef CE_
}
__device__ __forceinline__ void merge16(int (&a)[16], const int (&b)[16]) {
#pragma unroll
    for (int i = 0; i < 16; ++i) a[i] = kmax(a[i], b[15 - i]);
#pragma unroll
    for (int j = 8; j > 0; j >>= 1)
#pragma unroll
        for (int i = 0; i < 16; ++i) { const int l = i ^ j; if (l > i) { const int hi = kmax(a[i], a[l]), lo = kmin(a[i], a[l]); a[i] = hi; a[l] = lo; } }
}
constexpr int cand_i(int s) { int c = 0; for (int a = 0; a < 16; ++a) for (int b = 0; b < 16; ++b) { if ((a + 1) * (b + 1) > 16) continue; if (c == s) return a; ++c; } return 0; }
constexpr int cand_j(int s) { int c = 0; for (int a = 0; a < 16; ++a) for (int b = 0; b < 16; ++b) { if ((a + 1) * (b + 1) > 16) continue; if (c == s) return b; ++c; } return 0; }
constexpr int cand_slot(int i, int j) { int s = 0; for (int a = 0; a < 16; ++a) for (int b = 0; b < 16; ++b) { if ((a + 1) * (b + 1) > 16) continue; if (a == i && b == j) return s; ++s; } return -1; }

__device__ __forceinline__ void peer_topk(const Args& a, Frame& F, int layer) {
    const bf16* PQ = (const bf16*)(a.ws + WS_PQ); const bf16* SUBK = (const bf16*)(a.ws + WS_SUBK) + (size_t)layer * 16 * 128 * 128;
    unsigned short* EXPo = (unsigned short*)(a.ws + WS_EXP); float* GATEo = (float*)(a.ws + WS_GATE);
    const int tid = fresh_tid(), lane = tid & 63, wid = F.wave, r32 = lane & 31, hi = lane >> 5;
    const int h = F.vcu & 7;
    int ka[4];
#pragma unroll
    for (int i = 0; i < 4; ++i) ka[i] = r32 * 256 + (((2 * i + hi) ^ (r32 & 7)) << 4);
    char* Ks = F.ldsg;
    LAS unsigned char* ib = F.lds + 65536 + tid * 36;
    for (int i = tid; i < 2 * 128 * 16; i += NTHR) { const int row = i >> 4, ch = i & 15; const u32x4 v = *(const u32x4*)(SUBK + ((size_t)h * 256 + row) * 128 + ch * 8);
        *(u32x4*)(Ks + (row >> 7) * 32768 + KSWZ(row & 127, ch * 16)) = v; }
    __syncthreads();
    const int tt0 = F.vcu >> 3, tts = F.G >> 3;
    bf16x8 qn[8];
    { const bf16* qp = PQ + (size_t)(tt0 * 256 + wid * 32 + r32) * 2048 + h * 256 + hi * 8;
#pragma unroll
      for (int d0 = 0; d0 < 8; ++d0) qn[d0] = *reinterpret_cast<const bf16x8*>(qp + d0 * 16); }
    for (int tt = tt0; tt < T / 256; tt += tts) {
        const int t = tt * 256 + wid * 32 + r32;
        int top[2][16];
#pragma unroll
        for (int p = 0; p < 2; ++p) {
            bf16x8 qr[8];
#pragma unroll
            for (int d0 = 0; d0 < 8; ++d0) qr[d0] = qn[d0];
            { const int ttn = (p == 0) ? tt : ((tt + tts < T / 256) ? tt + tts : tt);
              const bf16* qp = PQ + (size_t)(ttn * 256 + wid * 32 + r32) * 2048 + h * 256 + (p ^ 1) * 128 + hi * 8;
#pragma unroll
              for (int d0 = 0; d0 < 8; ++d0) qn[d0] = *reinterpret_cast<const bf16x8*>(qp + d0 * 16); }
            int cur[16];
#pragma unroll
            for (int kt = 0; kt < 4; ++kt) { f32x16 sacc; att::qkt1(sacc, Ks + p * 32768 + kt * 32 * 256, qr, ka);
                int grp[16];
#pragma unroll
                for (int r = 0; r < 16; ++r) { const float sv_ = sacc[r]; grp[r] = (__float_as_int(sv_) & ~0x7F) | (kt * 32 + (r & 3) + 8 * (r >> 2) + 4 * hi); }
                sort16_desc(grp);
                if (kt == 0) {
#pragma unroll
                    for (int r = 0; r < 16; ++r) cur[r] = grp[r];
                } else merge16(cur, grp); }
            int oth[16]; ksettle(cur);
#pragma unroll
            for (int r = 0; r < 16; ++r) { auto rr = __builtin_amdgcn_permlane32_swap((unsigned)cur[r], (unsigned)cur[r], false, false); cur[r] = (int)rr[0]; oth[r] = (int)rr[1]; }
            ksettle(cur); ksettle(oth); merge16(cur, oth);
#pragma unroll
            for (int r = 0; r < 16; ++r) top[p][r] = cur[r];
        }
        float v0[16], v1[16];
#pragma unroll
        for (int r = 0; r < 16; ++r) { v0[r] = __builtin_bit_cast(float, top[0][r] & ~0x7F); v1[r] = __builtin_bit_cast(float, top[1][r] & ~0x7F); }
#pragma unroll
        for (int q = 0; q < 4; ++q) { *(LAS unsigned*)(ib + q * 4) = (top[0][4 * q] & 0x7F) | ((top[0][4 * q + 1] & 0x7F) << 8) | ((top[0][4 * q + 2] & 0x7F) << 16) | ((top[0][4 * q + 3] & 0x7F) << 24);
            *(LAS unsigned*)(ib + 16 + q * 4) = (top[1][4 * q] & 0x7F) | ((top[1][4 * q + 1] & 0x7F) << 8) | ((top[1][4 * q + 2] & 0x7F) << 16) | ((top[1][4 * q + 3] & 0x7F) << 24); }
        int best[16], g1[16];
#pragma unroll
        for (int r = 0; r < 32; ++r) { int key = (int)0xFF800000;
            if (r < 25) {
                const int iA = cand_i(r), jA = cand_j(r), iB = cand_i(25 + r), jB = cand_j(25 + r);
                const float sA = v0[iA] + v1[jA], sB = v0[iB] + v1[jB]; const int code = hi ? (iB * 16 + jB) : (iA * 16 + jA);
                key = (__builtin_bit_cast(int, hi ? sB : sA) & ~0xFF) | code; }
            if (r < 16) best[r] = key; else g1[r - 16] = key; }
        sort16_desc(best); sort16_desc(g1); merge16(best, g1); ksettle(best);
#pragma unroll
        for (int r = 0; r < 16; ++r) { auto rr = __builtin_amdgcn_permlane32_swap((unsigned)best[r], (unsigned)best[r], false, false); best[r] = (int)rr[0]; g1[r] = (int)rr[1]; }
        ksettle(best); ksettle(g1); merge16(best, g1);
        float cv[16], ex[16]; float sum = 0.f;
#pragma unroll
        for (int r = 0; r < 16; ++r) cv[r] = __builtin_bit_cast(float, best[r] & ~0xFF);
#pragma unroll
        for (int r = 0; r < 16; ++r) { ex[r] = __builtin_amdgcn_exp2f((cv[r] - cv[0]) * 1.4426950408889634f); sum += ex[r]; }
        const float rs = 1.0f / sum;
        LDS_WAIT();
        unsigned ee[16];
#pragma unroll
        for (int r = 0; r < 16; ++r) { const int code = best[r] & 0xFF; const unsigned e1 = ib[code >> 4], e2 = ib[16 + (code & 15)]; ee[r] = e1 * 128u + e2; }
        const size_t ob = ((size_t)t * 8 + h) * 16;
        if (hi == 0) { u32x4 w0 = {ee[0] | (ee[1] << 16), ee[2] | (ee[3] << 16), ee[4] | (ee[5] << 16), ee[6] | (ee[7] << 16)}, w1 = {ee[8] | (ee[9] << 16), ee[10] | (ee[11] << 16), ee[12] | (ee[13] << 16), ee[14] | (ee[15] << 16)};
            *(u32x4*)(EXPo + ob) = w0; *(u32x4*)(EXPo + ob + 8) = w1; }
        else {
#pragma unroll
            for (int q = 0; q < 4; ++q) { f32x4 gq = {ex[4 * q] * rs, ex[4 * q + 1] * rs, ex[4 * q + 2] * rs, ex[4 * q + 3] * rs}; *(f32x4*)(GATEo + ob + 4 * q) = gq; } }
        LDS_WAIT();
    }
    __syncthreads();
}

__device__ __forceinline__ float gelu_exact(float v) {
    const float av = fabsf(v), t = __builtin_amdgcn_rcpf(fmaf(av, 0.2316418882f, 1.0f));
    float q = fmaf(t, 0.5307027145f, -0.7265760135f); q = fmaf(q, t, 0.7107068705f); q = fmaf(q, t, -0.142248368f); q = fmaf(q, t, 0.127414796f); q = q * t;
    const float e = __builtin_amdgcn_exp2f(v * v * -0.72134752044f), m = v * (q * e);
    return v < 0.f ? m : v - m;
}
__device__ __forceinline__ float dot16_fp8(const u32x4 u, const f32x2 (&x2)[8]) {
    f32x2 d = {0.f, 0.f};
#pragma unroll
    for (int i = 0; i < 4; ++i) { const f32x2 a = __builtin_amdgcn_cvt_pk_f32_fp8((int)u[i], false), b = __builtin_amdgcn_cvt_pk_f32_fp8((int)u[i], true);
        d = __builtin_elementwise_fma(a, x2[2 * i], d); d = __builtin_elementwise_fma(b, x2[2 * i + 1], d); }
    return d.x + d.y;
}
__device__ __forceinline__ void axpy16_fp8(f32x2 (&o2)[8], const float h, const u32x4 v) {
    const f32x2 h2 = {h, h};
#pragma unroll
    for (int i = 0; i < 4; ++i) { const f32x2 a = __builtin_amdgcn_cvt_pk_f32_fp8((int)v[i], false), b = __builtin_amdgcn_cvt_pk_f32_fp8((int)v[i], true);
        o2[2 * i] = __builtin_elementwise_fma(a, h2, o2[2 * i]); o2[2 * i + 1] = __builtin_elementwise_fma(b, h2, o2[2 * i + 1]); }
}
__device__ __forceinline__ float reduce8(const float (&p)[8], int lane) {
    float s[4];
#pragma unroll
    for (int i = 0; i < 4; ++i) { auto rr = __builtin_amdgcn_permlane32_swap(__float_as_uint(p[2 * i]), __float_as_uint(p[2 * i + 1]), false, false); s[i] = __uint_as_float(rr[0]) + __uint_as_float(rr[1]); }
    float t[2];
#pragma unroll
    for (int i = 0; i < 2; ++i) { const bool hi = lane & 16; const float u = hi ? s[2 * i + 1] : s[2 * i], o = hi ? s[2 * i] : s[2 * i + 1]; t[i] = u + shx_f<16>(o); }
    const bool h8 = lane & 8; const float u = h8 ? t[1] : t[0], o = h8 ? t[0] : t[1]; float w = u + dpp_f<0x128>(o);
    w += dpp_f<0x141>(w); w += dpp_f<0x1B>(w); w += dpp_f<0xB1>(w);
    return w;
}
constexpr int qgrp(int q) { return 2 * ((q & 3) == 1 ? 2 : (q & 3) == 2 ? 1 : (q & 3)) + (q >> 2); }

template <int K, int J> __device__ __forceinline__ void sort128_stage(unsigned& lo, unsigned& hi, int lane) {
    const unsigned plo = shx_u<J>(lo), phi = shx_u<J>(hi);
    const bool up_lo = (K >= 64) ? true : ((lane & K) == 0), up_hi = (K == 64) ? false : up_lo, lower = (lane & J) == 0;
    lo = (lower == up_lo) ? min(lo, plo) : max(lo, plo); hi = (lower == up_hi) ? min(hi, phi) : max(hi, phi);
    if constexpr (J > 1) sort128_stage<K, J / 2>(lo, hi, lane);
}
template <int K> __device__ __forceinline__ void sort128_level(unsigned& lo, unsigned& hi, int lane) { sort128_stage<K, K / 2>(lo, hi, lane); if constexpr (K < 64) sort128_level<K * 2>(lo, hi, lane); }
__device__ __forceinline__ void sort128(unsigned& lo, unsigned& hi, int lane) {
    sort128_level<2>(lo, hi, lane);
    { const unsigned a = min(lo, hi), b = max(lo, hi); lo = a; hi = b; }
    sort128_stage<128, 32>(lo, hi, lane);
}
template <bool FINAL, bool DRY = false>
__device__ __forceinline__ void peer_gather(const Args& a, Frame& F, int layer) {
    const unsigned char* UB = a.ws + WS_UB + (size_t)layer * NEXP * DM; const unsigned char* VB = a.ws + WS_VB + (size_t)layer * NEXP * DM;
    const float* USC = (const float*)(a.ws + WS_USC) + layer * NEXP; const float* VSC = (const float*)(a.ws + WS_VSC) + layer * NEXP;
    const unsigned short* EXPi = (const unsigned short*)(a.ws + WS_EXP); const float* GATEi = (const float*)(a.ws + WS_GATE);
    float* X = a.out; bf16* XB = (bf16*)(a.ws + WS_XB); float* RSTD2 = (float*)(a.ws + WS_RSTD2); const float* gfin = a.in[15];
    const int lane = fresh_tid() & 63, gw = F.vcu * NWAVES + F.wave, NGW = F.G * NWAVES;
    const unsigned lane16 = (unsigned)lane * 16u;
    const int grp = lane >> 3; const int jperm = 8 * (lane & 7) + ((grp >> 1) == 1 ? 2 : (grp >> 1) == 2 ? 1 : (grp >> 1)) + 4 * (grp & 1);
    for (int t = gw; t < T; t += NGW) {
        __syncthreads();
        bf16* xbr = XB + (size_t)t * DM + 16 * lane;
        float x[16];
        { const u32x4 v0 = *(const u32x4*)xbr, v1 = *(const u32x4*)(xbr + 8);
          x[0] = bflo(v0.x); x[1] = bfhi(v0.x); x[2] = bflo(v0.y); x[3] = bfhi(v0.y); x[4] = bflo(v0.z); x[5] = bfhi(v0.z); x[6] = bflo(v0.w); x[7] = bfhi(v0.w);
          x[8] = bflo(v1.x); x[9] = bfhi(v1.x); x[10] = bflo(v1.y); x[11] = bfhi(v1.y); x[12] = bflo(v1.z); x[13] = bfhi(v1.z); x[14] = bflo(v1.w); x[15] = bfhi(v1.w); }
        f32x2 x2[8];
#pragma unroll
        for (int i = 0; i < 8; ++i) { x2[i].x = x[2 * i]; x2[i].y = x[2 * i + 1]; }
        float ss = 0.f;
#pragma unroll
        for (int i = 0; i < 16; ++i) ss = fmaf(x[i], x[i], ss);
        ss = wave_sum(ss);
        const float rstd = 1.0f / sqrtf(ss * (1.0f / DM) + EPS);
        const unsigned short* et = EXPi + (size_t)t * 128; const float* gt_ = GATEi + (size_t)t * 128;
        unsigned k_lo = ((unsigned)et[lane] << 7) | (unsigned)lane, k_hi = ((unsigned)et[64 + lane] << 7) | (unsigned)(64 + lane);
        sort128(k_lo, k_hi, lane);
        const int e_lo = (int)(k_lo >> 7), e_hi = (int)(k_hi >> 7);
        const float gs_lo = gt_[k_lo & 127u], gs_hi = gt_[k_hi & 127u];
        const int ep_lo = __shfl(e_lo, jperm), ep_hi = __shfl(e_hi, jperm);
        const float gl = __shfl(gs_lo, jperm) * VSC[ep_lo], gh = __shfl(gs_hi, jperm) * VSC[ep_hi];
        const float ul = USC[ep_lo] * rstd, uh = USC[ep_hi] * rstd;
        float a_lo = 0.f, a_hi = 0.f;
        u32x4 b0[8], b1[8], b2[8];
#define ROWLD(dst, tab, e_) dst = *(const u32x4*)((tab) + (size_t)(e_) * DM + lane16)
#define ULOAD(buf, B) do { const int ev_ = ((B) >> 3) ? e_hi : e_lo; _Pragma("unroll") for (int q = 0; q < 8; ++q) { const int e = __builtin_amdgcn_readlane(ev_, 8 * ((B) & 7) + q); ROWLD(buf[q], UB, e); } } while (0)
#define VLOAD(buf, B) do { const int ev_ = ((B) >> 3) ? e_hi : e_lo; _Pragma("unroll") for (int q = 0; q < 8; ++q) { const int e = __builtin_amdgcn_readlane(ev_, 8 * ((B) & 7) + q); ROWLD(buf[q], VB, e); } } while (0)
#define UCOMP(buf, B) do { float p[8]; _Pragma("unroll") for (int q = 0; q < 8; ++q) p[q] = dot16_fp8(buf[q], x2); const float w = reduce8(p, lane); const bool mine = (lane & 7) == ((B) & 7); \
        if ((B) >> 3) a_hi = mine ? w : a_hi; else a_lo = mine ? w : a_lo; } while (0)
        ULOAD(b0, 0); ULOAD(b1, 1);
#pragma unroll 1
        for (int B = 0; B < 12; B += 3) {
            if (B > 0) __syncthreads();
            ULOAD(b2, B + 2); UCOMP(b0, B);
            ULOAD(b0, B + 3); UCOMP(b1, B + 1);
            ULOAD(b1, B + 4); UCOMP(b2, B + 2); }
        ULOAD(b2, 14); UCOMP(b0, 12);
        ULOAD(b0, 15); UCOMP(b1, 13);
        VLOAD(b1, 0);  UCOMP(b2, 14);
        VLOAD(b2, 1);  UCOMP(b0, 15);
#undef ULOAD
#undef UCOMP
        __syncthreads();
        const float h_lo = gelu_exact(a_lo * ul) * gl, h_hi = gelu_exact(a_hi * uh) * gh;
        f32x2 o2[8];
#pragma unroll
        for (int i = 0; i < 8; ++i) o2[i] = (f32x2){0.f, 0.f};
#define VCOMP(buf, B) do { const int hv_ = __builtin_bit_cast(int, ((B) >> 3) ? h_hi : h_lo); _Pragma("unroll") for (int q = 0; q < 8; ++q) { const float hq = __builtin_bit_cast(float, __builtin_amdgcn_readlane(hv_, 8 * qgrp(q) + ((B) & 7))); axpy16_fp8(o2, hq, buf[q]); } } while (0)
#pragma unroll 1
        for (int B = 0; B < 12; B += 3) {
            if (B > 0) __syncthreads();
            VLOAD(b0, B + 2); VCOMP(b1, B);
            VLOAD(b1, B + 3); VCOMP(b2, B + 1);
            VLOAD(b2, B + 4); VCOMP(b0, B + 2); }
        VLOAD(b0, 14); VCOMP(b1, 12);
        VLOAD(b1, 15); VCOMP(b2, 13);
        VCOMP(b0, 14);
        VCOMP(b1, 15);
#undef VLOAD
#undef VCOMP
#undef ROWLD
        float o[16]; float s2 = 0.f;
#pragma unroll
        for (int i = 0; i < 8; ++i) { o[2 * i] = o2[i].x; o[2 * i + 1] = o2[i].y; }
        { const u32x4 v0 = *(const u32x4*)xbr, v1 = *(const u32x4*)(xbr + 8);
          o[0] += bflo(v0.x); o[1] += bfhi(v0.x); o[2] += bflo(v0.y); o[3] += bfhi(v0.y); o[4] += bflo(v0.z); o[5] += bfhi(v0.z); o[6] += bflo(v0.w); o[7] += bfhi(v0.w);
          o[8] += bflo(v1.x); o[9] += bfhi(v1.x); o[10] += bflo(v1.y); o[11] += bfhi(v1.y); o[12] += bflo(v1.z); o[13] += bfhi(v1.z); o[14] += bflo(v1.w); o[15] += bfhi(v1.w); }
#pragma unroll
        for (int i = 0; i < 16; ++i) s2 = fmaf(o[i], o[i], s2);
        s2 = wave_sum(s2);
        const float r2 = 1.0f / sqrtf(s2 * (1.0f / DM) + EPS);
        if constexpr (FINAL) {
            float* xw = (DRY ? (float*)(a.ws + WS_RB) : X) + (size_t)t * DM;
#pragma unroll
            for (int i = 0; i < 4; ++i) { const f32x4 g = *(const f32x4*)(gfin + 16 * lane + 4 * i); f32x4 y = {o[4 * i] * r2 * g[0], o[4 * i + 1] * r2 * g[1], o[4 * i + 2] * r2 * g[2], o[4 * i + 3] * r2 * g[3]}; *(f32x4*)(xw + 16 * lane + 4 * i) = y; }
        } else {
            bf16* xo = DRY ? (bf16*)(a.ws + WS_RB) + (size_t)t * DM + 16 * lane : xbr;
            u32x4 wa = {pk2(o[0], o[1]), pk2(o[2], o[3]), pk2(o[4], o[5]), pk2(o[6], o[7])}, wb = {pk2(o[8], o[9]), pk2(o[10], o[11]), pk2(o[12], o[13]), pk2(o[14], o[15])};
            *(u32x4*)xo = wa; *(u32x4*)(xo + 8) = wb;
            if (!DRY && lane == 0) RSTD2[t] = r2;
        }
    }
}

#define XB_TMO      128
#define XB_RDY      3456
#ifndef GM_SHARE
#define GM_SHARE 620
#endif
#define XB_XCNT(j)  (256  + 64 * (j))
#define XB_XSUB(j)  (1280 + 64 * (j))
#define XB_XGEN(j)  (2304 + 64 * (j))
#define XB_TOP      3328
#define XB_TOPGEN   3392
#define XCD_BAR_WORDS 3456
#define XB_SPIN_CAP (1u << 22)
__device__ __forceinline__ unsigned xb_ld(unsigned* p)              { return __hip_atomic_load(p, __ATOMIC_RELAXED, __HIP_MEMORY_SCOPE_AGENT); }
__device__ __forceinline__ unsigned xb_add(unsigned* p, unsigned v) { return __hip_atomic_fetch_add(p, v, __ATOMIC_RELAXED, __HIP_MEMORY_SCOPE_AGENT); }
__device__ __forceinline__ unsigned xb_xcc_id() { return (unsigned)__builtin_amdgcn_s_getreg((3 << 11) | 20) & 0xFu; }
#define XB_SPIN(cond, bar) do { unsigned _sp = 0; while (cond) { __builtin_amdgcn_s_sleep(1); \
    if ((++_sp & 255u) == 0u) { if (xb_ld(&(bar)[XB_TMO])) break; if (_sp > XB_SPIN_CAP) { atomicAdd(&(bar)[XB_TMO], 1u); break; } } } } while (0)
struct XcdBarrier { unsigned* bar; unsigned x; volatile LAS unsigned* st; };
__device__ __forceinline__ XcdBarrier xcd_barrier_post(unsigned* bar, volatile LAS unsigned* st) {
    XcdBarrier b; b.bar = bar; b.x = xb_xcc_id(); b.st = st;
    if (threadIdx.x == 0) (void)xb_add(&bar[XB_XCNT(b.x)], 1u);
    return b;
}
__device__ __forceinline__ void xcd_barrier_complete(unsigned* bar, unsigned x, unsigned& nloc, unsigned& nx) {
    const unsigned G = gridDim.x * gridDim.y * gridDim.z;
    unsigned sum, cnt, mine, sp = 0u;
    for (;;) {
        sum = 0u; cnt = 0u; mine = 0u;
#pragma unroll
        for (unsigned j = 0; j < 16; ++j) { const unsigned c = xb_ld(&bar[XB_XCNT(j)]); sum += c; cnt += (c > 0u) ? 1u : 0u; mine = (j == x) ? c : mine; }
        if (sum == G) break;
        __builtin_amdgcn_s_sleep(1);
        if ((++sp & 255u) == 0u) { if (xb_ld(&bar[XB_TMO])) break; if (sp > XB_SPIN_CAP) { atomicAdd(&bar[XB_TMO], 1u); break; } }
    }
    nloc = mine > 0u ? mine : 1u; nx = cnt > 0u ? cnt : 1u;
}
__device__ __forceinline__ void xcd_barrier(const XcdBarrier& b) {
    asm volatile("s_waitcnt vmcnt(0)" ::: "memory");
    __syncthreads();
    if (threadIdx.x == 0) {
        unsigned* bar = b.bar;
        __builtin_amdgcn_s_waitcnt(0);
        unsigned nloc = b.st[0], nx = b.st[1];
        if (nloc == 0u) { xcd_barrier_complete(bar, b.x, nloc, nx); b.st[0] = nloc; b.st[1] = nx; }
        const unsigned old = xb_add(&bar[XB_XSUB(b.x)], 1u);
        const unsigned gen = old / nloc;
        if (old + 1u == (gen + 1u) * nloc) {
            __builtin_amdgcn_fence(__ATOMIC_RELEASE, "agent");
            asm volatile("s_waitcnt vmcnt(0)" ::: "memory");
            const unsigned og = xb_add(&bar[XB_TOP], 1u);
            const unsigned tg = og / nx;
            if (og + 1u == (tg + 1u) * nx) xb_add(&bar[XB_TOPGEN], 1u);
            else XB_SPIN(xb_ld(&bar[XB_TOPGEN]) == tg, bar);
            __builtin_amdgcn_fence(__ATOMIC_ACQUIRE, "agent");
            xb_add(&bar[XB_XGEN(b.x)], 1u);
            asm volatile("s_waitcnt vmcnt(0)" ::: "memory");
        } else {
            XB_SPIN(xb_ld(&bar[XB_XGEN(b.x)]) == gen, bar);
            __builtin_amdgcn_fence(__ATOMIC_ACQUIRE, "agent");
            asm volatile("s_waitcnt vmcnt(0)" ::: "memory");
        }
    }
    __syncthreads();
}

__global__ void __launch_bounds__(NTHR, 2) yoco_fwd(Args args) {
    extern __shared__ __attribute__((aligned(16))) unsigned char lds_raw[];
    cg::grid_group grid = cg::this_grid();
    Frame F;
    F.lds = (LAS unsigned char*)lds_raw; F.ldsg = (char*)lds_raw;
    F.wave = __builtin_amdgcn_readfirstlane(threadIdx.x >> 6);
    F.G = gridDim.x; { const int bx = blockIdx.x; F.vcu = (F.G % 8 == 0) ? (bx % 8) * (F.G / 8) + bx / 8 : bx; }
    unsigned char* ws = args.ws;
    const int lo = args.ph_lo, hi = args.ph_hi;
    volatile LAS unsigned* bst = (volatile LAS unsigned*)(F.lds + 131072 + 320);
    if (threadIdx.x < 2) bst[threadIdx.x] = 0u;
    __syncthreads();
    XcdBarrier xbar; xbar.bar = (unsigned*)ws; xbar.x = 0; xbar.st = bst;
    if (hi - lo > 1) xbar = xcd_barrier_post((unsigned*)ws, bst);
#ifndef PH_MASK
#define PH_MASK 0x1fff
#endif
#define IN(k) (((PH_MASK >> (k)) & 1) && lo <= (k) && (k) < hi)
#define SEAM(k) do { if (IN(k) && IN((k) + 1)) { if ((k) == 0) grid.sync(); else xcd_barrier(xbar); } } while (0)
#define GSYNC() xcd_barrier(xbar)
#ifndef REP_MASK
#define REP_MASK 0
#endif
#define NREP(k) (((REP_MASK >> (k)) & 1) ? 2 : 1)
    typedef pg8::bf16_t pb;

    for (int rep_ = 0; rep_ < NREP(0); ++rep_) { if (rep_) GSYNC();
    if (IN(0)) {
        unsigned* rdy = (unsigned*)ws + XB_RDY + 64 * rep_; const int nb = F.G > 128 ? 64 : 0, bx = (int)blockIdx.x;
        const int den = (F.G - nb) * 1000 + nb * GM_SHARE, ra = (4 * NEXP * 1000 + den - 1) / den + 1, rb = ra * GM_SHARE / 1000;
        const int tlo = bx < nb ? bx * rb : nb * rb + (bx - nb) * ra, thi_ = tlo + (bx < nb ? rb : ra);
        const int tb_lo = tlo < 4 * NEXP ? tlo : 4 * NEXP, tb_hi = thi_ < 4 * NEXP ? thi_ : 4 * NEXP;
        phase0<0>(args, F, 0, 0);
        asm volatile("s_waitcnt vmcnt(0)" ::: "memory"); __syncthreads();
        if (threadIdx.x == 0) { __builtin_amdgcn_fence(__ATOMIC_RELEASE, "agent"); asm volatile("s_waitcnt vmcnt(0)" ::: "memory"); (void)xb_add(rdy, 1u); }
        phase0<1>(args, F, 0, 0);
        if (nb == 0 || bx < nb) {
            if (threadIdx.x == 0) { XB_SPIN(xb_ld(rdy) < (unsigned)F.G, (unsigned*)ws); __builtin_amdgcn_fence(__ATOMIC_ACQUIRE, "agent"); asm volatile("s_waitcnt vmcnt(0)" ::: "memory"); }
            __syncthreads();
            pg8::Gemm g{(const pb*)(ws + WS_MEMB), (const pb*)(ws + WS_WMKV), 2048, 2048, DM}; pg8::StaticOrder S; S.init(2048, 2048, F.G, (int)blockIdx.x);
            pg8::EpiRowBf16 E{(pb*)(ws + WS_MEMKV), 2048, (pb*)(ws + WS_MEMKV), 2048, 1 << 30, nullptr, nullptr};
            pg8::gemm_phase<pg8::EpiRowBf16, pg8::StaticOrder>(F.lds, g, S, E);
            __syncthreads();
        }
        phase0<2>(args, F, tb_lo, tb_hi);
    } } SEAM(0);

    for (int rep_ = 0; rep_ < NREP(1); ++rep_) { if (rep_) GSYNC();
    if (IN(1)) {
        { pg8::Gemm g{(const pb*)(ws + WS_XB), (const pb*)(ws + WS_WIN0), T, MIXW, DM}; pg8::StaticOrder S; S.init(T, MIXW, F.G, (int)blockIdx.x);
          pg8::EpiRowBf16 E{(pb*)(ws + WS_P0MAIN), DM, (pb*)(ws + WS_A2) + 1024, MIXW, 1024, (const float*)(ws + WS_RSTD0), nullptr};
          pg8::gemm_phase<pg8::EpiRowBf16, pg8::StaticOrder>(F.lds, g, S, E); }
    } } SEAM(1);

    if (IN(2)) { if (NREP(2) > 1) { pool_diff(args, F); mem_attn(args, F, (bf16*)(ws + WS_A2), 0, true); GSYNC(); }
        pool_diff(args, F); mem_attn(args, F, (bf16*)(ws + WS_A2), 0); } SEAM(2);

    for (int rep_ = 0; rep_ < NREP(3); ++rep_) { if (rep_) GSYNC();
    if (IN(3)) {
        pg8::Gemm g{(const pb*)(ws + WS_A2), (const pb*)(ws + WS_WC0), T, DM, MIXW}; pg8::StaticOrder S; S.init(T, DM, F.G, (int)blockIdx.x);
        pg8::EpiRes E{(pb*)(ws + WS_XB), (float*)(ws + WS_SSQ)};
        pg8::gemm_phase<pg8::EpiRes, pg8::StaticOrder>(F.lds, g, S, E);
    } } SEAM(3);

    for (int rep_ = 0; rep_ < NREP(4); ++rep_) { if (rep_) GSYNC();
    if (IN(4)) {
        pg8::Gemm g{(const pb*)(ws + WS_XB), (const pb*)(ws + WS_WQ0), T, 2048, DM}; pg8::StaticOrder S; S.init(T, 2048, F.G, (int)blockIdx.x);
        pg8::EpiRowBf16 E{(pb*)(ws + WS_PQ), 2048, (pb*)(ws + WS_PQ), 2048, 1 << 30, nullptr, (const float*)(ws + WS_SSQ)};
        pg8::gemm_phase<pg8::EpiRowBf16, pg8::StaticOrder>(F.lds, g, S, E);
    } } SEAM(4);

    for (int rep_ = 0; rep_ < NREP(5); ++rep_) { if (rep_) GSYNC();
    if (IN(5)) { peer_topk(args, F, 0); } } SEAM(5);
    if (IN(6)) {
#ifdef PROBE_PEER
        peer_gather<false, true>(args, F, 0); GSYNC();
#endif
        peer_gather<false>(args, F, 0); } SEAM(6);

    for (int rep_ = 0; rep_ < NREP(7); ++rep_) { if (rep_) GSYNC();
    if (IN(7)) {
        pg8::Gemm g{(const pb*)(ws + WS_XB), (const pb*)(ws + WS_WC4), T, 3584, DM}; pg8::StaticOrder S; S.init(T, 3584, F.G, (int)blockIdx.x);
        pg8::EpiKVQ E{(pb*)(ws + WS_KR), (pb*)(ws + WS_VV), (pb*)(ws + WS_A3), (float*)(ws + WS_KMP), (const float*)(ws + WS_RSTD2), (const float*)(ws + WS_ROPE)};
        pg8::gemm_phase<pg8::EpiKVQ, pg8::StaticOrder>(F.lds, g, S, E);
    } } SEAM(7);

    if (IN(8)) {
        bf16* A3 = (bf16*)(ws + WS_A3); const bf16* KR = (const bf16*)(ws + WS_KR); const bf16* VV = (const bf16*)(ws + WS_VV); const float* KMP = (const float*)(ws + WS_KMP);
        for (int rep_ = 0; rep_ < NREP(8); ++rep_) { const bool dry8 = (NREP(8) > 1) && rep_ == 0;
        for (int P = F.vcu; P < 512; P += F.G) { const int bh = P >> 3, p = P & 7, b = bh >> 3, h = bh & 7;
#pragma unroll 1
            for (int half = 0; half < 2; ++half) { const int j = half ? p : 15 - p;
                bf16* Q = A3 + ((size_t)b * SEQ + j * 256) * MIXW + h * 128;
                const bf16* K = KR + (size_t)bh * SEQ * 128; const bf16* V = VV + (size_t)bh * SEQ * 128;
                att::attn_unit<MIXW, 128, true, ATT_SD_MOBA>(Q, K, V, dry8 ? (bf16*)(ws + WS_XB) : Q, j, KMP + (size_t)b * 16 * 2048 + h * 128, F.ldsg); } }
        if (dry8) { mem_attn(args, F, A3, 1, true); GSYNC(); } }
        mem_attn(args, F, A3, 1);
    } SEAM(8);

    if (IN(9)) {
        pg8::Gemm g{(const pb*)(ws + WS_A3), (const pb*)(ws + WS_WOUT1), T, DM, MIXW}; pg8::StaticOrder S; S.init(T, DM, F.G, (int)blockIdx.x);
        pg8::EpiRes E{(pb*)(ws + WS_XB), (float*)(ws + WS_SSQ)};
        pg8::gemm_phase<pg8::EpiRes, pg8::StaticOrder>(F.lds, g, S, E);
    } SEAM(9);

    for (int rep_ = 0; rep_ < NREP(10); ++rep_) { if (rep_) GSYNC();
    if (IN(10)) {
        pg8::Gemm g{(const pb*)(ws + WS_XB), (const pb*)(ws + WS_WQ1), T, 2048, DM}; pg8::StaticOrder S; S.init(T, 2048, F.G, (int)blockIdx.x);
        pg8::EpiRowBf16 E{(pb*)(ws + WS_PQ), 2048, (pb*)(ws + WS_PQ), 2048, 1 << 30, nullptr, (const float*)(ws + WS_SSQ)};
        pg8::gemm_phase<pg8::EpiRowBf16, pg8::StaticOrder>(F.lds, g, S, E);
    } } SEAM(10);

    for (int rep_ = 0; rep_ < NREP(11); ++rep_) { if (rep_) GSYNC();
    if (IN(11)) { peer_topk(args, F, 1); } } SEAM(11);
    if (IN(12)) {
#ifdef PROBE_PEER
        peer_gather<true, true>(args, F, 1); GSYNC();
#endif
        peer_gather<true>(args, F, 1); }
#undef IN
#undef SEAM
}

extern "C" void kernel_launch(void* const* d_in, const int* in_sizes, int n_in, void* d_out, int out_size, void* d_ws, size_t ws_size, hipStream_t stream) {
    static int grid = 0;
    if (grid == 0) {
        if (n_in != 16 || out_size != T * DM || ws_size < WS_END) { fprintf(stderr, "kernel_launch: unexpected shapes: n_in %d out %d ws %zu (need %zu)\n", n_in, out_size, ws_size, (size_t)WS_END); grid = -1; return; }
        int dev = 0, cus = 0, per_cu = 0;
        if (hipGetDevice(&dev) != hipSuccess || hipDeviceGetAttribute(&cus, hipDeviceAttributeMultiprocessorCount, dev) != hipSuccess) { grid = -1; return; }
        if (hipFuncSetAttribute((const void*)yoco_fwd, hipFuncAttributeMaxDynamicSharedMemorySize, LDS_BYTES) != hipSuccess) { fprintf(stderr, "kernel_launch: hipFuncSetAttribute failed\n"); grid = -1; return; }
        if (hipOccupancyMaxActiveBlocksPerMultiprocessor(&per_cu, (const void*)yoco_fwd, NTHR, LDS_BYTES) != hipSuccess || per_cu < 1) { fprintf(stderr, "kernel_launch: occupancy query says %d\n", per_cu); per_cu = 1; }
        (void)hipGetLastError();
        grid = cus;
        fprintf(stderr, "kernel_launch: grid %d, per_cu %d, ws %zu\n", grid, per_cu, ws_size);
    }
    if (grid < 0) return;
    if (hipMemsetAsync(d_ws, 0, 16384, stream) != hipSuccess) { fprintf(stderr, "kernel_launch: memset failed\n"); return; }
    Args a{};
    for (int i = 0; i < 16; ++i) a.in[i] = (const float*)d_in[i];
    a.out = (float*)d_out; a.ws = (unsigned char*)d_ws;
#if MK_LAUNCHES == 1
    a.ph_lo = 0; a.ph_hi = 13;
    void* kargs[] = {&a};
    hipError_t e = hipLaunchCooperativeKernel((const void*)yoco_fwd, dim3(grid), dim3(NTHR), kargs, LDS_BYTES, stream);
    if (e != hipSuccess) fprintf(stderr, "kernel_launch: cooperative launch failed: %s (grid %d)\n", hipGetErrorString(e), grid);
#else
    for (int p = 0; p < 13; ++p) { a.ph_lo = p; a.ph_hi = p + 1;
        hipLaunchKernelGGL(yoco_fwd, dim3(grid), dim3(NTHR), LDS_BYTES, stream, a);
        const hipError_t le = hipPeekAtLastError(); if (le != hipSuccess) { fprintf(stderr, "kernel_launch: launch %d failed: %s\n", p, hipGetErrorName(le)); break; } }
#endif
}
```

```cpp
#include <hip/hip_runtime.h>
#include <hip/hip_cooperative_groups.h>
#include <cstdio>
#include <cstdint>
namespace cg = cooperative_groups;

#ifndef MK_LAUNCHES
#define MK_LAUNCHES 1
#endif

#define GAS __attribute__((address_space(1)))
#define LAS __attribute__((address_space(3)))
typedef unsigned short bf16;
typedef unsigned u32x4 __attribute__((ext_vector_type(4)));
typedef unsigned u32x2 __attribute__((ext_vector_type(2)));
typedef float f32x4 __attribute__((ext_vector_type(4)));
typedef float f32x2 __attribute__((ext_vector_type(2)));
typedef float f32x16 __attribute__((ext_vector_type(16)));
typedef short bf16x8 __attribute__((ext_vector_type(8)));
typedef short s16x4 __attribute__((ext_vector_type(4)));
typedef __bf16 bf16x2_t __attribute__((ext_vector_type(2)));

constexpr int NB = 8, SEQ = 4096, DM = 1024, T = NB * SEQ, MIXW = 1536, MEMT = 256;
constexpr int NEXP = 16384, NWAVES = 8, NTHR = 512;
constexpr float EPS = 1e-6f;

constexpr size_t MiB = 1u << 20;
constexpr size_t WS_RSTD0 = 1 * MiB;
constexpr size_t WS_RSTD2 = WS_RSTD0 + 128 * 1024;
constexpr size_t WS_USC   = WS_RSTD0 + 256 * 1024;
constexpr size_t WS_VSC   = WS_RSTD0 + 384 * 1024;
constexpr size_t WS_SSQ   = 2 * MiB;
constexpr size_t WS_KMP   = 4 * MiB;
constexpr size_t WS_ROPE  = 5 * MiB;
constexpr size_t WS_WIN0  = 8 * MiB;
constexpr size_t WS_WC4   = 11 * MiB;
constexpr size_t WS_WC0   = 18 * MiB;
constexpr size_t WS_WOUT1 = 21 * MiB;
constexpr size_t WS_WMKV  = 24 * MiB;
constexpr size_t WS_WQ0   = 28 * MiB;
constexpr size_t WS_WQ1   = 32 * MiB;
constexpr size_t WS_SUBK  = 36 * MiB;
constexpr size_t WS_MEMB  = 37 * MiB;
constexpr size_t WS_MEMKV = 41 * MiB;
constexpr size_t WS_EXP   = 49 * MiB;
constexpr size_t WS_GATE  = 57 * MiB;
constexpr size_t WS_UB    = 73 * MiB;
constexpr size_t WS_VB    = 105 * MiB;
constexpr size_t WS_XB    = 201 * MiB;
constexpr size_t WS_RB    = 265 * MiB;
constexpr size_t WS_P0MAIN = WS_RB;
constexpr size_t WS_A2    = WS_RB + 64 * MiB;
constexpr size_t WS_PQ    = WS_RB;
constexpr size_t WS_KR    = WS_RB;
constexpr size_t WS_VV    = WS_RB + 64 * MiB;
constexpr size_t WS_A3    = WS_RB + 128 * MiB;
constexpr size_t WS_END   = WS_RB + 224 * MiB;

constexpr int LDS_BYTES = 147456;

__device__ __forceinline__ unsigned f2bf(float f) { unsigned u = __builtin_bit_cast(unsigned, f); return (u + 0x7fffu + ((u >> 16) & 1u)) >> 16; }
__device__ __forceinline__ unsigned pk2(float lo, float hi) { return f2bf(lo) | (f2bf(hi) << 16); }
__device__ __forceinline__ unsigned cvtpk(float lo, float hi) { unsigned r; asm volatile("v_cvt_pk_bf16_f32 %0, %1, %2" : "=v"(r) : "v"(lo), "v"(hi)); return r; }
__device__ __forceinline__ float bflo(unsigned w) { return __builtin_bit_cast(float, w << 16); }
__device__ __forceinline__ float bfhi(unsigned w) { return __builtin_bit_cast(float, w & 0xffff0000u); }
template <int J> __device__ __forceinline__ unsigned shx_u(unsigned v) {
    if constexpr (J == 32) { auto rr = __builtin_amdgcn_permlane32_swap(v, v, false, false); return ((threadIdx.x & 32) ? rr[0] : rr[1]); }
    else return (unsigned)__builtin_amdgcn_ds_swizzle((int)v, (J << 10) | 0x1f);
}
template <int J> __device__ __forceinline__ float shx_f(float v) { return __uint_as_float(shx_u<J>(__float_as_uint(v))); }
template <int CTRL> __device__ __forceinline__ float dpp_f(float v) { return __uint_as_float((unsigned)__builtin_amdgcn_update_dpp(0, (int)__float_as_uint(v), CTRL, 0xF, 0xF, false)); }
__device__ __forceinline__ float wave_sum(float v) {
    v += dpp_f<0xB1>(v); v += dpp_f<0x4E>(v); v += dpp_f<0x141>(v); v += dpp_f<0x128>(v);
    v += shx_f<16>(v);
    { auto rr = __builtin_amdgcn_permlane32_swap(__float_as_uint(v), __float_as_uint(v), false, false); v = __uint_as_float(rr[0]) + __uint_as_float(rr[1]); }
    return v;
}
__device__ __forceinline__ float dot2(unsigned w, unsigned x, float acc) { return __builtin_amdgcn_fdot2_f32_bf16(__builtin_bit_cast(bf16x2_t, w), __builtin_bit_cast(bf16x2_t, x), acc, false); }
#define LDS_WAIT() asm volatile("s_waitcnt lgkmcnt(0)" ::: "memory")
#define VM_WAIT() asm volatile("s_waitcnt vmcnt(0)" ::: "memory")

namespace pg8 {
#define PG8_LAS __attribute__((address_space(3)))
typedef unsigned short bf16_t;
constexpr int BM = 256, BK = 64, HALF = 128, HTB = HALF * BK * 2, STAGE_BYTES = 8 * HTB, NXCD = 8, WGM = 8;
__host__ __device__ __forceinline__ int lds_byte(int r, int c) { const int st = (r >> 4) * 2 + (c >> 5), rr = r & 15, cc = c & 31, ob = rr * 64 + cc * 2; return st * 1024 + (ob ^ (((ob >> 9) & 1) << 5)); }
__host__ __device__ __forceinline__ void stage_rc(int b, int& R, int& C) { const int st = b / 1024, sb = b % 1024, swz = sb ^ (((sb >> 9) & 1) << 5); R = (st >> 1) * 16 + swz / 64; C = (st & 1) * 32 + (swz % 64) / 2; }
__host__ __device__ __forceinline__ int perm32(int rho) { const int n = rho >> 4, i = rho & 15; return 8 * (i >> 2) + 4 * n + (i & 3); }
struct Unit { int pm, pn; };
struct Gemm { const bf16_t* A; const bf16_t* Bt; int M, N, K; };
struct StaticOrder {
    int nM, nN, nwg, G, c;
    __host__ __device__ void init(int M, int N, int G_, int c_) { nM = M / BM; nN = N / BM; nwg = nM * nN; G = G_; c = c_; }
    __host__ __device__ bool next(int i, Unit& u) const {
        const long L = (long)i * G + c; if (L >= nwg) return false;
        int wgid = (int)L; { const int q = nwg / NXCD, r = nwg % NXCD, xcd = wgid % NXCD, off = wgid / NXCD; wgid = (xcd < r ? xcd * (q + 1) : r * (q + 1) + (xcd - r) * q) + off; }
        const int nig = WGM * nN, gid = wgid / nig, fm = gid * WGM, gsz = (nM - fm) < WGM ? (nM - fm) : WGM;
        u.pm = fm + ((wgid % nig) % gsz); u.pn = (wgid % nig) / gsz; return true;
    }
    __device__ __forceinline__ void a_ready(const Unit&) const {}
    __device__ __forceinline__ void done(const Unit&) const {}
};

struct EpiRowBf16 {
    static constexpr bool PERM = true, AFTER_DRAIN = false;
    bf16_t* O0; int ld0; bf16_t* O1; int ld1; int split; const float* rs; const float* ssq;
    __device__ __forceinline__ void operator()(const f32x4 (&acc)[2][2][4][2], const Unit& u, int wr, int wc, int fr, int fq) const {
        const int row0 = u.pm * BM + wr * 64 + fr; int colt = u.pn * BM; bf16_t* base = O0; int ldc = ld0;
        if (colt >= split) { base = O1; ldc = ld1; colt -= split; }
        const int col0 = colt + wc * 32 + 8 * fq;
#pragma unroll
        for (int ai = 0; ai < 2; ++ai)
#pragma unroll
            for (int m = 0; m < 4; ++m) { const int row = row0 + ai * HALF + m * 16; float sc = 1.f;
                if (rs) sc = rs[row];
                else if (ssq) { const f32x4* q = (const f32x4*)(ssq + (size_t)row * 16); const f32x4 a = q[0], b = q[1], c = q[2], d = q[3];
                    const float s = ((a[0] + a[1]) + (a[2] + a[3])) + ((b[0] + b[1]) + (b[2] + b[3])) + ((c[0] + c[1]) + (c[2] + c[3])) + ((d[0] + d[1]) + (d[2] + d[3]));
                    sc = __builtin_amdgcn_rsqf(s * (1.0f / 1024.0f) + EPS); }
                bf16_t* rowp = base + (size_t)row * ldc + col0;
#pragma unroll
                for (int bj = 0; bj < 2; ++bj) { const f32x4 v0 = acc[ai][bj][m][0] * sc, v1 = acc[ai][bj][m][1] * sc;
                    u32x4 w; w.x = cvtpk(v0[0], v0[1]); w.y = cvtpk(v0[2], v0[3]); w.z = cvtpk(v1[0], v1[1]); w.w = cvtpk(v1[2], v1[3]);
                    *(u32x4*)(rowp + bj * HALF) = w; } }
    }
};
struct EpiRes {
    static constexpr bool PERM = true, AFTER_DRAIN = false;
    bf16_t* xb; float* ssq;
    __device__ __forceinline__ void operator()(const f32x4 (&acc)[2][2][4][2], const Unit& u, int wr, int wc, int fr, int fq) const {
        const int row0 = u.pm * BM + wr * 64 + fr, col0 = u.pn * BM + wc * 32 + 8 * fq;
#pragma unroll
        for (int ai = 0; ai < 2; ++ai)
#pragma unroll
            for (int m = 0; m < 4; ++m) { const int row = row0 + ai * HALF + m * 16; bf16_t* p = xb + (size_t)row * DM + col0; float ss = 0.f;
#pragma unroll
                for (int bj = 0; bj < 2; ++bj) { const u32x4 r = *(const u32x4*)(p + bj * HALF); const f32x4 a0 = acc[ai][bj][m][0], a1 = acc[ai][bj][m][1];
                    const float o0 = bflo(r.x) + a0[0], o1 = bfhi(r.x) + a0[1], o2 = bflo(r.y) + a0[2], o3 = bfhi(r.y) + a0[3], o4 = bflo(r.z) + a1[0], o5 = bfhi(r.z) + a1[1], o6 = bflo(r.w) + a1[2], o7 = bfhi(r.w) + a1[3];
                    u32x4 w; w.x = cvtpk(o0, o1); w.y = cvtpk(o2, o3); w.z = cvtpk(o4, o5); w.w = cvtpk(o6, o7); *(u32x4*)(p + bj * HALF) = w;
                    ss += ((o0 * o0 + o1 * o1) + (o2 * o2 + o3 * o3)) + ((o4 * o4 + o5 * o5) + (o6 * o6 + o7 * o7)); }
                ss += __shfl_xor(ss, 16); ss += __shfl_xor(ss, 32);
                if (fq == 0) ssq[(size_t)row * 16 + u.pn * 4 + wc] = ss; }
    }
};
struct EpiKVQ {
    static constexpr bool PERM = true, AFTER_DRAIN = false;
    bf16_t* KR; bf16_t* VV; bf16_t* A3; float* KMP; const float* rs; const float* rope;
    __device__ __forceinline__ void operator()(const f32x4 (&acc)[2][2][4][2], const Unit& u, int wr, int wc, int fr, int fq) const {
        const int pn = u.pn, pm = u.pm, b = pm >> 4, s0 = (pm & 15) * 256, rl0 = wr * 64 + fr, g0 = 32 * wc + 8 * fq;
        float rsv[2][4];
#pragma unroll
        for (int ai = 0; ai < 2; ++ai)
#pragma unroll
            for (int m = 0; m < 4; ++m) rsv[ai][m] = rs[pm * BM + rl0 + ai * HALF + m * 16];
        if (pn < 4 || (pn >= 8 && pn < 12)) {
            const bool isK = pn < 4; const int hp = isK ? pn : pn - 8; const int i0 = 16 * wc + 4 * fq;
            f32x4 klo[2] = {{0.f, 0.f, 0.f, 0.f}, {0.f, 0.f, 0.f, 0.f}}, khi[2] = {{0.f, 0.f, 0.f, 0.f}, {0.f, 0.f, 0.f, 0.f}};
#pragma unroll
            for (int ai = 0; ai < 2; ++ai)
#pragma unroll
                for (int m = 0; m < 4; ++m) { const int rl = rl0 + ai * HALF + m * 16, s = s0 + rl;
                    const f32x4 cs0 = *(const f32x4*)(rope + ((size_t)s * 64 + i0) * 2), cs1 = *(const f32x4*)(rope + ((size_t)s * 64 + i0) * 2 + 4);
                    const f32x4 c = {cs0[0], cs0[2], cs1[0], cs1[2]}, sn = {cs0[1], cs0[3], cs1[1], cs1[3]};
#pragma unroll
                    for (int bj = 0; bj < 2; ++bj) { const int head = 2 * hp + bj;
                        const f32x4 v1 = acc[ai][bj][m][0] * rsv[ai][m], v2 = acc[ai][bj][m][1] * rsv[ai][m];
                        const f32x4 lo = v1 * c - v2 * sn, hi = v2 * c + v1 * sn;
                        u32x4 w; w.x = cvtpk(lo[0], lo[1]); w.y = cvtpk(lo[2], lo[3]); w.z = cvtpk(hi[0], hi[1]); w.w = cvtpk(hi[2], hi[3]);
                        bf16_t* dst = isK ? KR + ((size_t)(b * 8 + head) * SEQ + s) * 128 + g0 : A3 + (size_t)(pm * BM + rl) * MIXW + head * 128 + g0;
                        *(u32x4*)dst = w;
                        klo[bj] += lo; khi[bj] += hi; } }
            if (isK) {
#pragma unroll
                for (int bj = 0; bj < 2; ++bj) {
#pragma unroll
                    for (int j = 0; j < 4; ++j) {
#pragma unroll
                        for (int o = 1; o < 16; o <<= 1) { klo[bj][j] += __shfl_xor(klo[bj][j], o); khi[bj][j] += __shfl_xor(khi[bj][j], o); } }
                    if (fr == 0) { float* kp = KMP + ((size_t)pm * 2 + wr) * 1024 + (2 * hp + bj) * 128 + g0; *(f32x4*)kp = klo[bj]; *(f32x4*)(kp + 4) = khi[bj]; } } }
        } else {
            const bool isV = pn < 8;
#pragma unroll
            for (int bj = 0; bj < 2; ++bj)
#pragma unroll
                for (int ai = 0; ai < 2; ++ai)
#pragma unroll
                    for (int m = 0; m < 4; ++m) { const int rl = rl0 + ai * HALF + m * 16, s = s0 + rl;
                        const f32x4 v0 = acc[ai][bj][m][0] * rsv[ai][m], v1 = acc[ai][bj][m][1] * rsv[ai][m];
                        u32x4 w; w.x = cvtpk(v0[0], v0[1]); w.y = cvtpk(v0[2], v0[3]); w.z = cvtpk(v1[0], v1[1]); w.w = cvtpk(v1[2], v1[3]);
                        bf16_t* dst = isV ? VV + ((size_t)(b * 8 + 2 * (pn - 4) + bj) * SEQ + s) * 128 + g0 : A3 + (size_t)(pm * BM + rl) * MIXW + 1024 + (pn - 12) * 256 + bj * HALF + g0;
                        *(u32x4*)dst = w; }
        }
    }
};

template <class Epi, class Sched, bool ALIGN_EPI = true, bool SP2 = true>
__device__ __forceinline__ void gemm_phase(PG8_LAS unsigned char* lds, const Gemm g, const Sched& S, const Epi& E) {
    int tid = threadIdx.x; asm volatile("" : "+v"(tid));
    const int wid = __builtin_amdgcn_readfirstlane(tid >> 6), lane = tid & 63, wr = wid >> 2, wc = wid & 3, fr = lane & 15, fq = lane >> 4;
    const int K = g.K, nt = K / BK;
    unsigned voffA[2], voffB[2];
#pragma unroll
    for (int i = 0; i < 2; ++i) { int R, C; stage_rc(tid * 16 + i * 8192, R, C); const int Rb = Epi::PERM ? ((R & ~31) + perm32(R & 31)) : R;
        voffA[i] = (unsigned)(R * K + C) * 2u; voffB[i] = (unsigned)(Rb * K + C) * 2u; }
    const size_t kstep = (size_t)(BK * 2);
    const size_t hstep = (size_t)HALF * K * 2;
    const size_t tstep = 2 * hstep;
    const unsigned ldsw = (unsigned)wid * 1024u;
    const int aoff = lds_byte(wr * 64 + fr, fq * 8), boff = lds_byte(wc * 32 + fr, fq * 8);
#define PG8_SA(b, h) (((b) * 2 + (h)) * HTB)
#define PG8_SB(b, h) ((4 + (b) * 2 + (h)) * HTB)
#define PG8_STAGE(bufoff, gbase, voff) do { _Pragma("unroll") for (int _i = 0; _i < 2; ++_i) \
        __builtin_amdgcn_global_load_lds((const unsigned*)((const char*)(gbase) + (voff)[_i]), (PG8_LAS unsigned*)(lds + (bufoff) + ldsw + _i * 8192), 16, 0, 0); } while (0)
#define PG8_LDA(dst, b, h) do { _Pragma("unroll") for (int m = 0; m < 4; ++m) _Pragma("unroll") for (int k = 0; k < 2; ++k) dst[m][k] = *(const PG8_LAS bf16x8*)(lds + PG8_SA(b, h) + aoff + m * 2048 + k * 1024); } while (0)
#define PG8_LDB(dst, b, h) do { _Pragma("unroll") for (int n = 0; n < 2; ++n) _Pragma("unroll") for (int k = 0; k < 2; ++k) dst[n][k] = *(const PG8_LAS bf16x8*)(lds + PG8_SB(b, h) + boff + n * 2048 + k * 1024); } while (0)
#define PG8_MMA(ai, bj, At, Bt) do { __builtin_amdgcn_s_setprio(1); _Pragma("unroll") for (int m = 0; m < 4; ++m) _Pragma("unroll") for (int n = 0; n < 2; ++n) _Pragma("unroll") for (int k = 0; k < 2; ++k) \
        acc[ai][bj][m][n] = __builtin_amdgcn_mfma_f32_16x16x32_bf16(Bt[n][k], At[m][k], acc[ai][bj][m][n], 0, 0, 0); __builtin_amdgcn_s_setprio(0); } while (0)
#define PG8_WAIT_V(n) asm volatile("s_waitcnt vmcnt(" #n ")" ::: "memory")
#define PG8_WAIT_L(n) asm volatile("s_waitcnt lgkmcnt(" #n ")" ::: "memory")
#define PG8_BAR __builtin_amdgcn_s_barrier()
#define PG8_SCHED __builtin_amdgcn_sched_barrier(0)
    Unit cur, nxt; int ui = 0;
    if (!S.next(0, cur)) return;
    f32x4 acc[2][2][4][2];
#pragma unroll
    for (int a = 0; a < 2; ++a)
#pragma unroll
        for (int b = 0; b < 2; ++b)
#pragma unroll
            for (int m = 0; m < 4; ++m)
#pragma unroll
                for (int n = 0; n < 2; ++n) acc[a][b][m][n] = (f32x4){0.f, 0.f, 0.f, 0.f};
    bf16x8 At[4][2], B0[2][2], B1[2][2];
    const char* cA = (const char*)g.A + (size_t)cur.pm * tstep; const char* cB = (const char*)g.Bt + (size_t)cur.pn * tstep;
    S.a_ready(cur);
    if constexpr (SP2) {
        PG8_STAGE(PG8_SB(0, 0), cB, voffB); PG8_STAGE(PG8_SB(0, 1), cB + hstep, voffB); PG8_STAGE(PG8_SA(0, 0), cA, voffA); PG8_STAGE(PG8_SA(0, 1), cA + hstep, voffA);
        if (wr == 1) PG8_BAR;
        PG8_WAIT_V(2); PG8_BAR;
        PG8_STAGE(PG8_SB(1, 0), cB + kstep, voffB); PG8_STAGE(PG8_SA(1, 0), cA + kstep, voffA); PG8_STAGE(PG8_SB(1, 1), cB + hstep + kstep, voffB);
        PG8_WAIT_V(6); PG8_BAR;
    } else {
        PG8_STAGE(PG8_SB(0, 0), cB, voffB); PG8_STAGE(PG8_SA(0, 0), cA, voffA); PG8_STAGE(PG8_SB(0, 1), cB + hstep, voffB); PG8_STAGE(PG8_SA(0, 1), cA + hstep, voffA);
        if (wr == 1) PG8_BAR;
        PG8_WAIT_V(4); PG8_BAR;
        PG8_STAGE(PG8_SB(1, 0), cB + kstep, voffB); PG8_STAGE(PG8_SA(1, 0), cA + kstep, voffA); PG8_STAGE(PG8_SB(1, 1), cB + hstep + kstep, voffB);
        PG8_WAIT_V(6); PG8_BAR;
    }
    for (;;) {
        const bool has_next = S.next(ui + 1, nxt);
        const char* nA = has_next ? (const char*)g.A + (size_t)nxt.pm * tstep : cA; const char* nB = has_next ? (const char*)g.Bt + (size_t)nxt.pn * tstep : cB;
        for (int t = 0; t < nt; t += 2) {
            const bool last = (t == nt - 2);
            const char* a1 = cA + (size_t)(t + 1) * kstep;
            const char* a2 = last ? nA : cA + (size_t)(t + 2) * kstep; const char* b2 = last ? nB : cB + (size_t)(t + 2) * kstep;
            const char* a3 = a2 + kstep; const char* b3 = b2 + kstep;
            if (last && has_next) S.a_ready(nxt);
            if constexpr (SP2) {
            PG8_LDB(B0, 0, 0); PG8_LDB(B1, 0, 1); PG8_SCHED; PG8_LDA(At, 0, 0); PG8_STAGE(PG8_SA(1, 1), a1 + hstep, voffA);
            PG8_WAIT_V(8); PG8_WAIT_L(0); PG8_BAR; PG8_MMA(0, 0, At, B0); PG8_MMA(0, 1, At, B1); PG8_BAR; PG8_SCHED;
            PG8_LDA(At, 0, 1); PG8_STAGE(PG8_SB(0, 0), b2, voffB); PG8_STAGE(PG8_SB(0, 1), b2 + hstep, voffB); PG8_STAGE(PG8_SA(0, 0), a2, voffA);
            PG8_WAIT_V(8); PG8_WAIT_L(0); PG8_BAR; PG8_MMA(1, 0, At, B0); PG8_MMA(1, 1, At, B1); PG8_BAR; PG8_SCHED;
            PG8_LDB(B0, 1, 0); PG8_LDB(B1, 1, 1); PG8_SCHED; PG8_LDA(At, 1, 0); PG8_STAGE(PG8_SA(0, 1), a2 + hstep, voffA);
            PG8_WAIT_V(8); PG8_WAIT_L(0); PG8_BAR; PG8_MMA(0, 0, At, B0); PG8_MMA(0, 1, At, B1); PG8_BAR; PG8_SCHED;
            PG8_LDA(At, 1, 1); PG8_STAGE(PG8_SB(1, 0), b3, voffB); PG8_STAGE(PG8_SB(1, 1), b3 + hstep, voffB); PG8_STAGE(PG8_SA(1, 0), a3, voffA);
            PG8_WAIT_V(8); PG8_WAIT_L(0); PG8_BAR; PG8_MMA(1, 0, At, B0); PG8_MMA(1, 1, At, B1); PG8_BAR; PG8_SCHED;
            } else {
            PG8_LDB(B0, 0, 0); PG8_SCHED; PG8_LDA(At, 0, 0); PG8_STAGE(PG8_SA(1, 1), a1 + hstep, voffA);
            PG8_WAIT_L(8); PG8_BAR; PG8_WAIT_L(0); PG8_MMA(0, 0, At, B0); PG8_BAR; PG8_SCHED;
            PG8_LDB(B1, 0, 1); PG8_STAGE(PG8_SB(0, 0), b2, voffB);
            PG8_BAR; PG8_WAIT_L(0); PG8_MMA(0, 1, At, B1); PG8_BAR;
            PG8_LDA(At, 0, 1); PG8_STAGE(PG8_SA(0, 0), a2, voffA);
            PG8_BAR; PG8_WAIT_L(0); PG8_MMA(1, 0, At, B0); PG8_BAR; PG8_SCHED;
            PG8_STAGE(PG8_SB(0, 1), b2 + hstep, voffB);
            PG8_WAIT_V(6); PG8_BAR; PG8_MMA(1, 1, At, B1); PG8_BAR;
            PG8_LDB(B0, 1, 0); PG8_SCHED; PG8_LDA(At, 1, 0); PG8_STAGE(PG8_SA(0, 1), a2 + hstep, voffA);
            PG8_WAIT_L(8); PG8_BAR; PG8_WAIT_L(0); PG8_MMA(0, 0, At, B0); PG8_BAR; PG8_SCHED;
            PG8_LDB(B1, 1, 1); PG8_STAGE(PG8_SB(1, 0), b3, voffB);
            PG8_BAR; PG8_WAIT_L(0); PG8_MMA(0, 1, At, B1); PG8_BAR;
            PG8_LDA(At, 1, 1); PG8_STAGE(PG8_SA(1, 0), a3, voffA);
            PG8_BAR; PG8_WAIT_L(0); PG8_MMA(1, 0, At, B0); PG8_BAR; PG8_SCHED;
            PG8_STAGE(PG8_SB(1, 1), b3 + hstep, voffB);
            PG8_WAIT_V(6); PG8_BAR; PG8_MMA(1, 1, At, B1); PG8_BAR;
            }
        }
        if constexpr (ALIGN_EPI) { if (wr == 0) PG8_BAR; }
        if constexpr (!Epi::AFTER_DRAIN) { E(acc, cur, wr, wc, fr, fq); S.done(cur); }
        if (!has_next) break;
#pragma unroll
        for (int a = 0; a < 2; ++a)
#pragma unroll
            for (int b = 0; b < 2; ++b)
#pragma unroll
                for (int m = 0; m < 4; ++m)
#pragma unroll
                    for (int n = 0; n < 2; ++n) acc[a][b][m][n] = (f32x4){0.f, 0.f, 0.f, 0.f};
        cur = nxt; cA = nA; cB = nB; ++ui;
        if constexpr (ALIGN_EPI) { if (wr == 1) PG8_BAR; }
    }
    PG8_WAIT_V(0);
    if constexpr (!ALIGN_EPI) { if (wr == 0) PG8_BAR; }
    PG8_BAR;
#undef PG8_SA
#undef PG8_SB
#undef PG8_STAGE
#undef PG8_LDA
#undef PG8_LDB
#undef PG8_MMA
#undef PG8_WAIT_V
#undef PG8_WAIT_L
#undef PG8_BAR
#undef PG8_SCHED
}
}

namespace att {
constexpr int D = 128, NW = 8, QBLK = 32, KVBLK = 64;
constexpr float SCALE = 0.088388347648318440f;
constexpr float THR = 8.f;
constexpr size_t SHM_V = KVBLK * D * 2, SHM_K = KVBLK * D * 2, SHM_ATTN = 2 * SHM_V + 2 * SHM_K + NW * 64 * 4;
#define KSWZ(row, colB) ((row) * 256 + ((colB) ^ (((row) & 7) << 4)))
#define SBAR() __builtin_amdgcn_sched_barrier(0)
__device__ __forceinline__ int crow(int r, int hi) { return (r & 3) + 8 * (r >> 2) + 4 * hi; }

template <bool MOBA>
__device__ __forceinline__ void partialSM(f32x16& p0, f32x16& p1, float& m_reg, float& mn, float& alpha, int t, int qrow, int hi, unsigned selmask) {
  constexpr float C = SCALE * 1.4426950408889634f;
  if constexpr (MOBA) {
    if (t < 4) { const int kb = t * 64 + 4 * hi;
#pragma unroll
      for (int r = 0; r < 16; ++r) { const int kk = kb + (r & 3) + 8 * (r >> 2); p0[r] = (kk > qrow) ? -1e30f : p0[r]; p1[r] = (kk + 32 > qrow) ? -1e30f : p1[r]; }
    } else { const bool keep = (selmask >> ((t - 4) >> 2)) & 1u;
#pragma unroll
      for (int r = 0; r < 16; ++r) { p0[r] = keep ? p0[r] : -1e30f; p1[r] = keep ? p1[r] : -1e30f; } }
  }
  float pmax = p0[0];
#pragma unroll
  for (int r = 1; r < 16; ++r) pmax = fmaxf(pmax, p0[r]);
#pragma unroll
  for (int r = 0; r < 16; ++r) pmax = fmaxf(pmax, p1[r]);
  { auto rr = __builtin_amdgcn_permlane32_swap(__float_as_uint(pmax), __float_as_uint(pmax), false, false);
    pmax = fmaxf(__uint_as_float(rr[0]), __uint_as_float(rr[1])); }
  if (__builtin_expect(__all(pmax - m_reg <= THR / SCALE), 1)) { mn = m_reg; alpha = 1.f; }
  else { mn = fmaxf(m_reg, pmax); alpha = __builtin_amdgcn_exp2f((m_reg - mn) * C); m_reg = mn; }
  float mnC = -mn * C;
#pragma unroll
  for (int r = 0; r < 16; ++r) p0[r] = fmaf(p0[r], C, mnC);
#pragma unroll
  for (int r = 0; r < 16; ++r) p1[r] = fmaf(p1[r], C, mnC);
#pragma unroll
  for (int r = 0; r < 16; ++r) p0[r] = __builtin_amdgcn_exp2f(p0[r]);
}
__device__ __forceinline__ void finishSM(f32x16& p0, f32x16& p1, float alpha, float& l_reg, bf16x8& pa0, bf16x8& pa1, bf16x8& pa2, bf16x8& pa3) {
#pragma unroll
  for (int r = 0; r < 16; ++r) p1[r] = __builtin_amdgcn_exp2f(p1[r]);
  float ps = 0;
#pragma unroll
  for (int r = 0; r < 16; ++r) ps += p0[r];
#pragma unroll
  for (int r = 0; r < 16; ++r) ps += p1[r];
  { auto rr = __builtin_amdgcn_permlane32_swap(__float_as_uint(ps), __float_as_uint(ps), false, false);
    ps = __uint_as_float(rr[0]) + __uint_as_float(rr[1]); }
  l_reg = l_reg * alpha + ps;
#define PK4(P, BASE, OUT) do { unsigned a0 = cvtpk(P[BASE + 0], P[BASE + 1]), a1 = cvtpk(P[BASE + 2], P[BASE + 3]);   \
    unsigned b0 = cvtpk(P[BASE + 4], P[BASE + 5]), b1 = cvtpk(P[BASE + 6], P[BASE + 7]);                              \
    auto r0 = __builtin_amdgcn_permlane32_swap(a0, b0, false, false); auto r1 = __builtin_amdgcn_permlane32_swap(a1, b1, false, false); \
    u32x4 w = {r0[0], r1[0], r0[1], r1[1]}; OUT = *reinterpret_cast<bf16x8*>(&w); } while (0)
  PK4(p0, 0, pa0); PK4(p0, 8, pa1); PK4(p1, 0, pa2); PK4(p1, 8, pa3);
#undef PK4
}
__device__ __forceinline__ void qkt(f32x16& p0, f32x16& p1, const char* Ks, const bf16x8* qr, const int (&ka)[4]) {
  p0 = f32x16{}; p1 = f32x16{};
#pragma unroll
  for (int d0 = 0; d0 < 8; ++d0) {
    bf16x8 b0 = *reinterpret_cast<const bf16x8*>(Ks + ka[d0 & 3] + (d0 >> 2) * 128);
    bf16x8 b1 = *reinterpret_cast<const bf16x8*>(Ks + ka[d0 & 3] + (d0 >> 2) * 128 + 8192);
    p0 = __builtin_amdgcn_mfma_f32_32x32x16_bf16(b0, qr[d0], p0, 0, 0, 0);
    p1 = __builtin_amdgcn_mfma_f32_32x32x16_bf16(b1, qr[d0], p1, 0, 0, 0); }
}
__device__ __forceinline__ void qkt1(f32x16& p0, const char* Ks, const bf16x8* qr, const int (&ka)[4]) {
  p0 = f32x16{};
#pragma unroll
  for (int d0 = 0; d0 < 8; ++d0) {
    bf16x8 b0 = *reinterpret_cast<const bf16x8*>(Ks + ka[d0 & 3] + (d0 >> 2) * 128);
    p0 = __builtin_amdgcn_mfma_f32_32x32x16_bf16(b0, qr[d0], p0, 0, 0, 0); }
}
__device__ __forceinline__ int v_st(int k, int c) { const int kk = (k & ~0xC) | ((k & 4) << 1) | ((k & 8) >> 1); return ((kk >> 3) * 4 + (c >> 5)) * 512 + ((kk & 7) * 32 + (c & 31)) * 2; }
__device__ __forceinline__ int v_rd_base(int lane) { return ((lane & 3) << 3) | (((lane >> 2) & 3) << 6) | (((lane >> 4) & 1) << 5) | (((lane >> 5) & 1) << 8); }
constexpr int v_rd_off(int d0, int ks, int half) { return d0 * 512 + ks * 4096 + half * 2048; }
template <int OFF> __device__ __forceinline__ s16x4 tr_read(int vb) {
  s16x4 r; asm volatile("ds_read_b64_tr_b16 %0, %1 offset:%2" : "=&v"(r) : "v"(vb), "i"(OFF) : "memory"); return r;
}
template <int D0> __device__ __forceinline__ void pv_one(f32x16& od, int vb, bf16x8 pa0, bf16x8 pa1, bf16x8 pa2, bf16x8 pa3) {
  const s16x4 l0 = tr_read<v_rd_off(D0, 0, 0)>(vb), h0 = tr_read<v_rd_off(D0, 0, 1)>(vb), l1 = tr_read<v_rd_off(D0, 1, 0)>(vb), h1 = tr_read<v_rd_off(D0, 1, 1)>(vb);
  const s16x4 l2 = tr_read<v_rd_off(D0, 2, 0)>(vb), h2 = tr_read<v_rd_off(D0, 2, 1)>(vb), l3 = tr_read<v_rd_off(D0, 3, 0)>(vb), h3 = tr_read<v_rd_off(D0, 3, 1)>(vb);
  asm volatile("s_waitcnt lgkmcnt(0)" ::: "memory"); SBAR();
#define PK(L, H) (bf16x8){L[0], L[1], L[2], L[3], H[0], H[1], H[2], H[3]}
  od = __builtin_amdgcn_mfma_f32_32x32x16_bf16(pa0, PK(l0, h0), od, 0, 0, 0);
  od = __builtin_amdgcn_mfma_f32_32x32x16_bf16(pa1, PK(l1, h1), od, 0, 0, 0);
  od = __builtin_amdgcn_mfma_f32_32x32x16_bf16(pa2, PK(l2, h2), od, 0, 0, 0);
  od = __builtin_amdgcn_mfma_f32_32x32x16_bf16(pa3, PK(l3, h3), od, 0, 0, 0);
#undef PK
}
__device__ __forceinline__ void pv_d0(f32x16* o, int vb, bf16x8 pa0, bf16x8 pa1, bf16x8 pa2, bf16x8 pa3) {
  pv_one<0>(o[0], vb, pa0, pa1, pa2, pa3); pv_one<1>(o[1], vb, pa0, pa1, pa2, pa3); pv_one<2>(o[2], vb, pa0, pa1, pa2, pa3); pv_one<3>(o[3], vb, pa0, pa1, pa2, pa3);
}

template <int LDQ, int LDK, bool MOBA, int SDEPTH>
__device__ __forceinline__ void attn_unit(const bf16* Qb, const bf16* Kh, const bf16* Vh, bf16* Ob, int jblk, const float* kmp, char* lds) {
  int tid = threadIdx.x; asm volatile("" : "+v"(tid));
  const int wid = __builtin_amdgcn_readfirstlane(tid >> 6), lane = tid & 63, r32 = lane & 31, hi = lane >> 5;
  char* V_lds = lds; char* K_lds = lds + 2 * SHM_V;
  float* ws = (float*)(lds + 2 * SHM_V + 2 * SHM_K) + wid * 64; float* li_l = ws; float* al_l = ws + 32;
  float m_reg = -1e30f, l_reg = 0; f32x16 o[4] = {}; bf16x8 qr[8];
  const bf16* Qw = Qb + (long)(wid * QBLK + r32) * LDQ + hi * 8;
#pragma unroll
  for (int d0 = 0; d0 < 8; ++d0) qr[d0] = *reinterpret_cast<const bf16x8*>(Qw + d0 * 16);
  const int sr = tid >> 4, sc = (tid & 15) * 8, vst0 = v_st(sr, sc), vst1 = v_st(32 + sr, sc);
  const unsigned goff = (unsigned)(sr * LDK + sc) * 2u;
  const int vb0 = (int)(uintptr_t)V_lds + v_rd_base(lane);
  const int qrow = wid * QBLK + r32;
  int ka[4];
#pragma unroll
  for (int i = 0; i < 4; ++i) ka[i] = r32 * 256 + (((2 * i + hi) ^ (r32 & 7)) << 4);
  unsigned selmask = 0;
  struct { bf16x8 vs0, vs1, ks0, ks1; } sr_[SDEPTH];
  const int NT = MOBA ? 4 * (jblk + 1) : 4;
#define KOFF(t) (MOBA ? ((t) < 4 ? jblk * 256 + (t) * 64 : ((t) - 4) * 64) : (t) * 64)
#define SLOAD(i, k0) do { const char* kb_ = (const char*)Kh + (size_t)(k0) * (LDK * 2); const char* vb_ = (const char*)Vh + (size_t)(k0) * (LDK * 2); \
    sr_[i].vs0 = *reinterpret_cast<const bf16x8*>(vb_ + goff); sr_[i].vs1 = *reinterpret_cast<const bf16x8*>(vb_ + 32 * LDK * 2 + goff); \
    sr_[i].ks0 = *reinterpret_cast<const bf16x8*>(kb_ + goff); sr_[i].ks1 = *reinterpret_cast<const bf16x8*>(kb_ + 32 * LDK * 2 + goff); } while (0)
#define SWRITE(b, i) do { *(bf16x8*)(V_lds + (b) * SHM_V + vst0) = sr_[i].vs0;          \
    *(bf16x8*)(V_lds + (b) * SHM_V + vst1) = sr_[i].vs1; int kc = sc * 2;               \
    *(bf16x8*)(K_lds + (b) * SHM_K + KSWZ(sr, kc)) = sr_[i].ks0;                       \
    *(bf16x8*)(K_lds + (b) * SHM_K + KSWZ(32 + sr, kc)) = sr_[i].ks1; } while (0)
#define SWAIT() do { if constexpr (SDEPTH == 2) asm volatile("s_waitcnt vmcnt(4)" ::: "memory"); else asm volatile("s_waitcnt vmcnt(0)" ::: "memory"); } while (0)
#define RESC(a) do { if (__any((a) < 1.f)) { if (hi == 0) al_l[r32] = (a); asm volatile("s_waitcnt lgkmcnt(0)" ::: "memory"); \
    _Pragma("unroll") for (int d = 0; d < 4; ++d) _Pragma("unroll") for (int r = 0; r < 16; ++r) o[d][r] *= al_l[crow(r, hi)]; } } while (0)
  f32x16 pA0, pA1, pB0, pB1; float mnA, mnB, alA, alB; bf16x8 pa0, pa1, pa2, pa3;
  constexpr int SE = 0, SO = SDEPTH - 1;
  SLOAD(SE, KOFF(0));
  if constexpr (MOBA) {
    const int gr = tid >> 4, gc = (tid & 15) * 8; f32x4 a = {0.f, 0.f, 0.f, 0.f}, b = {0.f, 0.f, 0.f, 0.f};
    if (gr < jblk) { const float* p0_ = kmp + (size_t)gr * 2048 + gc; const f32x4 a0 = *(const f32x4*)p0_, a1 = *(const f32x4*)(p0_ + 4), b0 = *(const f32x4*)(p0_ + 1024), b1 = *(const f32x4*)(p0_ + 1028);
      a = (a0 + b0) * (1.0f / 256.0f); b = (a1 + b1) * (1.0f / 256.0f); }
    u32x4 w = {pk2(a[0], a[1]), pk2(a[2], a[3]), pk2(b[0], b[1]), pk2(b[2], b[3])};
    *(u32x4*)(K_lds + SHM_K + KSWZ(gr, gc * 2)) = w;
  }
  asm volatile("s_waitcnt vmcnt(0)" ::: "memory"); SWRITE(0, SE); __syncthreads();
  qkt(pA0, pA1, K_lds, qr, ka);
  if constexpr (MOBA) {
    f32x16 g; qkt1(g, K_lds + SHM_K, qr, ka);
    float gv[16];
#pragma unroll
    for (int r = 0; r < 8; ++r) { auto rr = __builtin_amdgcn_permlane32_swap(__float_as_uint(g[r]), __float_as_uint(g[r]), false, false);
      const float lo_ = __uint_as_float(rr[0]), hi_ = __uint_as_float(rr[1]);
      const int n0 = (r & 3) + 8 * (r >> 2); gv[n0] = lo_; gv[n0 + 4] = hi_; }
#pragma unroll
    for (int n = 0; n < 16; ++n) gv[n] = (n < jblk) ? gv[n] : -3e38f;
#pragma unroll
    for (int k = 0; k < 3; ++k) { float best = gv[0];
#pragma unroll
      for (int n = 1; n < 16; ++n) best = fmaxf(best, gv[n]);
      int idx = 16;
#pragma unroll
      for (int n = 15; n >= 0; --n) idx = (gv[n] == best) ? n : idx;
      if (best > -1e38f) selmask |= 1u << idx;
#pragma unroll
      for (int n = 0; n < 16; ++n) gv[n] = (n == idx) ? -3e38f : gv[n]; }
  }
  partialSM<MOBA>(pA0, pA1, m_reg, mnA, alA, 0, qrow, hi, selmask);
  SLOAD(SO, KOFF(1)); if constexpr (SDEPTH == 2) { if (2 < NT) SLOAD(SE, KOFF(2)); }
  if constexpr (MOBA) __syncthreads();
  SWAIT(); SWRITE(1, SO); __syncthreads();
  for (int j = 1; j + 1 < NT; j += 2) {
    SBAR(); qkt(pB0, pB1, K_lds + SHM_K, qr, ka);
    finishSM(pA0, pA1, alA, l_reg, pa0, pa1, pa2, pa3); SBAR();
    SLOAD(SO, KOFF(j + SDEPTH)); SBAR();
    pv_d0(o, vb0, pa0, pa1, pa2, pa3); partialSM<MOBA>(pB0, pB1, m_reg, mnB, alB, j, qrow, hi, selmask);
    __syncthreads(); SWAIT(); SWRITE(0, SE);
    RESC(alB); __syncthreads();
    SBAR(); qkt(pA0, pA1, K_lds, qr, ka);
    finishSM(pB0, pB1, alB, l_reg, pa0, pa1, pa2, pa3); SBAR();
    if (SDEPTH == 1 || j + 3 < NT) SLOAD(SE, KOFF(j + 1 + SDEPTH)); SBAR();
    pv_d0(o, vb0 + (int)SHM_V, pa0, pa1, pa2, pa3); partialSM<MOBA>(pA0, pA1, m_reg, mnA, alA, j + 1, qrow, hi, selmask);
    __syncthreads(); SWAIT(); SWRITE(1, SO);
    RESC(alA); __syncthreads();
  }
  SBAR(); qkt(pB0, pB1, K_lds + SHM_K, qr, ka);
  finishSM(pA0, pA1, alA, l_reg, pa0, pa1, pa2, pa3); SBAR();
  pv_d0(o, vb0, pa0, pa1, pa2, pa3); partialSM<MOBA>(pB0, pB1, m_reg, mnB, alB, NT - 1, qrow, hi, selmask);
  __syncthreads(); RESC(alB);
  finishSM(pB0, pB1, alB, l_reg, pa0, pa1, pa2, pa3); SBAR();
  pv_d0(o, vb0 + (int)SHM_V, pa0, pa1, pa2, pa3);
  if (hi == 0) li_l[r32] = l_reg; asm volatile("s_waitcnt lgkmcnt(0)" ::: "memory");
  float rli[16];
#pragma unroll
  for (int r = 0; r < 16; ++r) rli[r] = __builtin_amdgcn_rcpf(li_l[crow(r, hi)]);
  __syncthreads();
  char* ost = lds + wid * 8192;
#pragma unroll
  for (int r = 0; r < 16; ++r) { const int orow = crow(r, hi);
#pragma unroll
    for (int d0 = 0; d0 < 4; ++d0) *(unsigned short*)(ost + orow * 256 + (d0 * 32 + r32) * 2) = (unsigned short)f2bf(o[d0][r] * rli[r]); }
  asm volatile("s_waitcnt lgkmcnt(0)" ::: "memory");
  bf16* Ow = Ob + (long)(wid * QBLK) * LDQ;
#pragma unroll
  for (int i = 0; i < 8; ++i) { const int row = i * 4 + (lane >> 4), ch = lane & 15; const u32x4 v = *(const u32x4*)(ost + row * 256 + ch * 16);
    *(u32x4*)(Ow + (long)row * LDQ + ch * 8) = v; }
  __syncthreads();
#undef KOFF
#undef SLOAD
#undef SWRITE
#undef SWAIT
#undef RESC
}
}

#ifndef ATT_SD_MEM
#define ATT_SD_MEM 1
#endif
#ifndef ATT_SD_MOBA
#define ATT_SD_MOBA 1
#endif
struct Args {
    const float* in[16]; float* out; unsigned char* ws; int ph_lo, ph_hi;
};
struct Frame {
    LAS unsigned char* lds; char* ldsg;
    int wave, vcu, G;
};
__device__ __forceinline__ int fresh_tid() { int t = threadIdx.x; asm volatile("" : "+v"(t)); return t; }

template <int MAP>
__device__ __forceinline__ void transpose_item(const float* W, int ldw, bf16* dst, int ldd, int row_off, int koff, const float* sc, LAS float* scr, int kb, int nb, int lane) {
    const int k0 = 64 * kb, n0 = 32 * nb;
#pragma unroll 8
    for (int i = 0; i < 32; ++i) { const int kk = 2 * i + (lane >> 5); float v = W[(size_t)(k0 + kk) * ldw + n0 + (lane & 31)]; if (sc) v *= sc[k0 + kk]; scr[kk * 33 + (lane & 31)] = v; }
    LDS_WAIT(); asm volatile("" ::: "memory");
    const int c = lane & 7;
#pragma unroll
    for (int j = 0; j < 4; ++j) { const int n = (lane >> 3) + 8 * j; const LAS float* s = scr + (8 * c) * 33 + n;
        u32x4 o; o.x = pk2(s[0 * 33], s[1 * 33]); o.y = pk2(s[2 * 33], s[3 * 33]); o.z = pk2(s[4 * 33], s[5 * 33]); o.w = pk2(s[6 * 33], s[7 * 33]);
        const int ns = n0 + n; int row;
        if (MAP == 1 && ns < 1024) { const int d = ns & 127; row = row_off + (ns & ~127) + 32 * ((d >> 4) & 3) + 8 * ((d >> 2) & 3) + 4 * (d >> 6) + (d & 3); } else row = row_off + ns;
        *(u32x4*)(dst + (size_t)row * ldd + koff + k0 + 8 * c) = o; }
    LDS_WAIT(); asm volatile("" ::: "memory");
}

template <int PART> __device__ __forceinline__ void phase0(const Args& a, Frame& F, int tb_lo, int tb_hi) {
    unsigned char* ws = a.ws;
    const int lane = fresh_tid() & 63;
    const int gw = F.vcu * NWAVES + F.wave, NGW = F.G * NWAVES;
    const int gt = gw * 64 + lane, NGT = NGW * 64;
    LAS float* scr = (LAS float*)(F.lds + F.wave * 16384);
    const float* x = a.in[0]; const float* mem = a.in[1]; const float* g_mix = a.in[2]; const float* w_in = a.in[3]; const float* w_out = a.in[4]; const float* w_mkv = a.in[5];
    const float* pool_w = a.in[6]; const float* pool_sc = a.in[7]; const float* g_kv = a.in[8]; const float* w_kv = a.in[9]; const float* g_ffn = a.in[10]; const float* wq = a.in[11];
    const float* subk = a.in[12]; const float* pu = a.in[13]; const float* pv = a.in[14];
    constexpr int I1 = 16 * 48, I2 = 16 * 48, I3 = 16 * 64, I4 = 8 * 32, I5 = 24 * 32, I6 = 2 * 16 * 32, I7 = 2 * 16 * 64;
    if (PART == 0) for (int r = gw; r < I6; r += NGW) { const int l = r / 512, q = r % 512; transpose_item<0>(w_mkv + (size_t)l * DM * 1024, 1024, (bf16*)(ws + WS_WMKV), DM, l * 1024, 0, nullptr, scr, q / 32, q % 32, lane); }
    constexpr int NIT = I1 + I2 + I3 + I4 + I5 + I7;
    if (PART == 1) for (int it = gw; it < NIT; it += NGW) {
        int r = it;
        if (r < I1) { transpose_item<0>(w_in, MIXW, (bf16*)(ws + WS_WIN0), DM, 0, 0, g_mix, scr, r / 48, r % 48, lane); continue; } r -= I1;
        if (r < I2) { transpose_item<1>(w_in + (size_t)DM * MIXW, MIXW, (bf16*)(ws + WS_WC4), DM, 2048, 0, g_mix + DM, scr, r / 48, r % 48, lane); continue; } r -= I2;
        if (r < I3) { transpose_item<1>(w_kv, 2048, (bf16*)(ws + WS_WC4), DM, 0, 0, g_kv, scr, r / 64, r % 64, lane); continue; } r -= I3;
        if (r < I4) { transpose_item<0>(w_out + (size_t)1024 * DM, DM, (bf16*)(ws + WS_WC0), MIXW, 0, 1024, nullptr, scr, r / 32, r % 32, lane); continue; } r -= I4;
        if (r < I5) { transpose_item<0>(w_out + (size_t)MIXW * DM, DM, (bf16*)(ws + WS_WOUT1), MIXW, 0, 0, nullptr, scr, r / 32, r % 32, lane); continue; } r -= I5;
        { const int l = r / 1024, q = r % 1024; transpose_item<0>(wq + (size_t)l * DM * 2048, 2048, (bf16*)(ws + (l ? WS_WQ1 : WS_WQ0)), DM, 0, 0, g_ffn + l * DM, scr, q / 64, q % 64, lane); }
    }
    if (PART == 1) for (int it = gw; it < 2048; it += NGW) {
        const int itu = __builtin_amdgcn_readfirstlane(it); const int g = itu >> 9, cg8 = (itu >> 4) & 31, nch = itu & 15; const int n = nch * 64 + lane;
        float acc[8];
#pragma unroll
        for (int i = 0; i < 8; ++i) acc[i] = 0.f;
        const float* pw = pool_w + ((size_t)g * 256 + cg8 * 8) * 256;
#pragma unroll 1
        for (int k = 0; k < 4; ++k) { float cf[8]; const float sc = pool_sc[g * 256 + k * 64 + lane];
#pragma unroll
            for (int i = 0; i < 8; ++i) cf[i] = pw[i * 256 + k * 64 + lane] * sc;
            float wv[64];
#pragma unroll
            for (int l = 0; l < 64; ++l) wv[l] = w_out[(size_t)(g * 256 + k * 64 + l) * DM + n];
#pragma unroll
            for (int l = 0; l < 64; ++l) {
#pragma unroll
                for (int i = 0; i < 8; ++i) acc[i] = fmaf(__builtin_bit_cast(float, __builtin_amdgcn_readlane(__builtin_bit_cast(int, cf[i]), l)), wv[l], acc[i]); } }
        u32x4 o; o.x = pk2(acc[0], acc[1]); o.y = pk2(acc[2], acc[3]); o.z = pk2(acc[4], acc[5]); o.w = pk2(acc[6], acc[7]);
        *(u32x4*)((bf16*)(ws + WS_WC0) + (size_t)n * MIXW + g * 256 + cg8 * 8) = o;
    }
    {
        const size_t n8a = (size_t)2 * 16 * 128 * 128 / 8, n8b = (size_t)2048 * 1024 / 8;
        if (PART < 2) for (size_t i = (PART == 0 ? n8a : 0) + gt; i < (PART == 0 ? n8a + n8b : n8a); i += NGT) { const bool A = i < n8a; const size_t j = A ? i : i - n8a; const float* src = (A ? subk : mem) + j * 8; bf16* dst = (bf16*)(ws + (A ? WS_SUBK : WS_MEMB)) + j * 8;
            const f32x4 v0 = *(const f32x4*)src, v1 = *(const f32x4*)(src + 4); u32x4 o = {pk2(v0[0], v0[1]), pk2(v0[2], v0[3]), pk2(v1[0], v1[1]), pk2(v1[2], v1[3])}; *(u32x4*)dst = o; }
    }
    f32x4 v[4], n1[4], n2[4], gq[4]; int gcur = -1;
    auto ldrow = [&](int r, f32x4 (&d)[4]) { if (r < tb_hi) { const int tb = r / (2 * NEXP), rr = r % (2 * NEXP); const f32x4* src = (const f32x4*)((tb ? pv : pu) + (size_t)rr * DM) + lane;
#pragma unroll
        for (int i = 0; i < 4; ++i) d[i] = src[64 * i]; } };
    auto cvrow = [&](int r, const f32x4 (&vin)[4]) { const int tb = r / (2 * NEXP), rr = r % (2 * NEXP), l = rr / NEXP;
        f32x4 w4[4];
#pragma unroll
        for (int i = 0; i < 4; ++i) w4[i] = vin[i];
        if (!tb) { if (l != gcur) { const f32x4* gp = (const f32x4*)(g_ffn + l * DM) + lane; gcur = l;
#pragma unroll
                for (int i = 0; i < 4; ++i) gq[i] = gp[64 * i]; }
#pragma unroll
            for (int i = 0; i < 4; ++i) w4[i] *= gq[i]; }
        float am = 0.f;
#pragma unroll
        for (int i = 0; i < 4; ++i) am = fmaxf(fmaxf(fmaxf(am, fabsf(w4[i][0])), fmaxf(fabsf(w4[i][1]), fabsf(w4[i][2]))), fabsf(w4[i][3]));
#pragma unroll
        for (int o = 1; o < 64; o <<= 1) am = fmaxf(am, __shfl_xor(am, o));
        const int eb = (int)((__builtin_bit_cast(unsigned, am) >> 23) & 0xffu);
        const float sc = (eb < 16) ? 1.0f : __builtin_bit_cast(float, (unsigned)(127 + 7 + 127 - eb) << 23);
        const float isc = (eb < 16) ? 1.0f : __builtin_bit_cast(float, (unsigned)(eb - 7) << 23);
        unsigned* dst = (unsigned*)(ws + (tb ? WS_VB : WS_UB) + (size_t)rr * DM) + lane;
#pragma unroll
        for (int i = 0; i < 4; ++i) { int w = __builtin_amdgcn_cvt_pk_fp8_f32(w4[i][0] * sc, w4[i][1] * sc, 0, false); w = __builtin_amdgcn_cvt_pk_fp8_f32(w4[i][2] * sc, w4[i][3] * sc, w, true); dst[64 * i] = (unsigned)w; }
        if (lane == 0) ((float*)(ws + (tb ? WS_VSC : WS_USC)))[rr] = isc; };
    if (PART == 2) { const int r0 = tb_lo + F.wave; ldrow(r0, v); ldrow(r0 + NWAVES, n1);
        for (int r = r0; r < tb_hi; r += 3 * NWAVES) {
            ldrow(r + 2 * NWAVES, n2); cvrow(r, v);
            if (r + NWAVES < tb_hi) { ldrow(r + 3 * NWAVES, v); cvrow(r + NWAVES, n1); }
            if (r + 2 * NWAVES < tb_hi) { ldrow(r + 4 * NWAVES, n1); cvrow(r + 2 * NWAVES, n2); } } }
    if (PART == 2) for (int i = gt; i < SEQ * 64; i += NGT) { const int pos = i >> 6, fi = i & 63; const float inv = exp2f(-(float)fi * 0.20762050593046015f);
        float sn, cs_; sincosf((float)pos * inv, &sn, &cs_); f32x2 cs = {cs_, sn}; *(f32x2*)((float*)(ws + WS_ROPE) + (size_t)i * 2) = cs; }
    auto ldx = [&](int t, f32x4 (&d)[4]) { if (t < T) { const f32x4* xr = (const f32x4*)(x + (size_t)t * DM) + lane;
#pragma unroll
        for (int j = 0; j < 4; ++j) d[j] = xr[64 * j]; } };
    auto cvx = [&](int t, const f32x4 (&vin)[4]) { float s_ = 0.f;
#pragma unroll
        for (int j = 0; j < 4; ++j) s_ += (vin[j][0] * vin[j][0] + vin[j][1] * vin[j][1]) + (vin[j][2] * vin[j][2] + vin[j][3] * vin[j][3]);
        s_ = wave_sum(s_);
        u32x2* o8 = (u32x2*)((bf16*)(ws + WS_XB) + (size_t)t * DM) + lane;
#pragma unroll
        for (int j = 0; j < 4; ++j) { u32x2 w = {pk2(vin[j][0], vin[j][1]), pk2(vin[j][2], vin[j][3])}; o8[64 * j] = w; }
        if (lane == 0) ((float*)(ws + WS_RSTD0))[t] = 1.0f / sqrtf(s_ * (1.0f / DM) + EPS); };
    if (PART == 2) { ldx(gw, v); ldx(gw + NGW, n1);
        for (int t = gw; t < T; t += 3 * NGW) {
            ldx(t + 2 * NGW, n2); cvx(t, v);
            if (t + NGW < T) { ldx(t + 3 * NGW, v); cvx(t + NGW, n1); }
            if (t + 2 * NGW < T) { ldx(t + 4 * NGW, n1); cvx(t + 2 * NGW, n2); } } }
}

template <int W, int NT> __device__ __forceinline__ void pool_item(const bf16* pm, bf16* A2, int t0, int c0) {
    const int s0 = t0 & (SEQ - 1);
    u32x4 rows[W - 1 + NT];
#pragma unroll
    for (int i = 0; i < W - 1; ++i) { const u32x4 z = {0u, 0u, 0u, 0u}; rows[i] = z; if (s0 - (W - 1) + i >= 0) rows[i] = *(const u32x4*)(pm + (size_t)(t0 - (W - 1) + i) * DM + c0); }
#pragma unroll
    for (int k = 0; k < NT; ++k) rows[W - 1 + k] = *(const u32x4*)(pm + (size_t)(t0 + k) * DM + c0);
    float sum[8];
#pragma unroll
    for (int i = 0; i < 8; ++i) sum[i] = 0.f;
#pragma unroll
    for (int i = 0; i < W - 1; ++i) { const u32x4 v = rows[i];
        sum[0] += bflo(v.x); sum[1] += bfhi(v.x); sum[2] += bflo(v.y); sum[3] += bfhi(v.y); sum[4] += bflo(v.z); sum[5] += bfhi(v.z); sum[6] += bflo(v.w); sum[7] += bfhi(v.w); }
#pragma unroll
    for (int k = 0; k < NT; ++k) { const u32x4 v = rows[W - 1 + k];
        float xv[8] = {bflo(v.x), bfhi(v.x), bflo(v.y), bfhi(v.y), bflo(v.z), bfhi(v.z), bflo(v.w), bfhi(v.w)};
#pragma unroll
        for (int i = 0; i < 8; ++i) sum[i] += xv[i];
        const int s = s0 + k; const float inv = 1.0f / (float)((s + 1) < W ? (s + 1) : W);
        u32x4 o = {pk2(sum[0] * inv - xv[0], sum[1] * inv - xv[1]), pk2(sum[2] * inv - xv[2], sum[3] * inv - xv[3]), pk2(sum[4] * inv - xv[4], sum[5] * inv - xv[5]), pk2(sum[6] * inv - xv[6], sum[7] * inv - xv[7])};
        *(u32x4*)(A2 + (size_t)(t0 + k) * MIXW + c0) = o;
        const u32x4 q = rows[k];
        sum[0] -= bflo(q.x); sum[1] -= bfhi(q.x); sum[2] -= bflo(q.y); sum[3] -= bfhi(q.y); sum[4] -= bflo(q.z); sum[5] -= bfhi(q.z); sum[6] -= bflo(q.w); sum[7] -= bfhi(q.w); }
}
__device__ __forceinline__ void pool_diff(const Args& a, Frame& F) {
    const bf16* pm = (const bf16*)(a.ws + WS_P0MAIN); bf16* A2 = (bf16*)(a.ws + WS_A2);
    const int lane = fresh_tid() & 63, gw = F.vcu * NWAVES + F.wave, NGW = F.G * NWAVES;
    for (int wv = gw; wv < (T / 16) * 128 / 64; wv += NGW) {
        const int g = __builtin_amdgcn_readfirstlane(wv) & 3, tg = (wv >> 2) * 2 + (lane >> 5), t0 = tg * 16, c0 = (g * 32 + (lane & 31)) * 8;
        if (g == 0) pool_item<2, 16>(pm, A2, t0, c0); else if (g == 1) pool_item<4, 16>(pm, A2, t0, c0); else if (g == 2) pool_item<8, 16>(pm, A2, t0, c0);
        else { pool_item<16, 8>(pm, A2, t0, c0); pool_item<16, 8>(pm, A2, t0 + 8, c0); }
    }
}

__device__ __forceinline__ void mem_attn(const Args& a, Frame& F, bf16* Abuf, int layer, bool dry = false) {
    const bf16* MKV = (const bf16*)(a.ws + WS_MEMKV);
    for (int U = F.vcu; U < 512; U += F.G) { const int b = U >> 6, h = (U >> 4) & 3, qt = U & 15;
        bf16* Q = Abuf + ((size_t)b * SEQ + qt * 256) * MIXW + 1024 + h * 128;
        const bf16* K = MKV + (size_t)b * MEMT * 2048 + layer * 1024 + h * 128;
        att::attn_unit<MIXW, 2048, false, ATT_SD_MEM>(Q, K, K + 512, dry ? (bf16*)(a.ws + WS_EXP) : Q, 0, nullptr, F.ldsg); }
}

__device__ __forceinline__ int ord_enc(float x) { const int b = __builtin_bit_cast(int, x); return b ^ ((b >> 31) & 0x7fffffff); }
__device__ __forceinline__ float ord_dec(int k) { return __builtin_bit_cast(float, k ^ ((k >> 31) & 0x7fffffff)); }
template <int N> __device__ __forceinline__ void bitonic_desc(int (&a)[N]) {
#pragma unroll
    for (int k = 2; k <= N; k <<= 1)
#pragma unroll
        for (int j = k >> 1; j > 0; j >>= 1)
#pragma unroll
            for (int i = 0; i < N; ++i) { const int l = i ^ j; if (l > i) { const bool desc = ((i & k) == 0) || (k == N);
                const int hi = max(a[i], a[l]), lo = min(a[i], a[l]); a[i] = desc ? hi : lo; a[l] = desc ? lo : hi; } }
}
__device__ __forceinline__ int kmax(int x, int y) { int r; asm("v_max_f32 %0, %1, %2" : "=v"(r) : "v"(x), "v"(y)); return r; }
__device__ __forceinline__ int kmin(int x, int y) { int r; asm("v_min_f32 %0, %1, %2" : "=v"(r) : "v"(x), "v"(y)); return r; }
__device__ __forceinline__ void ksettle(int (&a)[16]) {
    asm volatile("s_nop 3" : "+v"(a[0]), "+v"(a[1]), "+v"(a[2]), "+v"(a[3]), "+v"(a[4]), "+v"(a[5]), "+v"(a[6]), "+v"(a[7]));
    asm volatile("s_nop 3" : "+v"(a[8]), "+v"(a[9]), "+v"(a[10]), "+v"(a[11]), "+v"(a[12]), "+v"(a[13]), "+v"(a[14]), "+v"(a[15]));
}
__device__ __forceinline__ void sort16_desc(int (&a)[16]) {
#define CE_(i, j) { const int hi_ = kmax(a[i], a[j]), lo_ = kmin(a[i], a[j]); a[i] = hi_; a[j] = lo_; }
    CE_(0, 13) CE_(1, 12) CE_(2, 15) CE_(3, 14) CE_(4, 8) CE_(5, 6) CE_(7, 11) CE_(9, 10)
    CE_(0, 5) CE_(1, 7) CE_(2, 9) CE_(3, 4) CE_(6, 13) CE_(8, 14) CE_(10, 15) CE_(11, 12)
    CE_(0, 1) CE_(2, 3) CE_(4, 5) CE_(6, 8) CE_(7, 9) CE_(10, 11) CE_(12, 13) CE_(14, 15)
    CE_(0, 2) CE_(1, 3) CE_(4, 10) CE_(5, 11) CE_(6, 7) CE_(8, 9) CE_(12, 14) CE_(13, 15)
    CE_(1, 2) CE_(3, 12) CE_(4, 6) CE_(5, 7) CE_(8, 10) CE_(9, 11) CE_(13, 14)
    CE_(1, 4) CE_(2, 6) CE_(5, 8) CE_(7, 10) CE_(9, 13) CE_(11, 14)
    CE_(2, 4) CE_(3, 6) CE_(9, 12) CE_(11, 13)
    CE_(3, 5) CE_(6, 8) CE_(7, 9) CE_(10, 12)
    CE_(3, 4) CE_(5, 6) CE_(7, 8) CE_(9, 10) CE_(11, 12)
    CE_(6, 7) CE_(8, 9)
#undef CE_
}
__device__ __forceinline__ void merge16(int (&a)[16], const int (&b)[16]) {
#pragma unroll
    for (int i = 0; i < 16; ++i) a[i] = kmax(a[i], b[15 - i]);
#pragma unroll
    for (int j = 8; j > 0; j >>= 1)
#pragma unroll
        for (int i = 0; i < 16; ++i) { const int l = i ^ j; if (l > i) { const int hi = kmax(a[i], a[l]), lo = kmin(a[i], a[l]); a[i] = hi; a[l] = lo; } }
}
constexpr int cand_i(int s) { int c = 0; for (int a = 0; a < 16; ++a) for (int b = 0; b < 16; ++b) { if ((a + 1) * (b + 1) > 16) continue; if (c == s) return a; ++c; } return 0; }
constexpr int cand_j(int s) { int c = 0; for (int a = 0; a < 16; ++a) for (int b = 0; b < 16; ++b) { if ((a + 1) * (b + 1) > 16) continue; if (c == s) return b; ++c; } return 0; }
constexpr int cand_slot(int i, int j) { int s = 0; for (int a = 0; a < 16; ++a) for (int b = 0; b < 16; ++b) { if ((a + 1) * (b + 1) > 16) continue; if (a == i && b == j) return s; ++s; } return -1; }

__device__ __forceinline__ void peer_topk(const Args& a, Frame& F, int layer) {
    const bf16* PQ = (const bf16*)(a.ws + WS_PQ); const bf16* SUBK = (const bf16*)(a.ws + WS_SUBK) + (size_t)layer * 16 * 128 * 128;
    unsigned short* EXPo = (unsigned short*)(a.ws + WS_EXP); float* GATEo = (float*)(a.ws + WS_GATE);
    const int tid = fresh_tid(), lane = tid & 63, wid = F.wave, r32 = lane & 31, hi = lane >> 5;
    const int h = F.vcu & 7;
    int ka[4];
#pragma unroll
    for (int i = 0; i < 4; ++i) ka[i] = r32 * 256 + (((2 * i + hi) ^ (r32 & 7)) << 4);
    char* Ks = F.ldsg;
    LAS unsigned char* ib = F.lds + 65536 + tid * 36;
    for (int i = tid; i < 2 * 128 * 16; i += NTHR) { const int row = i >> 4, ch = i & 15; const u32x4 v = *(const u32x4*)(SUBK + ((size_t)h * 256 + row) * 128 + ch * 8);
        *(u32x4*)(Ks + (row >> 7) * 32768 + KSWZ(row & 127, ch * 16)) = v; }
    __syncthreads();
    const int tt0 = F.vcu >> 3, tts = F.G >> 3;
    bf16x8 qn[8];
    { const bf16* qp = PQ + (size_t)(tt0 * 256 + wid * 32 + r32) * 2048 + h * 256 + hi * 8;
#pragma unroll
      for (int d0 = 0; d0 < 8; ++d0) qn[d0] = *reinterpret_cast<const bf16x8*>(qp + d0 * 16); }
    for (int tt = tt0; tt < T / 256; tt += tts) {
        const int t = tt * 256 + wid * 32 + r32;
        int top[2][16];
#pragma unroll
        for (int p = 0; p < 2; ++p) {
            bf16x8 qr[8];
#pragma unroll
            for (int d0 = 0; d0 < 8; ++d0) qr[d0] = qn[d0];
            { const int ttn = (p == 0) ? tt : ((tt + tts < T / 256) ? tt + tts : tt);
              const bf16* qp = PQ + (size_t)(ttn * 256 + wid * 32 + r32) * 2048 + h * 256 + (p ^ 1) * 128 + hi * 8;
#pragma unroll
              for (int d0 = 0; d0 < 8; ++d0) qn[d0] = *reinterpret_cast<const bf16x8*>(qp + d0 * 16); }
            int cur[16];
#pragma unroll
            for (int kt = 0; kt < 4; ++kt) { f32x16 sacc; att::qkt1(sacc, Ks + p * 32768 + kt * 32 * 256, qr, ka);
                int grp[16];
#pragma unroll
                for (int r = 0; r < 16; ++r) { const float sv_ = sacc[r]; grp[r] = (__float_as_int(sv_) & ~0x7F) | (kt * 32 + (r & 3) + 8 * (r >> 2) + 4 * hi); }
                sort16_desc(grp);
                if (kt == 0) {
#pragma unroll
                    for (int r = 0; r < 16; ++r) cur[r] = grp[r];
                } else merge16(cur, grp); }
            int oth[16]; ksettle(cur);
#pragma unroll
            for (int r = 0; r < 16; ++r) { auto rr = __builtin_amdgcn_permlane32_swap((unsigned)cur[r], (unsigned)cur[r], false, false); cur[r] = (int)rr[0]; oth[r] = (int)rr[1]; }
            ksettle(cur); ksettle(oth); merge16(cur, oth);
#pragma unroll
            for (int r = 0; r < 16; ++r) top[p][r] = cur[r];
        }
        float v0[16], v1[16];
#pragma unroll
        for (int r = 0; r < 16; ++r) { v0[r] = __builtin_bit_cast(float, top[0][r] & ~0x7F); v1[r] = __builtin_bit_cast(float, top[1][r] & ~0x7F); }
#pragma unroll
        for (int q = 0; q < 4; ++q) { *(LAS unsigned*)(ib + q * 4) = (top[0][4 * q] & 0x7F) | ((top[0][4 * q + 1] & 0x7F) << 8) | ((top[0][4 * q + 2] & 0x7F) << 16) | ((top[0][4 * q + 3] & 0x7F) << 24);
            *(LAS unsigned*)(ib + 16 + q * 4) = (top[1][4 * q] & 0x7F) | ((top[1][4 * q + 1] & 0x7F) << 8) | ((top[1][4 * q + 2] & 0x7F) << 16) | ((top[1][4 * q + 3] & 0x7F) << 24); }
        int best[16], g1[16];
#pragma unroll
        for (int r = 0; r < 32; ++r) { int key = (int)0xFF800000;
            if (r < 25) {
                const int iA = cand_i(r), jA = cand_j(r), iB = cand_i(25 + r), jB = cand_j(25 + r);
                const float sA = v0[iA] + v1[jA], sB = v0[iB] + v1[jB]; const int code = hi ? (iB * 16 + jB) : (iA * 16 + jA);
                key = (__builtin_bit_cast(int, hi ? sB : sA) & ~0xFF) | code; }
            if (r < 16) best[r] = key; else g1[r - 16] = key; }
        sort16_desc(best); sort16_desc(g1); merge16(best, g1); ksettle(best);
#pragma unroll
        for (int r = 0; r < 16; ++r) { auto rr = __builtin_amdgcn_permlane32_swap((unsigned)best[r], (unsigned)best[r], false, false); best[r] = (int)rr[0]; g1[r] = (int)rr[1]; }
        ksettle(best); ksettle(g1); merge16(best, g1);
        float cv[16], ex[16]; float sum = 0.f;
#pragma unroll
        for (int r = 0; r < 16; ++r) cv[r] = __builtin_bit_cast(float, best[r] & ~0xFF);
#pragma unroll
        for (int r = 0; r < 16; ++r) { ex[r] = __builtin_amdgcn_exp2f((cv[r] - cv[0]) * 1.4426950408889634f); sum += ex[r]; }
        const float rs = 1.0f / sum;
        LDS_WAIT();
        unsigned ee[16];
#pragma unroll
        for (int r = 0; r < 16; ++r) { const int code = best[r] & 0xFF; const unsigned e1 = ib[code >> 4], e2 = ib[16 + (code & 15)]; ee[r] = e1 * 128u + e2; }
        const size_t ob = ((size_t)t * 8 + h) * 16;
        if (hi == 0) { u32x4 w0 = {ee[0] | (ee[1] << 16), ee[2] | (ee[3] << 16), ee[4] | (ee[5] << 16), ee[6] | (ee[7] << 16)}, w1 = {ee[8] | (ee[9] << 16), ee[10] | (ee[11] << 16), ee[12] | (ee[13] << 16), ee[14] | (ee[15] << 16)};
            *(u32x4*)(EXPo + ob) = w0; *(u32x4*)(EXPo + ob + 8) = w1; }
        else {
#pragma unroll
            for (int q = 0; q < 4; ++q) { f32x4 gq = {ex[4 * q] * rs, ex[4 * q + 1] * rs, ex[4 * q + 2] * rs, ex[4 * q + 3] * rs}; *(f32x4*)(GATEo + ob + 4 * q) = gq; } }
        LDS_WAIT();
    }
    __syncthreads();
}

__device__ __forceinline__ float gelu_exact(float v) {
    const float av = fabsf(v), t = __builtin_amdgcn_rcpf(fmaf(av, 0.2316418882f, 1.0f));
    float q = fmaf(t, 0.5307027145f, -0.7265760135f); q = fmaf(q, t, 0.7107068705f); q = fmaf(q, t, -0.142248368f); q = fmaf(q, t, 0.127414796f); q = q * t;
    const float e = __builtin_amdgcn_exp2f(v * v * -0.72134752044f), m = v * (q * e);
    return v < 0.f ? m : v - m;
}
__device__ __forceinline__ float dot16_fp8(const u32x4 u, const f32x2 (&x2)[8]) {
    f32x2 d = {0.f, 0.f};
#pragma unroll
    for (int i = 0; i < 4; ++i) { const f32x2 a = __builtin_amdgcn_cvt_pk_f32_fp8((int)u[i], false), b = __builtin_amdgcn_cvt_pk_f32_fp8((int)u[i], true);
        d = __builtin_elementwise_fma(a, x2[2 * i], d); d = __builtin_elementwise_fma(b, x2[2 * i + 1], d); }
    return d.x + d.y;
}
__device__ __forceinline__ void axpy16_fp8(f32x2 (&o2)[8], const float h, const u32x4 v) {
    const f32x2 h2 = {h, h};
#pragma unroll
    for (int i = 0; i < 4; ++i) { const f32x2 a = __builtin_amdgcn_cvt_pk_f32_fp8((int)v[i], false), b = __builtin_amdgcn_cvt_pk_f32_fp8((int)v[i], true);
        o2[2 * i] = __builtin_elementwise_fma(a, h2, o2[2 * i]); o2[2 * i + 1] = __builtin_elementwise_fma(b, h2, o2[2 * i + 1]); }
}
__device__ __forceinline__ float reduce8(const float (&p)[8], int lane) {
    float s[4];
#pragma unroll
    for (int i = 0; i < 4; ++i) { auto rr = __builtin_amdgcn_permlane32_swap(__float_as_uint(p[2 * i]), __float_as_uint(p[2 * i + 1]), false, false); s[i] = __uint_as_float(rr[0]) + __uint_as_float(rr[1]); }
    float t[2];
#pragma unroll
    for (int i = 0; i < 2; ++i) { const bool hi = lane & 16; const float u = hi ? s[2 * i + 1] : s[2 * i], o = hi ? s[2 * i] : s[2 * i + 1]; t[i] = u + shx_f<16>(o); }
    const bool h8 = lane & 8; const float u = h8 ? t[1] : t[0], o = h8 ? t[0] : t[1]; float w = u + dpp_f<0x128>(o);
    w += dpp_f<0x141>(w); w += dpp_f<0x1B>(w); w += dpp_f<0xB1>(w);
    return w;
}
constexpr int qgrp(int q) { return 2 * ((q & 3) == 1 ? 2 : (q & 3) == 2 ? 1 : (q & 3)) + (q >> 2); }

template <int K, int J> __device__ __forceinline__ void sort128_stage(unsigned& lo, unsigned& hi, int lane) {
    const unsigned plo = shx_u<J>(lo), phi = shx_u<J>(hi);
    const bool up_lo = (K >= 64) ? true : ((lane & K) == 0), up_hi = (K == 64) ? false : up_lo, lower = (lane & J) == 0;
    lo = (lower == up_lo) ? min(lo, plo) : max(lo, plo); hi = (lower == up_hi) ? min(hi, phi) : max(hi, phi);
    if constexpr (J > 1) sort128_stage<K, J / 2>(lo, hi, lane);
}
template <int K> __device__ __forceinline__ void sort128_level(unsigned& lo, unsigned& hi, int lane) { sort128_stage<K, K / 2>(lo, hi, lane); if constexpr (K < 64) sort128_level<K * 2>(lo, hi, lane); }
__device__ __forceinline__ void sort128(unsigned& lo, unsigned& hi, int lane) {
    sort128_level<2>(lo, hi, lane);
    { const unsigned a = min(lo, hi), b = max(lo, hi); lo = a; hi = b; }
    sort128_stage<128, 32>(lo, hi, lane);
}
template <bool FINAL, bool DRY = false>
__device__ __forceinline__ void peer_gather(const Args& a, Frame& F, int layer) {
    const unsigned char* UB = a.ws + WS_UB + (size_t)layer * NEXP * DM; const unsigned char* VB = a.ws + WS_VB + (size_t)layer * NEXP * DM;
    const float* USC = (const float*)(a.ws + WS_USC) + layer * NEXP; const float* VSC = (const float*)(a.ws + WS_VSC) + layer * NEXP;
    const unsigned short* EXPi = (const unsigned short*)(a.ws + WS_EXP); const float* GATEi = (const float*)(a.ws + WS_GATE);
    float* X = a.out; bf16* XB = (bf16*)(a.ws + WS_XB); float* RSTD2 = (float*)(a.ws + WS_RSTD2); const float* gfin = a.in[15];
    const int lane = fresh_tid() & 63, gw = F.vcu * NWAVES + F.wave, NGW = F.G * NWAVES;
    const unsigned lane16 = (unsigned)lane * 16u;
    const int grp = lane >> 3; const int jperm = 8 * (lane & 7) + ((grp >> 1) == 1 ? 2 : (grp >> 1) == 2 ? 1 : (grp >> 1)) + 4 * (grp & 1);
    for (int t = gw; t < T; t += NGW) {
        __syncthreads();
        bf16* xbr = XB + (size_t)t * DM + 16 * lane;
        float x[16];
        { const u32x4 v0 = *(const u32x4*)xbr, v1 = *(const u32x4*)(xbr + 8);
          x[0] = bflo(v0.x); x[1] = bfhi(v0.x); x[2] = bflo(v0.y); x[3] = bfhi(v0.y); x[4] = bflo(v0.z); x[5] = bfhi(v0.z); x[6] = bflo(v0.w); x[7] = bfhi(v0.w);
          x[8] = bflo(v1.x); x[9] = bfhi(v1.x); x[10] = bflo(v1.y); x[11] = bfhi(v1.y); x[12] = bflo(v1.z); x[13] = bfhi(v1.z); x[14] = bflo(v1.w); x[15] = bfhi(v1.w); }
        f32x2 x2[8];
#pragma unroll
        for (int i = 0; i < 8; ++i) { x2[i].x = x[2 * i]; x2[i].y = x[2 * i + 1]; }
        float ss = 0.f;
#pragma unroll
        for (int i = 0; i < 16; ++i) ss = fmaf(x[i], x[i], ss);
        ss = wave_sum(ss);
        const float rstd = 1.0f / sqrtf(ss * (1.0f / DM) + EPS);
        const unsigned short* et = EXPi + (size_t)t * 128; const float* gt_ = GATEi + (size_t)t * 128;
        unsigned k_lo = ((unsigned)et[lane] << 7) | (unsigned)lane, k_hi = ((unsigned)et[64 + lane] << 7) | (unsigned)(64 + lane);
        sort128(k_lo, k_hi, lane);
        const int e_lo = (int)(k_lo >> 7), e_hi = (int)(k_hi >> 7);
        const float gs_lo = gt_[k_lo & 127u], gs_hi = gt_[k_hi & 127u];
        const int ep_lo = __shfl(e_lo, jperm), ep_hi = __shfl(e_hi, jperm);
        const float gl = __shfl(gs_lo, jperm) * VSC[ep_lo], gh = __shfl(gs_hi, jperm) * VSC[ep_hi];
        const float ul = USC[ep_lo] * rstd, uh = USC[ep_hi] * rstd;
        float a_lo = 0.f, a_hi = 0.f;
        u32x4 b0[8], b1[8], b2[8];
#define ROWLD(dst, tab, e_) dst = *(const u32x4*)((tab) + (size_t)(e_) * DM + lane16)
#define ULOAD(buf, B) do { const int ev_ = ((B) >> 3) ? e_hi : e_lo; _Pragma("unroll") for (int q = 0; q < 8; ++q) { const int e = __builtin_amdgcn_readlane(ev_, 8 * ((B) & 7) + q); ROWLD(buf[q], UB, e); } } while (0)
#define VLOAD(buf, B) do { const int ev_ = ((B) >> 3) ? e_hi : e_lo; _Pragma("unroll") for (int q = 0; q < 8; ++q) { const int e = __builtin_amdgcn_readlane(ev_, 8 * ((B) & 7) + q); ROWLD(buf[q], VB, e); } } while (0)
#define UCOMP(buf, B) do { float p[8]; _Pragma("unroll") for (int q = 0; q < 8; ++q) p[q] = dot16_fp8(buf[q], x2); const float w = reduce8(p, lane); const bool mine = (lane & 7) == ((B) & 7); \
        if ((B) >> 3) a_hi = mine ? w : a_hi; else a_lo = mine ? w : a_lo; } while (0)
        ULOAD(b0, 0); ULOAD(b1, 1);
#pragma unroll 1
        for (int B = 0; B < 12; B += 3) {
            if (B > 0) __syncthreads();
            ULOAD(b2, B + 2); UCOMP(b0, B);
            ULOAD(b0, B + 3); UCOMP(b1, B + 1);
            ULOAD(b1, B + 4); UCOMP(b2, B + 2); }
        ULOAD(b2, 14); UCOMP(b0, 12);
        ULOAD(b0, 15); UCOMP(b1, 13);
        VLOAD(b1, 0);  UCOMP(b2, 14);
        VLOAD(b2, 1);  UCOMP(b0, 15);
#undef ULOAD
#undef UCOMP
        __syncthreads();
        const float h_lo = gelu_exact(a_lo * ul) * gl, h_hi = gelu_exact(a_hi * uh) * gh;
        f32x2 o2[8];
#pragma unroll
        for (int i = 0; i < 8; ++i) o2[i] = (f32x2){0.f, 0.f};
#define VCOMP(buf, B) do { const int hv_ = __builtin_bit_cast(int, ((B) >> 3) ? h_hi : h_lo); _Pragma("unroll") for (int q = 0; q < 8; ++q) { const float hq = __builtin_bit_cast(float, __builtin_amdgcn_readlane(hv_, 8 * qgrp(q) + ((B) & 7))); axpy16_fp8(o2, hq, buf[q]); } } while (0)
#pragma unroll 1
        for (int B = 0; B < 12; B += 3) {
            if (B > 0) __syncthreads();
            VLOAD(b0, B + 2); VCOMP(b1, B);
            VLOAD(b1, B + 3); VCOMP(b2, B + 1);
            VLOAD(b2, B + 4); VCOMP(b0, B + 2); }
        VLOAD(b0, 14); VCOMP(b1, 12);
        VLOAD(b1, 15); VCOMP(b2, 13);
        VCOMP(b0, 14);
        VCOMP(b1, 15);
#undef VLOAD
#undef VCOMP
#undef ROWLD
        float o[16]; float s2 = 0.f;
#pragma unroll
        for (int i = 0; i < 8; ++i) { o[2 * i] = o2[i].x; o[2 * i + 1] = o2[i].y; }
        { const u32x4 v0 = *(const u32x4*)xbr, v1 = *(const u32x4*)(xbr + 8);
          o[0] += bflo(v0.x); o[1] += bfhi(v0.x); o[2] += bflo(v0.y); o[3] += bfhi(v0.y); o[4] += bflo(v0.z); o[5] += bfhi(v0.z); o[6] += bflo(v0.w); o[7] += bfhi(v0.w);
          o[8] += bflo(v1.x); o[9] += bfhi(v1.x); o[10] += bflo(v1.y); o[11] += bfhi(v1.y); o[12] += bflo(v1.z); o[13] += bfhi(v1.z); o[14] += bflo(v1.w); o[15] += bfhi(v1.w); }
#pragma unroll
        for (int i = 0; i < 16; ++i) s2 = fmaf(o[i], o[i], s2);
        s2 = wave_sum(s2);
        const float r2 = 1.0f / sqrtf(s2 * (1.0f / DM) + EPS);
        if constexpr (FINAL) {
            float* xw = (DRY ? (float*)(a.ws + WS_RB) : X) + (size_t)t * DM;
#pragma unroll
            for (int i = 0; i < 4; ++i) { const f32x4 g = *(const f32x4*)(gfin + 16 * lane + 4 * i); f32x4 y = {o[4 * i] * r2 * g[0], o[4 * i + 1] * r2 * g[1], o[4 * i + 2] * r2 * g[2], o[4 * i + 3] * r2 * g[3]}; *(f32x4*)(xw + 16 * lane + 4 * i) = y; }
        } else {
            bf16* xo = DRY ? (bf16*)(a.ws + WS_RB) + (size_t)t * DM + 16 * lane : xbr;
            u32x4 wa = {pk2(o[0], o[1]), pk2(o[2], o[3]), pk2(o[4], o[5]), pk2(o[6], o[7])}, wb = {pk2(o[8], o[9]), pk2(o[10], o[11]), pk2(o[12], o[13]), pk2(o[14], o[15])};
            *(u32x4*)xo = wa; *(u32x4*)(xo + 8) = wb;
            if (!DRY && lane == 0) RSTD2[t] = r2;
        }
    }
}

#define XB_TMO      128
#define XB_RDY      3456
#ifndef GM_SHARE
#define GM_SHARE 200
#endif
#define XB_XCNT(j)  (256  + 64 * (j))
#define XB_XSUB(j)  (1280 + 64 * (j))
#define XB_XGEN(j)  (2304 + 64 * (j))
#define XB_TOP      3328
#define XB_TOPGEN   3392
#define XCD_BAR_WORDS 3456
#define XB_SPIN_CAP (1u << 22)
__device__ __forceinline__ unsigned xb_ld(unsigned* p)              { return __hip_atomic_load(p, __ATOMIC_RELAXED, __HIP_MEMORY_SCOPE_AGENT); }
__device__ __forceinline__ unsigned xb_add(unsigned* p, unsigned v) { return __hip_atomic_fetch_add(p, v, __ATOMIC_RELAXED, __HIP_MEMORY_SCOPE_AGENT); }
__device__ __forceinline__ unsigned xb_xcc_id() { return (unsigned)__builtin_amdgcn_s_getreg((3 << 11) | 20) & 0xFu; }
#define XB_SPIN(cond, bar) do { unsigned _sp = 0; while (cond) { __builtin_amdgcn_s_sleep(1); \
    if ((++_sp & 255u) == 0u) { if (xb_ld(&(bar)[XB_TMO])) break; if (_sp > XB_SPIN_CAP) { atomicAdd(&(bar)[XB_TMO], 1u); break; } } } } while (0)
struct XcdBarrier { unsigned* bar; unsigned x; volatile LAS unsigned* st; };
__device__ __forceinline__ XcdBarrier xcd_barrier_post(unsigned* bar, volatile LAS unsigned* st) {
    XcdBarrier b; b.bar = bar; b.x = xb_xcc_id(); b.st = st;
    if (threadIdx.x == 0) (void)xb_add(&bar[XB_XCNT(b.x)], 1u);
    return b;
}
__device__ __forceinline__ void xcd_barrier_complete(unsigned* bar, unsigned x, unsigned& nloc, unsigned& nx) {
    const unsigned G = gridDim.x * gridDim.y * gridDim.z;
    unsigned sum, cnt, mine, sp = 0u;
    for (;;) {
        sum = 0u; cnt = 0u; mine = 0u;
#pragma unroll
        for (unsigned j = 0; j < 16; ++j) { const unsigned c = xb_ld(&bar[XB_XCNT(j)]); sum += c; cnt += (c > 0u) ? 1u : 0u; mine = (j == x) ? c : mine; }
        if (sum == G) break;
        __builtin_amdgcn_s_sleep(1);
        if ((++sp & 255u) == 0u) { if (xb_ld(&bar[XB_TMO])) break; if (sp > XB_SPIN_CAP) { atomicAdd(&bar[XB_TMO], 1u); break; } }
    }
    nloc = mine > 0u ? mine : 1u; nx = cnt > 0u ? cnt : 1u;
}
__device__ __forceinline__ void xcd_barrier(const XcdBarrier& b) {
    asm volatile("s_waitcnt vmcnt(0)" ::: "memory");
    __syncthreads();
    if (threadIdx.x == 0) {
        unsigned* bar = b.bar;
        __builtin_amdgcn_s_waitcnt(0);
        unsigned nloc = b.st[0], nx = b.st[1];
        if (nloc == 0u) { xcd_barrier_complete(bar, b.x, nloc, nx); b.st[0] = nloc; b.st[1] = nx; }
        const unsigned old = xb_add(&bar[XB_XSUB(b.x)], 1u);
        const unsigned gen = old / nloc;
        if (old + 1u == (gen + 1u) * nloc) {
            __builtin_amdgcn_fence(__ATOMIC_RELEASE, "agent");
            asm volatile("s_waitcnt vmcnt(0)" ::: "memory");
            const unsigned og = xb_add(&bar[XB_TOP], 1u);
            const unsigned tg = og / nx;
            if (og + 1u == (tg + 1u) * nx) xb_add(&bar[XB_TOPGEN], 1u);
            else XB_SPIN(xb_ld(&bar[XB_TOPGEN]) == tg, bar);
            __builtin_amdgcn_fence(__ATOMIC_ACQUIRE, "agent");
            xb_add(&bar[XB_XGEN(b.x)], 1u);
            asm volatile("s_waitcnt vmcnt(0)" ::: "memory");
        } else {
            XB_SPIN(xb_ld(&bar[XB_XGEN(b.x)]) == gen, bar);
            __builtin_amdgcn_fence(__ATOMIC_ACQUIRE, "agent");
            asm volatile("s_waitcnt vmcnt(0)" ::: "memory");
        }
    }
    __syncthreads();
}

__global__ void __launch_bounds__(NTHR, 2) yoco_fwd(Args args) {
    extern __shared__ __attribute__((aligned(16))) unsigned char lds_raw[];
    cg::grid_group grid = cg::this_grid();
    Frame F;
    F.lds = (LAS unsigned char*)lds_raw; F.ldsg = (char*)lds_raw;
    F.wave = __builtin_amdgcn_readfirstlane(threadIdx.x >> 6);
    F.G = gridDim.x; { const int bx = blockIdx.x; F.vcu = (F.G % 8 == 0) ? (bx % 8) * (F.G / 8) + bx / 8 : bx; }
    unsigned char* ws = args.ws;
    const int lo = args.ph_lo, hi = args.ph_hi;
    volatile LAS unsigned* bst = (volatile LAS unsigned*)(F.lds + 131072 + 320);
    if (threadIdx.x < 2) bst[threadIdx.x] = 0u;
    __syncthreads();
    XcdBarrier xbar; xbar.bar = (unsigned*)ws; xbar.x = 0; xbar.st = bst;
    if (hi - lo > 1) xbar = xcd_barrier_post((unsigned*)ws, bst);
#ifndef PH_MASK
#define PH_MASK 0x1fff
#endif
#define IN(k) (((PH_MASK >> (k)) & 1) && lo <= (k) && (k) < hi)
#define SEAM(k) do { if (IN(k) && IN((k) + 1)) { if ((k) == 0) grid.sync(); else xcd_barrier(xbar); } } while (0)
#define GSYNC() xcd_barrier(xbar)
#ifndef REP_MASK
#define REP_MASK 0
#endif
#define NREP(k) (((REP_MASK >> (k)) & 1) ? 2 : 1)
    typedef pg8::bf16_t pb;

    for (int rep_ = 0; rep_ < NREP(0); ++rep_) { if (rep_) GSYNC();
    if (IN(0)) {
        unsigned* rdy = (unsigned*)ws + XB_RDY + 64 * rep_; const int nb = F.G > 128 ? 64 : 0, bx = (int)blockIdx.x;
        const int den = (F.G - nb) * 1000 + nb * GM_SHARE, ra = (4 * NEXP * 1000 + den - 1) / den + 1, rb = ra * GM_SHARE / 1000;
        const int tlo = bx < nb ? bx * rb : nb * rb + (bx - nb) * ra, thi_ = tlo + (bx < nb ? rb : ra);
        const int tb_lo = tlo < 4 * NEXP ? tlo : 4 * NEXP, tb_hi = thi_ < 4 * NEXP ? thi_ : 4 * NEXP;
        phase0<0>(args, F, 0, 0);
        asm volatile("s_waitcnt vmcnt(0)" ::: "memory"); __syncthreads();
        if (threadIdx.x == 0) { __builtin_amdgcn_fence(__ATOMIC_RELEASE, "agent"); asm volatile("s_waitcnt vmcnt(0)" ::: "memory"); (void)xb_add(rdy, 1u); }
        phase0<1>(args, F, 0, 0);
        if (nb == 0 || bx < nb) {
            if (threadIdx.x == 0) { XB_SPIN(xb_ld(rdy) < (unsigned)F.G, (unsigned*)ws); __builtin_amdgcn_fence(__ATOMIC_ACQUIRE, "agent"); asm volatile("s_waitcnt vmcnt(0)" ::: "memory"); }
            __syncthreads();
            pg8::Gemm g{(const pb*)(ws + WS_MEMB), (const pb*)(ws + WS_WMKV), 2048, 2048, DM}; pg8::StaticOrder S; S.init(2048, 2048, F.G, (int)blockIdx.x);
            pg8::EpiRowBf16 E{(pb*)(ws + WS_MEMKV), 2048, (pb*)(ws + WS_MEMKV), 2048, 1 << 30, nullptr, nullptr};
            pg8::gemm_phase<pg8::EpiRowBf16, pg8::StaticOrder>(F.lds, g, S, E);
            __syncthreads();
        }
        phase0<2>(args, F, tb_lo, tb_hi);
    } } SEAM(0);

    for (int rep_ = 0; rep_ < NREP(1); ++rep_) { if (rep_) GSYNC();
    if (IN(1)) {
        { pg8::Gemm g{(const pb*)(ws + WS_XB), (const pb*)(ws + WS_WIN0), T, MIXW, DM}; pg8::StaticOrder S; S.init(T, MIXW, F.G, (int)blockIdx.x);
          pg8::EpiRowBf16 E{(pb*)(ws + WS_P0MAIN), DM, (pb*)(ws + WS_A2) + 1024, MIXW, 1024, (const float*)(ws + WS_RSTD0), nullptr};
          pg8::gemm_phase<pg8::EpiRowBf16, pg8::StaticOrder>(F.lds, g, S, E); }
    } } SEAM(1);

    if (IN(2)) { if (NREP(2) > 1) { pool_diff(args, F); mem_attn(args, F, (bf16*)(ws + WS_A2), 0, true); GSYNC(); }
        pool_diff(args, F); mem_attn(args, F, (bf16*)(ws + WS_A2), 0); } SEAM(2);

    for (int rep_ = 0; rep_ < NREP(3); ++rep_) { if (rep_) GSYNC();
    if (IN(3)) {
        pg8::Gemm g{(const pb*)(ws + WS_A2), (const pb*)(ws + WS_WC0), T, DM, MIXW}; pg8::StaticOrder S; S.init(T, DM, F.G, (int)blockIdx.x);
        pg8::EpiRes E{(pb*)(ws + WS_XB), (float*)(ws + WS_SSQ)};
        pg8::gemm_phase<pg8::EpiRes, pg8::StaticOrder>(F.lds, g, S, E);
    } } SEAM(3);

    for (int rep_ = 0; rep_ < NREP(4); ++rep_) { if (rep_) GSYNC();
    if (IN(4)) {
        pg8::Gemm g{(const pb*)(ws + WS_XB), (const pb*)(ws + WS_WQ0), T, 2048, DM}; pg8::StaticOrder S; S.init(T, 2048, F.G, (int)blockIdx.x);
        pg8::EpiRowBf16 E{(pb*)(ws + WS_PQ), 2048, (pb*)(ws + WS_PQ), 2048, 1 << 30, nullptr, (const float*)(ws + WS_SSQ)};
        pg8::gemm_phase<pg8::EpiRowBf16, pg8::StaticOrder>(F.lds, g, S, E);
    } } SEAM(4);

    for (int rep_ = 0; rep_ < NREP(5); ++rep_) { if (rep_) GSYNC();
    if (IN(5)) { peer_topk(args, F, 0); } } SEAM(5);
    if (IN(6)) {
#ifdef PROBE_PEER
        peer_gather<false, true>(args, F, 0); GSYNC();
#endif
        peer_gather<false>(args, F, 0); } SEAM(6);

    for (int rep_ = 0; rep_ < NREP(7); ++rep_) { if (rep_) GSYNC();
    if (IN(7)) {
        pg8::Gemm g{(const pb*)(ws + WS_XB), (const pb*)(ws + WS_WC4), T, 3584, DM}; pg8::StaticOrder S; S.init(T, 3584, F.G, (int)blockIdx.x);
        pg8::EpiKVQ E{(pb*)(ws + WS_KR), (pb*)(ws + WS_VV), (pb*)(ws + WS_A3), (float*)(ws + WS_KMP), (const float*)(ws + WS_RSTD2), (const float*)(ws + WS_ROPE)};
        pg8::gemm_phase<pg8::EpiKVQ, pg8::StaticOrder>(F.lds, g, S, E);
    } } SEAM(7);

    if (IN(8)) {
        bf16* A3 = (bf16*)(ws + WS_A3); const bf16* KR = (const bf16*)(ws + WS_KR); const bf16* VV = (const bf16*)(ws + WS_VV); const float* KMP = (const float*)(ws + WS_KMP);
        for (int rep_ = 0; rep_ < NREP(8); ++rep_) { const bool dry8 = (NREP(8) > 1) && rep_ == 0;
        for (int P = F.vcu; P < 512; P += F.G) { const int bh = P >> 3, p = P & 7, b = bh >> 3, h = bh & 7;
#pragma unroll 1
            for (int half = 0; half < 2; ++half) { const int j = half ? p : 15 - p;
                bf16* Q = A3 + ((size_t)b * SEQ + j * 256) * MIXW + h * 128;
                const bf16* K = KR + (size_t)bh * SEQ * 128; const bf16* V = VV + (size_t)bh * SEQ * 128;
                att::attn_unit<MIXW, 128, true, ATT_SD_MOBA>(Q, K, V, dry8 ? (bf16*)(ws + WS_XB) : Q, j, KMP + (size_t)b * 16 * 2048 + h * 128, F.ldsg); } }
        if (dry8) { mem_attn(args, F, A3, 1, true); GSYNC(); } }
        mem_attn(args, F, A3, 1);
    } SEAM(8);

    if (IN(9)) {
        pg8::Gemm g{(const pb*)(ws + WS_A3), (const pb*)(ws + WS_WOUT1), T, DM, MIXW}; pg8::StaticOrder S; S.init(T, DM, F.G, (int)blockIdx.x);
        pg8::EpiRes E{(pb*)(ws + WS_XB), (float*)(ws + WS_SSQ)};
        pg8::gemm_phase<pg8::EpiRes, pg8::StaticOrder>(F.lds, g, S, E);
    } SEAM(9);

    for (int rep_ = 0; rep_ < NREP(10); ++rep_) { if (rep_) GSYNC();
    if (IN(10)) {
        pg8::Gemm g{(const pb*)(ws + WS_XB), (const pb*)(ws + WS_WQ1), T, 2048, DM}; pg8::StaticOrder S; S.init(T, 2048, F.G, (int)blockIdx.x);
        pg8::EpiRowBf16 E{(pb*)(ws + WS_PQ), 2048, (pb*)(ws + WS_PQ), 2048, 1 << 30, nullptr, (const float*)(ws + WS_SSQ)};
        pg8::gemm_phase<pg8::EpiRowBf16, pg8::StaticOrder>(F.lds, g, S, E);
    } } SEAM(10);

    for (int rep_ = 0; rep_ < NREP(11); ++rep_) { if (rep_) GSYNC();
    if (IN(11)) { peer_topk(args, F, 1); } } SEAM(11);
    if (IN(12)) {
#ifdef PROBE_PEER
        peer_gather<true, true>(args, F, 1); GSYNC();
#endif
        peer_gather<true>(args, F, 1); }
#undef IN
#undef SEAM
}

extern "C" void kernel_launch(void* const* d_in, const int* in_sizes, int n_in, void* d_out, int out_size, void* d_ws, size_t ws_size, hipStream_t stream) {
    static int grid = 0;
    if (grid == 0) {
        if (n_in != 16 || out_size != T * DM || ws_size < WS_END) { fprintf(stderr, "kernel_launch: unexpected shapes: n_in %d out %d ws %zu (need %zu)\n", n_in, out_size, ws_size, (size_t)WS_END); grid = -1; return; }
        int dev = 0, cus = 0, per_cu = 0;
        if (hipGetDevice(&dev) != hipSuccess || hipDeviceGetAttribute(&cus, hipDeviceAttributeMultiprocessorCount, dev) != hipSuccess) { grid = -1; return; }
        if (hipFuncSetAttribute((const void*)yoco_fwd, hipFuncAttributeMaxDynamicSharedMemorySize, LDS_BYTES) != hipSuccess) { fprintf(stderr, "kernel_launch: hipFuncSetAttribute failed\n"); grid = -1; return; }
        if (hipOccupancyMaxActiveBlocksPerMultiprocessor(&per_cu, (const void*)yoco_fwd, NTHR, LDS_BYTES) != hipSuccess || per_cu < 1) { fprintf(stderr, "kernel_launch: occupancy query says %d\n", per_cu); per_cu = 1; }
        (void)hipGetLastError();
        grid = cus;
        fprintf(stderr, "kernel_launch: grid %d, per_cu %d, ws %zu\n", grid, per_cu, ws_size);
    }
    if (grid < 0) return;
    if (hipMemsetAsync(d_ws, 0, 16384, stream) != hipSuccess) { fprintf(stderr, "kernel_launch: memset failed\n"); return; }
    Args a{};
    for (int i = 0; i < 16; ++i) a.in[i] = (const float*)d_in[i];
    a.out = (float*)d_out; a.ws = (unsigned char*)d_ws;
#if MK_LAUNCHES == 1
    a.ph_lo = 0; a.ph_hi = 13;
    void* kargs[] = {&a};
    hipError_t e = hipLaunchCooperativeKernel((const void*)yoco_fwd, dim3(grid), dim3(NTHR), kargs, LDS_BYTES, stream);
    if (e != hipSuccess) fprintf(stderr, "kernel_launch: cooperative launch failed: %s (grid %d)\n", hipGetErrorString(e), grid);
#else
    for (int p = 0; p < 13; ++p) { a.ph_lo = p; a.ph_hi = p + 1;
        hipLaunchKernelGGL(yoco_fwd, dim3(grid), dim3(NTHR), LDS_BYTES, stream, a);
        const hipError_t le = hipPeekAtLastError(); if (le != hipSuccess) { fprintf(stderr, "kernel_launch: launch %d failed: %s\n", p, hipGetErrorName(le)); break; } }
#endif
}
```

```cpp
#include <hip/hip_runtime.h>
#include <hip/hip_cooperative_groups.h>
#include <cstdio>
#include <cstdint>
namespace cg = cooperative_groups;

#ifndef MK_LAUNCHES
#define MK_LAUNCHES 1
#endif

#define GAS __attribute__((address_space(1)))
#define LAS __attribute__((address_space(3)))
typedef unsigned short bf16;
typedef unsigned u32x4 __attribute__((ext_vector_type(4)));
typedef unsigned u32x2 __attribute__((ext_vector_type(2)));
typedef float f32x4 __attribute__((ext_vector_type(4)));
typedef float f32x2 __attribute__((ext_vector_type(2)));
typedef float f32x16 __attribute__((ext_vector_type(16)));
typedef short bf16x8 __attribute__((ext_vector_type(8)));
typedef short s16x4 __attribute__((ext_vector_type(4)));
typedef __bf16 bf16x2_t __attribute__((ext_vector_type(2)));

constexpr int NB = 8, SEQ = 4096, DM = 1024, T = NB * SEQ, MIXW = 1536, MEMT = 256;
constexpr int NEXP = 16384, NWAVES = 8, NTHR = 512;
constexpr float EPS = 1e-6f;

constexpr size_t MiB = 1u << 20;
constexpr size_t WS_RSTD0 = 1 * MiB;
constexpr size_t WS_RSTD2 = WS_RSTD0 + 128 * 1024;
constexpr size_t WS_USC   = WS_RSTD0 + 256 * 1024;
constexpr size_t WS_VSC   = WS_RSTD0 + 384 * 1024;
constexpr size_t WS_SSQ   = 2 * MiB;
constexpr size_t WS_KMP   = 4 * MiB;
constexpr size_t WS_ROPE  = 5 * MiB;
constexpr size_t WS_WIN0  = 8 * MiB;
constexpr size_t WS_WC4   = 11 * MiB;
constexpr size_t WS_WC0   = 18 * MiB;
constexpr size_t WS_WOUT1 = 21 * MiB;
constexpr size_t WS_WMKV  = 24 * MiB;
constexpr size_t WS_WQ0   = 28 * MiB;
constexpr size_t WS_WQ1   = 32 * MiB;
constexpr size_t WS_SUBK  = 36 * MiB;
constexpr size_t WS_MEMB  = 37 * MiB;
constexpr size_t WS_MEMKV = 41 * MiB;
constexpr size_t WS_EXP   = 49 * MiB;
constexpr size_t WS_GATE  = 57 * MiB;
constexpr size_t WS_UB    = 73 * MiB;
constexpr size_t WS_VB    = 105 * MiB;
constexpr size_t WS_XB    = 201 * MiB;
constexpr size_t WS_RB    = 265 * MiB;
constexpr size_t WS_P0MAIN = WS_RB;
constexpr size_t WS_A2    = WS_RB + 64 * MiB;
constexpr size_t WS_PQ    = WS_RB;
constexpr size_t WS_KR    = WS_RB;
constexpr size_t WS_VV    = WS_RB + 64 * MiB;
constexpr size_t WS_A3    = WS_RB + 128 * MiB;
constexpr size_t WS_END   = WS_RB + 224 * MiB;

constexpr int LDS_BYTES = 147456;

__device__ __forceinline__ unsigned f2bf(float f) { unsigned u = __builtin_bit_cast(unsigned, f); return (u + 0x7fffu + ((u >> 16) & 1u)) >> 16; }
__device__ __forceinline__ unsigned pk2(float lo, float hi) { return f2bf(lo) | (f2bf(hi) << 16); }
__device__ __forceinline__ unsigned cvtpk(float lo, float hi) { unsigned r; asm volatile("v_cvt_pk_bf16_f32 %0, %1, %2" : "=v"(r) : "v"(lo), "v"(hi)); return r; }
__device__ __forceinline__ float bflo(unsigned w) { return __builtin_bit_cast(float, w << 16); }
__device__ __forceinline__ float bfhi(unsigned w) { return __builtin_bit_cast(float, w & 0xffff0000u); }
template <int J> __device__ __forceinline__ unsigned shx_u(unsigned v) {
    if constexpr (J == 32) { auto rr = __builtin_amdgcn_permlane32_swap(v, v, false, false); return ((threadIdx.x & 32) ? rr[0] : rr[1]); }
    else return (unsigned)__builtin_amdgcn_ds_swizzle((int)v, (J << 10) | 0x1f);
}
template <int J> __device__ __forceinline__ float shx_f(float v) { return __uint_as_float(shx_u<J>(__float_as_uint(v))); }
template <int CTRL> __device__ __forceinline__ float dpp_f(float v) { return __uint_as_float((unsigned)__builtin_amdgcn_update_dpp(0, (int)__float_as_uint(v), CTRL, 0xF, 0xF, false)); }
__device__ __forceinline__ float wave_sum(float v) {
    v += dpp_f<0xB1>(v); v += dpp_f<0x4E>(v); v += dpp_f<0x141>(v); v += dpp_f<0x128>(v);
    v += shx_f<16>(v);
    { auto rr = __builtin_amdgcn_permlane32_swap(__float_as_uint(v), __float_as_uint(v), false, false); v = __uint_as_float(rr[0]) + __uint_as_float(rr[1]); }
    return v;
}
__device__ __forceinline__ float dot2(unsigned w, unsigned x, float acc) { return __builtin_amdgcn_fdot2_f32_bf16(__builtin_bit_cast(bf16x2_t, w), __builtin_bit_cast(bf16x2_t, x), acc, false); }
#define LDS_WAIT() asm volatile("s_waitcnt lgkmcnt(0)" ::: "memory")
#define VM_WAIT() asm volatile("s_waitcnt vmcnt(0)" ::: "memory")

namespace pg8 {
#define PG8_LAS __attribute__((address_space(3)))
typedef unsigned short bf16_t;
constexpr int BM = 256, BK = 64, HALF = 128, HTB = HALF * BK * 2, STAGE_BYTES = 8 * HTB, NXCD = 8, WGM = 8;
__host__ __device__ __forceinline__ int lds_byte(int r, int c) { const int st = (r >> 4) * 2 + (c >> 5), rr = r & 15, cc = c & 31, ob = rr * 64 + cc * 2; return st * 1024 + (ob ^ (((ob >> 9) & 1) << 5)); }
__host__ __device__ __forceinline__ void stage_rc(int b, int& R, int& C) { const int st = b / 1024, sb = b % 1024, swz = sb ^ (((sb >> 9) & 1) << 5); R = (st >> 1) * 16 + swz / 64; C = (st & 1) * 32 + (swz % 64) / 2; }
__host__ __device__ __forceinline__ int perm32(int rho) { const int n = rho >> 4, i = rho & 15; return 8 * (i >> 2) + 4 * n + (i & 3); }
struct Unit { int pm, pn; };
struct Gemm { const bf16_t* A; const bf16_t* Bt; int M, N, K; };
struct StaticOrder {
    int nM, nN, nwg, G, c;
    __host__ __device__ void init(int M, int N, int G_, int c_) { nM = M / BM; nN = N / BM; nwg = nM * nN; G = G_; c = c_; }
    __host__ __device__ bool next(int i, Unit& u) const {
        const long L = (long)i * G + c; if (L >= nwg) return false;
        int wgid = (int)L; { const int q = nwg / NXCD, r = nwg % NXCD, xcd = wgid % NXCD, off = wgid / NXCD; wgid = (xcd < r ? xcd * (q + 1) : r * (q + 1) + (xcd - r) * q) + off; }
        const int nig = WGM * nN, gid = wgid / nig, fm = gid * WGM, gsz = (nM - fm) < WGM ? (nM - fm) : WGM;
        u.pm = fm + ((wgid % nig) % gsz); u.pn = (wgid % nig) / gsz; return true;
    }
    __device__ __forceinline__ void a_ready(const Unit&) const {}
    __device__ __forceinline__ void done(const Unit&) const {}
};

struct EpiRowBf16 {
    static constexpr bool PERM = true, AFTER_DRAIN = false;
    bf16_t* O0; int ld0; bf16_t* O1; int ld1; int split; const float* rs; const float* ssq;
    __device__ __forceinline__ void operator()(const f32x4 (&acc)[2][2][4][2], const Unit& u, int wr, int wc, int fr, int fq) const {
        const int row0 = u.pm * BM + wr * 64 + fr; int colt = u.pn * BM; bf16_t* base = O0; int ldc = ld0;
        if (colt >= split) { base = O1; ldc = ld1; colt -= split; }
        const int col0 = colt + wc * 32 + 8 * fq;
#pragma unroll
        for (int ai = 0; ai < 2; ++ai)
#pragma unroll
            for (int m = 0; m < 4; ++m) { const int row = row0 + ai * HALF + m * 16; float sc = 1.f;
                if (rs) sc = rs[row];
                else if (ssq) { const f32x4* q = (const f32x4*)(ssq + (size_t)row * 16); const f32x4 a = q[0], b = q[1], c = q[2], d = q[3];
                    const float s = ((a[0] + a[1]) + (a[2] + a[3])) + ((b[0] + b[1]) + (b[2] + b[3])) + ((c[0] + c[1]) + (c[2] + c[3])) + ((d[0] + d[1]) + (d[2] + d[3]));
                    sc = __builtin_amdgcn_rsqf(s * (1.0f / 1024.0f) + EPS); }
                bf16_t* rowp = base + (size_t)row * ldc + col0;
#pragma unroll
                for (int bj = 0; bj < 2; ++bj) { const f32x4 v0 = acc[ai][bj][m][0] * sc, v1 = acc[ai][bj][m][1] * sc;
                    u32x4 w; w.x = cvtpk(v0[0], v0[1]); w.y = cvtpk(v0[2], v0[3]); w.z = cvtpk(v1[0], v1[1]); w.w = cvtpk(v1[2], v1[3]);
                    *(u32x4*)(rowp + bj * HALF) = w; } }
    }
};
struct EpiRes {
    static constexpr bool PERM = true, AFTER_DRAIN = false;
    bf16_t* xb; float* ssq;
    __device__ __forceinline__ void operator()(const f32x4 (&acc)[2][2][4][2], const Unit& u, int wr, int wc, int fr, int fq) const {
        const int row0 = u.pm * BM + wr * 64 + fr, col0 = u.pn * BM + wc * 32 + 8 * fq;
#pragma unroll
        for (int ai = 0; ai < 2; ++ai)
#pragma unroll
            for (int m = 0; m < 4; ++m) { const int row = row0 + ai * HALF + m * 16; bf16_t* p = xb + (size_t)row * DM + col0; float ss = 0.f;
#pragma unroll
                for (int bj = 0; bj < 2; ++bj) { const u32x4 r = *(const u32x4*)(p + bj * HALF); const f32x4 a0 = acc[ai][bj][m][0], a1 = acc[ai][bj][m][1];
                    const float o0 = bflo(r.x) + a0[0], o1 = bfhi(r.x) + a0[1], o2 = bflo(r.y) + a0[2], o3 = bfhi(r.y) + a0[3], o4 = bflo(r.z) + a1[0], o5 = bfhi(r.z) + a1[1], o6 = bflo(r.w) + a1[2], o7 = bfhi(r.w) + a1[3];
                    u32x4 w; w.x = cvtpk(o0, o1); w.y = cvtpk(o2, o3); w.z = cvtpk(o4, o5); w.w = cvtpk(o6, o7); *(u32x4*)(p + bj * HALF) = w;
                    ss += ((o0 * o0 + o1 * o1) + (o2 * o2 + o3 * o3)) + ((o4 * o4 + o5 * o5) + (o6 * o6 + o7 * o7)); }
                ss += __shfl_xor(ss, 16); ss += __shfl_xor(ss, 32);
                if (fq == 0) ssq[(size_t)row * 16 + u.pn * 4 + wc] = ss; }
    }
};
struct EpiKVQ {
    static constexpr bool PERM = true, AFTER_DRAIN = false;
    bf16_t* KR; bf16_t* VV; bf16_t* A3; float* KMP; const float* rs; const float* rope;
    __device__ __forceinline__ void operator()(const f32x4 (&acc)[2][2][4][2], const Unit& u, int wr, int wc, int fr, int fq) const {
        const int pn = u.pn, pm = u.pm, b = pm >> 4, s0 = (pm & 15) * 256, rl0 = wr * 64 + fr, g0 = 32 * wc + 8 * fq;
        float rsv[2][4];
#pragma unroll
        for (int ai = 0; ai < 2; ++ai)
#pragma unroll
            for (int m = 0; m < 4; ++m) rsv[ai][m] = rs[pm * BM + rl0 + ai * HALF + m * 16];
        if (pn < 4 || (pn >= 8 && pn < 12)) {
            const bool isK = pn < 4; const int hp = isK ? pn : pn - 8; const int i0 = 16 * wc + 4 * fq;
            f32x4 klo[2] = {{0.f, 0.f, 0.f, 0.f}, {0.f, 0.f, 0.f, 0.f}}, khi[2] = {{0.f, 0.f, 0.f, 0.f}, {0.f, 0.f, 0.f, 0.f}};
#pragma unroll
            for (int ai = 0; ai < 2; ++ai)
#pragma unroll
                for (int m = 0; m < 4; ++m) { const int rl = rl0 + ai * HALF + m * 16, s = s0 + rl;
                    const f32x4 cs0 = *(const f32x4*)(rope + ((size_t)s * 64 + i0) * 2), cs1 = *(const f32x4*)(rope + ((size_t)s * 64 + i0) * 2 + 4);
                    const f32x4 c = {cs0[0], cs0[2], cs1[0], cs1[2]}, sn = {cs0[1], cs0[3], cs1[1], cs1[3]};
#pragma unroll
                    for (int bj = 0; bj < 2; ++bj) { const int head = 2 * hp + bj;
                        const f32x4 v1 = acc[ai][bj][m][0] * rsv[ai][m], v2 = acc[ai][bj][m][1] * rsv[ai][m];
                        const f32x4 lo = v1 * c - v2 * sn, hi = v2 * c + v1 * sn;
                        u32x4 w; w.x = cvtpk(lo[0], lo[1]); w.y = cvtpk(lo[2], lo[3]); w.z = cvtpk(hi[0], hi[1]); w.w = cvtpk(hi[2], hi[3]);
                        bf16_t* dst = isK ? KR + ((size_t)(b * 8 + head) * SEQ + s) * 128 + g0 : A3 + (size_t)(pm * BM + rl) * MIXW + head * 128 + g0;
                        *(u32x4*)dst = w;
                        klo[bj] += lo; khi[bj] += hi; } }
            if (isK) {
#pragma unroll
                for (int bj = 0; bj < 2; ++bj) {
#pragma unroll
                    for (int j = 0; j < 4; ++j) {
#pragma unroll
                        for (int o = 1; o < 16; o <<= 1) { klo[bj][j] += __shfl_xor(klo[bj][j], o); khi[bj][j] += __shfl_xor(khi[bj][j], o); } }
                    if (fr == 0) { float* kp = KMP + ((size_t)pm * 2 + wr) * 1024 + (2 * hp + bj) * 128 + g0; *(f32x4*)kp = klo[bj]; *(f32x4*)(kp + 4) = khi[bj]; } } }
        } else {
            const bool isV = pn < 8;
#pragma unroll
            for (int bj = 0; bj < 2; ++bj)
#pragma unroll
                for (int ai = 0; ai < 2; ++ai)
#pragma unroll
                    for (int m = 0; m < 4; ++m) { const int rl = rl0 + ai * HALF + m * 16, s = s0 + rl;
                        const f32x4 v0 = acc[ai][bj][m][0] * rsv[ai][m], v1 = acc[ai][bj][m][1] * rsv[ai][m];
                        u32x4 w; w.x = cvtpk(v0[0], v0[1]); w.y = cvtpk(v0[2], v0[3]); w.z = cvtpk(v1[0], v1[1]); w.w = cvtpk(v1[2], v1[3]);
                        bf16_t* dst = isV ? VV + ((size_t)(b * 8 + 2 * (pn - 4) + bj) * SEQ + s) * 128 + g0 : A3 + (size_t)(pm * BM + rl) * MIXW + 1024 + (pn - 12) * 256 + bj * HALF + g0;
                        *(u32x4*)dst = w; }
        }
    }
};

template <class Epi, class Sched, bool ALIGN_EPI = true, bool SP2 = true>
__device__ __forceinline__ void gemm_phase(PG8_LAS unsigned char* lds, const Gemm g, const Sched& S, const Epi& E) {
    int tid = threadIdx.x; asm volatile("" : "+v"(tid));
    const int wid = __builtin_amdgcn_readfirstlane(tid >> 6), lane = tid & 63, wr = wid >> 2, wc = wid & 3, fr = lane & 15, fq = lane >> 4;
    const int K = g.K, nt = K / BK;
    unsigned voffA[2], voffB[2];
#pragma unroll
    for (int i = 0; i < 2; ++i) { int R, C; stage_rc(tid * 16 + i * 8192, R, C); const int Rb = Epi::PERM ? ((R & ~31) + perm32(R & 31)) : R;
        voffA[i] = (unsigned)(R * K + C) * 2u; voffB[i] = (unsigned)(Rb * K + C) * 2u; }
    const size_t kstep = (size_t)(BK * 2);
    const size_t hstep = (size_t)HALF * K * 2;
    const size_t tstep = 2 * hstep;
    const unsigned ldsw = (unsigned)wid * 1024u;
    const int aoff = lds_byte(wr * 64 + fr, fq * 8), boff = lds_byte(wc * 32 + fr, fq * 8);
#define PG8_SA(b, h) (((b) * 2 + (h)) * HTB)
#define PG8_SB(b, h) ((4 + (b) * 2 + (h)) * HTB)
#define PG8_STAGE(bufoff, gbase, voff) do { _Pragma("unroll") for (int _i = 0; _i < 2; ++_i) \
        __builtin_amdgcn_global_load_lds((const unsigned*)((const char*)(gbase) + (voff)[_i]), (PG8_LAS unsigned*)(lds + (bufoff) + ldsw + _i * 8192), 16, 0, 0); } while (0)
#define PG8_LDA(dst, b, h) do { _Pragma("unroll") for (int m = 0; m < 4; ++m) _Pragma("unroll") for (int k = 0; k < 2; ++k) dst[m][k] = *(const PG8_LAS bf16x8*)(lds + PG8_SA(b, h) + aoff + m * 2048 + k * 1024); } while (0)
#define PG8_LDB(dst, b, h) do { _Pragma("unroll") for (int n = 0; n < 2; ++n) _Pragma("unroll") for (int k = 0; k < 2; ++k) dst[n][k] = *(const PG8_LAS bf16x8*)(lds + PG8_SB(b, h) + boff + n * 2048 + k * 1024); } while (0)
#define PG8_MMA(ai, bj, At, Bt) do { __builtin_amdgcn_s_setprio(1); _Pragma("unroll") for (int m = 0; m < 4; ++m) _Pragma("unroll") for (int n = 0; n < 2; ++n) _Pragma("unroll") for (int k = 0; k < 2; ++k) \
        acc[ai][bj][m][n] = __builtin_amdgcn_mfma_f32_16x16x32_bf16(Bt[n][k], At[m][k], acc[ai][bj][m][n], 0, 0, 0); __builtin_amdgcn_s_setprio(0); } while (0)
#define PG8_WAIT_V(n) asm volatile("s_waitcnt vmcnt(" #n ")" ::: "memory")
#define PG8_WAIT_L(n) asm volatile("s_waitcnt lgkmcnt(" #n ")" ::: "memory")
#define PG8_BAR __builtin_amdgcn_s_barrier()
#define PG8_SCHED __builtin_amdgcn_sched_barrier(0)
    Unit cur, nxt; int ui = 0;
    if (!S.next(0, cur)) return;
    f32x4 acc[2][2][4][2];
#pragma unroll
    for (int a = 0; a < 2; ++a)
#pragma unroll
        for (int b = 0; b < 2; ++b)
#pragma unroll
            for (int m = 0; m < 4; ++m)
#pragma unroll
                for (int n = 0; n < 2; ++n) acc[a][b][m][n] = (f32x4){0.f, 0.f, 0.f, 0.f};
    bf16x8 At[4][2], B0[2][2], B1[2][2];
    const char* cA = (const char*)g.A + (size_t)cur.pm * tstep; const char* cB = (const char*)g.Bt + (size_t)cur.pn * tstep;
    S.a_ready(cur);
    if constexpr (SP2) {
        PG8_STAGE(PG8_SB(0, 0), cB, voffB); PG8_STAGE(PG8_SB(0, 1), cB + hstep, voffB); PG8_STAGE(PG8_SA(0, 0), cA, voffA); PG8_STAGE(PG8_SA(0, 1), cA + hstep, voffA);
        if (wr == 1) PG8_BAR;
        PG8_WAIT_V(2); PG8_BAR;
        PG8_STAGE(PG8_SB(1, 0), cB + kstep, voffB); PG8_STAGE(PG8_SA(1, 0), cA + kstep, voffA); PG8_STAGE(PG8_SB(1, 1), cB + hstep + kstep, voffB);
        PG8_WAIT_V(6); PG8_BAR;
    } else {
        PG8_STAGE(PG8_SB(0, 0), cB, voffB); PG8_STAGE(PG8_SA(0, 0), cA, voffA); PG8_STAGE(PG8_SB(0, 1), cB + hstep, voffB); PG8_STAGE(PG8_SA(0, 1), cA + hstep, voffA);
        if (wr == 1) PG8_BAR;
        PG8_WAIT_V(4); PG8_BAR;
        PG8_STAGE(PG8_SB(1, 0), cB + kstep, voffB); PG8_STAGE(PG8_SA(1, 0), cA + kstep, voffA); PG8_STAGE(PG8_SB(1, 1), cB + hstep + kstep, voffB);
        PG8_WAIT_V(6); PG8_BAR;
    }
    for (;;) {
        const bool has_next = S.next(ui + 1, nxt);
        const char* nA = has_next ? (const char*)g.A + (size_t)nxt.pm * tstep : cA; const char* nB = has_next ? (const char*)g.Bt + (size_t)nxt.pn * tstep : cB;
        for (int t = 0; t < nt; t += 2) {
            const bool last = (t == nt - 2);
            const char* a1 = cA + (size_t)(t + 1) * kstep;
            const char* a2 = last ? nA : cA + (size_t)(t + 2) * kstep; const char* b2 = last ? nB : cB + (size_t)(t + 2) * kstep;
            const char* a3 = a2 + kstep; const char* b3 = b2 + kstep;
            if (last && has_next) S.a_ready(nxt);
            if constexpr (SP2) {
            PG8_LDB(B0, 0, 0); PG8_LDB(B1, 0, 1); PG8_SCHED; PG8_LDA(At, 0, 0); PG8_STAGE(PG8_SA(1, 1), a1 + hstep, voffA);
            PG8_WAIT_V(8); PG8_WAIT_L(0); PG8_BAR; PG8_MMA(0, 0, At, B0); PG8_MMA(0, 1, At, B1); PG8_BAR; PG8_SCHED;
            PG8_LDA(At, 0, 1); PG8_STAGE(PG8_SB(0, 0), b2, voffB); PG8_STAGE(PG8_SB(0, 1), b2 + hstep, voffB); PG8_STAGE(PG8_SA(0, 0), a2, voffA);
            PG8_WAIT_V(8); PG8_WAIT_L(0); PG8_BAR; PG8_MMA(1, 0, At, B0); PG8_MMA(1, 1, At, B1); PG8_BAR; PG8_SCHED;
            PG8_LDB(B0, 1, 0); PG8_LDB(B1, 1, 1); PG8_SCHED; PG8_LDA(At, 1, 0); PG8_STAGE(PG8_SA(0, 1), a2 + hstep, voffA);
            PG8_WAIT_V(8); PG8_WAIT_L(0); PG8_BAR; PG8_MMA(0, 0, At, B0); PG8_MMA(0, 1, At, B1); PG8_BAR; PG8_SCHED;
            PG8_LDA(At, 1, 1); PG8_STAGE(PG8_SB(1, 0), b3, voffB); PG8_STAGE(PG8_SB(1, 1), b3 + hstep, voffB); PG8_STAGE(PG8_SA(1, 0), a3, voffA);
            PG8_WAIT_V(8); PG8_WAIT_L(0); PG8_BAR; PG8_MMA(1, 0, At, B0); PG8_MMA(1, 1, At, B1); PG8_BAR; PG8_SCHED;
            } else {
            PG8_LDB(B0, 0, 0); PG8_SCHED; PG8_LDA(At, 0, 0); PG8_STAGE(PG8_SA(1, 1), a1 + hstep, voffA);
            PG8_WAIT_L(8); PG8_BAR; PG8_WAIT_L(0); PG8_MMA(0, 0, At, B0); PG8_BAR; PG8_SCHED;
            PG8_LDB(B1, 0, 1); PG8_STAGE(PG8_SB(0, 0), b2, voffB);
            PG8_BAR; PG8_WAIT_L(0); PG8_MMA(0, 1, At, B1); PG8_BAR;
            PG8_LDA(At, 0, 1); PG8_STAGE(PG8_SA(0, 0), a2, voffA);
            PG8_BAR; PG8_WAIT_L(0); PG8_MMA(1, 0, At, B0); PG8_BAR; PG8_SCHED;
            PG8_STAGE(PG8_SB(0, 1), b2 + hstep, voffB);
            PG8_WAIT_V(6); PG8_BAR; PG8_MMA(1, 1, At, B1); PG8_BAR;
            PG8_LDB(B0, 1, 0); PG8_SCHED; PG8_LDA(At, 1, 0); PG8_STAGE(PG8_SA(0, 1), a2 + hstep, voffA);
            PG8_WAIT_L(8); PG8_BAR; PG8_WAIT_L(0); PG8_MMA(0, 0, At, B0); PG8_BAR; PG8_SCHED;
            PG8_LDB(B1, 1, 1); PG8_STAGE(PG8_SB(1, 0), b3, voffB);
            PG8_BAR; PG8_WAIT_L(0); PG8_MMA(0, 1, At, B1); PG8_BAR;
            PG8_LDA(At, 1, 1); PG8_STAGE(PG8_SA(1, 0), a3, voffA);
            PG8_BAR; PG8_WAIT_L(0); PG8_MMA(1, 0, At, B0); PG8_BAR; PG8_SCHED;
            PG8_STAGE(PG8_SB(1, 1), b3 + hstep, voffB);
            PG8_WAIT_V(6); PG8_BAR; PG8_MMA(1, 1, At, B1); PG8_BAR;
            }
        }
        if constexpr (ALIGN_EPI) { if (wr == 0) PG8_BAR; }
        if constexpr (!Epi::AFTER_DRAIN) { E(acc, cur, wr, wc, fr, fq); S.done(cur); }
        if (!has_next) break;
#pragma unroll
        for (int a = 0; a < 2; ++a)
#pragma unroll
            for (int b = 0; b < 2; ++b)
#pragma unroll
                for (int m = 0; m < 4; ++m)
#pragma unroll
                    for (int n = 0; n < 2; ++n) acc[a][b][m][n] = (f32x4){0.f, 0.f, 0.f, 0.f};
        cur = nxt; cA = nA; cB = nB; ++ui;
        if constexpr (ALIGN_EPI) { if (wr == 1) PG8_BAR; }
    }
    PG8_WAIT_V(0);
    if constexpr (!ALIGN_EPI) { if (wr == 0) PG8_BAR; }
    PG8_BAR;
#undef PG8_SA
#undef PG8_SB
#undef PG8_STAGE
#undef PG8_LDA
#undef PG8_LDB
#undef PG8_MMA
#undef PG8_WAIT_V
#undef PG8_WAIT_L
#undef PG8_BAR
#undef PG8_SCHED
}
}

namespace att {
constexpr int D = 128, NW = 8, QBLK = 32, KVBLK = 64;
constexpr float SCALE = 0.088388347648318440f;
constexpr float THR = 8.f;
constexpr size_t SHM_V = KVBLK * D * 2, SHM_K = KVBLK * D * 2, SHM_ATTN = 2 * SHM_V + 2 * SHM_K + NW * 64 * 4;
#define KSWZ(row, colB) ((row) * 256 + ((colB) ^ (((row) & 7) << 4)))
#define SBAR() __builtin_amdgcn_sched_barrier(0)
__device__ __forceinline__ int crow(int r, int hi) { return (r & 3) + 8 * (r >> 2) + 4 * hi; }

template <bool MOBA>
__device__ __forceinline__ void partialSM(f32x16& p0, f32x16& p1, float& m_reg, float& mn, float& alpha, int t, int qrow, int hi, unsigned selmask) {
  constexpr float C = SCALE * 1.4426950408889634f;
  if constexpr (MOBA) {
    if (t < 4) { const int kb = t * 64 + 4 * hi;
#pragma unroll
      for (int r = 0; r < 16; ++r) { const int kk = kb + (r & 3) + 8 * (r >> 2); p0[r] = (kk > qrow) ? -1e30f : p0[r]; p1[r] = (kk + 32 > qrow) ? -1e30f : p1[r]; }
    } else { const bool keep = (selmask >> ((t - 4) >> 2)) & 1u;
#pragma unroll
      for (int r = 0; r < 16; ++r) { p0[r] = keep ? p0[r] : -1e30f; p1[r] = keep ? p1[r] : -1e30f; } }
  }
  float pmax = p0[0];
#pragma unroll
  for (int r = 1; r < 16; ++r) pmax = fmaxf(pmax, p0[r]);
#pragma unroll
  for (int r = 0; r < 16; ++r) pmax = fmaxf(pmax, p1[r]);
  { auto rr = __builtin_amdgcn_permlane32_swap(__float_as_uint(pmax), __float_as_uint(pmax), false, false);
    pmax = fmaxf(__uint_as_float(rr[0]), __uint_as_float(rr[1])); }
  if (__builtin_expect(__all(pmax - m_reg <= THR / SCALE), 1)) { mn = m_reg; alpha = 1.f; }
  else { mn = fmaxf(m_reg, pmax); alpha = __builtin_amdgcn_exp2f((m_reg - mn) * C); m_reg = mn; }
  float mnC = -mn * C;
#pragma unroll
  for (int r = 0; r < 16; ++r) p0[r] = fmaf(p0[r], C, mnC);
#pragma unroll
  for (int r = 0; r < 16; ++r) p1[r] = fmaf(p1[r], C, mnC);
#pragma unroll
  for (int r = 0; r < 16; ++r) p0[r] = __builtin_amdgcn_exp2f(p0[r]);
}
__device__ __forceinline__ void finishSM(f32x16& p0, f32x16& p1, float alpha, float& l_reg, bf16x8& pa0, bf16x8& pa1, bf16x8& pa2, bf16x8& pa3) {
#pragma unroll
  for (int r = 0; r < 16; ++r) p1[r] = __builtin_amdgcn_exp2f(p1[r]);
  float ps = 0;
#pragma unroll
  for (int r = 0; r < 16; ++r) ps += p0[r];
#pragma unroll
  for (int r = 0; r < 16; ++r) ps += p1[r];
  { auto rr = __builtin_amdgcn_permlane32_swap(__float_as_uint(ps), __float_as_uint(ps), false, false);
    ps = __uint_as_float(rr[0]) + __uint_as_float(rr[1]); }
  l_reg = l_reg * alpha + ps;
#define PK4(P, BASE, OUT) do { unsigned a0 = cvtpk(P[BASE + 0], P[BASE + 1]), a1 = cvtpk(P[BASE + 2], P[BASE + 3]);   \
    unsigned b0 = cvtpk(P[BASE + 4], P[BASE + 5]), b1 = cvtpk(P[BASE + 6], P[BASE + 7]);                              \
    auto r0 = __builtin_amdgcn_permlane32_swap(a0, b0, false, false); auto r1 = __builtin_amdgcn_permlane32_swap(a1, b1, false, false); \
    u32x4 w = {r0[0], r1[0], r0[1], r1[1]}; OUT = *reinterpret_cast<bf16x8*>(&w); } while (0)
  PK4(p0, 0, pa0); PK4(p0, 8, pa1); PK4(p1, 0, pa2); PK4(p1, 8, pa3);
#undef PK4
}
__device__ __forceinline__ void qkt(f32x16& p0, f32x16& p1, const char* Ks, const bf16x8* qr, const int (&ka)[4]) {
  p0 = f32x16{}; p1 = f32x16{};
#pragma unroll
  for (int d0 = 0; d0 < 8; ++d0) {
    bf16x8 b0 = *reinterpret_cast<const bf16x8*>(Ks + ka[d0 & 3] + (d0 >> 2) * 128);
    bf16x8 b1 = *reinterpret_cast<const bf16x8*>(Ks + ka[d0 & 3] + (d0 >> 2) * 128 + 8192);
    p0 = __builtin_amdgcn_mfma_f32_32x32x16_bf16(b0, qr[d0], p0, 0, 0, 0);
    p1 = __builtin_amdgcn_mfma_f32_32x32x16_bf16(b1, qr[d0], p1, 0, 0, 0); }
}
__device__ __forceinline__ void qkt1(f32x16& p0, const char* Ks, const bf16x8* qr, const int (&ka)[4]) {
  p0 = f32x16{};
#pragma unroll
  for (int d0 = 0; d0 < 8; ++d0) {
    bf16x8 b0 = *reinterpret_cast<const bf16x8*>(Ks + ka[d0 & 3] + (d0 >> 2) * 128);
    p0 = __builtin_amdgcn_mfma_f32_32x32x16_bf16(b0, qr[d0], p0, 0, 0, 0); }
}
__device__ __forceinline__ int v_st(int k, int c) { const int kk = (k & ~0xC) | ((k & 4) << 1) | ((k & 8) >> 1); return ((kk >> 3) * 4 + (c >> 5)) * 512 + ((kk & 7) * 32 + (c & 31)) * 2; }
__device__ __forceinline__ int v_rd_base(int lane) { return ((lane & 3) << 3) | (((lane >> 2) & 3) << 6) | (((lane >> 4) & 1) << 5) | (((lane >> 5) & 1) << 8); }
constexpr int v_rd_off(int d0, int ks, int half) { return d0 * 512 + ks * 4096 + half * 2048; }
template <int OFF> __device__ __forceinline__ s16x4 tr_read(int vb) {
  s16x4 r; asm volatile("ds_read_b64_tr_b16 %0, %1 offset:%2" : "=&v"(r) : "v"(vb), "i"(OFF) : "memory"); return r;
}
template <int D0> __device__ __forceinline__ void pv_one(f32x16& od, int vb, bf16x8 pa0, bf16x8 pa1, bf16x8 pa2, bf16x8 pa3) {
  const s16x4 l0 = tr_read<v_rd_off(D0, 0, 0)>(vb), h0 = tr_read<v_rd_off(D0, 0, 1)>(vb), l1 = tr_read<v_rd_off(D0, 1, 0)>(vb), h1 = tr_read<v_rd_off(D0, 1, 1)>(vb);
  const s16x4 l2 = tr_read<v_rd_off(D0, 2, 0)>(vb), h2 = tr_read<v_rd_off(D0, 2, 1)>(vb), l3 = tr_read<v_rd_off(D0, 3, 0)>(vb), h3 = tr_read<v_rd_off(D0, 3, 1)>(vb);
  asm volatile("s_waitcnt lgkmcnt(0)" ::: "memory"); SBAR();
#define PK(L, H) (bf16x8){L[0], L[1], L[2], L[3], H[0], H[1], H[2], H[3]}
  od = __builtin_amdgcn_mfma_f32_32x32x16_bf16(pa0, PK(l0, h0), od, 0, 0, 0);
  od = __builtin_amdgcn_mfma_f32_32x32x16_bf16(pa1, PK(l1, h1), od, 0, 0, 0);
  od = __builtin_amdgcn_mfma_f32_32x32x16_bf16(pa2, PK(l2, h2), od, 0, 0, 0);
  od = __builtin_amdgcn_mfma_f32_32x32x16_bf16(pa3, PK(l3, h3), od, 0, 0, 0);
#undef PK
}
__device__ __forceinline__ void pv_d0(f32x16* o, int vb, bf16x8 pa0, bf16x8 pa1, bf16x8 pa2, bf16x8 pa3) {
  pv_one<0>(o[0], vb, pa0, pa1, pa2, pa3); pv_one<1>(o[1], vb, pa0, pa1, pa2, pa3); pv_one<2>(o[2], vb, pa0, pa1, pa2, pa3); pv_one<3>(o[3], vb, pa0, pa1, pa2, pa3);
}

template <int LDQ, int LDK, bool MOBA, int SDEPTH>
__device__ __forceinline__ void attn_unit(const bf16* Qb, const bf16* Kh, const bf16* Vh, bf16* Ob, int jblk, const float* kmp, char* lds) {
  int tid = threadIdx.x; asm volatile("" : "+v"(tid));
  const int wid = __builtin_amdgcn_readfirstlane(tid >> 6), lane = tid & 63, r32 = lane & 31, hi = lane >> 5;
  char* V_lds = lds; char* K_lds = lds + 2 * SHM_V;
  float* ws = (float*)(lds + 2 * SHM_V + 2 * SHM_K) + wid * 64; float* li_l = ws; float* al_l = ws + 32;
  float m_reg = -1e30f, l_reg = 0; f32x16 o[4] = {}; bf16x8 qr[8];
  const bf16* Qw = Qb + (long)(wid * QBLK + r32) * LDQ + hi * 8;
#pragma unroll
  for (int d0 = 0; d0 < 8; ++d0) qr[d0] = *reinterpret_cast<const bf16x8*>(Qw + d0 * 16);
  const int sr = tid >> 4, sc = (tid & 15) * 8, vst0 = v_st(sr, sc), vst1 = v_st(32 + sr, sc);
  const unsigned goff = (unsigned)(sr * LDK + sc) * 2u;
  const int vb0 = (int)(uintptr_t)V_lds + v_rd_base(lane);
  const int qrow = wid * QBLK + r32;
  int ka[4];
#pragma unroll
  for (int i = 0; i < 4; ++i) ka[i] = r32 * 256 + (((2 * i + hi) ^ (r32 & 7)) << 4);
  unsigned selmask = 0;
  struct { bf16x8 vs0, vs1, ks0, ks1; } sr_[SDEPTH];
  const int NT = MOBA ? 4 * (jblk + 1) : 4;
#define KOFF(t) (MOBA ? ((t) < 4 ? jblk * 256 + (t) * 64 : ((t) - 4) * 64) : (t) * 64)
#define SLOAD(i, k0) do { const char* kb_ = (const char*)Kh + (size_t)(k0) * (LDK * 2); const char* vb_ = (const char*)Vh + (size_t)(k0) * (LDK * 2); \
    sr_[i].vs0 = *reinterpret_cast<const bf16x8*>(vb_ + goff); sr_[i].vs1 = *reinterpret_cast<const bf16x8*>(vb_ + 32 * LDK * 2 + goff); \
    sr_[i].ks0 = *reinterpret_cast<const bf16x8*>(kb_ + goff); sr_[i].ks1 = *reinterpret_cast<const bf16x8*>(kb_ + 32 * LDK * 2 + goff); } while (0)
#define SWRITE(b, i) do { *(bf16x8*)(V_lds + (b) * SHM_V + vst0) = sr_[i].vs0;          \
    *(bf16x8*)(V_lds + (b) * SHM_V + vst1) = sr_[i].vs1; int kc = sc * 2;               \
    *(bf16x8*)(K_lds + (b) * SHM_K + KSWZ(sr, kc)) = sr_[i].ks0;                       \
    *(bf16x8*)(K_lds + (b) * SHM_K + KSWZ(32 + sr, kc)) = sr_[i].ks1; } while (0)
#define SWAIT() do { if constexpr (SDEPTH == 2) asm volatile("s_waitcnt vmcnt(4)" ::: "memory"); else asm volatile("s_waitcnt vmcnt(0)" ::: "memory"); } while (0)
#define RESC(a) do { if (__any((a) < 1.f)) { if (hi == 0) al_l[r32] = (a); asm volatile("s_waitcnt lgkmcnt(0)" ::: "memory"); \
    _Pragma("unroll") for (int d = 0; d < 4; ++d) _Pragma("unroll") for (int r = 0; r < 16; ++r) o[d][r] *= al_l[crow(r, hi)]; } } while (0)
  f32x16 pA0, pA1, pB0, pB1; float mnA, mnB, alA, alB; bf16x8 pa0, pa1, pa2, pa3;
  constexpr int SE = 0, SO = SDEPTH - 1;
  SLOAD(SE, KOFF(0));
  if constexpr (MOBA) {
    const int gr = tid >> 4, gc = (tid & 15) * 8; f32x4 a = {0.f, 0.f, 0.f, 0.f}, b = {0.f, 0.f, 0.f, 0.f};
    if (gr < jblk) { const float* p0_ = kmp + (size_t)gr * 2048 + gc; const f32x4 a0 = *(const f32x4*)p0_, a1 = *(const f32x4*)(p0_ + 4), b0 = *(const f32x4*)(p0_ + 1024), b1 = *(const f32x4*)(p0_ + 1028);
      a = (a0 + b0) * (1.0f / 256.0f); b = (a1 + b1) * (1.0f / 256.0f); }
    u32x4 w = {pk2(a[0], a[1]), pk2(a[2], a[3]), pk2(b[0], b[1]), pk2(b[2], b[3])};
    *(u32x4*)(K_lds + SHM_K + KSWZ(gr, gc * 2)) = w;
  }
  asm volatile("s_waitcnt vmcnt(0)" ::: "memory"); SWRITE(0, SE); __syncthreads();
  qkt(pA0, pA1, K_lds, qr, ka);
  if constexpr (MOBA) {
    f32x16 g; qkt1(g, K_lds + SHM_K, qr, ka);
    float gv[16];
#pragma unroll
    for (int r = 0; r < 8; ++r) { auto rr = __builtin_amdgcn_permlane32_swap(__float_as_uint(g[r]), __float_as_uint(g[r]), false, false);
      const float lo_ = __uint_as_float(rr[0]), hi_ = __uint_as_float(rr[1]);
      const int n0 = (r & 3) + 8 * (r >> 2); gv[n0] = lo_; gv[n0 + 4] = hi_; }
#pragma unroll
    for (int n = 0; n < 16; ++n) gv[n] = (n < jblk) ? gv[n] : -3e38f;
#pragma unroll
    for (int k = 0; k < 3; ++k) { float best = gv[0];
#pragma unroll
      for (int n = 1; n < 16; ++n) best = fmaxf(best, gv[n]);
      int idx = 16;
#pragma unroll
      for (int n = 15; n >= 0; --n) idx = (gv[n] == best) ? n : idx;
      if (best > -1e38f) selmask |= 1u << idx;
#pragma unroll
      for (int n = 0; n < 16; ++n) gv[n] = (n == idx) ? -3e38f : gv[n]; }
  }
  partialSM<MOBA>(pA0, pA1, m_reg, mnA, alA, 0, qrow, hi, selmask);
  SLOAD(SO, KOFF(1)); if constexpr (SDEPTH == 2) { if (2 < NT) SLOAD(SE, KOFF(2)); }
  if constexpr (MOBA) __syncthreads();
  SWAIT(); SWRITE(1, SO); __syncthreads();
  for (int j = 1; j + 1 < NT; j += 2) {
    SBAR(); qkt(pB0, pB1, K_lds + SHM_K, qr, ka);
    finishSM(pA0, pA1, alA, l_reg, pa0, pa1, pa2, pa3); SBAR();
    SLOAD(SO, KOFF(j + SDEPTH)); SBAR();
    pv_d0(o, vb0, pa0, pa1, pa2, pa3); partialSM<MOBA>(pB0, pB1, m_reg, mnB, alB, j, qrow, hi, selmask);
    __syncthreads(); SWAIT(); SWRITE(0, SE);
    RESC(alB); __syncthreads();
    SBAR(); qkt(pA0, pA1, K_lds, qr, ka);
    finishSM(pB0, pB1, alB, l_reg, pa0, pa1, pa2, pa3); SBAR();
    if (SDEPTH == 1 || j + 3 < NT) SLOAD(SE, KOFF(j + 1 + SDEPTH)); SBAR();
    pv_d0(o, vb0 + (int)SHM_V, pa0, pa1, pa2, pa3); partialSM<MOBA>(pA0, pA1, m_reg, mnA, alA, j + 1, qrow, hi, selmask);
    __syncthreads(); SWAIT(); SWRITE(1, SO);
    RESC(alA); __syncthreads();
  }
  SBAR(); qkt(pB0, pB1, K_lds + SHM_K, qr, ka);
  finishSM(pA0, pA1, alA, l_reg, pa0, pa1, pa2, pa3); SBAR();
  pv_d0(o, vb0, pa0, pa1, pa2, pa3); partialSM<MOBA>(pB0, pB1, m_reg, mnB, alB, NT - 1, qrow, hi, selmask);
  __syncthreads(); RESC(alB);
  finishSM(pB0, pB1, alB, l_reg, pa0, pa1, pa2, pa3); SBAR();
  pv_d0(o, vb0 + (int)SHM_V, pa0, pa1, pa2, pa3);
  if (hi == 0) li_l[r32] = l_reg; asm volatile("s_waitcnt lgkmcnt(0)" ::: "memory");
  float rli[16];
#pragma unroll
  for (int r = 0; r < 16; ++r) rli[r] = __builtin_amdgcn_rcpf(li_l[crow(r, hi)]);
  __syncthreads();
  char* ost = lds + wid * 8192;
#pragma unroll
  for (int r = 0; r < 16; ++r) { const int orow = crow(r, hi);
#pragma unroll
    for (int d0 = 0; d0 < 4; ++d0) *(unsigned short*)(ost + orow * 256 + (d0 * 32 + r32) * 2) = (unsigned short)f2bf(o[d0][r] * rli[r]); }
  asm volatile("s_waitcnt lgkmcnt(0)" ::: "memory");
  bf16* Ow = Ob + (long)(wid * QBLK) * LDQ;
#pragma unroll
  for (int i = 0; i < 8; ++i) { const int row = i * 4 + (lane >> 4), ch = lane & 15; const u32x4 v = *(const u32x4*)(ost + row * 256 + ch * 16);
    *(u32x4*)(Ow + (long)row * LDQ + ch * 8) = v; }
  __syncthreads();
#undef KOFF
#undef SLOAD
#undef SWRITE
#undef SWAIT
#undef RESC
}
}

#ifndef ATT_SD_MEM
#define ATT_SD_MEM 1
#endif
#ifndef ATT_SD_MOBA
#define ATT_SD_MOBA 1
#endif
struct Args {
    const float* in[16]; float* out; unsigned char* ws; int ph_lo, ph_hi;
};
struct Frame {
    LAS unsigned char* lds; char* ldsg;
    int wave, vcu, G;
};
__device__ __forceinline__ int fresh_tid() { int t = threadIdx.x; asm volatile("" : "+v"(t)); return t; }

template <int MAP>
__device__ __forceinline__ void transpose_item(const float* W, int ldw, bf16* dst, int ldd, int row_off, int koff, const float* sc, LAS float* scr, int kb, int nb, int lane) {
    const int k0 = 64 * kb, n0 = 32 * nb;
    float tv[32];
#pragma unroll
    for (int i = 0; i < 32; ++i) tv[i] = W[(size_t)(k0 + 2 * i + (lane >> 5)) * ldw + n0 + (lane & 31)];
    if (sc) { float sv[32];
#pragma unroll
        for (int i = 0; i < 32; ++i) sv[i] = sc[k0 + 2 * i + (lane >> 5)];
#pragma unroll
        for (int i = 0; i < 32; ++i) tv[i] *= sv[i]; }
#pragma unroll
    for (int i = 0; i < 32; ++i) scr[(2 * i + (lane >> 5)) * 33 + (lane & 31)] = tv[i];
    LDS_WAIT(); asm volatile("" ::: "memory");
    const int c = lane & 7;
#pragma unroll
    for (int j = 0; j < 4; ++j) { const int n = (lane >> 3) + 8 * j; const LAS float* s = scr + (8 * c) * 33 + n;
        u32x4 o; o.x = pk2(s[0 * 33], s[1 * 33]); o.y = pk2(s[2 * 33], s[3 * 33]); o.z = pk2(s[4 * 33], s[5 * 33]); o.w = pk2(s[6 * 33], s[7 * 33]);
        const int ns = n0 + n; int row;
        if (MAP == 1 && ns < 1024) { const int d = ns & 127; row = row_off + (ns & ~127) + 32 * ((d >> 4) & 3) + 8 * ((d >> 2) & 3) + 4 * (d >> 6) + (d & 3); } else row = row_off + ns;
        *(u32x4*)(dst + (size_t)row * ldd + koff + k0 + 8 * c) = o; }
    LDS_WAIT(); asm volatile("" ::: "memory");
}

template <int PART> __device__ __forceinline__ void phase0(const Args& a, Frame& F, int tb_lo, int tb_hi) {
    unsigned char* ws = a.ws;
    const int lane = fresh_tid() & 63;
    const int gw = F.vcu * NWAVES + F.wave, NGW = F.G * NWAVES;
    const int gt = gw * 64 + lane, NGT = NGW * 64;
    LAS float* scr = (LAS float*)(F.lds + F.wave * 16384);
    const float* x = a.in[0]; const float* mem = a.in[1]; const float* g_mix = a.in[2]; const float* w_in = a.in[3]; const float* w_out = a.in[4]; const float* w_mkv = a.in[5];
    const float* pool_w = a.in[6]; const float* pool_sc = a.in[7]; const float* g_kv = a.in[8]; const float* w_kv = a.in[9]; const float* g_ffn = a.in[10]; const float* wq = a.in[11];
    const float* subk = a.in[12]; const float* pu = a.in[13]; const float* pv = a.in[14];
    constexpr int I1 = 16 * 48, I2 = 16 * 48, I3 = 16 * 64, I4 = 8 * 32, I5 = 24 * 32, I6 = 2 * 16 * 32, I7 = 2 * 16 * 64;
    if (PART == 0) for (int r = gw; r < I6; r += NGW) { const int l = r / 512, q = r % 512; transpose_item<0>(w_mkv + (size_t)l * DM * 1024, 1024, (bf16*)(ws + WS_WMKV), DM, l * 1024, 0, nullptr, scr, q / 32, q % 32, lane); }
    constexpr int NIT = I1 + I2 + I3 + I4 + I5 + I7;
    if (PART == 1) for (int it = gw; it < NIT; it += NGW) {
        int r = it;
        if (r < I1) { transpose_item<0>(w_in, MIXW, (bf16*)(ws + WS_WIN0), DM, 0, 0, g_mix, scr, r / 48, r % 48, lane); continue; } r -= I1;
        if (r < I2) { transpose_item<1>(w_in + (size_t)DM * MIXW, MIXW, (bf16*)(ws + WS_WC4), DM, 2048, 0, g_mix + DM, scr, r / 48, r % 48, lane); continue; } r -= I2;
        if (r < I3) { transpose_item<1>(w_kv, 2048, (bf16*)(ws + WS_WC4), DM, 0, 0, g_kv, scr, r / 64, r % 64, lane); continue; } r -= I3;
        if (r < I4) { transpose_item<0>(w_out + (size_t)1024 * DM, DM, (bf16*)(ws + WS_WC0), MIXW, 0, 1024, nullptr, scr, r / 32, r % 32, lane); continue; } r -= I4;
        if (r < I5) { transpose_item<0>(w_out + (size_t)MIXW * DM, DM, (bf16*)(ws + WS_WOUT1), MIXW, 0, 0, nullptr, scr, r / 32, r % 32, lane); continue; } r -= I5;
        { const int l = r / 1024, q = r % 1024; transpose_item<0>(wq + (size_t)l * DM * 2048, 2048, (bf16*)(ws + (l ? WS_WQ1 : WS_WQ0)), DM, 0, 0, g_ffn + l * DM, scr, q / 64, q % 64, lane); }
    }
    if (PART == 1) for (int it = gw; it < 2048; it += NGW) {
        const int itu = __builtin_amdgcn_readfirstlane(it); const int g = itu >> 9, cg8 = (itu >> 4) & 31, nch = itu & 15; const int n = nch * 64 + lane;
        float acc[8];
#pragma unroll
        for (int i = 0; i < 8; ++i) acc[i] = 0.f;
        const float* pw = pool_w + ((size_t)g * 256 + cg8 * 8) * 256;
        float cfA[8], cfB[8], wvA[64], wvB[64];
        auto ldchunk = [&](int k, float (&cf)[8], float (&wv)[64]) { const float sc = pool_sc[g * 256 + k * 64 + lane];
#pragma unroll
            for (int i = 0; i < 8; ++i) cf[i] = pw[i * 256 + k * 64 + lane] * sc;
#pragma unroll
            for (int l = 0; l < 64; ++l) wv[l] = w_out[(size_t)(g * 256 + k * 64 + l) * DM + n]; };
        auto fmchunk = [&](const float (&cf)[8], const float (&wv)[64]) {
#pragma unroll
            for (int l = 0; l < 64; ++l) {
#pragma unroll
                for (int i = 0; i < 8; ++i) acc[i] = fmaf(__builtin_bit_cast(float, __builtin_amdgcn_readlane(__builtin_bit_cast(int, cf[i]), l)), wv[l], acc[i]); } };
        ldchunk(0, cfA, wvA); ldchunk(1, cfB, wvB); fmchunk(cfA, wvA);
        ldchunk(2, cfA, wvA); fmchunk(cfB, wvB);
        ldchunk(3, cfB, wvB); fmchunk(cfA, wvA);
        fmchunk(cfB, wvB);
        u32x4 o; o.x = pk2(acc[0], acc[1]); o.y = pk2(acc[2], acc[3]); o.z = pk2(acc[4], acc[5]); o.w = pk2(acc[6], acc[7]);
        *(u32x4*)((bf16*)(ws + WS_WC0) + (size_t)n * MIXW + g * 256 + cg8 * 8) = o;
    }
    {
        const size_t n8a = (size_t)2 * 16 * 128 * 128 / 8, n8b = (size_t)2048 * 1024 / 8;
        if (PART < 2) for (size_t i = (PART == 0 ? n8a : 0) + gt; i < (PART == 0 ? n8a + n8b : n8a); i += NGT) { const bool A = i < n8a; const size_t j = A ? i : i - n8a; const float* src = (A ? subk : mem) + j * 8; bf16* dst = (bf16*)(ws + (A ? WS_SUBK : WS_MEMB)) + j * 8;
            const f32x4 v0 = *(const f32x4*)src, v1 = *(const f32x4*)(src + 4); u32x4 o = {pk2(v0[0], v0[1]), pk2(v0[2], v0[3]), pk2(v1[0], v1[1]), pk2(v1[2], v1[3])}; *(u32x4*)dst = o; }
    }
    f32x4 v[4], n1[4], n2[4], gq[4]; int gcur = -1;
    auto ldrow = [&](int r, f32x4 (&d)[4]) { if (r < tb_hi) { const int tb = r / (2 * NEXP), rr = r % (2 * NEXP); const f32x4* src = (const f32x4*)((tb ? pv : pu) + (size_t)rr * DM) + lane;
#pragma unroll
        for (int i = 0; i < 4; ++i) d[i] = src[64 * i]; } };
    auto cvrow = [&](int r, const f32x4 (&vin)[4]) { const int tb = r / (2 * NEXP), rr = r % (2 * NEXP), l = rr / NEXP;
        f32x4 w4[4];
#pragma unroll
        for (int i = 0; i < 4; ++i) w4[i] = vin[i];
        if (!tb) { if (l != gcur) { const f32x4* gp = (const f32x4*)(g_ffn + l * DM) + lane; gcur = l;
#pragma unroll
                for (int i = 0; i < 4; ++i) gq[i] = gp[64 * i]; }
#pragma unroll
            for (int i = 0; i < 4; ++i) w4[i] *= gq[i]; }
        float am = 0.f;
#pragma unroll
        for (int i = 0; i < 4; ++i) am = fmaxf(fmaxf(fmaxf(am, fabsf(w4[i][0])), fmaxf(fabsf(w4[i][1]), fabsf(w4[i][2]))), fabsf(w4[i][3]));
#pragma unroll
        for (int o = 1; o < 64; o <<= 1) am = fmaxf(am, __shfl_xor(am, o));
        const int eb = (int)((__builtin_bit_cast(unsigned, am) >> 23) & 0xffu);
        const float sc = (eb < 16) ? 1.0f : __builtin_bit_cast(float, (unsigned)(127 + 7 + 127 - eb) << 23);
        const float isc = (eb < 16) ? 1.0f : __builtin_bit_cast(float, (unsigned)(eb - 7) << 23);
        unsigned* dst = (unsigned*)(ws + (tb ? WS_VB : WS_UB) + (size_t)rr * DM) + lane;
#pragma unroll
        for (int i = 0; i < 4; ++i) { int w = __builtin_amdgcn_cvt_pk_fp8_f32(w4[i][0] * sc, w4[i][1] * sc, 0, false); w = __builtin_amdgcn_cvt_pk_fp8_f32(w4[i][2] * sc, w4[i][3] * sc, w, true); dst[64 * i] = (unsigned)w; }
        if (lane == 0) ((float*)(ws + (tb ? WS_VSC : WS_USC)))[rr] = isc; };
    if (PART == 2) { const int r0 = tb_lo + F.wave; ldrow(r0, v); ldrow(r0 + NWAVES, n1);
        for (int r = r0; r < tb_hi; r += 3 * NWAVES) {
            ldrow(r + 2 * NWAVES, n2); cvrow(r, v);
            if (r + NWAVES < tb_hi) { ldrow(r + 3 * NWAVES, v); cvrow(r + NWAVES, n1); }
            if (r + 2 * NWAVES < tb_hi) { ldrow(r + 4 * NWAVES, n1); cvrow(r + 2 * NWAVES, n2); } } }
    if (PART == 2) for (int i = gt; i < SEQ * 64; i += NGT) { const int pos = i >> 6, fi = i & 63; const float inv = exp2f(-(float)fi * 0.20762050593046015f);
        float sn, cs_; sincosf((float)pos * inv, &sn, &cs_); f32x2 cs = {cs_, sn}; *(f32x2*)((float*)(ws + WS_ROPE) + (size_t)i * 2) = cs; }
    auto ldx = [&](int t, f32x4 (&d)[4]) { if (t < T) { const f32x4* xr = (const f32x4*)(x + (size_t)t * DM) + lane;
#pragma unroll
        for (int j = 0; j < 4; ++j) d[j] = xr[64 * j]; } };
    auto cvx = [&](int t, const f32x4 (&vin)[4]) { float s_ = 0.f;
#pragma unroll
        for (int j = 0; j < 4; ++j) s_ += (vin[j][0] * vin[j][0] + vin[j][1] * vin[j][1]) + (vin[j][2] * vin[j][2] + vin[j][3] * vin[j][3]);
        s_ = wave_sum(s_);
        u32x2* o8 = (u32x2*)((bf16*)(ws + WS_XB) + (size_t)t * DM) + lane;
#pragma unroll
        for (int j = 0; j < 4; ++j) { u32x2 w = {pk2(vin[j][0], vin[j][1]), pk2(vin[j][2], vin[j][3])}; o8[64 * j] = w; }
        if (lane == 0) ((float*)(ws + WS_RSTD0))[t] = 1.0f / sqrtf(s_ * (1.0f / DM) + EPS); };
    if (PART == 2) { ldx(gw, v); ldx(gw + NGW, n1);
        for (int t = gw; t < T; t += 3 * NGW) {
            ldx(t + 2 * NGW, n2); cvx(t, v);
            if (t + NGW < T) { ldx(t + 3 * NGW, v); cvx(t + NGW, n1); }
            if (t + 2 * NGW < T) { ldx(t + 4 * NGW, n1); cvx(t + 2 * NGW, n2); } } }
}

template <int W, int NT> __device__ __forceinline__ void pool_item(const bf16* pm, bf16* A2, int t0, int c0) {
    const int s0 = t0 & (SEQ - 1);
    u32x4 rows[W - 1 + NT];
#pragma unroll
    for (int i = 0; i < W - 1; ++i) { const u32x4 z = {0u, 0u, 0u, 0u}; rows[i] = z; if (s0 - (W - 1) + i >= 0) rows[i] = *(const u32x4*)(pm + (size_t)(t0 - (W - 1) + i) * DM + c0); }
#pragma unroll
    for (int k = 0; k < NT; ++k) rows[W - 1 + k] = *(const u32x4*)(pm + (size_t)(t0 + k) * DM + c0);
    float sum[8];
#pragma unroll
    for (int i = 0; i < 8; ++i) sum[i] = 0.f;
#pragma unroll
    for (int i = 0; i < W - 1; ++i) { const u32x4 v = rows[i];
        sum[0] += bflo(v.x); sum[1] += bfhi(v.x); sum[2] += bflo(v.y); sum[3] += bfhi(v.y); sum[4] += bflo(v.z); sum[5] += bfhi(v.z); sum[6] += bflo(v.w); sum[7] += bfhi(v.w); }
#pragma unroll
    for (int k = 0; k < NT; ++k) { const u32x4 v = rows[W - 1 + k];
        float xv[8] = {bflo(v.x), bfhi(v.x), bflo(v.y), bfhi(v.y), bflo(v.z), bfhi(v.z), bflo(v.w), bfhi(v.w)};
#pragma unroll
        for (int i = 0; i < 8; ++i) sum[i] += xv[i];
        const int s = s0 + k; const float inv = 1.0f / (float)((s + 1) < W ? (s + 1) : W);
        u32x4 o = {pk2(sum[0] * inv - xv[0], sum[1] * inv - xv[1]), pk2(sum[2] * inv - xv[2], sum[3] * inv - xv[3]), pk2(sum[4] * inv - xv[4], sum[5] * inv - xv[5]), pk2(sum[6] * inv - xv[6], sum[7] * inv - xv[7])};
        *(u32x4*)(A2 + (size_t)(t0 + k) * MIXW + c0) = o;
        const u32x4 q = rows[k];
        sum[0] -= bflo(q.x); sum[1] -= bfhi(q.x); sum[2] -= bflo(q.y); sum[3] -= bfhi(q.y); sum[4] -= bflo(q.z); sum[5] -= bfhi(q.z); sum[6] -= bflo(q.w); sum[7] -= bfhi(q.w); }
}
__device__ __forceinline__ void pool_diff(const Args& a, Frame& F) {
    const bf16* pm = (const bf16*)(a.ws + WS_P0MAIN); bf16* A2 = (bf16*)(a.ws + WS_A2);
    const int lane = fresh_tid() & 63, gw = F.vcu * NWAVES + F.wave, NGW = F.G * NWAVES;
    for (int wv = gw; wv < (T / 16) * 128 / 64; wv += NGW) {
        const int g = __builtin_amdgcn_readfirstlane(wv) & 3, tg = (wv >> 2) * 2 + (lane >> 5), t0 = tg * 16, c0 = (g * 32 + (lane & 31)) * 8;
        if (g == 0) pool_item<2, 16>(pm, A2, t0, c0); else if (g == 1) pool_item<4, 16>(pm, A2, t0, c0); else if (g == 2) pool_item<8, 16>(pm, A2, t0, c0);
        else { pool_item<16, 8>(pm, A2, t0, c0); pool_item<16, 8>(pm, A2, t0 + 8, c0); }
    }
}

__device__ __forceinline__ void mem_attn(const Args& a, Frame& F, bf16* Abuf, int layer, bool dry = false) {
    const bf16* MKV = (const bf16*)(a.ws + WS_MEMKV);
    for (int U = F.vcu; U < 512; U += F.G) { const int b = U >> 6, h = (U >> 4) & 3, qt = U & 15;
        bf16* Q = Abuf + ((size_t)b * SEQ + qt * 256) * MIXW + 1024 + h * 128;
        const bf16* K = MKV + (size_t)b * MEMT * 2048 + layer * 1024 + h * 128;
        att::attn_unit<MIXW, 2048, false, ATT_SD_MEM>(Q, K, K + 512, dry ? (bf16*)(a.ws + WS_EXP) : Q, 0, nullptr, F.ldsg); }
}

__device__ __forceinline__ int ord_enc(float x) { const int b = __builtin_bit_cast(int, x); return b ^ ((b >> 31) & 0x7fffffff); }
__device__ __forceinline__ float ord_dec(int k) { return __builtin_bit_cast(float, k ^ ((k >> 31) & 0x7fffffff)); }
template <int N> __device__ __forceinline__ void bitonic_desc(int (&a)[N]) {
#pragma unroll
    for (int k = 2; k <= N; k <<= 1)
#pragma unroll
        for (int j = k >> 1; j > 0; j >>= 1)
#pragma unroll
            for (int i = 0; i < N; ++i) { const int l = i ^ j; if (l > i) { const bool desc = ((i & k) == 0) || (k == N);
                const int hi = max(a[i], a[l]), lo = min(a[i], a[l]); a[i] = desc ? hi : lo; a[l] = desc ? lo : hi; } }
}
__device__ __forceinline__ int kmax(int x, int y) { int r; asm("v_max_f32 %0, %1, %2" : "=v"(r) : "v"(x), "v"(y)); return r; }
__device__ __forceinline__ int kmin(int x, int y) { int r; asm("v_min_f32 %0, %1, %2" : "=v"(r) : "v"(x), "v"(y)); return r; }
__device__ __forceinline__ void ksettle(int (&a)[16]) {
    asm volatile("s_nop 3" : "+v"(a[0]), "+v"(a[1]), "+v"(a[2]), "+v"(a[3]), "+v"(a[4]), "+v"(a[5]), "+v"(a[6]), "+v"(a[7]));
    asm volatile("s_nop 3" : "+v"(a[8]), "+v"(a[9]), "+v"(a[10]), "+v"(a[11]), "+v"(a[12]), "+v"(a[13]), "+v"(a[14]), "+v"(a[15]));
}
__device__ __forceinline__ void sort16_desc(int (&a)[16]) {
#define CE_(i, j) { const int hi_ = kmax(a[i], a[j]), lo_ = kmin(a[i], a[j]); a[i] = hi_; a[j] = lo_; }
    CE_(0, 13) CE_(1, 12) CE_(2, 15) CE_(3, 14) CE_(4, 8) CE_(5, 6) CE_(7, 11) CE_(9, 10)
    CE_(0, 5) CE_(1, 7) CE_(2, 9) CE_(3, 4) CE_(6, 13) CE_(8, 14) CE_(10, 15) CE_(11, 12)
    CE_(0, 1) CE_(2, 3) CE_(4, 5) CE_(6, 8) CE_(7, 9) CE_(10, 11) CE_(12, 13) CE_(14, 15)
    CE_(0, 2) CE_(1, 3) CE_(4, 10) CE_(5, 11) CE_(6, 7) CE_(8, 9) CE_(12, 14) CE_(13, 15)
    CE_(1, 2) CE_(3, 12) CE_(4, 6) CE_(5, 7) CE_(8, 10) CE_(9, 11) CE_(13, 14)
    CE_(1, 4) CE_(2, 6) CE_(5, 8) CE_(7, 10) CE_(9, 13) CE_(11, 14)
    CE_(2, 4) CE_(3, 6) CE_(9, 12) CE_(11, 13)
    CE_(3, 5) CE_(6, 8) CE_(7, 9) CE_(10, 12)
    CE_(3, 4) CE_(5, 6) CE_(7, 8) CE_(9, 10) CE_(11, 12)
    CE_(6, 7) CE_(8, 9)
#undef CE_
}
__device__ __forceinline__ void merge16(int (&a)[16], const int (&b)[16]) {
#pragma unroll
    for (int i = 0; i < 16; ++i) a[i] = kmax(a[i], b[15 - i]);
#pragma unroll
    for (int j = 8; j > 0; j >>= 1)
#pragma unroll
        for (int i = 0; i < 16; ++i) { const int l = i ^ j; if (l > i) { const int hi = kmax(a[i], a[l]), lo = kmin(a[i], a[l]); a[i] = hi; a[l] = lo; } }
}
constexpr int cand_i(int s) { int c = 0; for (int a = 0; a < 16; ++a) for (int b = 0; b < 16; ++b) { if ((a + 1) * (b + 1) > 16) continue; if (c == s) return a; ++c; } return 0; }
constexpr int cand_j(int s) { int c = 0; for (int a = 0; a < 16; ++a) for (int b = 0; b < 16; ++b) { if ((a + 1) * (b + 1) > 16) continue; if (c == s) return b; ++c; } return 0; }
constexpr int cand_slot(int i, int j) { int s = 0; for (int a = 0; a < 16; ++a) for (int b = 0; b < 16; ++b) { if ((a + 1) * (b + 1) > 16) continue; if (a == i && b == j) return s; ++s; } return -1; }

__device__ __forceinline__ void peer_topk(const Args& a, Frame& F, int layer) {
    const bf16* PQ = (const bf16*)(a.ws + WS_PQ); const bf16* SUBK = (const bf16*)(a.ws + WS_SUBK) + (size_t)layer * 16 * 128 * 128;
    unsigned short* EXPo = (unsigned short*)(a.ws + WS_EXP); float* GATEo = (float*)(a.ws + WS_GATE);
    const int tid = fresh_tid(), lane = tid & 63, wid = F.wave, r32 = lane & 31, hi = lane >> 5;
    const int h = F.vcu & 7;
    int ka[4];
#pragma unroll
    for (int i = 0; i < 4; ++i) ka[i] = r32 * 256 + (((2 * i + hi) ^ (r32 & 7)) << 4);
    char* Ks = F.ldsg;
    LAS unsigned char* ib = F.lds + 65536 + tid * 36;
    for (int i = tid; i < 2 * 128 * 16; i += NTHR) { const int row = i >> 4, ch = i & 15; const u32x4 v = *(const u32x4*)(SUBK + ((size_t)h * 256 + row) * 128 + ch * 8);
        *(u32x4*)(Ks + (row >> 7) * 32768 + KSWZ(row & 127, ch * 16)) = v; }
    __syncthreads();
    const int tt0 = F.vcu >> 3, tts = F.G >> 3;
    bf16x8 qn[8];
    { const bf16* qp = PQ + (size_t)(tt0 * 256 + wid * 32 + r32) * 2048 + h * 256 + hi * 8;
#pragma unroll
      for (int d0 = 0; d0 < 8; ++d0) qn[d0] = *reinterpret_cast<const bf16x8*>(qp + d0 * 16); }
    for (int tt = tt0; tt < T / 256; tt += tts) {
        const int t = tt * 256 + wid * 32 + r32;
        int top[2][16];
#pragma unroll
        for (int p = 0; p < 2; ++p) {
            bf16x8 qr[8];
#pragma unroll
            for (int d0 = 0; d0 < 8; ++d0) qr[d0] = qn[d0];
            { const int ttn = (p == 0) ? tt : ((tt + tts < T / 256) ? tt + tts : tt);
              const bf16* qp = PQ + (size_t)(ttn * 256 + wid * 32 + r32) * 2048 + h * 256 + (p ^ 1) * 128 + hi * 8;
#pragma unroll
              for (int d0 = 0; d0 < 8; ++d0) qn[d0] = *reinterpret_cast<const bf16x8*>(qp + d0 * 16); }
            int cur[16];
#pragma unroll
            for (int kt = 0; kt < 4; ++kt) { f32x16 sacc; att::qkt1(sacc, Ks + p * 32768 + kt * 32 * 256, qr, ka);
                int grp[16];
#pragma unroll
                for (int r = 0; r < 16; ++r) { const float sv_ = sacc[r]; grp[r] = (__float_as_int(sv_) & ~0x7F) | (kt * 32 + (r & 3) + 8 * (r >> 2) + 4 * hi); }
                sort16_desc(grp);
                if (kt == 0) {
#pragma unroll
                    for (int r = 0; r < 16; ++r) cur[r] = grp[r];
                } else merge16(cur, grp); }
            int oth[16]; ksettle(cur);
#pragma unroll
            for (int r = 0; r < 16; ++r) { auto rr = __builtin_amdgcn_permlane32_swap((unsigned)cur[r], (unsigned)cur[r], false, false); cur[r] = (int)rr[0]; oth[r] = (int)rr[1]; }
            ksettle(cur); ksettle(oth); merge16(cur, oth);
#pragma unroll
            for (int r = 0; r < 16; ++r) top[p][r] = cur[r];
        }
        float v0[16], v1[16];
#pragma unroll
        for (int r = 0; r < 16; ++r) { v0[r] = __builtin_bit_cast(float, top[0][r] & ~0x7F); v1[r] = __builtin_bit_cast(float, top[1][r] & ~0x7F); }
#pragma unroll
        for (int q = 0; q < 4; ++q) { *(LAS unsigned*)(ib + q * 4) = (top[0][4 * q] & 0x7F) | ((top[0][4 * q + 1] & 0x7F) << 8) | ((top[0][4 * q + 2] & 0x7F) << 16) | ((top[0][4 * q + 3] & 0x7F) << 24);
            *(LAS unsigned*)(ib + 16 + q * 4) = (top[1][4 * q] & 0x7F) | ((top[1][4 * q + 1] & 0x7F) << 8) | ((top[1][4 * q + 2] & 0x7F) << 16) | ((top[1][4 * q + 3] & 0x7F) << 24); }
        int best[16], g1[16];
#pragma unroll
        for (int r = 0; r < 32; ++r) { int key = (int)0xFF800000;
            if (r < 25) {
                const int iA = cand_i(r), jA = cand_j(r), iB = cand_i(25 + r), jB = cand_j(25 + r);
                const float sA = v0[iA] + v1[jA], sB = v0[iB] + v1[jB]; const int code = hi ? (iB * 16 + jB) : (iA * 16 + jA);
                key = (__builtin_bit_cast(int, hi ? sB : sA) & ~0xFF) | code; }
            if (r < 16) best[r] = key; else g1[r - 16] = key; }
        sort16_desc(best); sort16_desc(g1); merge16(best, g1); ksettle(best);
#pragma unroll
        for (int r = 0; r < 16; ++r) { auto rr = __builtin_amdgcn_permlane32_swap((unsigned)best[r], (unsigned)best[r], false, false); best[r] = (int)rr[0]; g1[r] = (int)rr[1]; }
        ksettle(best); ksettle(g1); merge16(best, g1);
        float cv[16], ex[16]; float sum = 0.f;
#pragma unroll
        for (int r = 0; r < 16; ++r) cv[r] = __builtin_bit_cast(float, best[r] & ~0xFF);
#pragma unroll
        for (int r = 0; r < 16; ++r) { ex[r] = __builtin_amdgcn_exp2f((cv[r] - cv[0]) * 1.4426950408889634f); sum += ex[r]; }
        const float rs = 1.0f / sum;
        LDS_WAIT();
        unsigned ee[16];
#pragma unroll
        for (int r = 0; r < 16; ++r) { const int code = best[r] & 0xFF; const unsigned e1 = ib[code >> 4], e2 = ib[16 + (code & 15)]; ee[r] = e1 * 128u + e2; }
        const size_t ob = ((size_t)t * 8 + h) * 16;
        if (hi == 0) { u32x4 w0 = {ee[0] | (ee[1] << 16), ee[2] | (ee[3] << 16), ee[4] | (ee[5] << 16), ee[6] | (ee[7] << 16)}, w1 = {ee[8] | (ee[9] << 16), ee[10] | (ee[11] << 16), ee[12] | (ee[13] << 16), ee[14] | (ee[15] << 16)};
            *(u32x4*)(EXPo + ob) = w0; *(u32x4*)(EXPo + ob + 8) = w1; }
        else {
#pragma unroll
            for (int q = 0; q < 4; ++q) { f32x4 gq = {ex[4 * q] * rs, ex[4 * q + 1] * rs, ex[4 * q + 2] * rs, ex[4 * q + 3] * rs}; *(f32x4*)(GATEo + ob + 4 * q) = gq; } }
        LDS_WAIT();
    }
    __syncthreads();
}

__device__ __forceinline__ float gelu_exact(float v) {
    const float av = fabsf(v), t = __builtin_amdgcn_rcpf(fmaf(av, 0.2316418882f, 1.0f));
    float q = fmaf(t, 0.5307027145f, -0.7265760135f); q = fmaf(q, t, 0.7107068705f); q = fmaf(q, t, -0.142248368f); q = fmaf(q, t, 0.127414796f); q = q * t;
    const float e = __builtin_amdgcn_exp2f(v * v * -0.72134752044f), m = v * (q * e);
    return v < 0.f ? m : v - m;
}
__device__ __forceinline__ float dot16_fp8(const u32x4 u, const f32x2 (&x2)[8]) {
    f32x2 d = {0.f, 0.f};
#pragma unroll
    for (int i = 0; i < 4; ++i) { const f32x2 a = __builtin_amdgcn_cvt_pk_f32_fp8((int)u[i], false), b = __builtin_amdgcn_cvt_pk_f32_fp8((int)u[i], true);
        d = __builtin_elementwise_fma(a, x2[2 * i], d); d = __builtin_elementwise_fma(b, x2[2 * i + 1], d); }
    return d.x + d.y;
}
__device__ __forceinline__ void axpy16_fp8(f32x2 (&o2)[8], const float h, const u32x4 v) {
    const f32x2 h2 = {h, h};
#pragma unroll
    for (int i = 0; i < 4; ++i) { const f32x2 a = __builtin_amdgcn_cvt_pk_f32_fp8((int)v[i], false), b = __builtin_amdgcn_cvt_pk_f32_fp8((int)v[i], true);
        o2[2 * i] = __builtin_elementwise_fma(a, h2, o2[2 * i]); o2[2 * i + 1] = __builtin_elementwise_fma(b, h2, o2[2 * i + 1]); }
}
__device__ __forceinline__ float reduce8(const float (&p)[8], int lane) {
    float s[4];
#pragma unroll
    for (int i = 0; i < 4; ++i) { auto rr = __builtin_amdgcn_permlane32_swap(__float_as_uint(p[2 * i]), __float_as_uint(p[2 * i + 1]), false, false); s[i] = __uint_as_float(rr[0]) + __uint_as_float(rr[1]); }
    float t[2];
#pragma unroll
    for (int i = 0; i < 2; ++i) { const bool hi = lane & 16; const float u = hi ? s[2 * i + 1] : s[2 * i], o = hi ? s[2 * i] : s[2 * i + 1]; t[i] = u + shx_f<16>(o); }
    const bool h8 = lane & 8; const float u = h8 ? t[1] : t[0], o = h8 ? t[0] : t[1]; float w = u + dpp_f<0x128>(o);
    w += dpp_f<0x141>(w); w += dpp_f<0x1B>(w); w += dpp_f<0xB1>(w);
    return w;
}
constexpr int qgrp(int q) { return 2 * ((q & 3) == 1 ? 2 : (q & 3) == 2 ? 1 : (q & 3)) + (q >> 2); }

template <int K, int J> __device__ __forceinline__ void sort128_stage(unsigned& lo, unsigned& hi, int lane) {
    const unsigned plo = shx_u<J>(lo), phi = shx_u<J>(hi);
    const bool up_lo = (K >= 64) ? true : ((lane & K) == 0), up_hi = (K == 64) ? false : up_lo, lower = (lane & J) == 0;
    lo = (lower == up_lo) ? min(lo, plo) : max(lo, plo); hi = (lower == up_hi) ? min(hi, phi) : max(hi, phi);
    if constexpr (J > 1) sort128_stage<K, J / 2>(lo, hi, lane);
}
template <int K> __device__ __forceinline__ void sort128_level(unsigned& lo, unsigned& hi, int lane) { sort128_stage<K, K / 2>(lo, hi, lane); if constexpr (K < 64) sort128_level<K * 2>(lo, hi, lane); }
__device__ __forceinline__ void sort128(unsigned& lo, unsigned& hi, int lane) {
    sort128_level<2>(lo, hi, lane);
    { const unsigned a = min(lo, hi), b = max(lo, hi); lo = a; hi = b; }
    sort128_stage<128, 32>(lo, hi, lane);
}
template <bool FINAL, bool DRY = false>
__device__ __forceinline__ void peer_gather(const Args& a, Frame& F, int layer) {
    const unsigned char* UB = a.ws + WS_UB + (size_t)layer * NEXP * DM; const unsigned char* VB = a.ws + WS_VB + (size_t)layer * NEXP * DM;
    const float* USC = (const float*)(a.ws + WS_USC) + layer * NEXP; const float* VSC = (const float*)(a.ws + WS_VSC) + layer * NEXP;
    const unsigned short* EXPi = (const unsigned short*)(a.ws + WS_EXP); const float* GATEi = (const float*)(a.ws + WS_GATE);
    float* X = a.out; bf16* XB = (bf16*)(a.ws + WS_XB); float* RSTD2 = (float*)(a.ws + WS_RSTD2); const float* gfin = a.in[15];
    const int lane = fresh_tid() & 63, gw = F.vcu * NWAVES + F.wave, NGW = F.G * NWAVES;
    const unsigned lane16 = (unsigned)lane * 16u;
    const int grp = lane >> 3; const int jperm = 8 * (lane & 7) + ((grp >> 1) == 1 ? 2 : (grp >> 1) == 2 ? 1 : (grp >> 1)) + 4 * (grp & 1);
    for (int t = gw; t < T; t += NGW) {
        __syncthreads();
        bf16* xbr = XB + (size_t)t * DM + 16 * lane;
        float x[16];
        { const u32x4 v0 = *(const u32x4*)xbr, v1 = *(const u32x4*)(xbr + 8);
          x[0] = bflo(v0.x); x[1] = bfhi(v0.x); x[2] = bflo(v0.y); x[3] = bfhi(v0.y); x[4] = bflo(v0.z); x[5] = bfhi(v0.z); x[6] = bflo(v0.w); x[7] = bfhi(v0.w);
          x[8] = bflo(v1.x); x[9] = bfhi(v1.x); x[10] = bflo(v1.y); x[11] = bfhi(v1.y); x[12] = bflo(v1.z); x[13] = bfhi(v1.z); x[14] = bflo(v1.w); x[15] = bfhi(v1.w); }
        f32x2 x2[8];
#pragma unroll
        for (int i = 0; i < 8; ++i) { x2[i].x = x[2 * i]; x2[i].y = x[2 * i + 1]; }
        float ss = 0.f;
#pragma unroll
        for (int i = 0; i < 16; ++i) ss = fmaf(x[i], x[i], ss);
        ss = wave_sum(ss);
        const float rstd = 1.0f / sqrtf(ss * (1.0f / DM) + EPS);
        const unsigned short* et = EXPi + (size_t)t * 128; const float* gt_ = GATEi + (size_t)t * 128;
        unsigned k_lo = ((unsigned)et[lane] << 7) | (unsigned)lane, k_hi = ((unsigned)et[64 + lane] << 7) | (unsigned)(64 + lane);
        sort128(k_lo, k_hi, lane);
        const int e_lo = (int)(k_lo >> 7), e_hi = (int)(k_hi >> 7);
        const float gs_lo = gt_[k_lo & 127u], gs_hi = gt_[k_hi & 127u];
        const int ep_lo = __shfl(e_lo, jperm), ep_hi = __shfl(e_hi, jperm);
        const float gl = __shfl(gs_lo, jperm) * VSC[ep_lo], gh = __shfl(gs_hi, jperm) * VSC[ep_hi];
        const float ul = USC[ep_lo] * rstd, uh = USC[ep_hi] * rstd;
        float a_lo = 0.f, a_hi = 0.f;
        u32x4 b0[8], b1[8], b2[8];
#define ROWLD(dst, tab, e_) dst = *(const u32x4*)((tab) + (size_t)(e_) * DM + lane16)
#define ULOAD(buf, B) do { const int ev_ = ((B) >> 3) ? e_hi : e_lo; _Pragma("unroll") for (int q = 0; q < 8; ++q) { const int e = __builtin_amdgcn_readlane(ev_, 8 * ((B) & 7) + q); ROWLD(buf[q], UB, e); } } while (0)
#define VLOAD(buf, B) do { const int ev_ = ((B) >> 3) ? e_hi : e_lo; _Pragma("unroll") for (int q = 0; q < 8; ++q) { const int e = __builtin_amdgcn_readlane(ev_, 8 * ((B) & 7) + q); ROWLD(buf[q], VB, e); } } while (0)
#define UCOMP(buf, B) do { float p[8]; _Pragma("unroll") for (int q = 0; q < 8; ++q) p[q] = dot16_fp8(buf[q], x2); const float w = reduce8(p, lane); const bool mine = (lane & 7) == ((B) & 7); \
        if ((B) >> 3) a_hi = mine ? w : a_hi; else a_lo = mine ? w : a_lo; } while (0)
        ULOAD(b0, 0); ULOAD(b1, 1);
#pragma unroll 1
        for (int B = 0; B < 12; B += 3) {
            if (B > 0) __syncthreads();
            ULOAD(b2, B + 2); UCOMP(b0, B);
            ULOAD(b0, B + 3); UCOMP(b1, B + 1);
            ULOAD(b1, B + 4); UCOMP(b2, B + 2); }
        ULOAD(b2, 14); UCOMP(b0, 12);
        ULOAD(b0, 15); UCOMP(b1, 13);
        VLOAD(b1, 0);  UCOMP(b2, 14);
        VLOAD(b2, 1);  UCOMP(b0, 15);
#undef ULOAD
#undef UCOMP
        __syncthreads();
        const float h_lo = gelu_exact(a_lo * ul) * gl, h_hi = gelu_exact(a_hi * uh) * gh;
        f32x2 o2[8];
#pragma unroll
        for (int i = 0; i < 8; ++i) o2[i] = (f32x2){0.f, 0.f};
#define VCOMP(buf, B) do { const int hv_ = __builtin_bit_cast(int, ((B) >> 3) ? h_hi : h_lo); _Pragma("unroll") for (int q = 0; q < 8; ++q) { const float hq = __builtin_bit_cast(float, __builtin_amdgcn_readlane(hv_, 8 * qgrp(q) + ((B) & 7))); axpy16_fp8(o2, hq, buf[q]); } } while (0)
#pragma unroll 1
        for (int B = 0; B < 12; B += 3) {
            if (B > 0) __syncthreads();
            VLOAD(b0, B + 2); VCOMP(b1, B);
            VLOAD(b1, B + 3); VCOMP(b2, B + 1);
            VLOAD(b2, B + 4); VCOMP(b0, B + 2); }
        VLOAD(b0, 14); VCOMP(b1, 12);
        VLOAD(b1, 15); VCOMP(b2, 13);
        VCOMP(b0, 14);
        VCOMP(b1, 15);
#undef VLOAD
#undef VCOMP
#undef ROWLD
        float o[16]; float s2 = 0.f;
#pragma unroll
        for (int i = 0; i < 8; ++i) { o[2 * i] = o2[i].x; o[2 * i + 1] = o2[i].y; }
        { const u32x4 v0 = *(const u32x4*)xbr, v1 = *(const u32x4*)(xbr + 8);
          o[0] += bflo(v0.x); o[1] += bfhi(v0.x); o[2] += bflo(v0.y); o[3] += bfhi(v0.y); o[4] += bflo(v0.z); o[5] += bfhi(v0.z); o[6] += bflo(v0.w); o[7] += bfhi(v0.w);
          o[8] += bflo(v1.x); o[9] += bfhi(v1.x); o[10] += bflo(v1.y); o[11] += bfhi(v1.y); o[12] += bflo(v1.z); o[13] += bfhi(v1.z); o[14] += bflo(v1.w); o[15] += bfhi(v1.w); }
#pragma unroll
        for (int i = 0; i < 16; ++i) s2 = fmaf(o[i], o[i], s2);
        s2 = wave_sum(s2);
        const float r2 = 1.0f / sqrtf(s2 * (1.0f / DM) + EPS);
        if constexpr (FINAL) {
            float* xw = (DRY ? (float*)(a.ws + WS_RB) : X) + (size_t)t * DM;
#pragma unroll
            for (int i = 0; i < 4; ++i) { const f32x4 g = *(const f32x4*)(gfin + 16 * lane + 4 * i); f32x4 y = {o[4 * i] * r2 * g[0], o[4 * i + 1] * r2 * g[1], o[4 * i + 2] * r2 * g[2], o[4 * i + 3] * r2 * g[3]}; *(f32x4*)(xw + 16 * lane + 4 * i) = y; }
        } else {
            bf16* xo = DRY ? (bf16*)(a.ws + WS_RB) + (size_t)t * DM + 16 * lane : xbr;
            u32x4 wa = {pk2(o[0], o[1]), pk2(o[2], o[3]), pk2(o[4], o[5]), pk2(o[6], o[7])}, wb = {pk2(o[8], o[9]), pk2(o[10], o[11]), pk2(o[12], o[13]), pk2(o[14], o[15])};
            *(u32x4*)xo = wa; *(u32x4*)(xo + 8) = wb;
            if (!DRY && lane == 0) RSTD2[t] = r2;
        }
    }
}

#define XB_TMO      128
#define XB_RDY      3456
#ifndef GM_SHARE
#define GM_SHARE 200
#endif
#define XB_XCNT(j)  (256  + 64 * (j))
#define XB_XSUB(j)  (1280 + 64 * (j))
#define XB_XGEN(j)  (2304 + 64 * (j))
#define XB_TOP      3328
#define XB_TOPGEN   3392
#define XCD_BAR_WORDS 3456
#define XB_SPIN_CAP (1u << 22)
__device__ __forceinline__ unsigned xb_ld(unsigned* p)              { return __hip_atomic_load(p, __ATOMIC_RELAXED, __HIP_MEMORY_SCOPE_AGENT); }
__device__ __forceinline__ unsigned xb_add(unsigned* p, unsigned v) { return __hip_atomic_fetch_add(p, v, __ATOMIC_RELAXED, __HIP_MEMORY_SCOPE_AGENT); }
__device__ __forceinline__ unsigned xb_xcc_id() { return (unsigned)__builtin_amdgcn_s_getreg((3 << 11) | 20) & 0xFu; }
#define XB_SPIN(cond, bar) do { unsigned _sp = 0; while (cond) { __builtin_amdgcn_s_sleep(1); \
    if ((++_sp & 255u) == 0u) { if (xb_ld(&(bar)[XB_TMO])) break; if (_sp > XB_SPIN_CAP) { atomicAdd(&(bar)[XB_TMO], 1u); break; } } } } while (0)
struct XcdBarrier { unsigned* bar; unsigned x; volatile LAS unsigned* st; };
__device__ __forceinline__ XcdBarrier xcd_barrier_post(unsigned* bar, volatile LAS unsigned* st) {
    XcdBarrier b; b.bar = bar; b.x = xb_xcc_id(); b.st = st;
    if (threadIdx.x == 0) (void)xb_add(&bar[XB_XCNT(b.x)], 1u);
    return b;
}
__device__ __forceinline__ void xcd_barrier_complete(unsigned* bar, unsigned x, unsigned& nloc, unsigned& nx) {
    const unsigned G = gridDim.x * gridDim.y * gridDim.z;
    unsigned sum, cnt, mine, sp = 0u;
    for (;;) {
        sum = 0u; cnt = 0u; mine = 0u;
#pragma unroll
        for (unsigned j = 0; j < 16; ++j) { const unsigned c = xb_ld(&bar[XB_XCNT(j)]); sum += c; cnt += (c > 0u) ? 1u : 0u; mine = (j == x) ? c : mine; }
        if (sum == G) break;
        __builtin_amdgcn_s_sleep(1);
        if ((++sp & 255u) == 0u) { if (xb_ld(&bar[XB_TMO])) break; if (sp > XB_SPIN_CAP) { atomicAdd(&bar[XB_TMO], 1u); break; } }
    }
    nloc = mine > 0u ? mine : 1u; nx = cnt > 0u ? cnt : 1u;
}
__device__ __forceinline__ void xcd_barrier(const XcdBarrier& b) {
    asm volatile("s_waitcnt vmcnt(0)" ::: "memory");
    __syncthreads();
    if (threadIdx.x == 0) {
        unsigned* bar = b.bar;
        __builtin_amdgcn_s_waitcnt(0);
        unsigned nloc = b.st[0], nx = b.st[1];
        if (nloc == 0u) { xcd_barrier_complete(bar, b.x, nloc, nx); b.st[0] = nloc; b.st[1] = nx; }
        const unsigned old = xb_add(&bar[XB_XSUB(b.x)], 1u);
        const unsigned gen = old / nloc;
        if (old + 1u == (gen + 1u) * nloc) {
            __builtin_amdgcn_fence(__ATOMIC_RELEASE, "agent");
            asm volatile("s_waitcnt vmcnt(0)" ::: "memory");
            const unsigned og = xb_add(&bar[XB_TOP], 1u);
            const unsigned tg = og / nx;
            if (og + 1u == (tg + 1u) * nx) xb_add(&bar[XB_TOPGEN], 1u);
            else XB_SPIN(xb_ld(&bar[XB_TOPGEN]) == tg, bar);
            __builtin_amdgcn_fence(__ATOMIC_ACQUIRE, "agent");
            xb_add(&bar[XB_XGEN(b.x)], 1u);
            asm volatile("s_waitcnt vmcnt(0)" ::: "memory");
        } else {
            XB_SPIN(xb_ld(&bar[XB_XGEN(b.x)]) == gen, bar);
            __builtin_amdgcn_fence(__ATOMIC_ACQUIRE, "agent");
            asm volatile("s_waitcnt vmcnt(0)" ::: "memory");
        }
    }
    __syncthreads();
}

__global__ void __launch_bounds__(NTHR, 2) yoco_fwd(Args args) {
    extern __shared__ __attribute__((aligned(16))) unsigned char lds_raw[];
    cg::grid_group grid = cg::this_grid();
    Frame F;
    F.lds = (LAS unsigned char*)lds_raw; F.ldsg = (char*)lds_raw;
    F.wave = __builtin_amdgcn_readfirstlane(threadIdx.x >> 6);
    F.G = gridDim.x; { const int bx = blockIdx.x; F.vcu = (F.G % 8 == 0) ? (bx % 8) * (F.G / 8) + bx / 8 : bx; }
    unsigned char* ws = args.ws;
    const int lo = args.ph_lo, hi = args.ph_hi;
    volatile LAS unsigned* bst = (volatile LAS unsigned*)(F.lds + 131072 + 320);
    if (threadIdx.x < 2) bst[threadIdx.x] = 0u;
    __syncthreads();
    XcdBarrier xbar; xbar.bar = (unsigned*)ws; xbar.x = 0; xbar.st = bst;
    if (hi - lo > 1) xbar = xcd_barrier_post((unsigned*)ws, bst);
#ifndef PH_MASK
#define PH_MASK 0x1fff
#endif
#define IN(k) (((PH_MASK >> (k)) & 1) && lo <= (k) && (k) < hi)
#define SEAM(k) do { if (IN(k) && IN((k) + 1)) { if ((k) == 0) grid.sync(); else xcd_barrier(xbar); } } while (0)
#define GSYNC() xcd_barrier(xbar)
#ifndef REP_MASK
#define REP_MASK 0
#endif
#define NREP(k) (((REP_MASK >> (k)) & 1) ? 2 : 1)
    typedef pg8::bf16_t pb;

    for (int rep_ = 0; rep_ < NREP(0); ++rep_) { if (rep_) GSYNC();
    if (IN(0)) {
        unsigned* rdy = (unsigned*)ws + XB_RDY + 64 * rep_; const int nb = F.G > 128 ? 64 : 0, bx = (int)blockIdx.x;
        const int den = (F.G - nb) * 1000 + nb * GM_SHARE, ra = (4 * NEXP * 1000 + den - 1) / den + 1, rb = ra * GM_SHARE / 1000;
        const int tlo = bx < nb ? bx * rb : nb * rb + (bx - nb) * ra, thi_ = tlo + (bx < nb ? rb : ra);
        const int tb_lo = tlo < 4 * NEXP ? tlo : 4 * NEXP, tb_hi = thi_ < 4 * NEXP ? thi_ : 4 * NEXP;
        phase0<0>(args, F, 0, 0);
        asm volatile("s_waitcnt vmcnt(0)" ::: "memory"); __syncthreads();
        if (threadIdx.x == 0) { __builtin_amdgcn_fence(__ATOMIC_RELEASE, "agent"); asm volatile("s_waitcnt vmcnt(0)" ::: "memory"); (void)xb_add(rdy, 1u); }
        phase0<1>(args, F, 0, 0);
        if (nb == 0 || bx < nb) {
            if (threadIdx.x == 0) { XB_SPIN(xb_ld(rdy) < (unsigned)F.G, (unsigned*)ws); __builtin_amdgcn_fence(__ATOMIC_ACQUIRE, "agent"); asm volatile("s_waitcnt vmcnt(0)" ::: "memory"); }
            __syncthreads();
            pg8::Gemm g{(const pb*)(ws + WS_MEMB), (const pb*)(ws + WS_WMKV), 2048, 2048, DM}; pg8::StaticOrder S; S.init(2048, 2048, F.G, (int)blockIdx.x);
            pg8::EpiRowBf16 E{(pb*)(ws + WS_MEMKV), 2048, (pb*)(ws + WS_MEMKV), 2048, 1 << 30, nullptr, nullptr};
            pg8::gemm_phase<pg8::EpiRowBf16, pg8::StaticOrder>(F.lds, g, S, E);
            __syncthreads();
        }
        phase0<2>(args, F, tb_lo, tb_hi);
    } } SEAM(0);

    for (int rep_ = 0; rep_ < NREP(1); ++rep_) { if (rep_) GSYNC();
    if (IN(1)) {
        { pg8::Gemm g{(const pb*)(ws + WS_XB), (const pb*)(ws + WS_WIN0), T, MIXW, DM}; pg8::StaticOrder S; S.init(T, MIXW, F.G, (int)blockIdx.x);
          pg8::EpiRowBf16 E{(pb*)(ws + WS_P0MAIN), DM, (pb*)(ws + WS_A2) + 1024, MIXW, 1024, (const float*)(ws + WS_RSTD0), nullptr};
          pg8::gemm_phase<pg8::EpiRowBf16, pg8::StaticOrder>(F.lds, g, S, E); }
    } } SEAM(1);

    if (IN(2)) { if (NREP(2) > 1) { pool_diff(args, F); mem_attn(args, F, (bf16*)(ws + WS_A2), 0, true); GSYNC(); }
        pool_diff(args, F); mem_attn(args, F, (bf16*)(ws + WS_A2), 0); } SEAM(2);

    for (int rep_ = 0; rep_ < NREP(3); ++rep_) { if (rep_) GSYNC();
    if (IN(3)) {
        pg8::Gemm g{(const pb*)(ws + WS_A2), (const pb*)(ws + WS_WC0), T, DM, MIXW}; pg8::StaticOrder S; S.init(T, DM, F.G, (int)blockIdx.x);
        pg8::EpiRes E{(pb*)(ws + WS_XB), (float*)(ws + WS_SSQ)};
        pg8::gemm_phase<pg8::EpiRes, pg8::StaticOrder>(F.lds, g, S, E);
    } } SEAM(3);

    for (int rep_ = 0; rep_ < NREP(4); ++rep_) { if (rep_) GSYNC();
    if (IN(4)) {
        pg8::Gemm g{(const pb*)(ws + WS_XB), (const pb*)(ws + WS_WQ0), T, 2048, DM}; pg8::StaticOrder S; S.init(T, 2048, F.G, (int)blockIdx.x);
        pg8::EpiRowBf16 E{(pb*)(ws + WS_PQ), 2048, (pb*)(ws + WS_PQ), 2048, 1 << 30, nullptr, (const float*)(ws + WS_SSQ)};
        pg8::gemm_phase<pg8::EpiRowBf16, pg8::StaticOrder>(F.lds, g, S, E);
    } } SEAM(4);

    for (int rep_ = 0; rep_ < NREP(5); ++rep_) { if (rep_) GSYNC();
    if (IN(5)) { peer_topk(args, F, 0); } } SEAM(5);
    if (IN(6)) {
#ifdef PROBE_PEER
        peer_gather<false, true>(args, F, 0); GSYNC();
#endif
        peer_gather<false>(args, F, 0); } SEAM(6);

    for (int rep_ = 0; rep_ < NREP(7); ++rep_) { if (rep_) GSYNC();
    if (IN(7)) {
        pg8::Gemm g{(const pb*)(ws + WS_XB), (const pb*)(ws + WS_WC4), T, 3584, DM}; pg8::StaticOrder S; S.init(T, 3584, F.G, (int)blockIdx.x);
        pg8::EpiKVQ E{(pb*)(ws + WS_KR), (pb*)(ws + WS_VV), (pb*)(ws + WS_A3), (float*)(ws + WS_KMP), (const float*)(ws + WS_RSTD2), (const float*)(ws + WS_ROPE)};
        pg8::gemm_phase<pg8::EpiKVQ, pg8::StaticOrder>(F.lds, g, S, E);
    } } SEAM(7);

    if (IN(8)) {
        bf16* A3 = (bf16*)(ws + WS_A3); const bf16* KR = (const bf16*)(ws + WS_KR); const bf16* VV = (const bf16*)(ws + WS_VV); const float* KMP = (const float*)(ws + WS_KMP);
        for (int rep_ = 0; rep_ < NREP(8); ++rep_) { const bool dry8 = (NREP(8) > 1) && rep_ == 0;
        for (int P = F.vcu; P < 512; P += F.G) { const int bh = P >> 3, p = P & 7, b = bh >> 3, h = bh & 7;
#pragma unroll 1
            for (int half = 0; half < 2; ++half) { const int j = half ? p : 15 - p;
                bf16* Q = A3 + ((size_t)b * SEQ + j * 256) * MIXW + h * 128;
                const bf16* K = KR + (size_t)bh * SEQ * 128; const bf16* V = VV + (size_t)bh * SEQ * 128;
                att::attn_unit<MIXW, 128, true, ATT_SD_MOBA>(Q, K, V, dry8 ? (bf16*)(ws + WS_XB) : Q, j, KMP + (size_t)b * 16 * 2048 + h * 128, F.ldsg); } }
        if (dry8) { mem_attn(args, F, A3, 1, true); GSYNC(); } }
        mem_attn(args, F, A3, 1);
    } SEAM(8);

    if (IN(9)) {
        pg8::Gemm g{(const pb*)(ws + WS_A3), (const pb*)(ws + WS_WOUT1), T, DM, MIXW}; pg8::StaticOrder S; S.init(T, DM, F.G, (int)blockIdx.x);
        pg8::EpiRes E{(pb*)(ws + WS_XB), (float*)(ws + WS_SSQ)};
        pg8::gemm_phase<pg8::EpiRes, pg8::StaticOrder>(F.lds, g, S, E);
    } SEAM(9);

    for (int rep_ = 0; rep_ < NREP(10); ++rep_) { if (rep_) GSYNC();
    if (IN(10)) {
        pg8::Gemm g{(const pb*)(ws + WS_XB), (const pb*)(ws + WS_WQ1), T, 2048, DM}; pg8::StaticOrder S; S.init(T, 2048, F.G, (int)blockIdx.x);
        pg8::EpiRowBf16 E{(pb*)(ws + WS_PQ), 2048, (pb*)(ws + WS_PQ), 2048, 1 << 30, nullptr, (const float*)(ws + WS_SSQ)};
        pg8::gemm_phase<pg8::EpiRowBf16, pg8::StaticOrder>(F.lds, g, S, E);
    } } SEAM(10);

    for (int rep_ = 0; rep_ < NREP(11); ++rep_) { if (rep_) GSYNC();
    if (IN(11)) { peer_topk(args, F, 1); } } SEAM(11);
    if (IN(12)) {
#ifdef PROBE_PEER
        peer_gather<true, true>(args, F, 1); GSYNC();
#endif
        peer_gather<true>(args, F, 1); }
#undef IN
#undef SEAM
}

extern "C" void kernel_launch(void* const* d_in, const int* in_sizes, int n_in, void* d_out, int out_size, void* d_ws, size_t ws_size, hipStream_t stream) {
    static int grid = 0;
    if (grid == 0) {
        if (n_in != 16 || out_size != T * DM || ws_size < WS_END) { fprintf(stderr, "kernel_launch: unexpected shapes: n_in %d out %d ws %zu (need %zu)\n", n_in, out_size, ws_size, (size_t)WS_END); grid = -1; return; }
        int dev = 0, cus = 0, per_cu = 0;
        if (hipGetDevice(&dev) != hipSuccess || hipDeviceGetAttribute(&cus, hipDeviceAttributeMultiprocessorCount, dev) != hipSuccess) { grid = -1; return; }
        if (hipFuncSetAttribute((const void*)yoco_fwd, hipFuncAttributeMaxDynamicSharedMemorySize, LDS_BYTES) != hipSuccess) { fprintf(stderr, "kernel_launch: hipFuncSetAttribute failed\n"); grid = -1; return; }
        if (hipOccupancyMaxActiveBlocksPerMultiprocessor(&per_cu, (const void*)yoco_fwd, NTHR, LDS_BYTES) != hipSuccess || per_cu < 1) { fprintf(stderr, "kernel_launch: occupancy query says %d\n", per_cu); per_cu = 1; }
        (void)hipGetLastError();
        grid = cus;
        fprintf(stderr, "kernel_launch: grid %d, per_cu %d, ws %zu\n", grid, per_cu, ws_size);
    }
    if (grid < 0) return;
    if (hipMemsetAsync(d_ws, 0, 16384, stream) != hipSuccess) { fprintf(stderr, "kernel_launch: memset failed\n"); return; }
    Args a{};
    for (int i = 0; i < 16; ++i) a.in[i] = (const float*)d_in[i];
    a.out = (float*)d_out; a.ws = (unsigned char*)d_ws;
#if MK_LAUNCHES == 1
    a.ph_lo = 0; a.ph_hi = 13;
    void* kargs[] = {&a};
    hipError_t e = hipLaunchCooperativeKernel((const void*)yoco_fwd, dim3(grid), dim3(NTHR), kargs, LDS_BYTES, stream);
    if (e != hipSuccess) fprintf(stderr, "kernel_launch: cooperative launch failed: %s (grid %d)\n", hipGetErrorString(e), grid);
#else
    for (int p = 0; p < 13; ++p) { a.ph_lo = p; a.ph_hi = p + 1;
        hipLaunchKernelGGL(yoco_fwd, dim3(grid), dim3(NTHR), LDS_BYTES, stream, a);
        const hipError_t le = hipPeekAtLastError(); if (le != hipSuccess) { fprintf(stderr, "kernel_launch: launch %d failed: %s\n", p, hipGetErrorName(le)); break; } }
#endif
}
```
